# Optimizing an MI355X kernel written in HIP

```python
import math
import jax
import jax.numpy as jnp
from jax import lax
import numpy as np

D_MODEL = 1024
BATCH = 2
SEQ = 8192
DEPTH = 2

CTX_LEN = 256
GRID_W = 64
N_ADA = 9
D_FF = 2816
MACARON_W = 0.5
NORM_EPS = 1e-6
MIX_W = 512
CONV_K = 3

M_HEADS = 4
M_DQK = 64
M_DV = MIX_W // M_HEADS
M_QK_W = M_HEADS * M_DQK
M_CHUNK = 64

R_DH = 64
R_HEADS = MIX_W // R_DH
DECAY_LORA = 64
AAA_LORA = 64
GATE_LORA = 128
R_GN_EPS = 64e-5

A_HEADS = 4
A_DV = MIX_W // A_HEADS
A_DH = A_DV // 2
Q_BLOCK = 128
ROPE_BASE = 10000.0

IN_SPLITS = (
    ('m_q', M_QK_W), ('m_k', M_QK_W), ('m_v', MIX_W), ('m_o', MIX_W),
    ('m_if', M_HEADS), ('m_ff', M_HEADS), ('m_ib', M_HEADS), ('m_fb', M_HEADS),
    ('r_r', MIX_W), ('r_k', MIX_W), ('r_v', MIX_W),
    ('r_wf', DECAY_LORA), ('r_wb', DECAY_LORA), ('r_af', AAA_LORA), ('r_ab', AAA_LORA), ('r_g', GATE_LORA),
    ('a_q', 2 * A_HEADS * A_DH), ('a_k', 2 * A_HEADS * A_DH), ('a_v', MIX_W),
    ('g_m', D_MODEL), ('g_r', D_MODEL), ('g_a', D_MODEL),
)
D_IN = sum(w for _, w in IN_SPLITS)

kernel_name = 'hybrid_mlstm_rwkv7_diffattn_macaron_prefix'


def _rmsnorm(x, g):
    x32 = x.astype(jnp.float32)
    y = x32 * lax.rsqrt(jnp.mean(x32 * x32, axis=-1, keepdims=True) + NORM_EPS)
    return (y * g.astype(jnp.float32)).astype(x.dtype)


def _modulate(h, shift, scale):
    return h * (1 + scale) + shift


def _ada(cvec, w_ada, b_ada):
    return jnp.split(jax.nn.silu(cvec) @ w_ada + b_ada, N_ADA, axis=-1)


def _split_cols(z):
    cols, off = {}, 0
    for name, width in IN_SPLITS:
        cols[name] = z[..., off:off + width]
        off += width
    return cols


def _dwconv_centred(x, w):
    pad = CONV_K // 2
    return lax.conv_general_dilated(
        x, w[:, None, :].astype(x.dtype), window_strides=(1,), padding=[(pad, pad)],
        dimension_numbers=('NWC', 'WIO', 'NWC'), feature_group_count=x.shape[-1])


def _swiglu_half_step(z, mods, g, w_gu, w_down):
    shift, scale, gate = mods
    h = _modulate(_rmsnorm(z, g), shift, scale)
    a, b = jnp.split(h @ w_gu, 2, axis=-1)
    return z + MACARON_W * gate * ((jax.nn.silu(a) * b) @ w_down)


def _rope2d_tables(n):
    rows = n // GRID_W
    row = jnp.repeat(jnp.arange(rows, dtype=jnp.float32), GRID_W)
    col = jnp.tile(jnp.arange(GRID_W, dtype=jnp.float32), rows)
    half = A_DH // 2
    inv = ROPE_BASE ** (-jnp.arange(0, half, 2, dtype=jnp.float32) / half)
    ang = jnp.concatenate([row[:, None] * inv, col[:, None] * inv], axis=-1)
    return jnp.cos(ang), jnp.sin(ang)


def _rope2d(x, cos, sin):
    x1, x2 = x[..., 0::2], x[..., 1::2]
    c = cos[None, :, None, None, :].astype(x.dtype)
    s = sin[None, :, None, None, :].astype(x.dtype)
    return jnp.stack([x1 * c - x2 * s, x1 * s + x2 * c], axis=-1).reshape(x.shape)


def _mlstm_chunkwise(q, k, v, ig, lf, state):
    bsz, nh, n, _ = q.shape
    nc = n // M_CHUNK
    to_chunks = lambda a: jnp.moveaxis(a.reshape(bsz, nh, nc, M_CHUNK, *a.shape[3:]), 2, 0)
    tril = jnp.tril(jnp.ones((M_CHUNK, M_CHUNK), dtype=bool))

    def step(carry, inp):
        c_st, n_st, m_st = carry
        qb, kb, vb, ib, fb = inp
        bcum = jnp.cumsum(fb, axis=-1)
        dlog = jnp.where(tril, bcum[..., :, None] - bcum[..., None, :] + ib[..., None, :], -jnp.inf)
        inter = bcum + m_st[..., None]
        mt = jnp.maximum(inter, jnp.max(dlog, axis=-1))
        s = jnp.einsum('bhtd,bhsd->bhts', qb, kb) * jnp.exp(dlog - mt[..., None])
        iw = jnp.exp(inter - mt)
        num = jnp.einsum('bhts,bhsv->bhtv', s, vb) + iw[..., None] * jnp.einsum('bhvd,bhtd->bhtv', c_st, qb)
        den = jnp.sum(s, axis=-1) + iw * jnp.einsum('bhd,bhtd->bht', n_st, qb)
        h = num / jnp.maximum(jnp.abs(den), jnp.exp(-mt))[..., None]
        btot = bcum[..., -1]
        wlog = btot[..., None] - bcum + ib
        m_new = jnp.maximum(btot + m_st, jnp.max(wlog, axis=-1))
        ws = jnp.exp(wlog - m_new[..., None])
        dec = jnp.exp(btot + m_st - m_new)
        c_new = dec[..., None, None] * c_st + jnp.einsum('bhs,bhsv,bhsd->bhvd', ws, vb, kb)
        n_new = dec[..., None] * n_st + jnp.einsum('bhs,bhsd->bhd', ws, kb)
        return (c_new, n_new, m_new), h

    state, hs = lax.scan(step, state, (to_chunks(q), to_chunks(k), to_chunks(v), to_chunks(ig), to_chunks(lf)))
    return jnp.moveaxis(hs, 0, 2).reshape(bsz, nh, n, -1), state


def _mlstm_mixer(pc, pl, conv_w, gate_bias, out_norm):
    f32 = jnp.float32

    def prep(p):
        qk = jax.nn.silu(_dwconv_centred(jnp.concatenate([p['m_q'], p['m_k']], axis=-1), conv_w)).astype(f32)
        bsz, n, _ = qk.shape
        heads = lambda a, d: a.reshape(bsz, n, M_HEADS, d).transpose(0, 2, 1, 3)
        q = heads(qk[..., :M_QK_W], M_DQK)
        k = heads(qk[..., M_QK_W:], M_DQK) * (M_DQK ** -0.5)
        v = heads(p['m_v'].astype(f32), M_DV)
        gates = [p[name].astype(f32).transpose(0, 2, 1) + gate_bias[j].astype(f32)[:, None]
                 for j, name in enumerate(('m_if', 'm_ff', 'm_ib', 'm_fb'))]
        return q, k, v, gates

    qc, kc, vc, gc = prep(pc)
    ql, kl, vl, gl = prep(pl)
    bsz = ql.shape[0]
    outs = []
    for d in range(2):
        flip = (lambda a: jnp.flip(a, axis=2)) if d == 1 else (lambda a: a)
        state = (jnp.zeros((bsz, M_HEADS, M_DV, M_DQK), f32), jnp.zeros((bsz, M_HEADS, M_DQK), f32),
                 jnp.zeros((bsz, M_HEADS), f32))
        hc, state = _mlstm_chunkwise(flip(qc), flip(kc), flip(vc), flip(gc[2 * d]),
                                     flip(jax.nn.log_sigmoid(gc[2 * d + 1])), state)
        hl, _ = _mlstm_chunkwise(flip(ql), flip(kl), flip(vl), flip(gl[2 * d]),
                                 flip(jax.nn.log_sigmoid(gl[2 * d + 1])), state)
        outs.append((flip(hc), flip(hl)))

    def post(h, p):
        b, _, n, _ = h.shape
        h = _rmsnorm(h.transpose(0, 2, 1, 3), out_norm.reshape(M_HEADS, M_DV)).reshape(b, n, MIX_W)
        return (h * jax.nn.sigmoid(p['m_o'].astype(f32))).astype(p['m_o'].dtype)

    return post(outs[0][0] + outs[1][0], pc), post(outs[0][1] + outs[1][1], pl)


def _rwkv7_scan(r, w, k, v, kk, a, state, reverse):
    tm = lambda t: jnp.moveaxis(t, 1, 0)

    def step(s, inp):
        rt, wt, kt, vt, kkt, at = inp
        sa = jnp.einsum('bhvk,bhk->bhv', s, -kkt)
        s = s * wt[:, :, None, :] + sa[..., None] * (kkt * at)[:, :, None, :] + vt[..., None] * kt[:, :, None, :]
        return s, jnp.einsum('bhvk,bhk->bhv', s, rt)

    state, ys = lax.scan(step, state, (tm(r), tm(w), tm(k), tm(v), tm(kk), tm(a)), reverse=reverse)
    return jnp.moveaxis(ys, 0, 1), state


def _rwkv7_mixer(pc, pl, conv_w, w0, w2, a0, a2, g2, k_k, k_a, r_k, ln_w, ln_b):
    f32 = jnp.float32

    def prep(p):
        rkv = _dwconv_centred(jnp.concatenate([p['r_r'], p['r_k'], p['r_v']], axis=-1), conv_w).astype(f32)
        bsz, n, _ = rkv.shape
        heads = lambda t: t.reshape(bsz, n, R_HEADS, R_DH)
        r, k, v = rkv[..., :MIX_W], rkv[..., MIX_W:2 * MIX_W], rkv[..., 2 * MIX_W:]
        kk = heads(k * k_k.astype(f32))
        kk = kk / jnp.maximum(jnp.sqrt(jnp.sum(kk * kk, axis=-1, keepdims=True)), 1e-12)
        per_dir = []
        for d, (wl, al) in enumerate((('r_wf', 'r_af'), ('r_wb', 'r_ab'))):
            w_raw = w0[d].astype(f32) + jnp.tanh(p[wl].astype(f32)) @ w2[d].astype(f32)
            decay = jnp.exp(-jnp.exp(-jax.nn.softplus(-w_raw) - 0.5))
            a = jax.nn.sigmoid(a0[d].astype(f32) + p[al].astype(f32) @ a2[d].astype(f32))
            k_dir = k * (1 + (a - 1) * k_a.astype(f32))
            per_dir.append((heads(decay), heads(k_dir), heads(a)))
        return heads(r), heads(k), heads(v), kk, per_dir

    rc, kc, vc, kkc, dc = prep(pc)
    rl, kl, vl, kkl, dl = prep(pl)
    bsz = rl.shape[0]
    y_ctx, y_lat = [], []
    for d in range(2):
        s0 = jnp.zeros((bsz, R_HEADS, R_DH, R_DH), f32)
        wc, kdc, ac = dc[d]
        wlt, kdl, alt = dl[d]
        yc_d, s_ctx = _rwkv7_scan(rc, wc, kdc, vc, kkc, ac, s0, reverse=(d == 1))
        yl_d, _ = _rwkv7_scan(rl, wlt, kdl, vl, kkl, alt, s_ctx, reverse=(d == 1))
        y_ctx.append(yc_d)
        y_lat.append(yl_d)

    def post(y, r, k, v, p):
        b, n = y.shape[:2]
        mu = jnp.mean(y, axis=-1, keepdims=True)
        var = jnp.mean(jnp.square(y - mu), axis=-1, keepdims=True)
        yn = ((y - mu) * lax.rsqrt(var + R_GN_EPS)).reshape(b, n, MIX_W) * ln_w.astype(f32) + ln_b.astype(f32)
        bonus = jnp.sum(r * k * r_k.astype(f32).reshape(R_HEADS, R_DH), axis=-1, keepdims=True) * v
        g = jax.nn.sigmoid(p['r_g'].astype(f32)) @ g2.astype(f32)
        return ((yn + bonus.reshape(b, n, MIX_W)) * g).astype(p['r_g'].dtype)

    return post(y_ctx[0] + y_ctx[1], rc, kc, vc, pc), post(y_lat[0] + y_lat[1], rl, kl, vl, pl)


def _lambda_init(layer):
    return 0.8 - 0.6 * math.exp(-0.3 * layer)


def _diff_attention(pc, pl, qk_norm, lam_p, subln, lam_init, cos, sin):
    f32 = jnp.float32

    def heads(p):
        b, n, _ = p['a_q'].shape
        q = _rmsnorm(p['a_q'].reshape(b, n, A_HEADS, 2, A_DH), qk_norm[0]) * (A_DH ** -0.5)
        k = _rmsnorm(p['a_k'].reshape(b, n, A_HEADS, 2, A_DH), qk_norm[1])
        return q, k, p['a_v'].reshape(b, n, A_HEADS, A_DV)

    qc, kc, vc = heads(pc)
    ql, kl, vl = heads(pl)
    ql = _rope2d(ql, cos, sin)
    kl = _rope2d(kl, cos, sin)
    lp = lam_p.astype(f32)
    lam = jnp.exp(jnp.sum(lp[0] * lp[1])) - jnp.exp(jnp.sum(lp[2] * lp[3])) + lam_init

    def attend(q, k, v):
        s = jnp.einsum('bqhmd,bkhmd->bhmqk', q, k).astype(f32)
        pr = jax.nn.softmax(s, axis=-1)
        amap = pr[:, :, 0] - lam * pr[:, :, 1]
        return jnp.einsum('bhqk,bkhv->bqhv', amap.astype(v.dtype), v)

    yc = attend(qc, kc, vc)
    k_all = jnp.concatenate([kc, kl], axis=1)
    v_all = jnp.concatenate([vc, vl], axis=1)
    b, n = ql.shape[:2]
    nb = n // Q_BLOCK
    qb = jnp.moveaxis(ql.reshape(b, nb, Q_BLOCK, A_HEADS, 2, A_DH), 1, 0)
    yl = lax.map(lambda q: attend(q, k_all, v_all), qb)
    yl = jnp.moveaxis(yl, 0, 1).reshape(b, n, A_HEADS, A_DV)
    post = lambda y: (_rmsnorm(y, subln) * (1 - lam_init)).reshape(y.shape[0], y.shape[1], MIX_W)
    return post(yc), post(yl)


def _merge(p, ym, yr, ya, w_branch, w_o):
    z = (jax.nn.sigmoid(p['g_m']) * (ym @ w_branch[0])
         + jax.nn.sigmoid(p['g_r']) * (yr @ w_branch[1])
         + jax.nn.sigmoid(p['g_a']) * (ya @ w_branch[2]))
    return z @ w_o


def setup_inputs(seed: int = 0) -> dict:
    key = jax.random.key(seed)
    ks = jax.random.split(key, 34)
    L, D = DEPTH, D_MODEL

    def nrm(i, shape, scale):
        return jax.random.normal(ks[i], shape, jnp.float32) * scale

    def uni(i, shape):
        return jax.random.uniform(ks[i], shape, jnp.float32)

    m_gate_bias = jnp.stack([nrm(13, (L, M_HEADS), 0.1), 3.0 + 3.0 * uni(14, (L, M_HEADS)),
                             nrm(15, (L, M_HEADS), 0.1), 3.0 + 3.0 * uni(16, (L, M_HEADS))], axis=1)
    return {
        'x': nrm(0, (BATCH, SEQ, D), 1.0),
        'c': nrm(1, (BATCH, D), 1.0),
        'ctx': nrm(2, (BATCH, CTX_LEN, D), 1.0),
        'c_ctx': nrm(3, (D,), 1.0),
        'w_ada': nrm(4, (L, D, N_ADA * D), 0.5 * D ** -0.5),
        'b_ada': nrm(5, (L, N_ADA * D), 0.01),
        'norm_g': 1.0 + nrm(6, (L, 3, D), 0.02),
        'ffn1_w_gu': nrm(7, (L, D, 2 * D_FF), D ** -0.5),
        'ffn1_w_down': nrm(8, (L, D_FF, D), D_FF ** -0.5),
        'ffn2_w_gu': nrm(9, (L, D, 2 * D_FF), D ** -0.5),
        'ffn2_w_down': nrm(10, (L, D_FF, D), D_FF ** -0.5),
        'w_in': nrm(11, (L, D, D_IN), D ** -0.5),
        'm_conv': nrm(12, (L, CONV_K, 2 * M_QK_W), CONV_K ** -0.5),
        'm_gate_bias': m_gate_bias,
        'm_out_norm': 1.0 + nrm(17, (L, MIX_W), 0.02),
        'r_conv': nrm(18, (L, CONV_K, 3 * MIX_W), CONV_K ** -0.5),
        'r_w0': -6.0 + 5.0 * uni(19, (L, 2, MIX_W)),
        'r_w2': nrm(20, (L, 2, DECAY_LORA, MIX_W), 0.5 * DECAY_LORA ** -0.5),
        'r_a0': nrm(21, (L, 2, MIX_W), 0.1),
        'r_a2': nrm(22, (L, 2, AAA_LORA, MIX_W), 0.5 * AAA_LORA ** -0.5),
        'r_g2': nrm(23, (L, GATE_LORA, MIX_W), GATE_LORA ** -0.5),
        'r_kk': 0.85 + nrm(24, (L, MIX_W), 0.02),
        'r_ka': 1.0 + nrm(25, (L, MIX_W), 0.02),
        'r_rk': nrm(26, (L, MIX_W), 0.1),
        'r_ln_w': 1.0 + nrm(27, (L, MIX_W), 0.02),
        'r_ln_b': nrm(28, (L, MIX_W), 0.01),
        'a_qk_norm': 1.0 + nrm(29, (L, 2, A_DH), 0.02),
        'a_lambda': nrm(30, (L, 4, A_DH), 0.1),
        'a_subln': 1.0 + nrm(31, (L, A_DV), 0.02),
        'w_branch': nrm(32, (L, 3, MIX_W, D), MIX_W ** -0.5),
        'w_o': nrm(33, (L, D, D), D ** -0.5),
    }


def reference(x, c, ctx, c_ctx, w_ada, b_ada, norm_g, ffn1_w_gu, ffn1_w_down, ffn2_w_gu, ffn2_w_down,
              w_in, m_conv, m_gate_bias, m_out_norm, r_conv, r_w0, r_w2, r_a0, r_a2, r_g2, r_kk, r_ka,
              r_rk, r_ln_w, r_ln_b, a_qk_norm, a_lambda, a_subln, w_branch, w_o):
    cos, sin = _rope2d_tables(x.shape[1])
    xc = ctx
    for li in range(DEPTH):
        last = li == DEPTH - 1
        mod_l = [m[:, None, :] for m in _ada(c, w_ada[li], b_ada[li])]
        mod_c = _ada(c_ctx, w_ada[li], b_ada[li])
        x = _swiglu_half_step(x, mod_l[0:3], norm_g[li, 0], ffn1_w_gu[li], ffn1_w_down[li])
        xc = _swiglu_half_step(xc, mod_c[0:3], norm_g[li, 0], ffn1_w_gu[li], ffn1_w_down[li])
        hl = _modulate(_rmsnorm(x, norm_g[li, 1]), mod_l[3], mod_l[4])
        hc = _modulate(_rmsnorm(xc, norm_g[li, 1]), mod_c[3], mod_c[4])
        pl = _split_cols(hl @ w_in[li])
        pc = _split_cols(hc @ w_in[li])
        ym_c, ym_l = _mlstm_mixer(pc, pl, m_conv[li], m_gate_bias[li], m_out_norm[li])
        yr_c, yr_l = _rwkv7_mixer(pc, pl, r_conv[li], r_w0[li], r_w2[li], r_a0[li], r_a2[li], r_g2[li],
                                  r_kk[li], r_ka[li], r_rk[li], r_ln_w[li], r_ln_b[li])
        ya_c, ya_l = _diff_attention(pc, pl, a_qk_norm[li], a_lambda[li], a_subln[li], _lambda_init(li), cos, sin)
        x = x + mod_l[5] * _merge(pl, ym_l, yr_l, ya_l, w_branch[li], w_o[li])
        x = _swiglu_half_step(x, mod_l[6:9], norm_g[li, 2], ffn2_w_gu[li], ffn2_w_down[li])
        if not last:
            xc = xc + mod_c[5] * _merge(pc, ym_c, yr_c, ya_c, w_branch[li], w_o[li])
            xc = _swiglu_half_step(xc, mod_c[6:9], norm_g[li, 2], ffn2_w_gu[li], ffn2_w_down[li])
    return x
```

```cpp
#include <hip/hip_runtime.h>
#include <hip/hip_cooperative_groups.h>
#include <cstdio>
#include <cstdint>
namespace cg = cooperative_groups;

#define LAS __attribute__((address_space(3)))
#define DI __device__ __forceinline__
typedef unsigned short bf16_t;
typedef short bf16x8 __attribute__((ext_vector_type(8)));
typedef float f32x4 __attribute__((ext_vector_type(4)));
typedef float f32x16 __attribute__((ext_vector_type(16)));
typedef float f32x2 __attribute__((ext_vector_type(2)));
typedef unsigned u32x4 __attribute__((ext_vector_type(4)));
typedef unsigned u32x2 __attribute__((ext_vector_type(2)));
typedef __bf16 bf16x2_t __attribute__((ext_vector_type(2)));

constexpr int DM = 1024, NLAT = 16384, NTOK = 16896, SEQL = 8192, CTXL = 256, DFF = 2816, DIN = 8080, ZW = 5008, ZWP = 5120;
constexpr int ZC_MQ = 0, ZC_MK = 256, ZC_MV = 512, ZC_MO = 1024, ZC_MG = 1536, ZC_RR = 1552, ZC_RK = 2064, ZC_RV = 2576, ZC_RL = 3088, ZC_AQ = 3472, ZC_AK = 3984, ZC_AV = 4496;
constexpr int NCHK = 132;
constexpr size_t WS_MODP = 0;
constexpr size_t WS_MODS = WS_MODP + (size_t)2 * 16 * 3 * 9216 * 4;
constexpr size_t WS_ROPE = WS_MODS + (size_t)2 * 3 * 9216 * 4;
constexpr size_t WS_XC   = WS_ROPE + (size_t)8192 * 64 * 4;
constexpr size_t WS_INVN = WS_XC + (size_t)512 * 1024 * 4;
constexpr size_t WS_MSC  = WS_INVN + (size_t)NTOK * 8 * 4;
constexpr size_t WS_MN   = WS_MSC + (size_t)2112 * 4 * 4;
constexpr size_t WS_WT   = WS_MN + (size_t)2112 * 64 * 4;
constexpr size_t WS_Z    = WS_WT + (size_t)25165824;
constexpr size_t WS_RWA  = WS_Z + (size_t)NTOK * ZW * 2;
constexpr size_t WS_RG   = WS_RWA + (size_t)NTOK * 2048 * 2;
constexpr size_t WS_MST  = WS_RG + (size_t)NTOK * 512 * 2;
constexpr size_t WS_YSUM = WS_MST + (size_t)2112 * 8192 * 2;
constexpr size_t WS_END  = WS_YSUM + (size_t)NTOK * 512 * 4;
constexpr size_t WT_GU = 0, WT_DN = (size_t)5632 * 1024;
constexpr size_t WT_IN = 0, WT_G = (size_t)5120 * 1024, WT_P = WT_G + (size_t)3072 * 1024, WT_O = WT_P + (size_t)3 * 1024 * 512, WT_L = WT_O + (size_t)1024 * 1024;
constexpr int LDS_BYTES = 141312;

DI float bf2f(bf16_t b) { return __uint_as_float(((unsigned)b) << 16); }
DI unsigned pk2(float lo, float hi) { f32x2 v = {lo, hi}; bf16x2_t b = __builtin_convertvector(v, bf16x2_t); return __builtin_bit_cast(unsigned, b); }
DI bf16_t f2bf(float f) { return (bf16_t)(pk2(f, 0.f) & 0xffffu); }
DI float lo16(unsigned u) { return __uint_as_float(u << 16); }
DI float hi16(unsigned u) { return __uint_as_float(u & 0xffff0000u); }
DI float sigmoidf_(float x) { return __builtin_amdgcn_rcpf(1.f + __expf(-x)); }
DI float siluf_(float x) { return x * __builtin_amdgcn_rcpf(1.f + __expf(-x)); }
DI float logsigf_(float x) { return x < 0.f ? x - log1pf(expf(x)) : -log1pf(expf(-x)); }
DI float wave_sum(float v) {
#pragma unroll
    for (int o = 1; o < 64; o <<= 1) v += __shfl_xor(v, o);
    return v;
}
DI float wave_max(float v) {
#pragma unroll
    for (int o = 1; o < 64; o <<= 1) v = fmaxf(v, __shfl_xor(v, o));
    return v;
}
DI void unpack8(const u32x4 u, float* f) { f[0] = lo16(u.x); f[1] = hi16(u.x); f[2] = lo16(u.y); f[3] = hi16(u.y); f[4] = lo16(u.z); f[5] = hi16(u.z); f[6] = lo16(u.w); f[7] = hi16(u.w); }
DI u32x4 pack8(const float* f) { u32x4 u; u.x = pk2(f[0], f[1]); u.y = pk2(f[2], f[3]); u.z = pk2(f[4], f[5]); u.w = pk2(f[6], f[7]); return u; }
DI int launder_v(int v) { asm volatile("" : "+v"(v)); return v; }
DI int launder_s(int v) { asm volatile("" : "+s"(v)); return v; }
DI int lane_id_() { return (int)__builtin_amdgcn_mbcnt_hi(~0u, __builtin_amdgcn_mbcnt_lo(~0u, 0u)); }
namespace pg8 {
#define PG8_LAS __attribute__((address_space(3)))
typedef unsigned short bf16_t;
typedef short bf16x8 __attribute__((ext_vector_type(8)));
typedef float f32x4 __attribute__((ext_vector_type(4)));
typedef unsigned u32x4 __attribute__((ext_vector_type(4)));
constexpr int BM = 256, BK = 64, HALF = 128, HTB = HALF * BK * 2  , STAGE_BYTES = 8 * HTB, NXCD = 8, WGM = 8;

__host__ __device__ __forceinline__ int lds_byte(int r, int c) { const int st = (r >> 4) * 2 + (c >> 5), rr = r & 15, cc = c & 31, ob = rr * 64 + cc * 2; return st * 1024 + (ob ^ (((ob >> 9) & 1) << 5)); }
__host__ __device__ __forceinline__ void stage_rc(int b, int& R, int& C) { const int st = b / 1024, sb = b % 1024, swz = sb ^ (((sb >> 9) & 1) << 5); R = (st >> 1) * 16 + swz / 64; C = (st & 1) * 32 + (swz % 64) / 2; }
__host__ __device__ __forceinline__ int perm32(int rho) { const int n = rho >> 4, i = rho & 15; return 8 * (i >> 2) + 4 * n + (i & 3); }

struct Unit { int pm, pn; };
struct Gemm { const bf16_t* A; const bf16_t* Bt; int M, N, K, lda, tid0; };

struct StaticOrder {
    int nM, nN, nwg, G, c;
    __host__ __device__ void init(int M, int N, int G_, int c_) { nM = M / BM; nN = N / BM; nwg = nM * nN; G = G_; c = c_; }
    __host__ __device__ bool next(int i, Unit& u) const {
        const long L = (long)i * G + c; if (L >= nwg) return false;
        int wgid = (int)L; { const int q = nwg / NXCD, r = nwg % NXCD, xcd = wgid % NXCD, off = wgid / NXCD; wgid = (xcd < r ? xcd * (q + 1) : r * (q + 1) + (xcd - r) * q) + off; }
        const int nig = WGM * nN, gid = wgid / nig, fm = gid * WGM, gsz = (nM - fm) < WGM ? (nM - fm) : WGM;
        u.pm = fm + ((wgid % nig) % gsz); u.pn = (wgid % nig) / gsz; return true;
    }
    __device__ __forceinline__ void a_ready(const Unit&) const {}
    __device__ __forceinline__ void done(const Unit&) const {}
};


template <class Epi, class Sched, bool ALIGN_EPI = false, bool SP2 = false>
__device__ __forceinline__ void gemm_phase(PG8_LAS unsigned char* lds, const Gemm g, const Sched& S, const Epi& E) {
    int tid = g.tid0; asm volatile("" : "+v"(tid)); const int wid = __builtin_amdgcn_readfirstlane(tid >> 6), lane = tid & 63, wr = wid >> 2, wc = wid & 3, fr = lane & 15, fq = lane >> 4;
    const int K = g.K, nt = K / BK;
    unsigned voffA[2], voffB[2];
#pragma unroll
    for (int i = 0; i < 2; ++i) { int R, C; stage_rc(tid * 16 + i * 8192, R, C); const int Rb = Epi::PERM ? ((R & ~31) + perm32(R & 31)) : R;
        voffA[i] = (unsigned)(R * g.lda + C) * 2u; voffB[i] = (unsigned)(Rb * K + C) * 2u; }
    const size_t kstep = (size_t)(BK * 2);
    const size_t hstepB = (size_t)HALF * K * 2, hstepA = (size_t)HALF * g.lda * 2;
    const size_t tstepA = 2 * hstepA, tstepB = 2 * hstepB;
    const unsigned ldsw = (unsigned)wid * 1024u;
    const int aoff = lds_byte(wr * 64 + fr, fq * 8), boff = lds_byte(wc * 32 + fr, fq * 8);
#define PG8_SA(b, h) (((b) * 2 + (h)) * HTB)
#define PG8_SB(b, h) ((4 + (b) * 2 + (h)) * HTB)
#define PG8_STAGE(bufoff, gbase, voff) do { _Pragma("unroll") for (int _i = 0; _i < 2; ++_i) \
        __builtin_amdgcn_global_load_lds((const unsigned*)((const char*)(gbase) + (voff)[_i]), (PG8_LAS unsigned*)(lds + (bufoff) + ldsw + _i * 8192), 16, 0, 0); } while (0)
#define PG8_LDA(dst, b, h) do { _Pragma("unroll") for (int m = 0; m < 4; ++m) _Pragma("unroll") for (int k = 0; k < 2; ++k) dst[m][k] = *(const PG8_LAS bf16x8*)(lds + PG8_SA(b, h) + aoff + m * 2048 + k * 1024); } while (0)
#define PG8_LDB(dst, b, h) do { _Pragma("unroll") for (int n = 0; n < 2; ++n) _Pragma("unroll") for (int k = 0; k < 2; ++k) dst[n][k] = *(const PG8_LAS bf16x8*)(lds + PG8_SB(b, h) + boff + n * 2048 + k * 1024); } while (0)
#define PG8_MMA(ai, bj, At, Bt) do { __builtin_amdgcn_s_setprio(1); _Pragma("unroll") for (int m = 0; m < 4; ++m) _Pragma("unroll") for (int n = 0; n < 2; ++n) _Pragma("unroll") for (int k = 0; k < 2; ++k) \
        acc[ai][bj][m][n] = __builtin_amdgcn_mfma_f32_16x16x32_bf16(Bt[n][k], At[m][k], acc[ai][bj][m][n], 0, 0, 0); __builtin_amdgcn_s_setprio(0); } while (0)
#define PG8_WAIT_V(n) asm volatile("s_waitcnt vmcnt(" #n ")" ::: "memory")
#define PG8_WAIT_L(n) asm volatile("s_waitcnt lgkmcnt(" #n ")" ::: "memory")
#define PG8_BAR __builtin_amdgcn_s_barrier()
#define PG8_SCHED __builtin_amdgcn_sched_barrier(0)
    Unit cur, nxt; int ui = 0;
    if (!S.next(0, cur)) return;
    f32x4 acc[2][2][4][2];
#pragma unroll
    for (int a = 0; a < 2; ++a)
#pragma unroll
        for (int b = 0; b < 2; ++b)
#pragma unroll
            for (int m = 0; m < 4; ++m)
#pragma unroll
                for (int n = 0; n < 2; ++n) acc[a][b][m][n] = (f32x4){0.f, 0.f, 0.f, 0.f};
    bf16x8 At[4][2], B0[2][2], B1[2][2];
    const char* cA = (const char*)g.A + (size_t)cur.pm * tstepA; const char* cB = (const char*)g.Bt + (size_t)cur.pn * tstepB;
    S.a_ready(cur);
    if constexpr (SP2) {
        PG8_STAGE(PG8_SB(0, 0), cB, voffB); PG8_STAGE(PG8_SB(0, 1), cB + hstepB, voffB); PG8_STAGE(PG8_SA(0, 0), cA, voffA); PG8_STAGE(PG8_SA(0, 1), cA + hstepA, voffA);
        if (wr == 1) PG8_BAR;
        PG8_WAIT_V(2); PG8_BAR;
        PG8_STAGE(PG8_SB(1, 0), cB + kstep, voffB); PG8_STAGE(PG8_SA(1, 0), cA + kstep, voffA); PG8_STAGE(PG8_SB(1, 1), cB + hstepB + kstep, voffB);
        PG8_WAIT_V(6); PG8_BAR;
    } else {
        PG8_STAGE(PG8_SB(0, 0), cB, voffB); PG8_STAGE(PG8_SA(0, 0), cA, voffA); PG8_STAGE(PG8_SB(0, 1), cB + hstepB, voffB); PG8_STAGE(PG8_SA(0, 1), cA + hstepA, voffA);
        if (wr == 1) PG8_BAR;
        PG8_WAIT_V(4); PG8_BAR;
        PG8_STAGE(PG8_SB(1, 0), cB + kstep, voffB); PG8_STAGE(PG8_SA(1, 0), cA + kstep, voffA); PG8_STAGE(PG8_SB(1, 1), cB + hstepB + kstep, voffB);
        PG8_WAIT_V(6); PG8_BAR;
    }
    for (;;) {
        const bool has_next = S.next(ui + 1, nxt);
        const char* nA = has_next ? (const char*)g.A + (size_t)nxt.pm * tstepA : cA; const char* nB = has_next ? (const char*)g.Bt + (size_t)nxt.pn * tstepB : cB;
        for (int t = 0; t < nt; t += 2) {
            const bool last = (t == nt - 2);
            const char* a1 = cA + (size_t)(t + 1) * kstep;
            const char* a2 = last ? nA : cA + (size_t)(t + 2) * kstep; const char* b2 = last ? nB : cB + (size_t)(t + 2) * kstep;
            const char* a3 = a2 + kstep; const char* b3 = b2 + kstep;
            if (last && has_next) S.a_ready(nxt);
            if constexpr (SP2) {
            PG8_LDB(B0, 0, 0); PG8_LDB(B1, 0, 1); PG8_SCHED; PG8_LDA(At, 0, 0); PG8_STAGE(PG8_SA(1, 1), a1 + hstepA, voffA);
            PG8_WAIT_V(8); PG8_WAIT_L(0); PG8_BAR; PG8_MMA(0, 0, At, B0); PG8_MMA(0, 1, At, B1); PG8_BAR; PG8_SCHED;
            PG8_LDA(At, 0, 1); PG8_STAGE(PG8_SB(0, 0), b2, voffB); PG8_STAGE(PG8_SB(0, 1), b2 + hstepB, voffB); PG8_STAGE(PG8_SA(0, 0), a2, voffA);
            PG8_WAIT_V(8); PG8_WAIT_L(0); PG8_BAR; PG8_MMA(1, 0, At, B0); PG8_MMA(1, 1, At, B1); PG8_BAR; PG8_SCHED;
            PG8_LDB(B0, 1, 0); PG8_LDB(B1, 1, 1); PG8_SCHED; PG8_LDA(At, 1, 0); PG8_STAGE(PG8_SA(0, 1), a2 + hstepA, voffA);
            PG8_WAIT_V(8); PG8_WAIT_L(0); PG8_BAR; PG8_MMA(0, 0, At, B0); PG8_MMA(0, 1, At, B1); PG8_BAR; PG8_SCHED;
            PG8_LDA(At, 1, 1); PG8_STAGE(PG8_SB(1, 0), b3, voffB); PG8_STAGE(PG8_SB(1, 1), b3 + hstepB, voffB); PG8_STAGE(PG8_SA(1, 0), a3, voffA);
            PG8_WAIT_V(8); PG8_WAIT_L(0); PG8_BAR; PG8_MMA(1, 0, At, B0); PG8_MMA(1, 1, At, B1); PG8_BAR; PG8_SCHED;
            } else {
            PG8_LDB(B0, 0, 0); PG8_SCHED; PG8_LDA(At, 0, 0); PG8_STAGE(PG8_SA(1, 1), a1 + hstepA, voffA);
            PG8_WAIT_L(8); PG8_BAR; PG8_WAIT_L(0); PG8_MMA(0, 0, At, B0); PG8_BAR; PG8_SCHED;
            PG8_LDB(B1, 0, 1); PG8_STAGE(PG8_SB(0, 0), b2, voffB);
            PG8_BAR; PG8_WAIT_L(0); PG8_MMA(0, 1, At, B1); PG8_BAR;
            PG8_LDA(At, 0, 1); PG8_STAGE(PG8_SA(0, 0), a2, voffA);
            PG8_BAR; PG8_WAIT_L(0); PG8_MMA(1, 0, At, B0); PG8_BAR; PG8_SCHED;
            PG8_STAGE(PG8_SB(0, 1), b2 + hstepB, voffB);
            PG8_WAIT_V(6); PG8_BAR; PG8_MMA(1, 1, At, B1); PG8_BAR;
            PG8_LDB(B0, 1, 0); PG8_SCHED; PG8_LDA(At, 1, 0); PG8_STAGE(PG8_SA(0, 1), a2 + hstepA, voffA);
            PG8_WAIT_L(8); PG8_BAR; PG8_WAIT_L(0); PG8_MMA(0, 0, At, B0); PG8_BAR; PG8_SCHED;
            PG8_LDB(B1, 1, 1); PG8_STAGE(PG8_SB(1, 0), b3, voffB);
            PG8_BAR; PG8_WAIT_L(0); PG8_MMA(0, 1, At, B1); PG8_BAR;
            PG8_LDA(At, 1, 1); PG8_STAGE(PG8_SA(1, 0), a3, voffA);
            PG8_BAR; PG8_WAIT_L(0); PG8_MMA(1, 0, At, B0); PG8_BAR; PG8_SCHED;
            PG8_STAGE(PG8_SB(1, 1), b3 + hstepB, voffB);
            PG8_WAIT_V(6); PG8_BAR; PG8_MMA(1, 1, At, B1); PG8_BAR;
            }
        }
        if constexpr (ALIGN_EPI) { if (wr == 0) PG8_BAR; }
        if constexpr (!Epi::AFTER_DRAIN) { E(acc, cur, wr, wc, fr, fq); S.done(cur); }
        if (!has_next) break;
#pragma unroll
        for (int a = 0; a < 2; ++a)
#pragma unroll
            for (int b = 0; b < 2; ++b)
#pragma unroll
                for (int m = 0; m < 4; ++m)
#pragma unroll
                    for (int n = 0; n < 2; ++n) acc[a][b][m][n] = (f32x4){0.f, 0.f, 0.f, 0.f};
        cur = nxt; cA = nA; cB = nB; ++ui;
        if constexpr (ALIGN_EPI) { if (wr == 1) PG8_BAR; }
    }
    PG8_WAIT_V(0);
    if constexpr (!ALIGN_EPI) { if (wr == 0) PG8_BAR; }
    PG8_BAR;
    if constexpr (Epi::AFTER_DRAIN) { E.fused(acc, cur, wr, wc, fr, fq, lds, wid, lane); S.done(cur); }
#undef PG8_SA
#undef PG8_SB
#undef PG8_STAGE
#undef PG8_LDA
#undef PG8_LDB
#undef PG8_MMA
#undef PG8_WAIT_V
#undef PG8_WAIT_L
#undef PG8_BAR
#undef PG8_SCHED
}
}

typedef const pg8::f32x4 (&AccRef)[2][2][4][2];
struct EpiSwiglu {
    static constexpr bool PERM = true, AFTER_DRAIN = false;
    bf16_t* H;
    DI void operator()(AccRef acc, const pg8::Unit& u, int wr, int wc, int fr, int fq) const {
        const int row0 = u.pm * 256 + wr * 64 + fr, col = u.pn * 128 + wc * 32 + 8 * fq;
#pragma unroll
        for (int ai = 0; ai < 2; ++ai)
#pragma unroll
            for (int m = 0; m < 4; ++m) {
                const int row = row0 + ai * 128 + m * 16; float f[8];
#pragma unroll
                for (int n = 0; n < 2; ++n)
#pragma unroll
                    for (int e = 0; e < 4; ++e) f[n * 4 + e] = siluf_(acc[ai][0][m][n][e]) * acc[ai][1][m][n][e];
                *(u32x4*)(H + (size_t)row * DFF + col) = pack8(f);
            }
    }
};
struct EpiResid {
    static constexpr bool PERM = true, AFTER_DRAIN = false;
    float* xlat; float* xc; const float* gate; float coef;
    DI void operator()(AccRef acc, const pg8::Unit& u, int wr, int wc, int fr, int fq) const {
        const int r0 = u.pm * 256; const int vec = r0 < NLAT ? (r0 >> 13) : 2;
        const float* gp = gate + vec * 9216;
        float* base = r0 < NLAT ? xlat + (size_t)r0 * DM : xc + (size_t)(r0 - NLAT) * DM;
#pragma unroll
        for (int bj = 0; bj < 2; ++bj) {
            const int col = u.pn * 256 + bj * 128 + wc * 32 + 8 * fq;
            const f32x4 g0 = *(const f32x4*)(gp + col) * coef, g1 = *(const f32x4*)(gp + col + 4) * coef;
#pragma unroll
            for (int ai = 0; ai < 2; ++ai)
#pragma unroll
                for (int m = 0; m < 4; ++m) {
                    float* xp = base + (size_t)(wr * 64 + fr + ai * 128 + m * 16) * DM + col;
                    f32x4 x0 = *(f32x4*)xp, x1 = *(f32x4*)(xp + 4);
                    x0 += g0 * acc[ai][bj][m][0]; x1 += g1 * acc[ai][bj][m][1];
                    *(f32x4*)xp = x0; *(f32x4*)(xp + 4) = x1;
                }
        }
    }
};
struct EpiWin {
    static constexpr bool PERM = true, AFTER_DRAIN = false;
    bf16_t* Z;
    DI void operator()(AccRef acc, const pg8::Unit& u, int wr, int wc, int fr, int fq) const {
        const int row0 = u.pm * 256 + wr * 64 + fr;
#pragma unroll
        for (int bj = 0; bj < 2; ++bj) {
            const int col = u.pn * 256 + bj * 128 + wc * 32 + 8 * fq;
            if (col >= ZW) continue;
            const int mode = (col >= ZC_RL && col < ZC_RL + 128) ? 1 : ((col >= ZC_RL + 256 && col < ZC_AQ) ? 2 : 0);
#pragma unroll
            for (int ai = 0; ai < 2; ++ai)
#pragma unroll
                for (int m = 0; m < 4; ++m) {
                    const int row = row0 + ai * 128 + m * 16; float f[8];
#pragma unroll
                    for (int n = 0; n < 2; ++n)
#pragma unroll
                        for (int e = 0; e < 4; ++e) { float v = acc[ai][bj][m][n][e]; if (mode == 1) v = 1.f - 2.f * __builtin_amdgcn_rcpf(1.f + __expf(2.f * v)); else if (mode == 2) v = sigmoidf_(v); f[n * 4 + e] = v; }
                    *(u32x4*)(Z + (size_t)row * ZW + col) = pack8(f);
                }
        }
    }
};
struct EpiLora {
    static constexpr bool PERM = true, AFTER_DRAIN = false;
    bf16_t* RWA; bf16_t* RG; const float* w0; const float* a0;
    DI void operator()(AccRef acc, const pg8::Unit& u, int wr, int wc, int fr, int fq) const {
        const int row0 = u.pm * 256 + wr * 64 + fr;
#pragma unroll
        for (int bj = 0; bj < 2; ++bj) {
            const int col = u.pn * 256 + bj * 128 + wc * 32 + 8 * fq; const int seg = col >> 9, cc = col & 511;
            const float* bp = seg < 2 ? w0 + seg * 512 + cc : a0 + (seg & 1) * 512 + cc;
#pragma unroll
            for (int ai = 0; ai < 2; ++ai)
#pragma unroll
                for (int m = 0; m < 4; ++m) {
                    const int row = row0 + ai * 128 + m * 16; float f[8];
#pragma unroll
                    for (int n = 0; n < 2; ++n)
#pragma unroll
                        for (int e = 0; e < 4; ++e) {
                            float v = acc[ai][bj][m][n][e] + (seg < 4 ? bp[n * 4 + e] : 0.f);
                            if (seg < 2) { const float ee = 0.60653066f * sigmoidf_(v); v = 1.f - __expf(-ee); } else if (seg < 4) v = sigmoidf_(v);
                            f[n * 4 + e] = v;
                        }
                    if (seg < 4) *(u32x4*)(RWA + (size_t)row * 2048 + col) = pack8(f); else *(u32x4*)(RG + (size_t)row * 512 + cc) = pack8(f);
                    __builtin_amdgcn_sched_barrier(0);
                }
        }
    }
};
struct EpiGate {
    static constexpr bool PERM = true, AFTER_DRAIN = false;
    bf16_t* G;
    DI void operator()(AccRef acc, const pg8::Unit& u, int wr, int wc, int fr, int fq) const {
        const int row0 = u.pm * 256 + wr * 64 + fr;
#pragma unroll
        for (int bj = 0; bj < 2; ++bj) {
            const int col = u.pn * 256 + bj * 128 + wc * 32 + 8 * fq;
#pragma unroll
            for (int ai = 0; ai < 2; ++ai)
#pragma unroll
                for (int m = 0; m < 4; ++m) {
                    const int row = row0 + ai * 128 + m * 16; float f[8];
#pragma unroll
                    for (int n = 0; n < 2; ++n)
#pragma unroll
                        for (int e = 0; e < 4; ++e) f[n * 4 + e] = sigmoidf_(acc[ai][bj][m][n][e]);
                    *(u32x4*)(G + (size_t)row * DM + col) = pack8(f);
                }
        }
    }
};
struct EpiBranch {
    static constexpr bool PERM = true, AFTER_DRAIN = false;
    const bf16_t* G; bf16_t* ZZ; int first;
    DI void operator()(AccRef acc, const pg8::Unit& u, int wr, int wc, int fr, int fq) const {
        const int row0 = u.pm * 256 + wr * 64 + fr;
#pragma unroll
        for (int bj = 0; bj < 2; ++bj) {
            const int col = u.pn * 256 + bj * 128 + wc * 32 + 8 * fq;
#pragma unroll
            for (int ai = 0; ai < 2; ++ai)
#pragma unroll
                for (int m = 0; m < 4; ++m) {
                    const size_t off = (size_t)(row0 + ai * 128 + m * 16) * DM + col; float g[8], o[8], f[8];
                    unpack8(*(const u32x4*)(G + off), g);
                    if (first) {
#pragma unroll
                        for (int e = 0; e < 8; ++e) o[e] = 0.f;
                    } else unpack8(*(const u32x4*)(ZZ + off), o);
#pragma unroll
                    for (int n = 0; n < 2; ++n)
#pragma unroll
                        for (int e = 0; e < 4; ++e) f[n * 4 + e] = o[n * 4 + e] + g[n * 4 + e] * acc[ai][bj][m][n][e];
                    *(u32x4*)(ZZ + off) = pack8(f);
                }
        }
    }
};
template <class Epi> DI void run_gemm(const int wv, unsigned char* smem, const bf16_t* A, int lda, const bf16_t* Bt, int M, int N, int K, const Epi& E) {
    pg8::Gemm g; g.A = A; g.Bt = Bt; g.M = M; g.N = N; g.K = launder_s(K); g.lda = launder_s(lda); g.tid0 = wv * 64 + lane_id_();
    pg8::StaticOrder S; S.init(M, N, (int)gridDim.x, launder_s((int)blockIdx.x));
    pg8::gemm_phase<Epi, pg8::StaticOrder, true, true>((PG8_LAS unsigned char*)smem, g, S, E);
    __syncthreads();
}

struct Prm {
    const float *x, *c, *ctx, *cctx, *w_ada, *b_ada, *norm_g, *f1gu, *f1dn, *f2gu, *f2dn, *w_in, *m_conv, *m_gb, *m_on, *r_conv, *r_w0, *r_w2, *r_a0, *r_a2, *r_g2,
        *r_kk, *r_ka, *r_rk, *r_lnw, *r_lnb, *a_qkn, *a_lam, *a_subln, *w_br, *w_o;
    float* out; unsigned char* ws; int wv, pad;
};
#define PH_IDS const int tid_l = launder_v(p.wv * 64 + lane_id_()); const int bid_l = launder_s((int)blockIdx.x); (void)tid_l; (void)bid_l;
#define TID tid_l
#define BID bid_l
#define NBLK ((int)gridDim.x)

DI void ph_modpart(const Prm& p, unsigned char* smem) { PH_IDS
    float* sc = (float*)smem; float* modp = (float*)(p.ws + WS_MODP);
    for (int it = BID; it < 576; it += NBLK) {
        const int l = it / 288, r = it % 288, ks = r / 18, cb = r % 18;
        __syncthreads();
        if (TID < 192) { const int v = TID >> 6, k = ks * 64 + (TID & 63); const float cv = v < 2 ? p.c[v * DM + k] : p.cctx[k]; sc[TID] = siluf_(cv); }
        __syncthreads();
        const int col = cb * 512 + TID; float a0 = 0.f, a1 = 0.f, a2 = 0.f;
        const float* w = p.w_ada + ((size_t)l * DM + ks * 64) * 9216 + col;
#pragma unroll 8
        for (int k = 0; k < 64; ++k) { const float wv = w[(size_t)k * 9216]; a0 += sc[k] * wv; a1 += sc[64 + k] * wv; a2 += sc[128 + k] * wv; }
        float* o = modp + ((size_t)(l * 16 + ks) * 3) * 9216 + col; o[0] = a0; o[9216] = a1; o[2 * 9216] = a2;
    }
    __syncthreads();
}
DI void ph_rope(const Prm& p) { PH_IDS
    float* rope = (float*)(p.ws + WS_ROPE);
    for (int i = BID * 512 + TID; i < SEQL * 32; i += NBLK * 512) {
        const int t = i >> 5, pp = i & 31, j = pp & 15;
        const float inv = powf(10000.f, -(float)j / 16.f); const float pos = (float)(pp < 16 ? (t >> 6) : (t & 63)); const float ang = pos * inv;
        rope[2 * i] = cosf(ang); rope[2 * i + 1] = sinf(ang);
    }
}
DI void ph_modreduce(const Prm& p) { PH_IDS
    const float* modp = (const float*)(p.ws + WS_MODP); float* mods = (float*)(p.ws + WS_MODS);
    for (int i = BID * 512 + TID; i < 2 * 3 * 9216; i += NBLK * 512) {
        const int l = i / 27648, rem = i % 27648, v = rem / 9216, col = rem % 9216;
        float s = p.b_ada[l * 9216 + col];
        for (int ks = 0; ks < 16; ++ks) s += modp[((size_t)(l * 16 + ks) * 3 + v) * 9216 + col];
        mods[i] = s;
    }
}
template <int MODE> DI void conv_weight(const Prm& p, const float* src, int ld, int c0, int K, int ncols, bf16_t* dst, unsigned char* smem) { PH_IDS
    float* t = (float*)smem; const int ntk = K / 64, ntn = (ncols + 63) / 64, tx = TID & 63, ty = TID >> 6;
    for (int it = BID; it < ntk * ntn; it += NBLK) {
        const int kt = it % ntk, nt = it / ntk;
        __syncthreads();
#pragma unroll
        for (int i = 0; i < 8; ++i) { const int k = ty * 8 + i, j = nt * 64 + tx; t[k * 65 + tx] = j < ncols ? src[(size_t)(kt * 64 + k) * ld + c0 + j] : 0.f; }
        __syncthreads();
#pragma unroll
        for (int i = 0; i < 8; ++i) {
            const int n = ty * 8 + i, j = nt * 64 + n;
            if (j < ncols) {
                int drow = j;
                if (MODE == 1) drow = j < DFF ? ((j >> 7) * 256 + (j & 127)) : (((j - DFF) >> 7) * 256 + 128 + ((j - DFF) & 127));
                dst[(size_t)drow * K + kt * 64 + tx] = f2bf(t[tx * 65 + n]);
            }
        }
    }
    __syncthreads();
}
DI void conv_ffn(const Prm& p, int l, int which, unsigned char* smem) {
    bf16_t* wt = (bf16_t*)(p.ws + WS_WT);
    conv_weight<1>(p, (which ? p.f2gu : p.f1gu) + (size_t)l * DM * 2 * DFF, 2 * DFF, 0, DM, 2 * DFF, wt + WT_GU, smem);
    conv_weight<0>(p, (which ? p.f2dn : p.f1dn) + (size_t)l * DFF * DM, DM, 0, DFF, DM, wt + WT_DN, smem);
}
DI void conv_mixer(const Prm& p, int l, unsigned char* smem) { PH_IDS
    bf16_t* wt = (bf16_t*)(p.ws + WS_WT);
    conv_weight<0>(p, p.w_in + (size_t)l * DM * DIN, DIN, 0, DM, ZW, wt + WT_IN, smem);
    conv_weight<0>(p, p.w_in + (size_t)l * DM * DIN, DIN, ZW, DM, 3 * DM, wt + WT_G, smem);
    for (int b = 0; b < 3; ++b) conv_weight<0>(p, p.w_br + (size_t)(l * 3 + b) * 512 * DM, DM, 0, 512, DM, wt + WT_P + (size_t)b * DM * 512, smem);
    conv_weight<0>(p, p.w_o + (size_t)l * DM * DM, DM, 0, DM, DM, wt + WT_O, smem);
    bf16_t* wl = wt + WT_L;
    for (int i = BID * 512 + TID; i < 2560 * 384; i += NBLK * 512) {
        const int n = i / 384, k = i % 384, seg = n >> 9, cc = n & 511; float v = 0.f;
        if (seg < 2) { if ((k >> 6) == seg) v = p.r_w2[((size_t)(l * 2 + seg) * 64 + (k & 63)) * 512 + cc]; }
        else if (seg < 4) { if ((k >> 6) == seg) v = p.r_a2[((size_t)(l * 2 + seg - 2) * 64 + (k & 63)) * 512 + cc]; }
        else { if (k >= 256) v = p.r_g2[((size_t)l * 128 + (k - 256)) * 512 + cc]; }
        wl[i] = f2bf(v);
    }
}
DI void ph_norm(const Prm& p, int l, int which, bool first) { PH_IDS
    const int lane = TID & 63, wid = TID >> 6;
    const float* g = p.norm_g + (l * 3 + which) * DM; const float* mods = (const float*)(p.ws + WS_MODS) + (size_t)l * 27648;
    bf16_t* hb = (bf16_t*)(p.ws + WS_RWA); float* xc = (float*)(p.ws + WS_XC);
    for (int row = BID * 8 + wid; row < NTOK; row += NBLK * 8) {
        const int vec = row < NLAT ? (row >> 13) : 2;
        const float* sh = mods + vec * 9216 + (3 * which) * DM; const float* scl = sh + DM;
        float* xd = row < NLAT ? p.out + (size_t)row * DM : xc + (size_t)(row - NLAT) * DM;
        const float* xr = first ? (row < NLAT ? p.x + (size_t)row * DM : p.ctx + (size_t)(row - NLAT) * DM) : xd;
        f32x4 xv[4]; float ss = 0.f;
#pragma unroll
        for (int i = 0; i < 4; ++i) { xv[i] = *(const f32x4*)(xr + i * 256 + lane * 4); ss += xv[i][0] * xv[i][0] + xv[i][1] * xv[i][1] + xv[i][2] * xv[i][2] + xv[i][3] * xv[i][3]; }
        ss = wave_sum(ss); const float rinv = rsqrtf(ss * (1.f / DM) + 1e-6f);
#pragma unroll
        for (int i = 0; i < 4; ++i) {
            const int col = i * 256 + lane * 4;
            if (first) *(f32x4*)(xd + col) = xv[i];
            const f32x4 gv = *(const f32x4*)(g + col), sv = *(const f32x4*)(scl + col), hv = *(const f32x4*)(sh + col);
            float h[4];
#pragma unroll
            for (int e = 0; e < 4; ++e) h[e] = xv[i][e] * rinv * gv[e] * (1.f + sv[e]) + hv[e];
            u32x2 o; o.x = pk2(h[0], h[1]); o.y = pk2(h[2], h[3]);
            *(u32x2*)(hb + (size_t)row * DM + col) = o;
        }
    }
}
DI void ph_zero_ysum(const Prm& p) { PH_IDS
    f32x4* y = (f32x4*)(p.ws + WS_YSUM); const f32x4 zr = {0.f, 0.f, 0.f, 0.f};
    for (int i = BID * 512 + TID; i < NTOK * 128; i += NBLK * 512) y[i] = zr;
}
DI void ph_rkv_conv(const Prm& p, int l) { PH_IDS
    const int lane = TID & 63, wid = TID >> 6;
    const bf16_t* z = (const bf16_t*)(p.ws + WS_Z); bf16_t* tmp = (bf16_t*)(p.ws + WS_RWA); float* invn = (float*)(p.ws + WS_INVN);
    const float* cw = p.r_conv + (size_t)l * 3 * 1536;
    for (int row = BID * 8 + wid; row < NTOK; row += NBLK * 8) {
        const int t = row < NLAT ? (row & 8191) : ((row - NLAT) & 255), L = row < NLAT ? SEQL : CTXL;
        const bool hp = t > 0, hn = t < L - 1;
#pragma unroll
        for (int g = 0; g < 3; ++g) {
            const int ch = g * 512 + lane * 8; const bf16_t* zp = z + (size_t)row * ZW + ZC_RR + ch;
            const u32x4 zero = {0u, 0u, 0u, 0u};
            const u32x4 uc = *(const u32x4*)zp, up = hp ? *(const u32x4*)(zp - ZW) : zero, un = hn ? *(const u32x4*)(zp + ZW) : zero;
            float c[8], pv[8], nx[8], o[8]; unpack8(uc, c); unpack8(up, pv); unpack8(un, nx);
#pragma unroll
            for (int e = 0; e < 8; ++e) o[e] = cw[ch + e] * pv[e] + cw[1536 + ch + e] * c[e] + cw[3072 + ch + e] * nx[e];
            *(u32x4*)(tmp + (size_t)row * 1536 + ch) = pack8(o);
            if (g == 1) {
                float ss = 0.f;
#pragma unroll
                for (int e = 0; e < 8; ++e) { const float kk = o[e] * p.r_kk[l * 512 + lane * 8 + e]; ss += kk * kk; }
                ss += __shfl_xor(ss, 1); ss += __shfl_xor(ss, 2); ss += __shfl_xor(ss, 4);
                if ((lane & 7) == 0) invn[(size_t)row * 8 + (lane >> 3)] = 1.f / fmaxf(sqrtf(ss), 1e-12f);
            }
        }
    }
}
DI void ph_rkv_copy(const Prm& p) { PH_IDS
    const int lane = TID & 63, wid = TID >> 6;
    bf16_t* z = (bf16_t*)(p.ws + WS_Z); const bf16_t* tmp = (const bf16_t*)(p.ws + WS_RWA);
    for (int row = BID * 8 + wid; row < NTOK; row += NBLK * 8)
#pragma unroll
        for (int g = 0; g < 3; ++g) { const int ch = g * 512 + lane * 8; *(u32x4*)(z + (size_t)row * ZW + ZC_RR + ch) = *(const u32x4*)(tmp + (size_t)row * 1536 + ch); }
}
DI void ph_attn_prep(const Prm& p, int l) { PH_IDS
    const int lane = TID & 63, wid = TID >> 6, hw = lane >> 5, pp = lane & 31;
    bf16_t* z = (bf16_t*)(p.ws + WS_Z); const float* rope = (const float*)(p.ws + WS_ROPE); const float* qkn = p.a_qkn + l * 128;
    for (int row = BID * 8 + wid; row < NTOK; row += NBLK * 8) {
        const bool islat = row < NLAT; const int t = row & 8191;
        float cs = 1.f, sn = 0.f; if (islat) { cs = rope[((size_t)t * 32 + pp) * 2]; sn = rope[((size_t)t * 32 + pp) * 2 + 1]; }
#pragma unroll
        for (int it = 0; it < 8; ++it) {
            const int seg = it * 2 + hw, which = seg >> 3, col = (which ? ZC_AK : ZC_AQ) + (seg & 7) * 64 + 2 * pp;
            unsigned* zp = (unsigned*)(z + (size_t)row * ZW + col);
            const unsigned u = *zp; const float x1 = lo16(u), x2 = hi16(u);
            float ss = x1 * x1 + x2 * x2;
            ss += __shfl_xor(ss, 1); ss += __shfl_xor(ss, 2); ss += __shfl_xor(ss, 4); ss += __shfl_xor(ss, 8); ss += __shfl_xor(ss, 16);
            const float rinv = rsqrtf(ss * (1.f / 64.f) + 1e-6f) * (which ? 1.f : 0.125f);
            const float y1 = x1 * rinv * qkn[which * 64 + 2 * pp], y2 = x2 * rinv * qkn[which * 64 + 2 * pp + 1];
            *zp = pk2(y1 * cs - y2 * sn, y1 * sn + y2 * cs);
        }
    }
}

#define MFMA16(a, b, c) __builtin_amdgcn_mfma_f32_16x16x32_bf16((a), (b), (c), 0, 0, 0)
#define MFMA32(a, b, c) __builtin_amdgcn_mfma_f32_32x32x16_bf16((a), (b), (c), 0, 0, 0)
DI float wave_incl_scan_add(float v, int lane) {
#pragma unroll
    for (int o = 1; o < 64; o <<= 1) { const float t = __shfl_up(v, o); if (lane >= o) v += t; }
    return v;
}
DI float wave_incl_scan_max(float v, int lane) {
#pragma unroll
    for (int o = 1; o < 64; o <<= 1) { const float t = __shfl_up(v, o); if (lane >= o) v = fmaxf(v, t); }
    return v;
}
DI float mconv(const bf16_t* z, const float* cw, size_t row, int t, int L, int ch) {
    const bf16_t* zp = z + row * ZW + ch;
    float a = cw[512 + ch] * bf2f(zp[0]);
    if (t > 0) a += cw[ch] * bf2f(zp[-ZW]);
    if (t < L - 1) a += cw[1024 + ch] * bf2f(zp[ZW]);
    return siluf_(a);
}
DI void ph_mlstm_a(const Prm& p, int l, unsigned char* smem) { PH_IDS
    const int lane = TID & 63, wid = TID >> 6;
    const bf16_t* z = (const bf16_t*)(p.ws + WS_Z); bf16_t* mst = (bf16_t*)(p.ws + WS_MST); float* msc = (float*)(p.ws + WS_MSC); float* mn = (float*)(p.ws + WS_MN);
    const float* cw = p.m_conv + (size_t)l * 3 * 512; const float* gb = p.m_gb + l * 16;
    bf16_t* kT = (bf16_t*)smem; bf16_t* vT = (bf16_t*)(smem + 9216); float* wsl = (float*)(smem + 9216 + 18432);
    for (int u = BID; u < 2112; u += NBLK) {
        const int d = u / 1056, r = u % 1056, b = r / 528, h = (r % 528) / NCHK, c = r % NCHK;
        const int slot = ((d * 2 + b) * 4 + h) * NCHK + c;
        const bool isctx = c < 4; const int cs = isctx ? c : c - 4, nch = isctx ? 4 : 128, oc = d ? nch - 1 - cs : cs, L = isctx ? CTXL : SEQL;
        const size_t base = isctx ? (size_t)NLAT + b * CTXL + oc * 64 : (size_t)b * SEQL + oc * 64;
        __syncthreads();
        if (wid == 0) {
            const int o = d ? 63 - lane : lane; const bf16_t* zr = z + (base + o) * ZW + ZC_MG + 8 * d + h;
            const float ig = bf2f(zr[0]) + gb[(2 * d) * 4 + h], lf = logsigf_(bf2f(zr[4]) + gb[(2 * d + 1) * 4 + h]);
            const float bc = wave_incl_scan_add(lf, lane), bt = __shfl(bc, 63), wl = bt - bc + ig, ml = wave_max(wl);
            wsl[lane] = __expf(wl - ml);
            if (lane == 0) { msc[slot * 4] = bt; msc[slot * 4 + 1] = ml; }
        }
        __syncthreads();
#pragma unroll
        for (int i = 0; i < 8; ++i) {
            const int idx = TID + 512 * i, dq = idx & 63, pp = idx >> 6, o = d ? 63 - pp : pp;
            kT[dq * 72 + pp] = f2bf(mconv(z, cw, base + o, oc * 64 + o, L, 256 + h * 64 + dq) * 0.125f);
        }
#pragma unroll
        for (int i = 0; i < 16; ++i) {
            const int idx = TID + 512 * i, vv = idx & 127, pp = idx >> 7, o = d ? 63 - pp : pp;
            vT[vv * 72 + pp] = f2bf(bf2f(z[(base + o) * ZW + ZC_MV + h * 128 + vv]) * wsl[pp]);
        }
        __syncthreads();
        f32x4 acc[4];
#pragma unroll
        for (int nt = 0; nt < 4; ++nt) acc[nt] = (f32x4){0.f, 0.f, 0.f, 0.f};
#pragma unroll
        for (int ks = 0; ks < 2; ++ks) {
            const bf16x8 a = *(const bf16x8*)(vT + (16 * wid + (lane & 15)) * 72 + ks * 32 + (lane >> 4) * 8);
#pragma unroll
            for (int nt = 0; nt < 4; ++nt) { const bf16x8 bb = *(const bf16x8*)(kT + (16 * nt + (lane & 15)) * 72 + ks * 32 + (lane >> 4) * 8); acc[nt] = MFMA16(a, bb, acc[nt]); }
        }
#pragma unroll
        for (int nt = 0; nt < 4; ++nt)
#pragma unroll
            for (int j = 0; j < 4; ++j) mst[(size_t)slot * 8192 + (16 * wid + (lane >> 4) * 4 + j) * 64 + 16 * nt + (lane & 15)] = f2bf(acc[nt][j]);
        if (TID < 64) { float s = 0.f; for (int pp = 0; pp < 64; ++pp) s += wsl[pp] * bf2f(kT[TID * 72 + pp]); mn[slot * 64 + TID] = s; }
    }
    __syncthreads();
}
DI void ph_mlstm_b(const Prm& p) { PH_IDS
    bf16_t* mst = (bf16_t*)(p.ws + WS_MST); float* msc = (float*)(p.ws + WS_MSC); float* mn = (float*)(p.ws + WS_MN);
    for (int e = BID * 512 + TID; e < 16 * 8256; e += NBLK * 512) {
        const int chain = e / 8256, idx = e % 8256; float m = 0.f, C = 0.f;
        for (int c0 = 0; c0 < NCHK; c0 += 4) {
            float uu[4], bt[4], ml[4];
#pragma unroll
            for (int j = 0; j < 4; ++j) {
                const int slot = chain * NCHK + c0 + j; bt[j] = msc[slot * 4]; ml[j] = msc[slot * 4 + 1];
                uu[j] = idx < 8192 ? bf2f(mst[(size_t)slot * 8192 + idx]) : mn[slot * 64 + idx - 8192];
            }
#pragma unroll
            for (int j = 0; j < 4; ++j) {
                const int slot = chain * NCHK + c0 + j;
                if (idx < 8192) mst[(size_t)slot * 8192 + idx] = f2bf(C); else mn[slot * 64 + idx - 8192] = C;
                if (idx == 0) msc[slot * 4 + 2] = m;
                const float mnew = fmaxf(bt[j] + m, ml[j]);
                C = __expf(bt[j] + m - mnew) * C + __expf(ml[j] - mnew) * uu[j]; m = mnew;
            }
        }
    }
}
DI void ph_mlstm_c(const Prm& p, int l, unsigned char* smem) { PH_IDS
    const int lane = TID & 63, wid = TID >> 6;
    bf16_t* z = (bf16_t*)(p.ws + WS_Z); const bf16_t* mst = (const bf16_t*)(p.ws + WS_MST); const float* msc = (const float*)(p.ws + WS_MSC); const float* mn = (const float*)(p.ws + WS_MN);
    const float* cw = p.m_conv + (size_t)l * 3 * 512; const float* gb = p.m_gb + l * 16;
    bf16_t* qs = (bf16_t*)smem; bf16_t* ks_ = (bf16_t*)(smem + 9216); bf16_t* vT = (bf16_t*)(smem + 18432); bf16_t* Sp = (bf16_t*)(smem + 36864);
    float* hsum = (float*)(smem + 46080); float* fa = (float*)(smem + 46080 + 33792);
    float *bcum = fa, *gg = fa + 64, *Mrow = fa + 128, *iw = fa + 192, *den = fa + 256, *nq = fa + 320;
    for (int u = BID; u < 1056; u += NBLK) {
        const int b = u / 528, h = (u % 528) / NCHK, cc = u % NCHK;
        const bool isctx = cc < 4; const int oc = isctx ? cc : cc - 4, nch = isctx ? 4 : 128, L = isctx ? CTXL : SEQL;
        const size_t base = isctx ? (size_t)NLAT + b * CTXL + oc * 64 : (size_t)b * SEQL + oc * 64;
        for (int d = 0; d < 2; ++d) {
            const int cs = d ? nch - 1 - oc : oc, c = isctx ? cs : cs + 4, slot = ((d * 2 + b) * 4 + h) * NCHK + c;
            const float mst_m = msc[slot * 4 + 2];
            __syncthreads();
            if (wid == 0) {
                const int o = d ? 63 - lane : lane; const bf16_t* zr = z + (base + o) * ZW + ZC_MG + 8 * d + h;
                const float ig = bf2f(zr[0]) + gb[(2 * d) * 4 + h], lf = logsigf_(bf2f(zr[4]) + gb[(2 * d + 1) * 4 + h]);
                const float bc = wave_incl_scan_add(lf, lane), g = ig - bc, pm = wave_incl_scan_max(g, lane), M = fmaxf(mst_m, pm);
                bcum[lane] = bc; gg[lane] = g; Mrow[lane] = M; iw[lane] = __expf(mst_m - M);
            }
#pragma unroll 2
            for (int i = 0; i < 16; ++i) {
                const int idx = TID + 512 * i, chq = idx & 127, pp = idx >> 7, o = d ? 63 - pp : pp, isk = chq >> 6, dq = chq & 63;
                const float v = mconv(z, cw, base + o, oc * 64 + o, L, isk * 256 + h * 64 + dq);
                if (isk) ks_[pp * 72 + dq] = f2bf(v * 0.125f); else qs[pp * 72 + dq] = f2bf(v);
            }
#pragma unroll 4
            for (int i = 0; i < 16; ++i) {
                const int idx = TID + 512 * i, vv = idx & 127, pp = idx >> 7, o = d ? 63 - pp : pp;
                vT[vv * 72 + pp] = z[(base + o) * ZW + ZC_MV + h * 128 + vv];
            }
            __syncthreads();
            {
                const int mt = wid >> 1;
#pragma unroll
                for (int nn = 0; nn < 2; ++nn) {
                    const int nt = 2 * (wid & 1) + nn; f32x4 acc = {0.f, 0.f, 0.f, 0.f};
#pragma unroll
                    for (int ks = 0; ks < 2; ++ks) {
                        const bf16x8 a = *(const bf16x8*)(qs + (16 * mt + (lane & 15)) * 72 + ks * 32 + (lane >> 4) * 8);
                        const bf16x8 bb = *(const bf16x8*)(ks_ + (16 * nt + (lane & 15)) * 72 + ks * 32 + (lane >> 4) * 8);
                        acc = MFMA16(a, bb, acc);
                    }
                    const int s = 16 * nt + (lane & 15);
#pragma unroll
                    for (int j = 0; j < 4; ++j) { const int pp = 16 * mt + (lane >> 4) * 4 + j; const float v = s <= pp ? acc[j] * __expf(gg[s] - Mrow[pp]) : 0.f; Sp[pp * 72 + s] = f2bf(v); }
                }
                if (TID < 64) { float s = 0.f; for (int dq = 0; dq < 64; ++dq) s += mn[slot * 64 + dq] * bf2f(qs[TID * 72 + dq]); nq[TID] = s; }
            }
            __syncthreads();
            if (TID < 64) { float s = 0.f; for (int k = 0; k < 64; ++k) s += bf2f(Sp[TID * 72 + k]); den[TID] = s + iw[TID] * nq[TID]; }
            f32x4 a1[4], a2[4];
#pragma unroll
            for (int mt = 0; mt < 4; ++mt) { a1[mt] = (f32x4){0.f, 0.f, 0.f, 0.f}; a2[mt] = (f32x4){0.f, 0.f, 0.f, 0.f}; }
#pragma unroll
            for (int ks = 0; ks < 2; ++ks) {
                const bf16x8 bv = *(const bf16x8*)(vT + (16 * wid + (lane & 15)) * 72 + ks * 32 + (lane >> 4) * 8);
                const bf16x8 bc = *(const bf16x8*)(mst + (size_t)slot * 8192 + (16 * wid + (lane & 15)) * 64 + ks * 32 + (lane >> 4) * 8);
#pragma unroll
                for (int mt = 0; mt < 4; ++mt) {
                    const bf16x8 as = *(const bf16x8*)(Sp + (16 * mt + (lane & 15)) * 72 + ks * 32 + (lane >> 4) * 8);
                    const bf16x8 aq = *(const bf16x8*)(qs + (16 * mt + (lane & 15)) * 72 + ks * 32 + (lane >> 4) * 8);
                    a1[mt] = MFMA16(as, bv, a1[mt]); a2[mt] = MFMA16(aq, bc, a2[mt]);
                }
            }
            __syncthreads();
            {
                const int vv = 16 * wid + (lane & 15);
#pragma unroll
                for (int mt = 0; mt < 4; ++mt)
#pragma unroll
                    for (int j = 0; j < 4; ++j) {
                        const int pp = 16 * mt + (lane >> 4) * 4 + j, o = d ? 63 - pp : pp;
                        const float val = (a1[mt][j] + iw[pp] * a2[mt][j]) / fmaxf(fabsf(den[pp]), __expf(-(bcum[pp] + Mrow[pp])));
                        if (d == 0) hsum[o * 132 + vv] = val; else hsum[o * 132 + vv] += val;
                    }
            }
        }
        __syncthreads();
#pragma unroll
        for (int i = 0; i < 8; ++i) {
            const int o = wid * 8 + i; const float x0 = hsum[o * 132 + lane], x1 = hsum[o * 132 + lane + 64];
            const float ss = wave_sum(x0 * x0 + x1 * x1), rinv = rsqrtf(ss * (1.f / 128.f) + 1e-6f);
            bf16_t* zo = z + (base + o) * ZW + ZC_MO + h * 128; const float* on = p.m_on + l * 512 + h * 128;
            zo[lane] = f2bf(x0 * rinv * on[lane] * sigmoidf_(bf2f(zo[lane])));
            zo[lane + 64] = f2bf(x1 * rinv * on[lane + 64] * sigmoidf_(bf2f(zo[lane + 64])));
        }
    }
    __syncthreads();
}
DI int swap23(int s) { return (s & ~12) | ((s & 4) << 1) | ((s & 8) >> 1); }
DI void ph_attn(const Prm& p, int l, unsigned char* smem) { PH_IDS
    const int lane = TID & 63, wid = TID >> 6, q = lane & 31, hh = lane >> 5, qg = wid >> 1, mp = wid & 1;
    bf16_t* z = (bf16_t*)(p.ws + WS_Z);
    float lam; const float lam_init = 0.8f - 0.6f * expf(-0.3f * (float)l);
    { const float* lp = p.a_lam + l * 256; float s1 = 0.f, s2 = 0.f; for (int i = 0; i < 64; ++i) { s1 += lp[i] * lp[64 + i]; s2 += lp[128 + i] * lp[192 + i]; } lam = expf(s1) - expf(s2) + lam_init; }
    bf16_t* Qs = (bf16_t*)smem; float* ex = (float*)smem;
    constexpr int KB_OFF = 34816, VT_OFF = 69632;
    for (int u = BID; u < 528; u += NBLK) {
        int b, head, nt; size_t qrow0;
        if (u < 512) { b = u >> 8; head = (u >> 6) & 3; qrow0 = (size_t)b * SEQL + (u & 63) * 128; nt = 132; }
        else { const int uu = u - 512; b = uu >> 3; head = (uu >> 1) & 3; qrow0 = (size_t)NLAT + b * CTXL + (uu & 1) * 128; nt = 4; }
        const bool lat = u < 512;
        __syncthreads();
#pragma unroll
        for (int i = 0; i < 4; ++i) { const int idx = TID + 512 * i, r = idx >> 4, cp = idx & 15; *(u32x4*)(Qs + r * 136 + cp * 8) = *(const u32x4*)(z + (qrow0 + r) * ZW + ZC_AQ + head * 128 + cp * 8); }
        u32x4 kreg[2], vreg[2];
        const int kp = TID & 31, vg = TID >> 5;
#define ATT_KROW0(j) ((lat && (j) >= 4) ? (size_t)b * SEQL + 64 * ((j) - 4) : (size_t)NLAT + b * CTXL + 64 * (j))
#define ATT_LOAD(j) do { const size_t kr0 = ATT_KROW0(j); \
            _Pragma("unroll") for (int i = 0; i < 2; ++i) { const int idx = TID + 512 * i, r = idx >> 4, cp = idx & 15; kreg[i] = *(const u32x4*)(z + (kr0 + r) * ZW + ZC_AK + head * 128 + cp * 8); } \
            _Pragma("unroll") for (int i = 0; i < 2; ++i) vreg[i] = *(const u32x4*)(z + (kr0 + 2 * kp + i) * ZW + ZC_AV + head * 128 + 8 * vg); } while (0)
#define ATT_WRITE(buf) do { bf16_t* Kw = (bf16_t*)(smem + KB_OFF + (buf) * 17408); bf16_t* Vw = (bf16_t*)(smem + VT_OFF + (buf) * 18432); \
            _Pragma("unroll") for (int i = 0; i < 2; ++i) { const int idx = TID + 512 * i, r = idx >> 4, cp = idx & 15; *(u32x4*)(Kw + r * 136 + cp * 8) = kreg[i]; } \
            _Pragma("unroll") for (int w = 0; w < 4; ++w) { \
                *(unsigned*)(Vw + (8 * vg + 2 * w) * 72 + 2 * kp) = (vreg[0][w] & 0xffffu) | (vreg[1][w] << 16); \
                *(unsigned*)(Vw + (8 * vg + 2 * w + 1) * 72 + 2 * kp) = (vreg[0][w] >> 16) | (vreg[1][w] & 0xffff0000u); } } while (0)
        ATT_LOAD(0); ATT_WRITE(0);
        __syncthreads();
        f32x16 o[4]; float mrun = -1e30f, lrun = 0.f;
#pragma unroll
        for (int dvb = 0; dvb < 4; ++dvb)
#pragma unroll
            for (int i = 0; i < 16; ++i) o[dvb][i] = 0.f;
        for (int j = 0; j < nt; ++j) {
            const int cur = j & 1;
            if (j + 1 < nt) ATT_LOAD(j + 1);
            const bf16_t* Kb = (const bf16_t*)(smem + KB_OFF + cur * 17408); const bf16_t* Vt = (const bf16_t*)(smem + VT_OFF + cur * 18432);
            f32x16 s0, s1;
#pragma unroll
            for (int i = 0; i < 16; ++i) { s0[i] = 0.f; s1[i] = 0.f; }
#pragma unroll
            for (int kk = 0; kk < 4; ++kk) {
                const bf16x8 qf = *(const bf16x8*)(Qs + (32 * qg + q) * 136 + mp * 64 + kk * 16 + hh * 8);
                const bf16x8 k0 = *(const bf16x8*)(Kb + swap23(q) * 136 + mp * 64 + kk * 16 + hh * 8);
                const bf16x8 k1 = *(const bf16x8*)(Kb + (32 + swap23(q)) * 136 + mp * 64 + kk * 16 + hh * 8);
                s0 = MFMA32(k0, qf, s0); s1 = MFMA32(k1, qf, s1);
            }
            float mx = s0[0];
#pragma unroll
            for (int i = 1; i < 16; ++i) mx = fmaxf(mx, s0[i]);
#pragma unroll
            for (int i = 0; i < 16; ++i) mx = fmaxf(mx, s1[i]);
            mx = fmaxf(mx, __shfl_xor(mx, 32));
            const float mnew = fmaxf(mrun, mx), alpha = __expf(mrun - mnew); mrun = mnew;
            float ps = 0.f;
#pragma unroll
            for (int i = 0; i < 16; ++i) { s0[i] = __expf(s0[i] - mnew); s1[i] = __expf(s1[i] - mnew); ps += s0[i] + s1[i]; }
            lrun = lrun * alpha + ps;
#pragma unroll
            for (int dvb = 0; dvb < 4; ++dvb)
#pragma unroll
                for (int i = 0; i < 16; ++i) o[dvb][i] *= alpha;
            bf16x8 pf[4];
#pragma unroll
            for (int cc = 0; cc < 2; ++cc) {
                u32x4 a, c2;
                a.x = pk2(s0[8 * cc], s0[8 * cc + 1]); a.y = pk2(s0[8 * cc + 2], s0[8 * cc + 3]); a.z = pk2(s0[8 * cc + 4], s0[8 * cc + 5]); a.w = pk2(s0[8 * cc + 6], s0[8 * cc + 7]);
                c2.x = pk2(s1[8 * cc], s1[8 * cc + 1]); c2.y = pk2(s1[8 * cc + 2], s1[8 * cc + 3]); c2.z = pk2(s1[8 * cc + 4], s1[8 * cc + 5]); c2.w = pk2(s1[8 * cc + 6], s1[8 * cc + 7]);
                pf[cc] = __builtin_bit_cast(bf16x8, a); pf[2 + cc] = __builtin_bit_cast(bf16x8, c2);
            }
#pragma unroll
            for (int dvb = 0; dvb < 4; ++dvb)
#pragma unroll
                for (int c = 0; c < 4; ++c) {
                    const bf16x8 vf = *(const bf16x8*)(Vt + (dvb * 32 + q) * 72 + 16 * c + 8 * hh);
                    o[dvb] = MFMA32(vf, pf[c], o[dvb]);
                }
            if (j + 1 < nt) ATT_WRITE(cur ^ 1);
            __syncthreads();
        }
        const float lsum = lrun + __shfl_xor(lrun, 32);
        const float inv = (mp ? lam : 1.f) / lsum;
        if (mp) {
#pragma unroll
            for (int dvb = 0; dvb < 4; ++dvb)
#pragma unroll
                for (int i = 0; i < 16; ++i) ex[(qg * 64 + dvb * 16 + i) * 64 + lane] = o[dvb][i] * inv;
        }
        __syncthreads();
        if (!mp) {
            float ss = 0.f;
#pragma unroll
            for (int dvb = 0; dvb < 4; ++dvb)
#pragma unroll
                for (int i = 0; i < 16; ++i) { const float v = o[dvb][i] * inv - ex[(qg * 64 + dvb * 16 + i) * 64 + lane]; o[dvb][i] = v; ss += v * v; }
            ss += __shfl_xor(ss, 32);
            const float rinv = rsqrtf(ss * (1.f / 128.f) + 1e-6f) * (1.f - lam_init);
            bf16_t* orow = z + (qrow0 + 32 * qg + q) * ZW + ZC_AQ + head * 128; const float* sub = p.a_subln + l * 128;
#pragma unroll
            for (int dvb = 0; dvb < 4; ++dvb)
#pragma unroll
                for (int ig = 0; ig < 4; ++ig) {
                    const int dv0 = dvb * 32 + 8 * ig + 4 * hh; u32x2 w;
                    w.x = pk2(o[dvb][4 * ig] * rinv * sub[dv0], o[dvb][4 * ig + 1] * rinv * sub[dv0 + 1]);
                    w.y = pk2(o[dvb][4 * ig + 2] * rinv * sub[dv0 + 2], o[dvb][4 * ig + 3] * rinv * sub[dv0 + 3]);
                    *(u32x2*)(orow + dv0) = w;
                }
        }
    }
    __syncthreads();
}

template <int CTRL> DI float dppf(float v) { return __int_as_float(__builtin_amdgcn_update_dpp(0, __float_as_int(v), CTRL, 0xf, 0xf, false)); }
DI float allreduce16(float x) { x += dppf<0x128>(x); x += dppf<0x124>(x); x += dppf<0x122>(x); x += dppf<0x121>(x); return x; }
DI void ph_rwkv_scan(const Prm& p, int l, unsigned char* smem) { PH_IDS
    const int lane = TID & 63, wid = TID >> 6;
    const bf16_t* z = (const bf16_t*)(p.ws + WS_Z); const bf16_t* rwa = (const bf16_t*)(p.ws + WS_RWA); const float* invn = (const float*)(p.ws + WS_INVN);
    float* ysum = (float*)(p.ws + WS_YSUM);
    constexpr int TC = 32, OPW = 328, NC = 264, OPS_B = TC * OPW * 4, YP_OFF = 2 * OPS_B, YP_B = TC * 128 * 4;
    for (int u = BID; u < 256; u += NBLK) {
        const int chain = u >> 3, d = chain >> 4, b = (chain >> 3) & 1, h = chain & 7, r0 = (u & 7) * 8;
        const float ckk = p.r_kk[l * 512 + h * 64 + lane], cka = p.r_ka[l * 512 + h * 64 + lane];
#define RW_ROW(ck, i) ((ck) < 8 ? (size_t)NLAT + b * CTXL + (d ? CTXL - 1 - ((ck) * TC + (i)) : ((ck) * TC + (i))) : (size_t)b * SEQL + (d ? SEQL - 1 - (((ck) - 8) * TC + (i)) : (((ck) - 8) * TC + (i))))
        bf16_t g_r[6], g_k[6], g_u[6], g_a[6], g_v[6]; float g_i[6];
        const int sw = wid - 2;
#define RW_LOAD(ck) do { _Pragma("unroll") for (int jj = 0; jj < 6; ++jj) { const int i = sw + 6 * jj; if (i < TC) { const size_t row = RW_ROW(ck, i); \
            g_r[jj] = z[row * ZW + ZC_RR + h * 64 + lane]; g_k[jj] = z[row * ZW + ZC_RK + h * 64 + lane]; g_v[jj] = z[row * ZW + ZC_RV + h * 64 + r0 + (lane & 7)]; \
            g_u[jj] = rwa[row * 2048 + d * 512 + h * 64 + lane]; g_a[jj] = rwa[row * 2048 + 1024 + d * 512 + h * 64 + lane]; g_i[jj] = invn[row * 8 + h]; } } } while (0)
#define RW_WRITE(buf) do { float* ops = (float*)(smem + (buf) * OPS_B); _Pragma("unroll") for (int jj = 0; jj < 6; ++jj) { const int i = sw + 6 * jj; if (i < TC) { \
            const float k = bf2f(g_k[jj]), a = bf2f(g_a[jj]), kk = k * ckk * g_i[jj]; float* o = ops + i * OPW; \
            o[lane] = 1.f - bf2f(g_u[jj]); o[64 + lane] = kk; o[128 + lane] = kk * a; o[192 + lane] = k * (1.f + (a - 1.f) * cka); o[256 + lane] = bf2f(g_r[jj]); \
            if (lane < 8) o[320 + lane] = bf2f(g_v[jj]); } } } while (0)
#define RW_FLUSH(ck) do { const float* yp = (const float*)(smem + YP_OFF + ((ck) & 1) * YP_B); const int f = TID - 128; if (f < 256) { const int i = f >> 3, rl = f & 7; \
            const f32x4* y4 = (const f32x4*)(yp + i * 128 + rl * 16); const f32x4 s4 = y4[0] + y4[1] + y4[2] + y4[3]; \
            unsafeAtomicAdd(ysum + RW_ROW(ck, i) * 512 + h * 64 + r0 + rl, (s4[0] + s4[1]) + (s4[2] + s4[3])); } } while (0)
        __syncthreads();
        if (wid >= 2) { RW_LOAD(0); RW_WRITE(0); RW_LOAD(1); }
        __syncthreads();
        f32x4 S = {0.f, 0.f, 0.f, 0.f};
        const int rl = wid * 4 + (lane >> 4), ksub = lane & 15;
        for (int ck = 0; ck < NC; ++ck) {
            if (wid >= 2) {
                if (ck + 1 < NC) RW_WRITE((ck + 1) & 1);
                if (ck + 2 < NC) RW_LOAD(ck + 2);
                if (ck > 0) RW_FLUSH(ck - 1);
            } else {
                const float* ops = (const float*)(smem + (ck & 1) * OPS_B); float* yp = (float*)(smem + YP_OFF + (ck & 1) * YP_B);
                f32x4 nw = *(const f32x4*)(ops + 4 * ksub), nk = *(const f32x4*)(ops + 64 + 4 * ksub), nb = *(const f32x4*)(ops + 128 + 4 * ksub),
                      nd = *(const f32x4*)(ops + 192 + 4 * ksub), nr = *(const f32x4*)(ops + 256 + 4 * ksub); float nv = ops[320 + rl];
#pragma unroll 2
                for (int i = 0; i < TC; ++i) {
                    const f32x4 w4 = nw, k4 = nk, b4 = nb, d4 = nd, r4 = nr; const float v = nv;
                    if (i + 1 < TC) { const float* o2 = ops + (i + 1) * OPW; nw = *(const f32x4*)(o2 + 4 * ksub); nk = *(const f32x4*)(o2 + 64 + 4 * ksub); nb = *(const f32x4*)(o2 + 128 + 4 * ksub);
                        nd = *(const f32x4*)(o2 + 192 + 4 * ksub); nr = *(const f32x4*)(o2 + 256 + 4 * ksub); nv = o2[320 + rl]; }
                    const f32x4 t = S * k4; const float sa = -allreduce16((t[0] + t[1]) + (t[2] + t[3]));
                    S = S * w4 + (b4 * sa + d4 * v);
                    const f32x4 y = S * r4;
                    yp[i * 128 + rl * 16 + ksub] = (y[0] + y[1]) + (y[2] + y[3]);
                }
            }
            __syncthreads();
        }
        if (wid >= 2) RW_FLUSH(NC - 1);
    }
    __syncthreads();
}
DI void ph_rwkv_post(const Prm& p, int l) { PH_IDS
    const int lane = TID & 63, wid = TID >> 6, ch0 = lane * 8;
    bf16_t* z = (bf16_t*)(p.ws + WS_Z); const float* ysum = (const float*)(p.ws + WS_YSUM); const bf16_t* rg = (const bf16_t*)(p.ws + WS_RG);
    for (int row = BID * 8 + wid; row < NTOK; row += NBLK * 8) {
        const f32x4 ya = *(const f32x4*)(ysum + (size_t)row * 512 + ch0), yb = *(const f32x4*)(ysum + (size_t)row * 512 + ch0 + 4);
        float y[8] = {ya[0], ya[1], ya[2], ya[3], yb[0], yb[1], yb[2], yb[3]}, r[8], k[8], v[8], g[8], o[8];
        bf16_t* zr = z + (size_t)row * ZW + ZC_RR + ch0;
        unpack8(*(const u32x4*)zr, r); unpack8(*(const u32x4*)(zr + 512), k); unpack8(*(const u32x4*)(zr + 1024), v); unpack8(*(const u32x4*)(rg + (size_t)row * 512 + ch0), g);
        float s = 0.f, bs = 0.f;
#pragma unroll
        for (int e = 0; e < 8; ++e) { s += y[e]; bs += r[e] * k[e] * p.r_rk[l * 512 + ch0 + e]; }
        s += __shfl_xor(s, 1); s += __shfl_xor(s, 2); s += __shfl_xor(s, 4); bs += __shfl_xor(bs, 1); bs += __shfl_xor(bs, 2); bs += __shfl_xor(bs, 4);
        const float mu = s * (1.f / 64.f); float vs = 0.f;
#pragma unroll
        for (int e = 0; e < 8; ++e) { const float dlt = y[e] - mu; vs += dlt * dlt; }
        vs += __shfl_xor(vs, 1); vs += __shfl_xor(vs, 2); vs += __shfl_xor(vs, 4);
        const float rstd = rsqrtf(vs * (1.f / 64.f) + 64e-5f);
#pragma unroll
        for (int e = 0; e < 8; ++e) o[e] = ((y[e] - mu) * rstd * p.r_lnw[l * 512 + ch0 + e] + p.r_lnb[l * 512 + ch0 + e] + bs * v[e]) * g[e];
        *(u32x4*)zr = pack8(o);
    }
}

__global__ void __launch_bounds__(512) mega(Prm p0) {
    Prm p = p0; p.wv = __builtin_amdgcn_readfirstlane((int)threadIdx.x >> 6);
    extern __shared__ __attribute__((aligned(16))) unsigned char smem[];
    cg::grid_group grid = cg::this_grid();
    bf16_t* wt = (bf16_t*)(p.ws + WS_WT); bf16_t* zb = (bf16_t*)(p.ws + WS_Z); bf16_t* hb = (bf16_t*)(p.ws + WS_RWA); bf16_t* gtmp = hb + (size_t)NTOK * DM;
    bf16_t* zz = (bf16_t*)(p.ws + WS_MST); float* xc = (float*)(p.ws + WS_XC); const float* mods = (const float*)(p.ws + WS_MODS);
    ph_modpart(p, smem); ph_rope(p); conv_ffn(p, 0, 0, smem);
    grid.sync();
    ph_modreduce(p);
    grid.sync();
#define MERGE_B(l, b) do { \
                    { EpiGate E; E.G = gtmp; run_gemm(p.wv, smem, hb, DM, wt + WT_G + (size_t)(b) * DM * DM, NTOK, DM, DM, E); } \
                    { EpiBranch E; E.G = gtmp; E.ZZ = zz; E.first = ((b) == 0); const int yc = (b) == 0 ? ZC_MO : ((b) == 1 ? ZC_RR : ZC_AQ); \
                      run_gemm(p.wv, smem, zb + yc, ZW, wt + WT_P + (size_t)(b) * DM * 512, NTOK, DM, 512, E); } \
 } while (0)
#define MIXER_STAGE(l) do { const float* ml = mods + (size_t)(l) * 27648; \
                ph_norm(p, l, 1, false); conv_mixer(p, l, smem); ph_zero_ysum(p); \
                grid.sync(); \
                { EpiWin E; E.Z = zb; run_gemm(p.wv, smem, hb, DM, wt + WT_IN, NTOK, ZWP, DM, E); } \
                grid.sync(); \
                ph_rkv_conv(p, l); ph_attn_prep(p, l); ph_mlstm_a(p, l, smem); \
                grid.sync(); \
                ph_rkv_copy(p); ph_mlstm_b(p); \
                grid.sync(); \
                { EpiLora E; E.RWA = hb; E.RG = (bf16_t*)(p.ws + WS_RG); E.w0 = p.r_w0 + l * 1024; E.a0 = p.r_a0 + l * 1024; run_gemm(p.wv, smem, zb + ZC_RL, ZW, wt + WT_L, NTOK, 2560, 384, E); } \
                grid.sync(); \
                ph_rwkv_scan(p, l, smem); \
                grid.sync(); \
                ph_attn(p, l, smem); ph_mlstm_c(p, l, smem); \
                grid.sync(); \
                ph_rwkv_post(p, l); ph_norm(p, l, 1, false); \
                grid.sync(); \
                MERGE_B(l, 0); MERGE_B(l, 1); MERGE_B(l, 2); \
                grid.sync(); \
                { EpiResid E; E.xlat = p.out; E.xc = xc; E.gate = ml + 5 * DM; E.coef = 1.f; run_gemm(p.wv, smem, zz, DM, wt + WT_O, NTOK, DM, DM, E); } \
                grid.sync(); \
 } while (0)
#define FFN_STAGE(l, f) do { const float* ml = mods + (size_t)(l) * 27648; \
            ph_norm(p, l, f == 0 ? 0 : 2, l == 0 && f == 0); \
            if (!(l == 0 && f == 0)) conv_ffn(p, l, f, smem); \
            grid.sync(); \
            { EpiSwiglu E; E.H = zb; run_gemm(p.wv, smem, hb, DM, wt + WT_GU, NTOK, 2 * DFF, DM, E); } \
            grid.sync(); \
            { EpiResid E; E.xlat = p.out; E.xc = xc; E.gate = ml + (f == 0 ? 2 : 8) * DM; E.coef = 0.5f; run_gemm(p.wv, smem, zb, DFF, wt + WT_DN, NTOK, DM, DFF, E); } \
            grid.sync(); \
 } while (0)
    FFN_STAGE(0, 0); MIXER_STAGE(0); FFN_STAGE(0, 1); FFN_STAGE(1, 0); MIXER_STAGE(1); FFN_STAGE(1, 1);
}

extern "C" void kernel_launch(void* const* d_in, const int* in_sizes, int n_in, void* d_out, int out_size, void* d_ws, size_t ws_size, hipStream_t stream) {
    static int grid_blocks = 0;
    if (!grid_blocks) {
        int dev = 0, cus = 0, per_cu = 0;
        hipGetDevice(&dev);
        hipDeviceGetAttribute(&cus, hipDeviceAttributeMultiprocessorCount, dev);
        hipFuncSetAttribute((const void*)mega, hipFuncAttributeMaxDynamicSharedMemorySize, LDS_BYTES);
        hipOccupancyMaxActiveBlocksPerMultiprocessor(&per_cu, (const void*)mega, 512, LDS_BYTES);
        if (per_cu < 1) per_cu = 1;
        grid_blocks = cus * per_cu;
        if (ws_size < WS_END) fprintf(stderr, "kernel_launch: workspace too small: %zu < %zu\n", ws_size, (size_t)WS_END);
    }
    Prm p{};
    const float** pp = (const float**)&p;
    for (int i = 0; i < 31; ++i) pp[i] = (const float*)d_in[i];
    p.out = (float*)d_out; p.ws = (unsigned char*)d_ws;
    void* args[] = {&p};
    hipError_t e = hipLaunchCooperativeKernel((const void*)mega, dim3(grid_blocks), dim3(512), args, LDS_BYTES, stream);
    if (e != hipSuccess) fprintf(stderr, "cooperative launch failed: %s (grid %d)\n", hipGetErrorString(e), grid_blocks);
}
```

```cpp
#include <hip/hip_runtime.h>
#include <hip/hip_cooperative_groups.h>
#include <cstdio>
#include <cstdint>
namespace cg = cooperative_groups;

#define LAS __attribute__((address_space(3)))
#define DI __device__ __forceinline__
typedef unsigned short bf16_t;
typedef short bf16x8 __attribute__((ext_vector_type(8)));
typedef float f32x4 __attribute__((ext_vector_type(4)));
typedef float f32x16 __attribute__((ext_vector_type(16)));
typedef float f32x2 __attribute__((ext_vector_type(2)));
typedef unsigned u32x4 __attribute__((ext_vector_type(4)));
typedef unsigned u32x2 __attribute__((ext_vector_type(2)));
typedef __bf16 bf16x2_t __attribute__((ext_vector_type(2)));

constexpr int DM = 1024, NLAT = 16384, NTOK = 16896, SEQL = 8192, CTXL = 256, DFF = 2816, DIN = 8080, ZW = 5008, ZWP = 5120;
constexpr int ZC_MQ = 0, ZC_MK = 256, ZC_MV = 512, ZC_MO = 1024, ZC_MG = 1536, ZC_RR = 1552, ZC_RK = 2064, ZC_RV = 2576, ZC_RL = 3088, ZC_AQ = 3472, ZC_AK = 3984, ZC_AV = 4496;
constexpr int NCHK = 132;
constexpr size_t WS_MODP = 0;
constexpr size_t WS_MODS = WS_MODP + (size_t)2 * 16 * 3 * 9216 * 4;
constexpr size_t WS_ROPE = WS_MODS + (size_t)2 * 3 * 9216 * 4;
constexpr size_t WS_XC   = WS_ROPE + (size_t)8192 * 64 * 4;
constexpr size_t WS_INVN = WS_XC + (size_t)512 * 1024 * 4;
constexpr size_t WS_MSC  = WS_INVN + (size_t)NTOK * 8 * 4;
constexpr size_t WS_MN   = WS_MSC + (size_t)2112 * 4 * 4;
constexpr size_t WS_WT   = WS_MN + (size_t)2112 * 64 * 4;
constexpr size_t WS_Z    = WS_WT + (size_t)25165824;
constexpr size_t WS_RWA  = WS_Z + (size_t)NTOK * ZW * 2;
constexpr size_t WS_RG   = WS_RWA + (size_t)NTOK * 2048 * 2;
constexpr size_t WS_MST  = WS_RG + (size_t)NTOK * 512 * 2;
constexpr size_t WS_YSUM = WS_MST + (size_t)2112 * 8192 * 2;
constexpr size_t WS_END  = WS_YSUM + (size_t)NTOK * 512 * 4;
constexpr size_t WT_GU = 0, WT_DN = (size_t)5632 * 1024;
constexpr size_t WT_IN = 0, WT_G = (size_t)5120 * 1024, WT_P = WT_G + (size_t)3072 * 1024, WT_O = WT_P + (size_t)3 * 1024 * 512, WT_L = WT_O + (size_t)1024 * 1024;
constexpr int LDS_BYTES = 155648;

DI float bf2f(bf16_t b) { return __uint_as_float(((unsigned)b) << 16); }
DI unsigned pk2(float lo, float hi) { f32x2 v = {lo, hi}; bf16x2_t b = __builtin_convertvector(v, bf16x2_t); return __builtin_bit_cast(unsigned, b); }
DI bf16_t f2bf(float f) { return (bf16_t)(pk2(f, 0.f) & 0xffffu); }
DI float lo16(unsigned u) { return __uint_as_float(u << 16); }
DI float hi16(unsigned u) { return __uint_as_float(u & 0xffff0000u); }
DI float sigmoidf_(float x) { return __builtin_amdgcn_rcpf(1.f + __expf(-x)); }
DI float siluf_(float x) { return x * __builtin_amdgcn_rcpf(1.f + __expf(-x)); }
DI float logsigf_(float x) { return x < 0.f ? x - log1pf(expf(x)) : -log1pf(expf(-x)); }
DI float wave_sum(float v) {
#pragma unroll
    for (int o = 1; o < 64; o <<= 1) v += __shfl_xor(v, o);
    return v;
}
DI float wave_max(float v) {
#pragma unroll
    for (int o = 1; o < 64; o <<= 1) v = fmaxf(v, __shfl_xor(v, o));
    return v;
}
DI void unpack8(const u32x4 u, float* f) { f[0] = lo16(u.x); f[1] = hi16(u.x); f[2] = lo16(u.y); f[3] = hi16(u.y); f[4] = lo16(u.z); f[5] = hi16(u.z); f[6] = lo16(u.w); f[7] = hi16(u.w); }
DI u32x4 pack8(const float* f) { u32x4 u; u.x = pk2(f[0], f[1]); u.y = pk2(f[2], f[3]); u.z = pk2(f[4], f[5]); u.w = pk2(f[6], f[7]); return u; }
DI int launder_v(int v) { asm volatile("" : "+v"(v)); return v; }
DI int launder_s(int v) { asm volatile("" : "+s"(v)); return v; }
DI int lane_id_() { return (int)__builtin_amdgcn_mbcnt_hi(~0u, __builtin_amdgcn_mbcnt_lo(~0u, 0u)); }
namespace pg8 {
#define PG8_LAS __attribute__((address_space(3)))
typedef unsigned short bf16_t;
typedef short bf16x8 __attribute__((ext_vector_type(8)));
typedef float f32x4 __attribute__((ext_vector_type(4)));
typedef unsigned u32x4 __attribute__((ext_vector_type(4)));
constexpr int BM = 256, BK = 64, HALF = 128, HTB = HALF * BK * 2  , STAGE_BYTES = 8 * HTB, NXCD = 8, WGM = 8;

__host__ __device__ __forceinline__ int lds_byte(int r, int c) { const int st = (r >> 4) * 2 + (c >> 5), rr = r & 15, cc = c & 31, ob = rr * 64 + cc * 2; return st * 1024 + (ob ^ (((ob >> 9) & 1) << 5)); }
__host__ __device__ __forceinline__ void stage_rc(int b, int& R, int& C) { const int st = b / 1024, sb = b % 1024, swz = sb ^ (((sb >> 9) & 1) << 5); R = (st >> 1) * 16 + swz / 64; C = (st & 1) * 32 + (swz % 64) / 2; }
__host__ __device__ __forceinline__ int perm32(int rho) { const int n = rho >> 4, i = rho & 15; return 8 * (i >> 2) + 4 * n + (i & 3); }

struct Unit { int pm, pn; };
struct Gemm { const bf16_t* A; const bf16_t* Bt; int M, N, K, lda, tid0; };

struct StaticOrder {
    int nM, nN, nwg, G, c;
    __host__ __device__ void init(int M, int N, int G_, int c_) { nM = M / BM; nN = N / BM; nwg = nM * nN; G = G_; c = c_; }
    __host__ __device__ bool next(int i, Unit& u) const {
        const long L = (long)i * G + c; if (L >= nwg) return false;
        int wgid = (int)L; { const int q = nwg / NXCD, r = nwg % NXCD, xcd = wgid % NXCD, off = wgid / NXCD; wgid = (xcd < r ? xcd * (q + 1) : r * (q + 1) + (xcd - r) * q) + off; }
        const int nig = WGM * nN, gid = wgid / nig, fm = gid * WGM, gsz = (nM - fm) < WGM ? (nM - fm) : WGM;
        u.pm = fm + ((wgid % nig) % gsz); u.pn = (wgid % nig) / gsz; return true;
    }
    __device__ __forceinline__ void a_ready(const Unit&) const {}
    __device__ __forceinline__ void done(const Unit&) const {}
};


template <class Epi, class Sched, bool ALIGN_EPI = false, bool SP2 = false>
__device__ __forceinline__ void gemm_phase(PG8_LAS unsigned char* lds, const Gemm g, const Sched& S, const Epi& E) {
    int tid = g.tid0; asm volatile("" : "+v"(tid)); const int wid = __builtin_amdgcn_readfirstlane(tid >> 6), lane = tid & 63, wr = wid >> 2, wc = wid & 3, fr = lane & 15, fq = lane >> 4;
    const int K = g.K, nt = K / BK;
    unsigned voffA[2], voffB[2];
#pragma unroll
    for (int i = 0; i < 2; ++i) { int R, C; stage_rc(tid * 16 + i * 8192, R, C); const int Rb = Epi::PERM ? ((R & ~31) + perm32(R & 31)) : R;
        voffA[i] = (unsigned)(R * g.lda + C) * 2u; voffB[i] = (unsigned)(Rb * K + C) * 2u; }
    const size_t kstep = (size_t)(BK * 2);
    const size_t hstepB = (size_t)HALF * K * 2, hstepA = (size_t)HALF * g.lda * 2;
    const size_t tstepA = 2 * hstepA, tstepB = 2 * hstepB;
    const unsigned ldsw = (unsigned)wid * 1024u;
    const int aoff = lds_byte(wr * 64 + fr, fq * 8), boff = lds_byte(wc * 32 + fr, fq * 8);
#define PG8_SA(b, h) (((b) * 2 + (h)) * HTB)
#define PG8_SB(b, h) ((4 + (b) * 2 + (h)) * HTB)
#define PG8_STAGE(bufoff, gbase, voff) do { _Pragma("unroll") for (int _i = 0; _i < 2; ++_i) \
        __builtin_amdgcn_global_load_lds((const unsigned*)((const char*)(gbase) + (voff)[_i]), (PG8_LAS unsigned*)(lds + (bufoff) + ldsw + _i * 8192), 16, 0, 0); } while (0)
#define PG8_LDA(dst, b, h) do { _Pragma("unroll") for (int m = 0; m < 4; ++m) _Pragma("unroll") for (int k = 0; k < 2; ++k) dst[m][k] = *(const PG8_LAS bf16x8*)(lds + PG8_SA(b, h) + aoff + m * 2048 + k * 1024); } while (0)
#define PG8_LDB(dst, b, h) do { _Pragma("unroll") for (int n = 0; n < 2; ++n) _Pragma("unroll") for (int k = 0; k < 2; ++k) dst[n][k] = *(const PG8_LAS bf16x8*)(lds + PG8_SB(b, h) + boff + n * 2048 + k * 1024); } while (0)
#define PG8_MMA(ai, bj, At, Bt) do { __builtin_amdgcn_s_setprio(1); _Pragma("unroll") for (int m = 0; m < 4; ++m) _Pragma("unroll") for (int n = 0; n < 2; ++n) _Pragma("unroll") for (int k = 0; k < 2; ++k) \
        acc[ai][bj][m][n] = __builtin_amdgcn_mfma_f32_16x16x32_bf16(Bt[n][k], At[m][k], acc[ai][bj][m][n], 0, 0, 0); __builtin_amdgcn_s_setprio(0); } while (0)
#define PG8_WAIT_V(n) asm volatile("s_waitcnt vmcnt(" #n ")" ::: "memory")
#define PG8_WAIT_L(n) asm volatile("s_waitcnt lgkmcnt(" #n ")" ::: "memory")
#define PG8_BAR __builtin_amdgcn_s_barrier()
#define PG8_SCHED __builtin_amdgcn_sched_barrier(0)
    Unit cur, nxt; int ui = 0;
    if (!S.next(0, cur)) return;
    f32x4 acc[2][2][4][2];
#pragma unroll
    for (int a = 0; a < 2; ++a)
#pragma unroll
        for (int b = 0; b < 2; ++b)
#pragma unroll
            for (int m = 0; m < 4; ++m)
#pragma unroll
                for (int n = 0; n < 2; ++n) acc[a][b][m][n] = (f32x4){0.f, 0.f, 0.f, 0.f};
    bf16x8 At[4][2], B0[2][2], B1[2][2];
    const char* cA = (const char*)g.A + (size_t)cur.pm * tstepA; const char* cB = (const char*)g.Bt + (size_t)cur.pn * tstepB;
    S.a_ready(cur);
    if constexpr (SP2) {
        PG8_STAGE(PG8_SB(0, 0), cB, voffB); PG8_STAGE(PG8_SB(0, 1), cB + hstepB, voffB); PG8_STAGE(PG8_SA(0, 0), cA, voffA); PG8_STAGE(PG8_SA(0, 1), cA + hstepA, voffA);
        if (wr == 1) PG8_BAR;
        PG8_WAIT_V(2); PG8_BAR;
        PG8_STAGE(PG8_SB(1, 0), cB + kstep, voffB); PG8_STAGE(PG8_SA(1, 0), cA + kstep, voffA); PG8_STAGE(PG8_SB(1, 1), cB + hstepB + kstep, voffB);
        PG8_WAIT_V(6); PG8_BAR;
    } else {
        PG8_STAGE(PG8_SB(0, 0), cB, voffB); PG8_STAGE(PG8_SA(0, 0), cA, voffA); PG8_STAGE(PG8_SB(0, 1), cB + hstepB, voffB); PG8_STAGE(PG8_SA(0, 1), cA + hstepA, voffA);
        if (wr == 1) PG8_BAR;
        PG8_WAIT_V(4); PG8_BAR;
        PG8_STAGE(PG8_SB(1, 0), cB + kstep, voffB); PG8_STAGE(PG8_SA(1, 0), cA + kstep, voffA); PG8_STAGE(PG8_SB(1, 1), cB + hstepB + kstep, voffB);
        PG8_WAIT_V(6); PG8_BAR;
    }
    for (;;) {
        const bool has_next = S.next(ui + 1, nxt);
        const char* nA = has_next ? (const char*)g.A + (size_t)nxt.pm * tstepA : cA; const char* nB = has_next ? (const char*)g.Bt + (size_t)nxt.pn * tstepB : cB;
        for (int t = 0; t < nt; t += 2) {
            const bool last = (t == nt - 2);
            const char* a1 = cA + (size_t)(t + 1) * kstep;
            const char* a2 = last ? nA : cA + (size_t)(t + 2) * kstep; const char* b2 = last ? nB : cB + (size_t)(t + 2) * kstep;
            const char* a3 = a2 + kstep; const char* b3 = b2 + kstep;
            if (last && has_next) S.a_ready(nxt);
            if constexpr (SP2) {
            PG8_LDB(B0, 0, 0); PG8_LDB(B1, 0, 1); PG8_SCHED; PG8_LDA(At, 0, 0); PG8_STAGE(PG8_SA(1, 1), a1 + hstepA, voffA);
            PG8_WAIT_V(8); PG8_WAIT_L(0); PG8_BAR; PG8_MMA(0, 0, At, B0); PG8_MMA(0, 1, At, B1); PG8_BAR; PG8_SCHED;
            PG8_LDA(At, 0, 1); PG8_STAGE(PG8_SB(0, 0), b2, voffB); PG8_STAGE(PG8_SB(0, 1), b2 + hstepB, voffB); PG8_STAGE(PG8_SA(0, 0), a2, voffA);
            PG8_WAIT_V(8); PG8_WAIT_L(0); PG8_BAR; PG8_MMA(1, 0, At, B0); PG8_MMA(1, 1, At, B1); PG8_BAR; PG8_SCHED;
            PG8_LDB(B0, 1, 0); PG8_LDB(B1, 1, 1); PG8_SCHED; PG8_LDA(At, 1, 0); PG8_STAGE(PG8_SA(0, 1), a2 + hstepA, voffA);
            PG8_WAIT_V(8); PG8_WAIT_L(0); PG8_BAR; PG8_MMA(0, 0, At, B0); PG8_MMA(0, 1, At, B1); PG8_BAR; PG8_SCHED;
            PG8_LDA(At, 1, 1); PG8_STAGE(PG8_SB(1, 0), b3, voffB); PG8_STAGE(PG8_SB(1, 1), b3 + hstepB, voffB); PG8_STAGE(PG8_SA(1, 0), a3, voffA);
            PG8_WAIT_V(8); PG8_WAIT_L(0); PG8_BAR; PG8_MMA(1, 0, At, B0); PG8_MMA(1, 1, At, B1); PG8_BAR; PG8_SCHED;
            } else {
            PG8_LDB(B0, 0, 0); PG8_SCHED; PG8_LDA(At, 0, 0); PG8_STAGE(PG8_SA(1, 1), a1 + hstepA, voffA);
            PG8_WAIT_L(8); PG8_BAR; PG8_WAIT_L(0); PG8_MMA(0, 0, At, B0); PG8_BAR; PG8_SCHED;
            PG8_LDB(B1, 0, 1); PG8_STAGE(PG8_SB(0, 0), b2, voffB);
            PG8_BAR; PG8_WAIT_L(0); PG8_MMA(0, 1, At, B1); PG8_BAR;
            PG8_LDA(At, 0, 1); PG8_STAGE(PG8_SA(0, 0), a2, voffA);
            PG8_BAR; PG8_WAIT_L(0); PG8_MMA(1, 0, At, B0); PG8_BAR; PG8_SCHED;
            PG8_STAGE(PG8_SB(0, 1), b2 + hstepB, voffB);
            PG8_WAIT_V(6); PG8_BAR; PG8_MMA(1, 1, At, B1); PG8_BAR;
            PG8_LDB(B0, 1, 0); PG8_SCHED; PG8_LDA(At, 1, 0); PG8_STAGE(PG8_SA(0, 1), a2 + hstepA, voffA);
            PG8_WAIT_L(8); PG8_BAR; PG8_WAIT_L(0); PG8_MMA(0, 0, At, B0); PG8_BAR; PG8_SCHED;
            PG8_LDB(B1, 1, 1); PG8_STAGE(PG8_SB(1, 0), b3, voffB);
            PG8_BAR; PG8_WAIT_L(0); PG8_MMA(0, 1, At, B1); PG8_BAR;
            PG8_LDA(At, 1, 1); PG8_STAGE(PG8_SA(1, 0), a3, voffA);
            PG8_BAR; PG8_WAIT_L(0); PG8_MMA(1, 0, At, B0); PG8_BAR; PG8_SCHED;
            PG8_STAGE(PG8_SB(1, 1), b3 + hstepB, voffB);
            PG8_WAIT_V(6); PG8_BAR; PG8_MMA(1, 1, At, B1); PG8_BAR;
            }
        }
        if constexpr (ALIGN_EPI) { if (wr == 0) PG8_BAR; }
        if constexpr (!Epi::AFTER_DRAIN) { E(acc, cur, wr, wc, fr, fq); S.done(cur); }
        if (!has_next) break;
#pragma unroll
        for (int a = 0; a < 2; ++a)
#pragma unroll
            for (int b = 0; b < 2; ++b)
#pragma unroll
                for (int m = 0; m < 4; ++m)
#pragma unroll
                    for (int n = 0; n < 2; ++n) acc[a][b][m][n] = (f32x4){0.f, 0.f, 0.f, 0.f};
        cur = nxt; cA = nA; cB = nB; ++ui;
        if constexpr (ALIGN_EPI) { if (wr == 1) PG8_BAR; }
    }
    PG8_WAIT_V(0);
    if constexpr (!ALIGN_EPI) { if (wr == 0) PG8_BAR; }
    PG8_BAR;
    if constexpr (Epi::AFTER_DRAIN) { E.fused(acc, cur, wr, wc, fr, fq, lds, wid, lane); S.done(cur); }
#undef PG8_SA
#undef PG8_SB
#undef PG8_STAGE
#undef PG8_LDA
#undef PG8_LDB
#undef PG8_MMA
#undef PG8_WAIT_V
#undef PG8_WAIT_L
#undef PG8_BAR
#undef PG8_SCHED
}
}

typedef const pg8::f32x4 (&AccRef)[2][2][4][2];
struct EpiSwiglu {
    static constexpr bool PERM = true, AFTER_DRAIN = false;
    bf16_t* H;
    DI void operator()(AccRef acc, const pg8::Unit& u, int wr, int wc, int fr, int fq) const {
        const int row0 = u.pm * 256 + wr * 64 + fr, col = u.pn * 128 + wc * 32 + 8 * fq;
#pragma unroll
        for (int ai = 0; ai < 2; ++ai)
#pragma unroll
            for (int m = 0; m < 4; ++m) {
                const int row = row0 + ai * 128 + m * 16; float f[8];
#pragma unroll
                for (int n = 0; n < 2; ++n)
#pragma unroll
                    for (int e = 0; e < 4; ++e) f[n * 4 + e] = siluf_(acc[ai][0][m][n][e]) * acc[ai][1][m][n][e];
                *(u32x4*)(H + (size_t)row * DFF + col) = pack8(f);
            }
    }
};
struct EpiResid {
    static constexpr bool PERM = true, AFTER_DRAIN = false;
    float* xlat; float* xc; const float* gate; float coef;
    DI void operator()(AccRef acc, const pg8::Unit& u, int wr, int wc, int fr, int fq) const {
        const int r0 = u.pm * 256; const int vec = r0 < NLAT ? (r0 >> 13) : 2;
        const float* gp = gate + vec * 9216;
        float* base = r0 < NLAT ? xlat + (size_t)r0 * DM : xc + (size_t)(r0 - NLAT) * DM;
#pragma unroll
        for (int bj = 0; bj < 2; ++bj) {
            const int col = u.pn * 256 + bj * 128 + wc * 32 + 8 * fq;
            const f32x4 g0 = *(const f32x4*)(gp + col) * coef, g1 = *(const f32x4*)(gp + col + 4) * coef;
#pragma unroll
            for (int ai = 0; ai < 2; ++ai)
#pragma unroll
                for (int m = 0; m < 4; ++m) {
                    float* xp = base + (size_t)(wr * 64 + fr + ai * 128 + m * 16) * DM + col;
                    f32x4 x0 = *(f32x4*)xp, x1 = *(f32x4*)(xp + 4);
                    x0 += g0 * acc[ai][bj][m][0]; x1 += g1 * acc[ai][bj][m][1];
                    *(f32x4*)xp = x0; *(f32x4*)(xp + 4) = x1;
                }
        }
    }
};
struct EpiWin {
    static constexpr bool PERM = true, AFTER_DRAIN = false;
    bf16_t* Z;
    DI void operator()(AccRef acc, const pg8::Unit& u, int wr, int wc, int fr, int fq) const {
        const int row0 = u.pm * 256 + wr * 64 + fr;
#pragma unroll
        for (int bj = 0; bj < 2; ++bj) {
            const int col = u.pn * 256 + bj * 128 + wc * 32 + 8 * fq;
            if (col >= ZW) continue;
            const int mode = (col >= ZC_RL && col < ZC_RL + 128) ? 1 : ((col >= ZC_RL + 256 && col < ZC_AQ) ? 2 : 0);
#pragma unroll
            for (int ai = 0; ai < 2; ++ai)
#pragma unroll
                for (int m = 0; m < 4; ++m) {
                    const int row = row0 + ai * 128 + m * 16; float f[8];
#pragma unroll
                    for (int n = 0; n < 2; ++n)
#pragma unroll
                        for (int e = 0; e < 4; ++e) { float v = acc[ai][bj][m][n][e]; if (mode == 1) v = 1.f - 2.f * __builtin_amdgcn_rcpf(1.f + __expf(2.f * v)); else if (mode == 2) v = sigmoidf_(v); f[n * 4 + e] = v; }
                    *(u32x4*)(Z + (size_t)row * ZW + col) = pack8(f);
                }
        }
    }
};
struct EpiLora {
    static constexpr bool PERM = true, AFTER_DRAIN = false;
    bf16_t* RWA; bf16_t* RG; const float* w0; const float* a0;
    DI void operator()(AccRef acc, const pg8::Unit& u, int wr, int wc, int fr, int fq) const {
        const int row0 = u.pm * 256 + wr * 64 + fr;
#pragma unroll
        for (int bj = 0; bj < 2; ++bj) {
            const int col = u.pn * 256 + bj * 128 + wc * 32 + 8 * fq; const int seg = col >> 9, cc = col & 511;
            const float* bp = seg < 2 ? w0 + seg * 512 + cc : a0 + (seg & 1) * 512 + cc;
#pragma unroll
            for (int ai = 0; ai < 2; ++ai)
#pragma unroll
                for (int m = 0; m < 4; ++m) {
                    const int row = row0 + ai * 128 + m * 16; float f[8];
#pragma unroll
                    for (int n = 0; n < 2; ++n)
#pragma unroll
                        for (int e = 0; e < 4; ++e) {
                            float v = acc[ai][bj][m][n][e] + (seg < 4 ? bp[n * 4 + e] : 0.f);
                            if (seg < 2) { const float ee = 0.60653066f * sigmoidf_(v); v = 1.f - __expf(-ee); } else if (seg < 4) v = sigmoidf_(v);
                            f[n * 4 + e] = v;
                        }
                    if (seg < 4) *(u32x4*)(RWA + (size_t)row * 2048 + col) = pack8(f); else *(u32x4*)(RG + (size_t)row * 512 + cc) = pack8(f);
                    __builtin_amdgcn_sched_barrier(0);
                }
        }
    }
};
struct EpiGate {
    static constexpr bool PERM = true, AFTER_DRAIN = false;
    bf16_t* G;
    DI void operator()(AccRef acc, const pg8::Unit& u, int wr, int wc, int fr, int fq) const {
        const int row0 = u.pm * 256 + wr * 64 + fr;
#pragma unroll
        for (int bj = 0; bj < 2; ++bj) {
            const int col = u.pn * 256 + bj * 128 + wc * 32 + 8 * fq;
#pragma unroll
            for (int ai = 0; ai < 2; ++ai)
#pragma unroll
                for (int m = 0; m < 4; ++m) {
                    const int row = row0 + ai * 128 + m * 16; float f[8];
#pragma unroll
                    for (int n = 0; n < 2; ++n)
#pragma unroll
                        for (int e = 0; e < 4; ++e) f[n * 4 + e] = sigmoidf_(acc[ai][bj][m][n][e]);
                    *(u32x4*)(G + (size_t)row * DM + col) = pack8(f);
                }
        }
    }
};
struct EpiBranch {
    static constexpr bool PERM = true, AFTER_DRAIN = false;
    const bf16_t* G; bf16_t* ZZ; int first;
    DI void operator()(AccRef acc, const pg8::Unit& u, int wr, int wc, int fr, int fq) const {
        const int row0 = u.pm * 256 + wr * 64 + fr;
#pragma unroll
        for (int bj = 0; bj < 2; ++bj) {
            const int col = u.pn * 256 + bj * 128 + wc * 32 + 8 * fq;
#pragma unroll
            for (int ai = 0; ai < 2; ++ai)
#pragma unroll
                for (int m = 0; m < 4; ++m) {
                    const size_t off = (size_t)(row0 + ai * 128 + m * 16) * DM + col; float g[8], o[8], f[8];
                    unpack8(*(const u32x4*)(G + off), g);
                    if (first) {
#pragma unroll
                        for (int e = 0; e < 8; ++e) o[e] = 0.f;
                    } else unpack8(*(const u32x4*)(ZZ + off), o);
#pragma unroll
                    for (int n = 0; n < 2; ++n)
#pragma unroll
                        for (int e = 0; e < 4; ++e) f[n * 4 + e] = o[n * 4 + e] + g[n * 4 + e] * acc[ai][bj][m][n][e];
                    *(u32x4*)(ZZ + off) = pack8(f);
                }
        }
    }
};
template <class Epi> DI void run_gemm(const int wv, unsigned char* smem, const bf16_t* A, int lda, const bf16_t* Bt, int M, int N, int K, const Epi& E) {
    pg8::Gemm g; g.A = A; g.Bt = Bt; g.M = M; g.N = N; g.K = launder_s(K); g.lda = launder_s(lda); g.tid0 = wv * 64 + lane_id_();
    pg8::StaticOrder S; S.init(M, N, (int)gridDim.x, launder_s((int)blockIdx.x));
    pg8::gemm_phase<Epi, pg8::StaticOrder, true, true>((PG8_LAS unsigned char*)smem, g, S, E);
    __syncthreads();
}

struct Prm {
    const float *x, *c, *ctx, *cctx, *w_ada, *b_ada, *norm_g, *f1gu, *f1dn, *f2gu, *f2dn, *w_in, *m_conv, *m_gb, *m_on, *r_conv, *r_w0, *r_w2, *r_a0, *r_a2, *r_g2,
        *r_kk, *r_ka, *r_rk, *r_lnw, *r_lnb, *a_qkn, *a_lam, *a_subln, *w_br, *w_o;
    float* out; unsigned char* ws; int wv, pad;
};
#define PH_IDS const int tid_l = launder_v(p.wv * 64 + lane_id_()); const int bid_l = launder_s((int)blockIdx.x); (void)tid_l; (void)bid_l;
#define TID tid_l
#define BID bid_l
#define NBLK ((int)gridDim.x)

DI void ph_modpart(const Prm& p, unsigned char* smem) { PH_IDS
    float* sc = (float*)smem; float* modp = (float*)(p.ws + WS_MODP);
    for (int it = BID; it < 576; it += NBLK) {
        const int l = it / 288, r = it % 288, ks = r / 18, cb = r % 18;
        __syncthreads();
        if (TID < 192) { const int v = TID >> 6, k = ks * 64 + (TID & 63); const float cv = v < 2 ? p.c[v * DM + k] : p.cctx[k]; sc[TID] = siluf_(cv); }
        __syncthreads();
        const int col = cb * 512 + TID; float a0 = 0.f, a1 = 0.f, a2 = 0.f;
        const float* w = p.w_ada + ((size_t)l * DM + ks * 64) * 9216 + col;
#pragma unroll 8
        for (int k = 0; k < 64; ++k) { const float wv = w[(size_t)k * 9216]; a0 += sc[k] * wv; a1 += sc[64 + k] * wv; a2 += sc[128 + k] * wv; }
        float* o = modp + ((size_t)(l * 16 + ks) * 3) * 9216 + col; o[0] = a0; o[9216] = a1; o[2 * 9216] = a2;
    }
    __syncthreads();
}
DI void ph_rope(const Prm& p) { PH_IDS
    float* rope = (float*)(p.ws + WS_ROPE);
    for (int i = BID * 512 + TID; i < SEQL * 32; i += NBLK * 512) {
        const int t = i >> 5, pp = i & 31, j = pp & 15;
        const float inv = powf(10000.f, -(float)j / 16.f); const float pos = (float)(pp < 16 ? (t >> 6) : (t & 63)); const float ang = pos * inv;
        rope[2 * i] = cosf(ang); rope[2 * i + 1] = sinf(ang);
    }
}
DI void ph_modreduce(const Prm& p) { PH_IDS
    const float* modp = (const float*)(p.ws + WS_MODP); float* mods = (float*)(p.ws + WS_MODS);
    for (int i = BID * 512 + TID; i < 2 * 3 * 9216; i += NBLK * 512) {
        const int l = i / 27648, rem = i % 27648, v = rem / 9216, col = rem % 9216;
        float s = p.b_ada[l * 9216 + col];
        for (int ks = 0; ks < 16; ++ks) s += modp[((size_t)(l * 16 + ks) * 3 + v) * 9216 + col];
        mods[i] = s;
    }
}
template <int MODE> DI void conv_weight(const Prm& p, const float* src, int ld, int c0, int K, int ncols, bf16_t* dst, unsigned char* smem) { PH_IDS
    float* t = (float*)smem; const int ntk = K / 64, ntn = (ncols + 63) / 64, tx = TID & 63, ty = TID >> 6;
    for (int it = BID; it < ntk * ntn; it += NBLK) {
        const int kt = it % ntk, nt = it / ntk;
        __syncthreads();
#pragma unroll
        for (int i = 0; i < 8; ++i) { const int k = ty * 8 + i, j = nt * 64 + tx; t[k * 65 + tx] = j < ncols ? src[(size_t)(kt * 64 + k) * ld + c0 + j] : 0.f; }
        __syncthreads();
#pragma unroll
        for (int i = 0; i < 8; ++i) {
            const int n = ty * 8 + i, j = nt * 64 + n;
            if (j < ncols) {
                int drow = j;
                if (MODE == 1) drow = j < DFF ? ((j >> 7) * 256 + (j & 127)) : (((j - DFF) >> 7) * 256 + 128 + ((j - DFF) & 127));
                dst[(size_t)drow * K + kt * 64 + tx] = f2bf(t[tx * 65 + n]);
            }
        }
    }
    __syncthreads();
}
DI void conv_ffn(const Prm& p, int l, int which, unsigned char* smem) {
    bf16_t* wt = (bf16_t*)(p.ws + WS_WT);
    conv_weight<1>(p, (which ? p.f2gu : p.f1gu) + (size_t)l * DM * 2 * DFF, 2 * DFF, 0, DM, 2 * DFF, wt + WT_GU, smem);
    conv_weight<0>(p, (which ? p.f2dn : p.f1dn) + (size_t)l * DFF * DM, DM, 0, DFF, DM, wt + WT_DN, smem);
}
DI void conv_mixer(const Prm& p, int l, unsigned char* smem) { PH_IDS
    bf16_t* wt = (bf16_t*)(p.ws + WS_WT);
    conv_weight<0>(p, p.w_in + (size_t)l * DM * DIN, DIN, 0, DM, ZW, wt + WT_IN, smem);
    conv_weight<0>(p, p.w_in + (size_t)l * DM * DIN, DIN, ZW, DM, 3 * DM, wt + WT_G, smem);
    for (int b = 0; b < 3; ++b) conv_weight<0>(p, p.w_br + (size_t)(l * 3 + b) * 512 * DM, DM, 0, 512, DM, wt + WT_P + (size_t)b * DM * 512, smem);
    conv_weight<0>(p, p.w_o + (size_t)l * DM * DM, DM, 0, DM, DM, wt + WT_O, smem);
    bf16_t* wl = wt + WT_L;
    for (int i = BID * 512 + TID; i < 2560 * 384; i += NBLK * 512) {
        const int n = i / 384, k = i % 384, seg = n >> 9, cc = n & 511; float v = 0.f;
        if (seg < 2) { if ((k >> 6) == seg) v = p.r_w2[((size_t)(l * 2 + seg) * 64 + (k & 63)) * 512 + cc]; }
        else if (seg < 4) { if ((k >> 6) == seg) v = p.r_a2[((size_t)(l * 2 + seg - 2) * 64 + (k & 63)) * 512 + cc]; }
        else { if (k >= 256) v = p.r_g2[((size_t)l * 128 + (k - 256)) * 512 + cc]; }
        wl[i] = f2bf(v);
    }
}
DI void ph_norm(const Prm& p, int l, int which, bool first) { PH_IDS
    const int lane = TID & 63, wid = TID >> 6;
    const float* g = p.norm_g + (l * 3 + which) * DM; const float* mods = (const float*)(p.ws + WS_MODS) + (size_t)l * 27648;
    bf16_t* hb = (bf16_t*)(p.ws + WS_RWA); float* xc = (float*)(p.ws + WS_XC);
    for (int row = BID * 8 + wid; row < NTOK; row += NBLK * 8) {
        const int vec = row < NLAT ? (row >> 13) : 2;
        const float* sh = mods + vec * 9216 + (3 * which) * DM; const float* scl = sh + DM;
        float* xd = row < NLAT ? p.out + (size_t)row * DM : xc + (size_t)(row - NLAT) * DM;
        const float* xr = first ? (row < NLAT ? p.x + (size_t)row * DM : p.ctx + (size_t)(row - NLAT) * DM) : xd;
        f32x4 xv[4]; float ss = 0.f;
#pragma unroll
        for (int i = 0; i < 4; ++i) { xv[i] = *(const f32x4*)(xr + i * 256 + lane * 4); ss += xv[i][0] * xv[i][0] + xv[i][1] * xv[i][1] + xv[i][2] * xv[i][2] + xv[i][3] * xv[i][3]; }
        ss = wave_sum(ss); const float rinv = rsqrtf(ss * (1.f / DM) + 1e-6f);
#pragma unroll
        for (int i = 0; i < 4; ++i) {
            const int col = i * 256 + lane * 4;
            if (first) *(f32x4*)(xd + col) = xv[i];
            const f32x4 gv = *(const f32x4*)(g + col), sv = *(const f32x4*)(scl + col), hv = *(const f32x4*)(sh + col);
            float h[4];
#pragma unroll
            for (int e = 0; e < 4; ++e) h[e] = xv[i][e] * rinv * gv[e] * (1.f + sv[e]) + hv[e];
            u32x2 o; o.x = pk2(h[0], h[1]); o.y = pk2(h[2], h[3]);
            *(u32x2*)(hb + (size_t)row * DM + col) = o;
        }
    }
}
DI void ph_zero_ysum(const Prm& p) { PH_IDS
    f32x4* y = (f32x4*)(p.ws + WS_YSUM); const f32x4 zr = {0.f, 0.f, 0.f, 0.f};
    for (int i = BID * 512 + TID; i < NTOK * 128; i += NBLK * 512) y[i] = zr;
}
DI void ph_rkv_conv(const Prm& p, int l) { PH_IDS
    const int lane = TID & 63, wid = TID >> 6;
    const bf16_t* z = (const bf16_t*)(p.ws + WS_Z); bf16_t* tmp = (bf16_t*)(p.ws + WS_RWA); float* invn = (float*)(p.ws + WS_INVN);
    const float* cw = p.r_conv + (size_t)l * 3 * 1536;
    for (int row = BID * 8 + wid; row < NTOK; row += NBLK * 8) {
        const int t = row < NLAT ? (row & 8191) : ((row - NLAT) & 255), L = row < NLAT ? SEQL : CTXL;
        const bool hp = t > 0, hn = t < L - 1;
#pragma unroll
        for (int g = 0; g < 3; ++g) {
            const int ch = g * 512 + lane * 8; const bf16_t* zp = z + (size_t)row * ZW + ZC_RR + ch;
            const u32x4 zero = {0u, 0u, 0u, 0u};
            const u32x4 uc = *(const u32x4*)zp, up = hp ? *(const u32x4*)(zp - ZW) : zero, un = hn ? *(const u32x4*)(zp + ZW) : zero;
            float c[8], pv[8], nx[8], o[8]; unpack8(uc, c); unpack8(up, pv); unpack8(un, nx);
#pragma unroll
            for (int e = 0; e < 8; ++e) o[e] = cw[ch + e] * pv[e] + cw[1536 + ch + e] * c[e] + cw[3072 + ch + e] * nx[e];
            *(u32x4*)(tmp + (size_t)row * 1536 + ch) = pack8(o);
            if (g == 1) {
                float ss = 0.f;
#pragma unroll
                for (int e = 0; e < 8; ++e) { const float kk = o[e] * p.r_kk[l * 512 + lane * 8 + e]; ss += kk * kk; }
                ss += __shfl_xor(ss, 1); ss += __shfl_xor(ss, 2); ss += __shfl_xor(ss, 4);
                if ((lane & 7) == 0) invn[(size_t)row * 8 + (lane >> 3)] = 1.f / fmaxf(sqrtf(ss), 1e-12f);
            }
        }
    }
}
DI void ph_rkv_copy(const Prm& p) { PH_IDS
    const int lane = TID & 63, wid = TID >> 6;
    bf16_t* z = (bf16_t*)(p.ws + WS_Z); const bf16_t* tmp = (const bf16_t*)(p.ws + WS_RWA);
    for (int row = BID * 8 + wid; row < NTOK; row += NBLK * 8)
#pragma unroll
        for (int g = 0; g < 3; ++g) { const int ch = g * 512 + lane * 8; *(u32x4*)(z + (size_t)row * ZW + ZC_RR + ch) = *(const u32x4*)(tmp + (size_t)row * 1536 + ch); }
}
DI void ph_attn_prep(const Prm& p, int l) { PH_IDS
    const int lane = TID & 63, wid = TID >> 6, hw = lane >> 5, pp = lane & 31;
    bf16_t* z = (bf16_t*)(p.ws + WS_Z); const float* rope = (const float*)(p.ws + WS_ROPE); const float* qkn = p.a_qkn + l * 128;
    for (int row = BID * 8 + wid; row < NTOK; row += NBLK * 8) {
        const bool islat = row < NLAT; const int t = row & 8191;
        float cs = 1.f, sn = 0.f; if (islat) { cs = rope[((size_t)t * 32 + pp) * 2]; sn = rope[((size_t)t * 32 + pp) * 2 + 1]; }
#pragma unroll
        for (int it = 0; it < 8; ++it) {
            const int seg = it * 2 + hw, which = seg >> 3, col = (which ? ZC_AK : ZC_AQ) + (seg & 7) * 64 + 2 * pp;
            unsigned* zp = (unsigned*)(z + (size_t)row * ZW + col);
            const unsigned u = *zp; const float x1 = lo16(u), x2 = hi16(u);
            float ss = x1 * x1 + x2 * x2;
            ss += __shfl_xor(ss, 1); ss += __shfl_xor(ss, 2); ss += __shfl_xor(ss, 4); ss += __shfl_xor(ss, 8); ss += __shfl_xor(ss, 16);
            const float rinv = rsqrtf(ss * (1.f / 64.f) + 1e-6f) * (which ? 1.f : 0.125f);
            const float y1 = x1 * rinv * qkn[which * 64 + 2 * pp], y2 = x2 * rinv * qkn[which * 64 + 2 * pp + 1];
            *zp = pk2(y1 * cs - y2 * sn, y1 * sn + y2 * cs);
        }
    }
}

#define MFMA16(a, b, c) __builtin_amdgcn_mfma_f32_16x16x32_bf16((a), (b), (c), 0, 0, 0)
#define MFMA32(a, b, c) __builtin_amdgcn_mfma_f32_32x32x16_bf16((a), (b), (c), 0, 0, 0)
DI float wave_incl_scan_add(float v, int lane) {
#pragma unroll
    for (int o = 1; o < 64; o <<= 1) { const float t = __shfl_up(v, o); if (lane >= o) v += t; }
    return v;
}
DI float wave_incl_scan_max(float v, int lane) {
#pragma unroll
    for (int o = 1; o < 64; o <<= 1) { const float t = __shfl_up(v, o); if (lane >= o) v = fmaxf(v, t); }
    return v;
}
DI float mconv(const bf16_t* z, const float* cw, size_t row, int t, int L, int ch) {
    const bf16_t* zp = z + row * ZW + ch;
    float a = cw[512 + ch] * bf2f(zp[0]);
    if (t > 0) a += cw[ch] * bf2f(zp[-ZW]);
    if (t < L - 1) a += cw[1024 + ch] * bf2f(zp[ZW]);
    return siluf_(a);
}
DI void ph_mlstm_a(const Prm& p, int l, unsigned char* smem) { PH_IDS
    const int lane = TID & 63, wid = TID >> 6;
    const bf16_t* z = (const bf16_t*)(p.ws + WS_Z); bf16_t* mst = (bf16_t*)(p.ws + WS_MST); float* msc = (float*)(p.ws + WS_MSC); float* mn = (float*)(p.ws + WS_MN);
    const float* cw = p.m_conv + (size_t)l * 3 * 512; const float* gb = p.m_gb + l * 16;
    bf16_t* kT = (bf16_t*)smem; bf16_t* vT = (bf16_t*)(smem + 9216); float* wsl = (float*)(smem + 9216 + 18432);
    for (int u = BID; u < 2112; u += NBLK) {
        const int d = u / 1056, r = u % 1056, b = r / 528, h = (r % 528) / NCHK, c = r % NCHK;
        const int slot = ((d * 2 + b) * 4 + h) * NCHK + c;
        const bool isctx = c < 4; const int cs = isctx ? c : c - 4, nch = isctx ? 4 : 128, oc = d ? nch - 1 - cs : cs, L = isctx ? CTXL : SEQL;
        const size_t base = isctx ? (size_t)NLAT + b * CTXL + oc * 64 : (size_t)b * SEQL + oc * 64;
        __syncthreads();
        if (wid == 0) {
            const int o = d ? 63 - lane : lane; const bf16_t* zr = z + (base + o) * ZW + ZC_MG + 8 * d + h;
            const float ig = bf2f(zr[0]) + gb[(2 * d) * 4 + h], lf = logsigf_(bf2f(zr[4]) + gb[(2 * d + 1) * 4 + h]);
            const float bc = wave_incl_scan_add(lf, lane), bt = __shfl(bc, 63), wl = bt - bc + ig, ml = wave_max(wl);
            wsl[lane] = __expf(wl - ml);
            if (lane == 0) { msc[slot * 4] = bt; msc[slot * 4 + 1] = ml; }
        }
        __syncthreads();
#pragma unroll
        for (int i = 0; i < 8; ++i) {
            const int idx = TID + 512 * i, dq = idx & 63, pp = idx >> 6, o = d ? 63 - pp : pp;
            kT[dq * 72 + pp] = f2bf(mconv(z, cw, base + o, oc * 64 + o, L, 256 + h * 64 + dq) * 0.125f);
        }
#pragma unroll
        for (int i = 0; i < 16; ++i) {
            const int idx = TID + 512 * i, vv = idx & 127, pp = idx >> 7, o = d ? 63 - pp : pp;
            vT[vv * 72 + pp] = f2bf(bf2f(z[(base + o) * ZW + ZC_MV + h * 128 + vv]) * wsl[pp]);
        }
        __syncthreads();
        f32x4 acc[4];
#pragma unroll
        for (int nt = 0; nt < 4; ++nt) acc[nt] = (f32x4){0.f, 0.f, 0.f, 0.f};
#pragma unroll
        for (int ks = 0; ks < 2; ++ks) {
            const bf16x8 a = *(const bf16x8*)(vT + (16 * wid + (lane & 15)) * 72 + ks * 32 + (lane >> 4) * 8);
#pragma unroll
            for (int nt = 0; nt < 4; ++nt) { const bf16x8 bb = *(const bf16x8*)(kT + (16 * nt + (lane & 15)) * 72 + ks * 32 + (lane >> 4) * 8); acc[nt] = MFMA16(a, bb, acc[nt]); }
        }
#pragma unroll
        for (int nt = 0; nt < 4; ++nt)
#pragma unroll
            for (int j = 0; j < 4; ++j) mst[(size_t)slot * 8192 + (16 * wid + (lane >> 4) * 4 + j) * 64 + 16 * nt + (lane & 15)] = f2bf(acc[nt][j]);
        if (TID < 64) { float s = 0.f; for (int pp = 0; pp < 64; ++pp) s += wsl[pp] * bf2f(kT[TID * 72 + pp]); mn[slot * 64 + TID] = s; }
    }
    __syncthreads();
}
DI void ph_mlstm_b(const Prm& p) { PH_IDS
    bf16_t* mst = (bf16_t*)(p.ws + WS_MST); float* msc = (float*)(p.ws + WS_MSC); float* mn = (float*)(p.ws + WS_MN);
    for (int e = BID * 512 + TID; e < 16 * 8256; e += NBLK * 512) {
        const int chain = e / 8256, idx = e % 8256; float m = 0.f, C = 0.f;
        for (int c0 = 0; c0 < NCHK; c0 += 12) {
            float uu[12], bt[12], ml[12];
#pragma unroll
            for (int j = 0; j < 12; ++j) {
                const int slot = chain * NCHK + c0 + j; bt[j] = msc[slot * 4]; ml[j] = msc[slot * 4 + 1];
                uu[j] = idx < 8192 ? bf2f(mst[(size_t)slot * 8192 + idx]) : mn[slot * 64 + idx - 8192];
            }
#pragma unroll
            for (int j = 0; j < 12; ++j) {
                const int slot = chain * NCHK + c0 + j;
                if (idx < 8192) mst[(size_t)slot * 8192 + idx] = f2bf(C); else mn[slot * 64 + idx - 8192] = C;
                if (idx == 0) msc[slot * 4 + 2] = m;
                const float mnew = fmaxf(bt[j] + m, ml[j]);
                C = __expf(bt[j] + m - mnew) * C + __expf(ml[j] - mnew) * uu[j]; m = mnew;
            }
        }
    }
}
DI void ph_mlstm_c(const Prm& p, int l, unsigned char* smem, int ubeg, int ustride) { PH_IDS
    const int lane = TID & 63, wid = TID >> 6;
    bf16_t* z = (bf16_t*)(p.ws + WS_Z); const bf16_t* mst = (const bf16_t*)(p.ws + WS_MST); const float* msc = (const float*)(p.ws + WS_MSC); const float* mn = (const float*)(p.ws + WS_MN);
    const float* cw = p.m_conv + (size_t)l * 3 * 512; const float* gb = p.m_gb + l * 16;
    bf16_t* qs = (bf16_t*)smem; bf16_t* ks_ = (bf16_t*)(smem + 9216); bf16_t* vT = (bf16_t*)(smem + 18432); bf16_t* Sp = (bf16_t*)(smem + 36864);
    float* hsum = (float*)(smem + 46080); float* fa = (float*)(smem + 46080 + 33792);
    float *bcum = fa, *gg = fa + 64, *Mrow = fa + 128, *iw = fa + 192, *den = fa + 256, *nq = fa + 320;
    for (int u = ubeg; u < 1056; u += ustride) {
        const int b = u / 528, h = (u % 528) / NCHK, cc = u % NCHK;
        const bool isctx = cc < 4; const int oc = isctx ? cc : cc - 4, nch = isctx ? 4 : 128, L = isctx ? CTXL : SEQL;
        const size_t base = isctx ? (size_t)NLAT + b * CTXL + oc * 64 : (size_t)b * SEQL + oc * 64;
        for (int d = 0; d < 2; ++d) {
            const int cs = d ? nch - 1 - oc : oc, c = isctx ? cs : cs + 4, slot = ((d * 2 + b) * 4 + h) * NCHK + c;
            const float mst_m = msc[slot * 4 + 2];
            __syncthreads();
            if (wid == 0) {
                const int o = d ? 63 - lane : lane; const bf16_t* zr = z + (base + o) * ZW + ZC_MG + 8 * d + h;
                const float ig = bf2f(zr[0]) + gb[(2 * d) * 4 + h], lf = logsigf_(bf2f(zr[4]) + gb[(2 * d + 1) * 4 + h]);
                const float bc = wave_incl_scan_add(lf, lane), g = ig - bc, pm = wave_incl_scan_max(g, lane), M = fmaxf(mst_m, pm);
                bcum[lane] = bc; gg[lane] = g; Mrow[lane] = M; iw[lane] = __expf(mst_m - M);
            }
#pragma unroll 2
            for (int i = 0; i < 16; ++i) {
                const int idx = TID + 512 * i, chq = idx & 127, pp = idx >> 7, o = d ? 63 - pp : pp, isk = chq >> 6, dq = chq & 63;
                const float v = mconv(z, cw, base + o, oc * 64 + o, L, isk * 256 + h * 64 + dq);
                if (isk) ks_[pp * 72 + dq] = f2bf(v * 0.125f); else qs[pp * 72 + dq] = f2bf(v);
            }
#pragma unroll 4
            for (int i = 0; i < 16; ++i) {
                const int idx = TID + 512 * i, vv = idx & 127, pp = idx >> 7, o = d ? 63 - pp : pp;
                vT[vv * 72 + pp] = z[(base + o) * ZW + ZC_MV + h * 128 + vv];
            }
            __syncthreads();
            {
                const int mt = wid >> 1;
#pragma unroll
                for (int nn = 0; nn < 2; ++nn) {
                    const int nt = 2 * (wid & 1) + nn; f32x4 acc = {0.f, 0.f, 0.f, 0.f};
#pragma unroll
                    for (int ks = 0; ks < 2; ++ks) {
                        const bf16x8 a = *(const bf16x8*)(qs + (16 * mt + (lane & 15)) * 72 + ks * 32 + (lane >> 4) * 8);
                        const bf16x8 bb = *(const bf16x8*)(ks_ + (16 * nt + (lane & 15)) * 72 + ks * 32 + (lane >> 4) * 8);
                        acc = MFMA16(a, bb, acc);
                    }
                    const int s = 16 * nt + (lane & 15);
#pragma unroll
                    for (int j = 0; j < 4; ++j) { const int pp = 16 * mt + (lane >> 4) * 4 + j; const float v = s <= pp ? acc[j] * __expf(gg[s] - Mrow[pp]) : 0.f; Sp[pp * 72 + s] = f2bf(v); }
                }
                if (TID < 64) { float s = 0.f; for (int dq = 0; dq < 64; ++dq) s += mn[slot * 64 + dq] * bf2f(qs[TID * 72 + dq]); nq[TID] = s; }
            }
            __syncthreads();
            if (TID < 64) { float s = 0.f; for (int k = 0; k < 64; ++k) s += bf2f(Sp[TID * 72 + k]); den[TID] = s + iw[TID] * nq[TID]; }
            f32x4 a1[4], a2[4];
#pragma unroll
            for (int mt = 0; mt < 4; ++mt) { a1[mt] = (f32x4){0.f, 0.f, 0.f, 0.f}; a2[mt] = (f32x4){0.f, 0.f, 0.f, 0.f}; }
#pragma unroll
            for (int ks = 0; ks < 2; ++ks) {
                const bf16x8 bv = *(const bf16x8*)(vT + (16 * wid + (lane & 15)) * 72 + ks * 32 + (lane >> 4) * 8);
                const bf16x8 bc = *(const bf16x8*)(mst + (size_t)slot * 8192 + (16 * wid + (lane & 15)) * 64 + ks * 32 + (lane >> 4) * 8);
#pragma unroll
                for (int mt = 0; mt < 4; ++mt) {
                    const bf16x8 as = *(const bf16x8*)(Sp + (16 * mt + (lane & 15)) * 72 + ks * 32 + (lane >> 4) * 8);
                    const bf16x8 aq = *(const bf16x8*)(qs + (16 * mt + (lane & 15)) * 72 + ks * 32 + (lane >> 4) * 8);
                    a1[mt] = MFMA16(as, bv, a1[mt]); a2[mt] = MFMA16(aq, bc, a2[mt]);
                }
            }
            __syncthreads();
            {
                const int vv = 16 * wid + (lane & 15);
#pragma unroll
                for (int mt = 0; mt < 4; ++mt)
#pragma unroll
                    for (int j = 0; j < 4; ++j) {
                        const int pp = 16 * mt + (lane >> 4) * 4 + j, o = d ? 63 - pp : pp;
                        const float val = (a1[mt][j] + iw[pp] * a2[mt][j]) / fmaxf(fabsf(den[pp]), __expf(-(bcum[pp] + Mrow[pp])));
                        if (d == 0) hsum[o * 132 + vv] = val; else hsum[o * 132 + vv] += val;
                    }
            }
        }
        __syncthreads();
#pragma unroll
        for (int i = 0; i < 8; ++i) {
            const int o = wid * 8 + i; const float x0 = hsum[o * 132 + lane], x1 = hsum[o * 132 + lane + 64];
            const float ss = wave_sum(x0 * x0 + x1 * x1), rinv = rsqrtf(ss * (1.f / 128.f) + 1e-6f);
            bf16_t* zo = z + (base + o) * ZW + ZC_MO + h * 128; const float* on = p.m_on + l * 512 + h * 128;
            zo[lane] = f2bf(x0 * rinv * on[lane] * sigmoidf_(bf2f(zo[lane])));
            zo[lane + 64] = f2bf(x1 * rinv * on[lane + 64] * sigmoidf_(bf2f(zo[lane + 64])));
        }
    }
    __syncthreads();
}
DI int swap23(int s) { return (s & ~12) | ((s & 4) << 1) | ((s & 8) >> 1); }
DI void ph_attn(const Prm& p, int l, unsigned char* smem, int ubeg, int ustride) { PH_IDS
    const int lane = TID & 63, wid = TID >> 6, q = lane & 31, hh = lane >> 5, qg = wid >> 1, mp = wid & 1;
    bf16_t* z = (bf16_t*)(p.ws + WS_Z);
    float lam; const float lam_init = 0.8f - 0.6f * expf(-0.3f * (float)l);
    { const float* lp = p.a_lam + l * 256; float s1 = 0.f, s2 = 0.f; for (int i = 0; i < 64; ++i) { s1 += lp[i] * lp[64 + i]; s2 += lp[128 + i] * lp[192 + i]; } lam = expf(s1) - expf(s2) + lam_init; }
    bf16_t* Qs = (bf16_t*)smem; float* ex = (float*)smem;
    constexpr int KB_OFF = 34816, VT_OFF = 69632;
    for (int u = ubeg; u < 528; u += ustride) {
        int b, head, nt; size_t qrow0;
        if (u < 512) { b = u >> 8; head = (u >> 6) & 3; qrow0 = (size_t)b * SEQL + (u & 63) * 128; nt = 132; }
        else { const int uu = u - 512; b = uu >> 3; head = (uu >> 1) & 3; qrow0 = (size_t)NLAT + b * CTXL + (uu & 1) * 128; nt = 4; }
        const bool lat = u < 512;
        __syncthreads();
#pragma unroll
        for (int i = 0; i < 4; ++i) { const int idx = TID + 512 * i, r = idx >> 4, cp = idx & 15; *(u32x4*)(Qs + r * 136 + cp * 8) = *(const u32x4*)(z + (qrow0 + r) * ZW + ZC_AQ + head * 128 + cp * 8); }
        u32x4 kreg[2], vreg[2];
        const int kp = TID & 31, vg = TID >> 5;
#define ATT_KROW0(j) ((lat && (j) >= 4) ? (size_t)b * SEQL + 64 * ((j) - 4) : (size_t)NLAT + b * CTXL + 64 * (j))
#define ATT_LOAD(j) do { const size_t kr0 = ATT_KROW0(j); \
            _Pragma("unroll") for (int i = 0; i < 2; ++i) { const int idx = TID + 512 * i, r = idx >> 4, cp = idx & 15; kreg[i] = *(const u32x4*)(z + (kr0 + r) * ZW + ZC_AK + head * 128 + cp * 8); } \
            _Pragma("unroll") for (int i = 0; i < 2; ++i) vreg[i] = *(const u32x4*)(z + (kr0 + 2 * kp + i) * ZW + ZC_AV + head * 128 + 8 * vg); } while (0)
#define ATT_WRITE(buf) do { bf16_t* Kw = (bf16_t*)(smem + KB_OFF + (buf) * 17408); bf16_t* Vw = (bf16_t*)(smem + VT_OFF + (buf) * 18432); \
            _Pragma("unroll") for (int i = 0; i < 2; ++i) { const int idx = TID + 512 * i, r = idx >> 4, cp = idx & 15; *(u32x4*)(Kw + r * 136 + cp * 8) = kreg[i]; } \
            _Pragma("unroll") for (int w = 0; w < 4; ++w) { \
                *(unsigned*)(Vw + (8 * vg + 2 * w) * 72 + 2 * kp) = (vreg[0][w] & 0xffffu) | (vreg[1][w] << 16); \
                *(unsigned*)(Vw + (8 * vg + 2 * w + 1) * 72 + 2 * kp) = (vreg[0][w] >> 16) | (vreg[1][w] & 0xffff0000u); } } while (0)
        ATT_LOAD(0); ATT_WRITE(0);
        __syncthreads();
        f32x16 o[4]; float mrun = -1e30f, lrun = 0.f;
#pragma unroll
        for (int dvb = 0; dvb < 4; ++dvb)
#pragma unroll
            for (int i = 0; i < 16; ++i) o[dvb][i] = 0.f;
        for (int j = 0; j < nt; ++j) {
            const int cur = j & 1;
            if (j + 1 < nt) ATT_LOAD(j + 1);
            const bf16_t* Kb = (const bf16_t*)(smem + KB_OFF + cur * 17408); const bf16_t* Vt = (const bf16_t*)(smem + VT_OFF + cur * 18432);
            f32x16 s0, s1;
#pragma unroll
            for (int i = 0; i < 16; ++i) { s0[i] = 0.f; s1[i] = 0.f; }
#pragma unroll
            for (int kk = 0; kk < 4; ++kk) {
                const bf16x8 qf = *(const bf16x8*)(Qs + (32 * qg + q) * 136 + mp * 64 + kk * 16 + hh * 8);
                const bf16x8 k0 = *(const bf16x8*)(Kb + swap23(q) * 136 + mp * 64 + kk * 16 + hh * 8);
                const bf16x8 k1 = *(const bf16x8*)(Kb + (32 + swap23(q)) * 136 + mp * 64 + kk * 16 + hh * 8);
                s0 = MFMA32(k0, qf, s0); s1 = MFMA32(k1, qf, s1);
            }
            float mx = s0[0];
#pragma unroll
            for (int i = 1; i < 16; ++i) mx = fmaxf(mx, s0[i]);
#pragma unroll
            for (int i = 0; i < 16; ++i) mx = fmaxf(mx, s1[i]);
            mx = fmaxf(mx, __shfl_xor(mx, 32));
            const float mnew = fmaxf(mrun, mx), alpha = __expf(mrun - mnew); mrun = mnew;
            float ps = 0.f;
#pragma unroll
            for (int i = 0; i < 16; ++i) { s0[i] = __expf(s0[i] - mnew); s1[i] = __expf(s1[i] - mnew); ps += s0[i] + s1[i]; }
            lrun = lrun * alpha + ps;
#pragma unroll
            for (int dvb = 0; dvb < 4; ++dvb)
#pragma unroll
                for (int i = 0; i < 16; ++i) o[dvb][i] *= alpha;
            bf16x8 pf[4];
#pragma unroll
            for (int cc = 0; cc < 2; ++cc) {
                u32x4 a, c2;
                a.x = pk2(s0[8 * cc], s0[8 * cc + 1]); a.y = pk2(s0[8 * cc + 2], s0[8 * cc + 3]); a.z = pk2(s0[8 * cc + 4], s0[8 * cc + 5]); a.w = pk2(s0[8 * cc + 6], s0[8 * cc + 7]);
                c2.x = pk2(s1[8 * cc], s1[8 * cc + 1]); c2.y = pk2(s1[8 * cc + 2], s1[8 * cc + 3]); c2.z = pk2(s1[8 * cc + 4], s1[8 * cc + 5]); c2.w = pk2(s1[8 * cc + 6], s1[8 * cc + 7]);
                pf[cc] = __builtin_bit_cast(bf16x8, a); pf[2 + cc] = __builtin_bit_cast(bf16x8, c2);
            }
#pragma unroll
            for (int dvb = 0; dvb < 4; ++dvb)
#pragma unroll
                for (int c = 0; c < 4; ++c) {
                    const bf16x8 vf = *(const bf16x8*)(Vt + (dvb * 32 + q) * 72 + 16 * c + 8 * hh);
                    o[dvb] = MFMA32(vf, pf[c], o[dvb]);
                }
            if (j + 1 < nt) ATT_WRITE(cur ^ 1);
            __syncthreads();
        }
        const float lsum = lrun + __shfl_xor(lrun, 32);
        const float inv = (mp ? lam : 1.f) / lsum;
        if (mp) {
#pragma unroll
            for (int dvb = 0; dvb < 4; ++dvb)
#pragma unroll
                for (int i = 0; i < 16; ++i) ex[(qg * 64 + dvb * 16 + i) * 64 + lane] = o[dvb][i] * inv;
        }
        __syncthreads();
        if (!mp) {
            float ss = 0.f;
#pragma unroll
            for (int dvb = 0; dvb < 4; ++dvb)
#pragma unroll
                for (int i = 0; i < 16; ++i) { const float v = o[dvb][i] * inv - ex[(qg * 64 + dvb * 16 + i) * 64 + lane]; o[dvb][i] = v; ss += v * v; }
            ss += __shfl_xor(ss, 32);
            const float rinv = rsqrtf(ss * (1.f / 128.f) + 1e-6f) * (1.f - lam_init);
            bf16_t* orow = z + (qrow0 + 32 * qg + q) * ZW + ZC_AQ + head * 128; const float* sub = p.a_subln + l * 128;
#pragma unroll
            for (int dvb = 0; dvb < 4; ++dvb)
#pragma unroll
                for (int ig = 0; ig < 4; ++ig) {
                    const int dv0 = dvb * 32 + 8 * ig + 4 * hh; u32x2 w;
                    w.x = pk2(o[dvb][4 * ig] * rinv * sub[dv0], o[dvb][4 * ig + 1] * rinv * sub[dv0 + 1]);
                    w.y = pk2(o[dvb][4 * ig + 2] * rinv * sub[dv0 + 2], o[dvb][4 * ig + 3] * rinv * sub[dv0 + 3]);
                    *(u32x2*)(orow + dv0) = w;
                }
        }
    }
    __syncthreads();
}

template <int CTRL> DI float dppf(float v) { return __int_as_float(__builtin_amdgcn_update_dpp(0, __float_as_int(v), CTRL, 0xf, 0xf, false)); }
DI float allreduce16(float x) { x += dppf<0x128>(x); x += dppf<0x124>(x); x += dppf<0x122>(x); x += dppf<0x121>(x); return x; }
DI void ph_rwkv_scan(const Prm& p, int l, unsigned char* smem, int ubeg, int ustride) { PH_IDS
    const int lane = TID & 63, wid = TID >> 6;
    const bf16_t* z = (const bf16_t*)(p.ws + WS_Z); const bf16_t* rwa = (const bf16_t*)(p.ws + WS_RWA); const float* invn = (const float*)(p.ws + WS_INVN);
    float* ysum = (float*)(p.ws + WS_YSUM);
    constexpr int TC = 32, OPW = 352, NC = 264, OPS_B = TC * OPW * 4, YP_OFF = 2 * OPS_B;
    for (int u = ubeg; u < 64; u += ustride) {
        const int chain = u >> 1, half = u & 1, d = chain >> 4, b = (chain >> 3) & 1, h = chain & 7;
        const float ckk = p.r_kk[l * 512 + h * 64 + lane], cka = p.r_ka[l * 512 + h * 64 + lane];
#define RW_ROW(ck, i) ((ck) < 8 ? (size_t)NLAT + b * CTXL + (d ? CTXL - 1 - ((ck) * TC + (i)) : ((ck) * TC + (i))) : (size_t)b * SEQL + (d ? SEQL - 1 - (((ck) - 8) * TC + (i)) : (((ck) - 8) * TC + (i))))
        bf16_t g_r[4], g_k[4], g_u[4], g_a[4]; float g_i[4]; unsigned g_v;
#define RW_LOAD(ck) do { _Pragma("unroll") for (int jj = 0; jj < 4; ++jj) { const size_t row = RW_ROW(ck, wid + 8 * jj); \
            g_r[jj] = z[row * ZW + ZC_RR + h * 64 + lane]; g_k[jj] = z[row * ZW + ZC_RK + h * 64 + lane]; \
            g_u[jj] = rwa[row * 2048 + d * 512 + h * 64 + lane]; g_a[jj] = rwa[row * 2048 + 1024 + d * 512 + h * 64 + lane]; g_i[jj] = invn[row * 8 + h]; } \
            g_v = *(const unsigned*)(z + RW_ROW(ck, TID >> 4) * ZW + ZC_RV + h * 64 + half * 32 + (TID & 15) * 2); } while (0)
#define RW_WRITE(buf) do { float* ops = (float*)(smem + (buf) * OPS_B); _Pragma("unroll") for (int jj = 0; jj < 4; ++jj) { \
            const float k = bf2f(g_k[jj]), a = bf2f(g_a[jj]), kk = k * ckk * g_i[jj]; float* o = ops + (wid + 8 * jj) * OPW; \
            o[lane] = 1.f - bf2f(g_u[jj]); o[64 + lane] = kk; o[128 + lane] = kk * a; o[192 + lane] = k * (1.f + (a - 1.f) * cka); o[256 + lane] = bf2f(g_r[jj]); } \
            { float* o = ops + (TID >> 4) * OPW + 320 + (TID & 15) * 2; o[0] = lo16(g_v); o[1] = hi16(g_v); } } while (0)
        __syncthreads();
        RW_LOAD(0); RW_WRITE(0);
        __syncthreads();
        f32x2 Sa = {0.f, 0.f}, Sb = {0.f, 0.f};
        const int rl = wid * 4 + (lane >> 4), ksub = lane & 15;
        float* ypw = (float*)(smem + YP_OFF) + wid * (TC * 64);
        for (int ck = 0; ck < NC; ++ck) {
            if (ck + 1 < NC) RW_LOAD(ck + 1);
            const float* ops = (const float*)(smem + (ck & 1) * OPS_B);
#define RW_GET(X, i) do { const float* o_ = ops + (i) * OPW; w_##X = *(const f32x4*)(o_ + 4 * ksub); k_##X = *(const f32x4*)(o_ + 64 + 4 * ksub); b_##X = *(const f32x4*)(o_ + 128 + 4 * ksub); \
                d_##X = *(const f32x4*)(o_ + 192 + 4 * ksub); r_##X = *(const f32x4*)(o_ + 256 + 4 * ksub); v_##X = o_[320 + rl]; } while (0)
#define RW_STEP(X, i) do { float dt = Sa.x * k_##X[0]; dt = fmaf(Sa.y, k_##X[1], dt); dt = fmaf(Sb.x, k_##X[2], dt); dt = fmaf(Sb.y, k_##X[3], dt); \
                const float sa = -allreduce16(dt); \
                const f32x2 ba = {b_##X[0], b_##X[1]}, bb = {b_##X[2], b_##X[3]}, da = {d_##X[0], d_##X[1]}, db = {d_##X[2], d_##X[3]}, wa = {w_##X[0], w_##X[1]}, wb = {w_##X[2], w_##X[3]}; \
                Sa = Sa * wa + (ba * sa + da * v_##X); Sb = Sb * wb + (bb * sa + db * v_##X); \
                float y = Sa.x * r_##X[0]; y = fmaf(Sa.y, r_##X[1], y); y = fmaf(Sb.x, r_##X[2], y); y = fmaf(Sb.y, r_##X[3], y); \
                ypw[(i) * 64 + lane] = y; } while (0)
            f32x4 w_A, k_A, b_A, d_A, r_A, w_B, k_B, b_B, d_B, r_B; float v_A, v_B;
            RW_GET(A, 0);
#pragma unroll 1
            for (int i = 0; i < TC; i += 2) {
                RW_GET(B, i + 1);
                RW_STEP(A, i);
                if (i + 2 < TC) RW_GET(A, i + 2);
                RW_STEP(B, i + 1);
            }
            if (ck + 1 < NC) RW_WRITE((ck + 1) & 1);
            {
#pragma unroll
                for (int e = 0; e < 2; ++e) {
                    const int idx = lane * 2 + e, i = idx >> 2, rw = idx & 3;
                    const f32x4* y4 = (const f32x4*)(ypw + i * 64 + rw * 16); const f32x4 s4 = (y4[0] + y4[1]) + (y4[2] + y4[3]);
                    atomicAdd(ysum + RW_ROW(ck, i) * 512 + h * 64 + half * 32 + wid * 4 + rw, (s4[0] + s4[1]) + (s4[2] + s4[3]));
                }
            }
            asm volatile("s_waitcnt lgkmcnt(0)\n\ts_barrier" ::: "memory");
        }
    }
    __syncthreads();
}
DI void ph_rwkv_post(const Prm& p, int l) { PH_IDS
    const int lane = TID & 63, wid = TID >> 6, ch0 = lane * 8;
    bf16_t* z = (bf16_t*)(p.ws + WS_Z); const float* ysum = (const float*)(p.ws + WS_YSUM); const bf16_t* rg = (const bf16_t*)(p.ws + WS_RG);
    for (int row = BID * 8 + wid; row < NTOK; row += NBLK * 8) {
        const f32x4 ya = *(const f32x4*)(ysum + (size_t)row * 512 + ch0), yb = *(const f32x4*)(ysum + (size_t)row * 512 + ch0 + 4);
        float y[8] = {ya[0], ya[1], ya[2], ya[3], yb[0], yb[1], yb[2], yb[3]}, r[8], k[8], v[8], g[8], o[8];
        bf16_t* zr = z + (size_t)row * ZW + ZC_RR + ch0;
        unpack8(*(const u32x4*)zr, r); unpack8(*(const u32x4*)(zr + 512), k); unpack8(*(const u32x4*)(zr + 1024), v); unpack8(*(const u32x4*)(rg + (size_t)row * 512 + ch0), g);
        float s = 0.f, bs = 0.f;
#pragma unroll
        for (int e = 0; e < 8; ++e) { s += y[e]; bs += r[e] * k[e] * p.r_rk[l * 512 + ch0 + e]; }
        s += __shfl_xor(s, 1); s += __shfl_xor(s, 2); s += __shfl_xor(s, 4); bs += __shfl_xor(bs, 1); bs += __shfl_xor(bs, 2); bs += __shfl_xor(bs, 4);
        const float mu = s * (1.f / 64.f); float vs = 0.f;
#pragma unroll
        for (int e = 0; e < 8; ++e) { const float dlt = y[e] - mu; vs += dlt * dlt; }
        vs += __shfl_xor(vs, 1); vs += __shfl_xor(vs, 2); vs += __shfl_xor(vs, 4);
        const float rstd = rsqrtf(vs * (1.f / 64.f) + 64e-5f);
#pragma unroll
        for (int e = 0; e < 8; ++e) o[e] = ((y[e] - mu) * rstd * p.r_lnw[l * 512 + ch0 + e] + p.r_lnb[l * 512 + ch0 + e] + bs * v[e]) * g[e];
        *(u32x4*)zr = pack8(o);
    }
}

#ifndef PROBE_A
#define PROBE_A 0
#endif
#ifndef PROBE_B
#define PROBE_B 0
#endif
#ifndef PROBE_ADIV
#define PROBE_ADIV 1
#endif
#ifndef PROBE_BDIV
#define PROBE_BDIV 1
#endif
#if PROBE_A || PROBE_B
#define PT(id, ...) do { unsigned long long t0_ = wall_clock64(); __VA_ARGS__; unsigned long long dt_ = wall_clock64() - t0_; if ((id) == PROBE_A) pacc1 += dt_; if ((id) == PROBE_B) pacc2 += dt_; } while (0)
#else
#define PT(id, ...) do { __VA_ARGS__; } while (0)
#endif
__global__ void __launch_bounds__(512) mega(Prm p0) {
    Prm p = p0; p.wv = __builtin_amdgcn_readfirstlane((int)threadIdx.x >> 6);
    const int BIDK = (int)blockIdx.x;
    extern __shared__ __attribute__((aligned(16))) unsigned char smem[];
    cg::grid_group grid = cg::this_grid();
    bf16_t* wt = (bf16_t*)(p.ws + WS_WT); bf16_t* zb = (bf16_t*)(p.ws + WS_Z); bf16_t* hb = (bf16_t*)(p.ws + WS_RWA); bf16_t* gtmp = hb + (size_t)NTOK * DM;
    bf16_t* zz = (bf16_t*)(p.ws + WS_MST); float* xc = (float*)(p.ws + WS_XC); const float* mods = (const float*)(p.ws + WS_MODS);
#if PROBE_A || PROBE_B
    unsigned long long pacc1 = 0, pacc2 = 0; const unsigned long long pstart = wall_clock64();
#endif
    PT(15, ph_modpart(p, smem); ph_rope(p); conv_ffn(p, 0, 0, smem));
    PT(14, grid.sync());
    ph_modreduce(p);
    PT(14, grid.sync());
#define MERGE_B(l, b) do { \
                    { EpiGate E; E.G = gtmp; run_gemm(p.wv, smem, hb, DM, wt + WT_G + (size_t)(b) * DM * DM, (l) == 1 ? NLAT : NTOK, DM, DM, E); } \
                    { EpiBranch E; E.G = gtmp; E.ZZ = zz; E.first = ((b) == 0); const int yc = (b) == 0 ? ZC_MO : ((b) == 1 ? ZC_RR : ZC_AQ); \
                      run_gemm(p.wv, smem, zb + yc, ZW, wt + WT_P + (size_t)(b) * DM * 512, (l) == 1 ? NLAT : NTOK, DM, 512, E); } \
 } while (0)
#define MIXER_STAGE(l) do { const float* ml = mods + (size_t)(l) * 27648; \
                PT(13, ph_norm(p, l, 1, false); conv_mixer(p, l, smem); ph_zero_ysum(p)); \
                PT(14, grid.sync()); \
                PT(8, { EpiWin E; E.Z = zb; run_gemm(p.wv, smem, hb, DM, wt + WT_IN, NTOK, ZWP, DM, E); }); \
                PT(14, grid.sync()); \
                PT(4, ph_rkv_conv(p, l); ph_attn_prep(p, l)); PT(5, ph_mlstm_a(p, l, smem)); \
                PT(14, grid.sync()); \
                PT(6, ph_rkv_copy(p)); PT(7, ph_mlstm_b(p)); \
                PT(14, grid.sync()); \
                PT(16, { EpiLora E; E.RWA = hb; E.RG = (bf16_t*)(p.ws + WS_RG); E.w0 = p.r_w0 + l * 1024; E.a0 = p.r_a0 + l * 1024; run_gemm(p.wv, smem, zb + ZC_RL, ZW, wt + WT_L, NTOK, 2560, 384, E); }); \
                PT(14, grid.sync()); \
                if (BIDK < 64) { PT(1, ph_rwkv_scan(p, l, smem, BIDK, 64)); } else { PT(2, ph_attn(p, l, smem, BIDK - 64, NBLK - 64)); PT(3, ph_mlstm_c(p, l, smem, BIDK - 64, NBLK - 64)); } \
                PT(14, grid.sync()); \
                PT(12, ph_rwkv_post(p, l); ph_norm(p, l, 1, false)); \
                PT(14, grid.sync()); \
                PT(9, MERGE_B(l, 0); MERGE_B(l, 1); MERGE_B(l, 2)); \
                PT(14, grid.sync()); \
                PT(17, { EpiResid E; E.xlat = p.out; E.xc = xc; E.gate = ml + 5 * DM; E.coef = 1.f; run_gemm(p.wv, smem, zz, DM, wt + WT_O, (l) == 1 ? NLAT : NTOK, DM, DM, E); }); \
                PT(14, grid.sync()); \
 } while (0)
#define FFN_STAGE(l, f) do { const float* ml = mods + (size_t)(l) * 27648; \
            PT(18, ph_norm(p, l, f == 0 ? 0 : 2, l == 0 && f == 0); \
            if (!(l == 0 && f == 0)) conv_ffn(p, l, f, smem)); \
            PT(14, grid.sync()); \
            PT(10, { EpiSwiglu E; E.H = zb; run_gemm(p.wv, smem, hb, DM, wt + WT_GU, ((l) == 1 && (f) == 1) ? NLAT : NTOK, 2 * DFF, DM, E); }); \
            PT(14, grid.sync()); \
            PT(11, { EpiResid E; E.xlat = p.out; E.xc = xc; E.gate = ml + (f == 0 ? 2 : 8) * DM; E.coef = 0.5f; run_gemm(p.wv, smem, zb, DFF, wt + WT_DN, ((l) == 1 && (f) == 1) ? NLAT : NTOK, DM, DFF, E); }); \
            PT(14, grid.sync()); \
 } while (0)
    FFN_STAGE(0, 0); MIXER_STAGE(0); FFN_STAGE(0, 1); FFN_STAGE(1, 0); MIXER_STAGE(1); FFN_STAGE(1, 1);
#if PROBE_A || PROBE_B
    if (blockIdx.x == 0) {
        const unsigned long long pend = wall_clock64();
        if (PROBE_A == 99) pacc1 = pend - pstart;
        if (PROBE_B == 99) pacc2 = pend - pstart;
        unsigned long long q1 = pacc1 / (4000ull * PROBE_ADIV), q2 = pacc2 / (4000ull * PROBE_BDIV); if (q1 > 63) q1 = 63; if (q2 > 63) q2 = 63;
        const unsigned long long waitt = (q1 + 64 * q2) * 2000ull;
        while (wall_clock64() - pend < waitt) __builtin_amdgcn_s_sleep(32);
    }
#endif
}

extern "C" void kernel_launch(void* const* d_in, const int* in_sizes, int n_in, void* d_out, int out_size, void* d_ws, size_t ws_size, hipStream_t stream) {
    static int grid_blocks = 0;
    if (!grid_blocks) {
        int dev = 0, cus = 0, per_cu = 0;
        hipGetDevice(&dev);
        hipDeviceGetAttribute(&cus, hipDeviceAttributeMultiprocessorCount, dev);
        hipFuncSetAttribute((const void*)mega, hipFuncAttributeMaxDynamicSharedMemorySize, LDS_BYTES);
        hipOccupancyMaxActiveBlocksPerMultiprocessor(&per_cu, (const void*)mega, 512, LDS_BYTES);
        if (per_cu < 1) per_cu = 1;
        grid_blocks = cus * per_cu;
        if (ws_size < WS_END) fprintf(stderr, "kernel_launch: workspace too small: %zu < %zu\n", ws_size, (size_t)WS_END);
    }
    Prm p{};
    const float** pp = (const float**)&p;
    for (int i = 0; i < 31; ++i) pp[i] = (const float*)d_in[i];
    p.out = (float*)d_out; p.ws = (unsigned char*)d_ws;
    void* args[] = {&p};
    hipError_t e = hipLaunchCooperativeKernel((const void*)mega, dim3(grid_blocks), dim3(512), args, LDS_BYTES, stream);
    if (e != hipSuccess) fprintf(stderr, "cooperative launch failed: %s (grid %d)\n", hipGetErrorString(e), grid_blocks);
}
```

```cpp
#include <hip/hip_runtime.h>
#include <hip/hip_cooperative_groups.h>
#include <cstdio>
#include <cstdint>
namespace cg = cooperative_groups;
#ifndef PROBE_SCAN
#define PROBE_SCAN 0
#endif

#define LAS __attribute__((address_space(3)))
#define DI __device__ __forceinline__
typedef unsigned short bf16_t;
typedef short bf16x8 __attribute__((ext_vector_type(8)));
typedef float f32x4 __attribute__((ext_vector_type(4)));
typedef float f32x16 __attribute__((ext_vector_type(16)));
typedef float f32x2 __attribute__((ext_vector_type(2)));
typedef unsigned u32x4 __attribute__((ext_vector_type(4)));
typedef unsigned u32x2 __attribute__((ext_vector_type(2)));
typedef __bf16 bf16x2_t __attribute__((ext_vector_type(2)));

constexpr int DM = 1024, NLAT = 16384, NTOK = 16896, SEQL = 8192, CTXL = 256, DFF = 2816, DIN = 8080, ZW = 5008, ZWP = 5120;
constexpr int ZC_MQ = 0, ZC_MK = 256, ZC_MV = 512, ZC_MO = 1024, ZC_MG = 1536, ZC_RR = 1552, ZC_RK = 2064, ZC_RV = 2576, ZC_RL = 3088, ZC_AQ = 3472, ZC_AK = 3984, ZC_AV = 4496;
constexpr int NCHK = 132;
constexpr size_t WS_MODP = 0;
constexpr size_t WS_MODS = WS_MODP + (size_t)2 * 16 * 3 * 9216 * 4;
constexpr size_t WS_ROPE = WS_MODS + (size_t)2 * 3 * 9216 * 4;
constexpr size_t WS_XC   = WS_ROPE + (size_t)8192 * 64 * 4;
constexpr size_t WS_INVN = WS_XC + (size_t)512 * 1024 * 4;
constexpr size_t WS_MSC  = WS_INVN + (size_t)NTOK * 8 * 4;
constexpr size_t WS_MN   = WS_MSC + (size_t)2112 * 4 * 4;
constexpr size_t WS_WT   = WS_MN + (size_t)2112 * 64 * 4;
constexpr size_t WS_Z    = WS_WT + (size_t)25165824;
constexpr size_t WS_RWA  = WS_Z + (size_t)NTOK * ZW * 2;
constexpr size_t WS_RG   = WS_RWA + (size_t)NTOK * 2048 * 2;
constexpr size_t WS_MST  = WS_RG + (size_t)NTOK * 512 * 2;
constexpr size_t WS_YSUM = WS_MST + (size_t)2112 * 8192 * 2;
constexpr size_t WS_END  = WS_YSUM + (size_t)NTOK * 512 * 4;
constexpr size_t WT_GU = 0, WT_DN = (size_t)5632 * 1024;
constexpr size_t WT_IN = 0, WT_G = (size_t)5120 * 1024, WT_P = WT_G + (size_t)3072 * 1024, WT_O = WT_P + (size_t)3 * 1024 * 512, WT_L = WT_O + (size_t)1024 * 1024;
constexpr int LDS_BYTES = 155648;

DI float bf2f(bf16_t b) { return __uint_as_float(((unsigned)b) << 16); }
DI unsigned pk2(float lo, float hi) { f32x2 v = {lo, hi}; bf16x2_t b = __builtin_convertvector(v, bf16x2_t); return __builtin_bit_cast(unsigned, b); }
DI bf16_t f2bf(float f) { return (bf16_t)(pk2(f, 0.f) & 0xffffu); }
DI float lo16(unsigned u) { return __uint_as_float(u << 16); }
DI float hi16(unsigned u) { return __uint_as_float(u & 0xffff0000u); }
DI float sigmoidf_(float x) { return __builtin_amdgcn_rcpf(1.f + __expf(-x)); }
DI float siluf_(float x) { return x * __builtin_amdgcn_rcpf(1.f + __expf(-x)); }
DI float logsigf_(float x) { return x < 0.f ? x - log1pf(expf(x)) : -log1pf(expf(-x)); }
DI float wave_sum(float v) {
#pragma unroll
    for (int o = 1; o < 64; o <<= 1) v += __shfl_xor(v, o);
    return v;
}
DI float wave_max(float v) {
#pragma unroll
    for (int o = 1; o < 64; o <<= 1) v = fmaxf(v, __shfl_xor(v, o));
    return v;
}
DI void unpack8(const u32x4 u, float* f) { f[0] = lo16(u.x); f[1] = hi16(u.x); f[2] = lo16(u.y); f[3] = hi16(u.y); f[4] = lo16(u.z); f[5] = hi16(u.z); f[6] = lo16(u.w); f[7] = hi16(u.w); }
DI u32x4 pack8(const float* f) { u32x4 u; u.x = pk2(f[0], f[1]); u.y = pk2(f[2], f[3]); u.z = pk2(f[4], f[5]); u.w = pk2(f[6], f[7]); return u; }
DI int launder_v(int v) { asm volatile("" : "+v"(v)); return v; }
DI int launder_s(int v) { asm volatile("" : "+s"(v)); return v; }
DI int lane_id_() { return (int)__builtin_amdgcn_mbcnt_hi(~0u, __builtin_amdgcn_mbcnt_lo(~0u, 0u)); }
namespace pg8 {
#define PG8_LAS __attribute__((address_space(3)))
typedef unsigned short bf16_t;
typedef short bf16x8 __attribute__((ext_vector_type(8)));
typedef float f32x4 __attribute__((ext_vector_type(4)));
typedef unsigned u32x4 __attribute__((ext_vector_type(4)));
constexpr int BM = 256, BK = 64, HALF = 128, HTB = HALF * BK * 2  , STAGE_BYTES = 8 * HTB, NXCD = 8, WGM = 8;

__host__ __device__ __forceinline__ int lds_byte(int r, int c) { const int st = (r >> 4) * 2 + (c >> 5), rr = r & 15, cc = c & 31, ob = rr * 64 + cc * 2; return st * 1024 + (ob ^ (((ob >> 9) & 1) << 5)); }
__host__ __device__ __forceinline__ void stage_rc(int b, int& R, int& C) { const int st = b / 1024, sb = b % 1024, swz = sb ^ (((sb >> 9) & 1) << 5); R = (st >> 1) * 16 + swz / 64; C = (st & 1) * 32 + (swz % 64) / 2; }
__host__ __device__ __forceinline__ int perm32(int rho) { const int n = rho >> 4, i = rho & 15; return 8 * (i >> 2) + 4 * n + (i & 3); }

struct Unit { int pm, pn; };
struct Gemm { const bf16_t* A; const bf16_t* Bt; int M, N, K, lda, tid0; };

struct StaticOrder {
    int nM, nN, nwg, G, c;
    __host__ __device__ void init(int M, int N, int G_, int c_) { nM = M / BM; nN = N / BM; nwg = nM * nN; G = G_; c = c_; }
    __host__ __device__ bool next(int i, Unit& u) const {
        const long L = (long)i * G + c; if (L >= nwg) return false;
        int wgid = (int)L; { const int q = nwg / NXCD, r = nwg % NXCD, xcd = wgid % NXCD, off = wgid / NXCD; wgid = (xcd < r ? xcd * (q + 1) : r * (q + 1) + (xcd - r) * q) + off; }
        const int nig = WGM * nN, gid = wgid / nig, fm = gid * WGM, gsz = (nM - fm) < WGM ? (nM - fm) : WGM;
        u.pm = fm + ((wgid % nig) % gsz); u.pn = (wgid % nig) / gsz; return true;
    }
    __device__ __forceinline__ void a_ready(const Unit&) const {}
    __device__ __forceinline__ void done(const Unit&) const {}
};


template <class Epi, class Sched, bool ALIGN_EPI = false, bool SP2 = false>
__device__ __forceinline__ void gemm_phase(PG8_LAS unsigned char* lds, const Gemm g, const Sched& S, const Epi& E) {
    int tid = g.tid0; asm volatile("" : "+v"(tid)); const int wid = __builtin_amdgcn_readfirstlane(tid >> 6), lane = tid & 63, wr = wid >> 2, wc = wid & 3, fr = lane & 15, fq = lane >> 4;
    const int K = g.K, nt = K / BK;
    unsigned voffA[2], voffB[2];
#pragma unroll
    for (int i = 0; i < 2; ++i) { int R, C; stage_rc(tid * 16 + i * 8192, R, C); const int Rb = Epi::PERM ? ((R & ~31) + perm32(R & 31)) : R;
        voffA[i] = (unsigned)(R * g.lda + C) * 2u; voffB[i] = (unsigned)(Rb * K + C) * 2u; }
    const size_t kstep = (size_t)(BK * 2);
    const size_t hstepB = (size_t)HALF * K * 2, hstepA = (size_t)HALF * g.lda * 2;
    const size_t tstepA = 2 * hstepA, tstepB = 2 * hstepB;
    const unsigned ldsw = (unsigned)wid * 1024u;
    const int aoff = lds_byte(wr * 64 + fr, fq * 8), boff = lds_byte(wc * 32 + fr, fq * 8);
#define PG8_SA(b, h) (((b) * 2 + (h)) * HTB)
#define PG8_SB(b, h) ((4 + (b) * 2 + (h)) * HTB)
#define PG8_STAGE(bufoff, gbase, voff) do { _Pragma("unroll") for (int _i = 0; _i < 2; ++_i) \
        __builtin_amdgcn_global_load_lds((const unsigned*)((const char*)(gbase) + (voff)[_i]), (PG8_LAS unsigned*)(lds + (bufoff) + ldsw + _i * 8192), 16, 0, 0); } while (0)
#define PG8_LDA(dst, b, h) do { _Pragma("unroll") for (int m = 0; m < 4; ++m) _Pragma("unroll") for (int k = 0; k < 2; ++k) dst[m][k] = *(const PG8_LAS bf16x8*)(lds + PG8_SA(b, h) + aoff + m * 2048 + k * 1024); } while (0)
#define PG8_LDB(dst, b, h) do { _Pragma("unroll") for (int n = 0; n < 2; ++n) _Pragma("unroll") for (int k = 0; k < 2; ++k) dst[n][k] = *(const PG8_LAS bf16x8*)(lds + PG8_SB(b, h) + boff + n * 2048 + k * 1024); } while (0)
#define PG8_MMA(ai, bj, At, Bt) do { __builtin_amdgcn_s_setprio(1); _Pragma("unroll") for (int m = 0; m < 4; ++m) _Pragma("unroll") for (int n = 0; n < 2; ++n) _Pragma("unroll") for (int k = 0; k < 2; ++k) \
        acc[ai][bj][m][n] = __builtin_amdgcn_mfma_f32_16x16x32_bf16(Bt[n][k], At[m][k], acc[ai][bj][m][n], 0, 0, 0); __builtin_amdgcn_s_setprio(0); } while (0)
#define PG8_WAIT_V(n) asm volatile("s_waitcnt vmcnt(" #n ")" ::: "memory")
#define PG8_WAIT_L(n) asm volatile("s_waitcnt lgkmcnt(" #n ")" ::: "memory")
#define PG8_BAR __builtin_amdgcn_s_barrier()
#define PG8_SCHED __builtin_amdgcn_sched_barrier(0)
    Unit cur, nxt; int ui = 0;
    if (!S.next(0, cur)) return;
    f32x4 acc[2][2][4][2];
#pragma unroll
    for (int a = 0; a < 2; ++a)
#pragma unroll
        for (int b = 0; b < 2; ++b)
#pragma unroll
            for (int m = 0; m < 4; ++m)
#pragma unroll
                for (int n = 0; n < 2; ++n) acc[a][b][m][n] = (f32x4){0.f, 0.f, 0.f, 0.f};
    bf16x8 At[4][2], B0[2][2], B1[2][2];
    const char* cA = (const char*)g.A + (size_t)cur.pm * tstepA; const char* cB = (const char*)g.Bt + (size_t)cur.pn * tstepB;
    S.a_ready(cur);
    if constexpr (SP2) {
        PG8_STAGE(PG8_SB(0, 0), cB, voffB); PG8_STAGE(PG8_SB(0, 1), cB + hstepB, voffB); PG8_STAGE(PG8_SA(0, 0), cA, voffA); PG8_STAGE(PG8_SA(0, 1), cA + hstepA, voffA);
        if (wr == 1) PG8_BAR;
        PG8_WAIT_V(2); PG8_BAR;
        PG8_STAGE(PG8_SB(1, 0), cB + kstep, voffB); PG8_STAGE(PG8_SA(1, 0), cA + kstep, voffA); PG8_STAGE(PG8_SB(1, 1), cB + hstepB + kstep, voffB);
        PG8_WAIT_V(6); PG8_BAR;
    } else {
        PG8_STAGE(PG8_SB(0, 0), cB, voffB); PG8_STAGE(PG8_SA(0, 0), cA, voffA); PG8_STAGE(PG8_SB(0, 1), cB + hstepB, voffB); PG8_STAGE(PG8_SA(0, 1), cA + hstepA, voffA);
        if (wr == 1) PG8_BAR;
        PG8_WAIT_V(4); PG8_BAR;
        PG8_STAGE(PG8_SB(1, 0), cB + kstep, voffB); PG8_STAGE(PG8_SA(1, 0), cA + kstep, voffA); PG8_STAGE(PG8_SB(1, 1), cB + hstepB + kstep, voffB);
        PG8_WAIT_V(6); PG8_BAR;
    }
    for (;;) {
        const bool has_next = S.next(ui + 1, nxt);
        const char* nA = has_next ? (const char*)g.A + (size_t)nxt.pm * tstepA : cA; const char* nB = has_next ? (const char*)g.Bt + (size_t)nxt.pn * tstepB : cB;
        for (int t = 0; t < nt; t += 2) {
            const bool last = (t == nt - 2);
            const char* a1 = cA + (size_t)(t + 1) * kstep;
            const char* a2 = last ? nA : cA + (size_t)(t + 2) * kstep; const char* b2 = last ? nB : cB + (size_t)(t + 2) * kstep;
            const char* a3 = a2 + kstep; const char* b3 = b2 + kstep;
            if (last && has_next) S.a_ready(nxt);
            if constexpr (SP2) {
            PG8_LDB(B0, 0, 0); PG8_LDB(B1, 0, 1); PG8_SCHED; PG8_LDA(At, 0, 0); PG8_STAGE(PG8_SA(1, 1), a1 + hstepA, voffA);
            PG8_WAIT_V(8); PG8_WAIT_L(0); PG8_BAR; PG8_MMA(0, 0, At, B0); PG8_MMA(0, 1, At, B1); PG8_BAR; PG8_SCHED;
            PG8_LDA(At, 0, 1); PG8_STAGE(PG8_SB(0, 0), b2, voffB); PG8_STAGE(PG8_SB(0, 1), b2 + hstepB, voffB); PG8_STAGE(PG8_SA(0, 0), a2, voffA);
            PG8_WAIT_V(8); PG8_WAIT_L(0); PG8_BAR; PG8_MMA(1, 0, At, B0); PG8_MMA(1, 1, At, B1); PG8_BAR; PG8_SCHED;
            PG8_LDB(B0, 1, 0); PG8_LDB(B1, 1, 1); PG8_SCHED; PG8_LDA(At, 1, 0); PG8_STAGE(PG8_SA(0, 1), a2 + hstepA, voffA);
            PG8_WAIT_V(8); PG8_WAIT_L(0); PG8_BAR; PG8_MMA(0, 0, At, B0); PG8_MMA(0, 1, At, B1); PG8_BAR; PG8_SCHED;
            PG8_LDA(At, 1, 1); PG8_STAGE(PG8_SB(1, 0), b3, voffB); PG8_STAGE(PG8_SB(1, 1), b3 + hstepB, voffB); PG8_STAGE(PG8_SA(1, 0), a3, voffA);
            PG8_WAIT_V(8); PG8_WAIT_L(0); PG8_BAR; PG8_MMA(1, 0, At, B0); PG8_MMA(1, 1, At, B1); PG8_BAR; PG8_SCHED;
            } else {
            PG8_LDB(B0, 0, 0); PG8_SCHED; PG8_LDA(At, 0, 0); PG8_STAGE(PG8_SA(1, 1), a1 + hstepA, voffA);
            PG8_WAIT_L(8); PG8_BAR; PG8_WAIT_L(0); PG8_MMA(0, 0, At, B0); PG8_BAR; PG8_SCHED;
            PG8_LDB(B1, 0, 1); PG8_STAGE(PG8_SB(0, 0), b2, voffB);
            PG8_BAR; PG8_WAIT_L(0); PG8_MMA(0, 1, At, B1); PG8_BAR;
            PG8_LDA(At, 0, 1); PG8_STAGE(PG8_SA(0, 0), a2, voffA);
            PG8_BAR; PG8_WAIT_L(0); PG8_MMA(1, 0, At, B0); PG8_BAR; PG8_SCHED;
            PG8_STAGE(PG8_SB(0, 1), b2 + hstepB, voffB);
            PG8_WAIT_V(6); PG8_BAR; PG8_MMA(1, 1, At, B1); PG8_BAR;
            PG8_LDB(B0, 1, 0); PG8_SCHED; PG8_LDA(At, 1, 0); PG8_STAGE(PG8_SA(0, 1), a2 + hstepA, voffA);
            PG8_WAIT_L(8); PG8_BAR; PG8_WAIT_L(0); PG8_MMA(0, 0, At, B0); PG8_BAR; PG8_SCHED;
            PG8_LDB(B1, 1, 1); PG8_STAGE(PG8_SB(1, 0), b3, voffB);
            PG8_BAR; PG8_WAIT_L(0); PG8_MMA(0, 1, At, B1); PG8_BAR;
            PG8_LDA(At, 1, 1); PG8_STAGE(PG8_SA(1, 0), a3, voffA);
            PG8_BAR; PG8_WAIT_L(0); PG8_MMA(1, 0, At, B0); PG8_BAR; PG8_SCHED;
            PG8_STAGE(PG8_SB(1, 1), b3 + hstepB, voffB);
            PG8_WAIT_V(6); PG8_BAR; PG8_MMA(1, 1, At, B1); PG8_BAR;
            }
        }
        if constexpr (ALIGN_EPI) { if (wr == 0) PG8_BAR; }
        if constexpr (!Epi::AFTER_DRAIN) { E(acc, cur, wr, wc, fr, fq); S.done(cur); }
        if (!has_next) break;
#pragma unroll
        for (int a = 0; a < 2; ++a)
#pragma unroll
            for (int b = 0; b < 2; ++b)
#pragma unroll
                for (int m = 0; m < 4; ++m)
#pragma unroll
                    for (int n = 0; n < 2; ++n) acc[a][b][m][n] = (f32x4){0.f, 0.f, 0.f, 0.f};
        cur = nxt; cA = nA; cB = nB; ++ui;
        if constexpr (ALIGN_EPI) { if (wr == 1) PG8_BAR; }
    }
    PG8_WAIT_V(0);
    if constexpr (!ALIGN_EPI) { if (wr == 0) PG8_BAR; }
    PG8_BAR;
    if constexpr (Epi::AFTER_DRAIN) { E.fused(acc, cur, wr, wc, fr, fq, lds, wid, lane); S.done(cur); }
#undef PG8_SA
#undef PG8_SB
#undef PG8_STAGE
#undef PG8_LDA
#undef PG8_LDB
#undef PG8_MMA
#undef PG8_WAIT_V
#undef PG8_WAIT_L
#undef PG8_BAR
#undef PG8_SCHED
}
}

typedef const pg8::f32x4 (&AccRef)[2][2][4][2];
struct EpiSwiglu {
    static constexpr bool PERM = true, AFTER_DRAIN = false;
    bf16_t* H;
    DI void operator()(AccRef acc, const pg8::Unit& u, int wr, int wc, int fr, int fq) const {
        const int row0 = u.pm * 256 + wr * 64 + fr, col = u.pn * 128 + wc * 32 + 8 * fq;
#pragma unroll
        for (int ai = 0; ai < 2; ++ai)
#pragma unroll
            for (int m = 0; m < 4; ++m) {
                const int row = row0 + ai * 128 + m * 16; float f[8];
#pragma unroll
                for (int n = 0; n < 2; ++n)
#pragma unroll
                    for (int e = 0; e < 4; ++e) f[n * 4 + e] = siluf_(acc[ai][0][m][n][e]) * acc[ai][1][m][n][e];
                *(u32x4*)(H + (size_t)row * DFF + col) = pack8(f);
            }
    }
};
struct EpiResid {
    static constexpr bool PERM = true, AFTER_DRAIN = false;
    float* xlat; float* xc; const float* gate; float coef;
    DI void operator()(AccRef acc, const pg8::Unit& u, int wr, int wc, int fr, int fq) const {
        const int r0 = u.pm * 256; const int vec = r0 < NLAT ? (r0 >> 13) : 2;
        const float* gp = gate + vec * 9216;
        float* base = r0 < NLAT ? xlat + (size_t)r0 * DM : xc + (size_t)(r0 - NLAT) * DM;
#pragma unroll
        for (int bj = 0; bj < 2; ++bj) {
            const int col = u.pn * 256 + bj * 128 + wc * 32 + 8 * fq;
            const f32x4 g0 = *(const f32x4*)(gp + col) * coef, g1 = *(const f32x4*)(gp + col + 4) * coef;
#pragma unroll
            for (int ai = 0; ai < 2; ++ai)
#pragma unroll
                for (int m = 0; m < 4; ++m) {
                    float* xp = base + (size_t)(wr * 64 + fr + ai * 128 + m * 16) * DM + col;
                    f32x4 x0 = *(f32x4*)xp, x1 = *(f32x4*)(xp + 4);
                    x0 += g0 * acc[ai][bj][m][0]; x1 += g1 * acc[ai][bj][m][1];
                    *(f32x4*)xp = x0; *(f32x4*)(xp + 4) = x1;
                }
        }
    }
};
struct EpiWin {
    static constexpr bool PERM = true, AFTER_DRAIN = false;
    bf16_t* Z;
    DI void operator()(AccRef acc, const pg8::Unit& u, int wr, int wc, int fr, int fq) const {
        const int row0 = u.pm * 256 + wr * 64 + fr;
#pragma unroll
        for (int bj = 0; bj < 2; ++bj) {
            const int col = u.pn * 256 + bj * 128 + wc * 32 + 8 * fq;
            if (col >= ZW) continue;
            const int mode = (col >= ZC_RL && col < ZC_RL + 128) ? 1 : ((col >= ZC_RL + 256 && col < ZC_AQ) ? 2 : 0);
#pragma unroll
            for (int ai = 0; ai < 2; ++ai)
#pragma unroll
                for (int m = 0; m < 4; ++m) {
                    const int row = row0 + ai * 128 + m * 16; float f[8];
#pragma unroll
                    for (int n = 0; n < 2; ++n)
#pragma unroll
                        for (int e = 0; e < 4; ++e) { float v = acc[ai][bj][m][n][e]; if (mode == 1) v = 1.f - 2.f * __builtin_amdgcn_rcpf(1.f + __expf(2.f * v)); else if (mode == 2) v = sigmoidf_(v); f[n * 4 + e] = v; }
                    *(u32x4*)(Z + (size_t)row * ZW + col) = pack8(f);
                }
        }
    }
};
struct EpiLora {
    static constexpr bool PERM = true, AFTER_DRAIN = false;
    bf16_t* RWA; bf16_t* RG; const float* w0; const float* a0;
    DI void operator()(AccRef acc, const pg8::Unit& u, int wr, int wc, int fr, int fq) const {
        const int row0 = u.pm * 256 + wr * 64 + fr;
#pragma unroll
        for (int bj = 0; bj < 2; ++bj) {
            const int col = u.pn * 256 + bj * 128 + wc * 32 + 8 * fq; const int seg = col >> 9, cc = col & 511;
            const float* bp = seg < 2 ? w0 + seg * 512 + cc : a0 + (seg & 1) * 512 + cc;
#pragma unroll
            for (int ai = 0; ai < 2; ++ai)
#pragma unroll
                for (int m = 0; m < 4; ++m) {
                    const int row = row0 + ai * 128 + m * 16; float f[8];
#pragma unroll
                    for (int n = 0; n < 2; ++n)
#pragma unroll
                        for (int e = 0; e < 4; ++e) {
                            float v = acc[ai][bj][m][n][e] + (seg < 4 ? bp[n * 4 + e] : 0.f);
                            if (seg < 2) { const float ee = 0.60653066f * sigmoidf_(v); v = 1.f - __expf(-ee); } else if (seg < 4) v = sigmoidf_(v);
                            f[n * 4 + e] = v;
                        }
                    if (seg < 4) *(u32x4*)(RWA + (size_t)row * 2048 + col) = pack8(f); else *(u32x4*)(RG + (size_t)row * 512 + cc) = pack8(f);
                    __builtin_amdgcn_sched_barrier(0);
                }
        }
    }
};
struct EpiGate {
    static constexpr bool PERM = true, AFTER_DRAIN = false;
    bf16_t* G;
    DI void operator()(AccRef acc, const pg8::Unit& u, int wr, int wc, int fr, int fq) const {
        const int row0 = u.pm * 256 + wr * 64 + fr;
#pragma unroll
        for (int bj = 0; bj < 2; ++bj) {
            const int col = u.pn * 256 + bj * 128 + wc * 32 + 8 * fq;
#pragma unroll
            for (int ai = 0; ai < 2; ++ai)
#pragma unroll
                for (int m = 0; m < 4; ++m) {
                    const int row = row0 + ai * 128 + m * 16; float f[8];
#pragma unroll
                    for (int n = 0; n < 2; ++n)
#pragma unroll
                        for (int e = 0; e < 4; ++e) f[n * 4 + e] = sigmoidf_(acc[ai][bj][m][n][e]);
                    *(u32x4*)(G + (size_t)row * DM + col) = pack8(f);
                }
        }
    }
};
struct EpiBranch {
    static constexpr bool PERM = true, AFTER_DRAIN = false;
    const bf16_t* G; bf16_t* ZZ; int first;
    DI void operator()(AccRef acc, const pg8::Unit& u, int wr, int wc, int fr, int fq) const {
        const int row0 = u.pm * 256 + wr * 64 + fr;
#pragma unroll
        for (int bj = 0; bj < 2; ++bj) {
            const int col = u.pn * 256 + bj * 128 + wc * 32 + 8 * fq;
#pragma unroll
            for (int ai = 0; ai < 2; ++ai)
#pragma unroll
                for (int m = 0; m < 4; ++m) {
                    const size_t off = (size_t)(row0 + ai * 128 + m * 16) * DM + col; float g[8], o[8], f[8];
                    unpack8(*(const u32x4*)(G + off), g);
                    if (first) {
#pragma unroll
                        for (int e = 0; e < 8; ++e) o[e] = 0.f;
                    } else unpack8(*(const u32x4*)(ZZ + off), o);
#pragma unroll
                    for (int n = 0; n < 2; ++n)
#pragma unroll
                        for (int e = 0; e < 4; ++e) f[n * 4 + e] = o[n * 4 + e] + g[n * 4 + e] * acc[ai][bj][m][n][e];
                    *(u32x4*)(ZZ + off) = pack8(f);
                }
        }
    }
};
template <class Epi> DI void run_gemm(const int wv, unsigned char* smem, const bf16_t* A, int lda, const bf16_t* Bt, int M, int N, int K, const Epi& E) {
    pg8::Gemm g; g.A = A; g.Bt = Bt; g.M = M; g.N = N; g.K = launder_s(K); g.lda = launder_s(lda); g.tid0 = wv * 64 + lane_id_();
    pg8::StaticOrder S; S.init(M, N, (int)gridDim.x, launder_s((int)blockIdx.x));
    pg8::gemm_phase<Epi, pg8::StaticOrder, true, true>((PG8_LAS unsigned char*)smem, g, S, E);
    __syncthreads();
}

struct Prm {
    const float *x, *c, *ctx, *cctx, *w_ada, *b_ada, *norm_g, *f1gu, *f1dn, *f2gu, *f2dn, *w_in, *m_conv, *m_gb, *m_on, *r_conv, *r_w0, *r_w2, *r_a0, *r_a2, *r_g2,
        *r_kk, *r_ka, *r_rk, *r_lnw, *r_lnb, *a_qkn, *a_lam, *a_subln, *w_br, *w_o;
    float* out; unsigned char* ws; int wv, pad;
};
#define PH_IDS const int tid_l = launder_v(p.wv * 64 + lane_id_()); const int bid_l = launder_s((int)blockIdx.x); (void)tid_l; (void)bid_l;
#define TID tid_l
#define BID bid_l
#define NBLK ((int)gridDim.x)

DI void ph_modpart(const Prm& p, unsigned char* smem) { PH_IDS
    float* sc = (float*)smem; float* modp = (float*)(p.ws + WS_MODP);
    for (int it = BID; it < 576; it += NBLK) {
        const int l = it / 288, r = it % 288, ks = r / 18, cb = r % 18;
        __syncthreads();
        if (TID < 192) { const int v = TID >> 6, k = ks * 64 + (TID & 63); const float cv = v < 2 ? p.c[v * DM + k] : p.cctx[k]; sc[TID] = siluf_(cv); }
        __syncthreads();
        const int col = cb * 512 + TID; float a0 = 0.f, a1 = 0.f, a2 = 0.f;
        const float* w = p.w_ada + ((size_t)l * DM + ks * 64) * 9216 + col;
#pragma unroll 8
        for (int k = 0; k < 64; ++k) { const float wv = w[(size_t)k * 9216]; a0 += sc[k] * wv; a1 += sc[64 + k] * wv; a2 += sc[128 + k] * wv; }
        float* o = modp + ((size_t)(l * 16 + ks) * 3) * 9216 + col; o[0] = a0; o[9216] = a1; o[2 * 9216] = a2;
    }
    __syncthreads();
}
DI void ph_rope(const Prm& p) { PH_IDS
    float* rope = (float*)(p.ws + WS_ROPE);
    for (int i = BID * 512 + TID; i < SEQL * 32; i += NBLK * 512) {
        const int t = i >> 5, pp = i & 31, j = pp & 15;
        const float inv = powf(10000.f, -(float)j / 16.f); const float pos = (float)(pp < 16 ? (t >> 6) : (t & 63)); const float ang = pos * inv;
        rope[2 * i] = cosf(ang); rope[2 * i + 1] = sinf(ang);
    }
}
DI void ph_modreduce(const Prm& p) { PH_IDS
    const float* modp = (const float*)(p.ws + WS_MODP); float* mods = (float*)(p.ws + WS_MODS);
    for (int i = BID * 512 + TID; i < 2 * 3 * 9216; i += NBLK * 512) {
        const int l = i / 27648, rem = i % 27648, v = rem / 9216, col = rem % 9216;
        float s = p.b_ada[l * 9216 + col];
        for (int ks = 0; ks < 16; ++ks) s += modp[((size_t)(l * 16 + ks) * 3 + v) * 9216 + col];
        mods[i] = s;
    }
}
template <int MODE> DI void conv_weight(const Prm& p, const float* src, int ld, int c0, int K, int ncols, bf16_t* dst, unsigned char* smem) { PH_IDS
    float* t = (float*)smem; const int ntk = K / 64, ntn = (ncols + 63) / 64, tx = TID & 63, ty = TID >> 6;
    for (int it = BID; it < ntk * ntn; it += NBLK) {
        const int kt = it % ntk, nt = it / ntk;
        __syncthreads();
#pragma unroll
        for (int i = 0; i < 8; ++i) { const int k = ty * 8 + i, j = nt * 64 + tx; t[k * 65 + tx] = j < ncols ? src[(size_t)(kt * 64 + k) * ld + c0 + j] : 0.f; }
        __syncthreads();
#pragma unroll
        for (int i = 0; i < 8; ++i) {
            const int n = ty * 8 + i, j = nt * 64 + n;
            if (j < ncols) {
                int drow = j;
                if (MODE == 1) drow = j < DFF ? ((j >> 7) * 256 + (j & 127)) : (((j - DFF) >> 7) * 256 + 128 + ((j - DFF) & 127));
                dst[(size_t)drow * K + kt * 64 + tx] = f2bf(t[tx * 65 + n]);
            }
        }
    }
    __syncthreads();
}
DI void conv_ffn(const Prm& p, int l, int which, unsigned char* smem) {
    bf16_t* wt = (bf16_t*)(p.ws + WS_WT);
    conv_weight<1>(p, (which ? p.f2gu : p.f1gu) + (size_t)l * DM * 2 * DFF, 2 * DFF, 0, DM, 2 * DFF, wt + WT_GU, smem);
    conv_weight<0>(p, (which ? p.f2dn : p.f1dn) + (size_t)l * DFF * DM, DM, 0, DFF, DM, wt + WT_DN, smem);
}
DI void conv_mixer(const Prm& p, int l, unsigned char* smem) { PH_IDS
    bf16_t* wt = (bf16_t*)(p.ws + WS_WT);
    conv_weight<0>(p, p.w_in + (size_t)l * DM * DIN, DIN, 0, DM, ZW, wt + WT_IN, smem);
    conv_weight<0>(p, p.w_in + (size_t)l * DM * DIN, DIN, ZW, DM, 3 * DM, wt + WT_G, smem);
    for (int b = 0; b < 3; ++b) conv_weight<0>(p, p.w_br + (size_t)(l * 3 + b) * 512 * DM, DM, 0, 512, DM, wt + WT_P + (size_t)b * DM * 512, smem);
    conv_weight<0>(p, p.w_o + (size_t)l * DM * DM, DM, 0, DM, DM, wt + WT_O, smem);
    bf16_t* wl = wt + WT_L;
    for (int i = BID * 512 + TID; i < 2560 * 384; i += NBLK * 512) {
        const int n = i / 384, k = i % 384, seg = n >> 9, cc = n & 511; float v = 0.f;
        if (seg < 2) { if ((k >> 6) == seg) v = p.r_w2[((size_t)(l * 2 + seg) * 64 + (k & 63)) * 512 + cc]; }
        else if (seg < 4) { if ((k >> 6) == seg) v = p.r_a2[((size_t)(l * 2 + seg - 2) * 64 + (k & 63)) * 512 + cc]; }
        else { if (k >= 256) v = p.r_g2[((size_t)l * 128 + (k - 256)) * 512 + cc]; }
        wl[i] = f2bf(v);
    }
}
DI void ph_norm(const Prm& p, int l, int which, bool first) { PH_IDS
    const int lane = TID & 63, wid = TID >> 6;
    const float* g = p.norm_g + (l * 3 + which) * DM; const float* mods = (const float*)(p.ws + WS_MODS) + (size_t)l * 27648;
    bf16_t* hb = (bf16_t*)(p.ws + WS_RWA); float* xc = (float*)(p.ws + WS_XC);
    for (int row = BID * 8 + wid; row < NTOK; row += NBLK * 8) {
        const int vec = row < NLAT ? (row >> 13) : 2;
        const float* sh = mods + vec * 9216 + (3 * which) * DM; const float* scl = sh + DM;
        float* xd = row < NLAT ? p.out + (size_t)row * DM : xc + (size_t)(row - NLAT) * DM;
        const float* xr = first ? (row < NLAT ? p.x + (size_t)row * DM : p.ctx + (size_t)(row - NLAT) * DM) : xd;
        f32x4 xv[4]; float ss = 0.f;
#pragma unroll
        for (int i = 0; i < 4; ++i) { xv[i] = *(const f32x4*)(xr + i * 256 + lane * 4); ss += xv[i][0] * xv[i][0] + xv[i][1] * xv[i][1] + xv[i][2] * xv[i][2] + xv[i][3] * xv[i][3]; }
        ss = wave_sum(ss); const float rinv = rsqrtf(ss * (1.f / DM) + 1e-6f);
#pragma unroll
        for (int i = 0; i < 4; ++i) {
            const int col = i * 256 + lane * 4;
            if (first) *(f32x4*)(xd + col) = xv[i];
            const f32x4 gv = *(const f32x4*)(g + col), sv = *(const f32x4*)(scl + col), hv = *(const f32x4*)(sh + col);
            float h[4];
#pragma unroll
            for (int e = 0; e < 4; ++e) h[e] = xv[i][e] * rinv * gv[e] * (1.f + sv[e]) + hv[e];
            u32x2 o; o.x = pk2(h[0], h[1]); o.y = pk2(h[2], h[3]);
            *(u32x2*)(hb + (size_t)row * DM + col) = o;
        }
    }
}
DI void ph_zero_ysum(const Prm& p) { PH_IDS
    f32x4* y = (f32x4*)(p.ws + WS_YSUM); const f32x4 zr = {0.f, 0.f, 0.f, 0.f};
    for (int i = BID * 512 + TID; i < NTOK * 128; i += NBLK * 512) y[i] = zr;
}
DI void ph_rkv_conv(const Prm& p, int l) { PH_IDS
    const int lane = TID & 63, wid = TID >> 6;
    const bf16_t* z = (const bf16_t*)(p.ws + WS_Z); bf16_t* tmp = (bf16_t*)(p.ws + WS_RWA); float* invn = (float*)(p.ws + WS_INVN);
    const float* cw = p.r_conv + (size_t)l * 3 * 1536;
    for (int row = BID * 8 + wid; row < NTOK; row += NBLK * 8) {
        const int t = row < NLAT ? (row & 8191) : ((row - NLAT) & 255), L = row < NLAT ? SEQL : CTXL;
        const bool hp = t > 0, hn = t < L - 1;
#pragma unroll
        for (int g = 0; g < 3; ++g) {
            const int ch = g * 512 + lane * 8; const bf16_t* zp = z + (size_t)row * ZW + ZC_RR + ch;
            const u32x4 zero = {0u, 0u, 0u, 0u};
            const u32x4 uc = *(const u32x4*)zp, up = hp ? *(const u32x4*)(zp - ZW) : zero, un = hn ? *(const u32x4*)(zp + ZW) : zero;
            float c[8], pv[8], nx[8], o[8]; unpack8(uc, c); unpack8(up, pv); unpack8(un, nx);
#pragma unroll
            for (int e = 0; e < 8; ++e) o[e] = cw[ch + e] * pv[e] + cw[1536 + ch + e] * c[e] + cw[3072 + ch + e] * nx[e];
            *(u32x4*)(tmp + (size_t)row * 1536 + ch) = pack8(o);
            if (g == 1) {
                float ss = 0.f;
#pragma unroll
                for (int e = 0; e < 8; ++e) { const float kk = o[e] * p.r_kk[l * 512 + lane * 8 + e]; ss += kk * kk; }
                ss += __shfl_xor(ss, 1); ss += __shfl_xor(ss, 2); ss += __shfl_xor(ss, 4);
                if ((lane & 7) == 0) invn[(size_t)row * 8 + (lane >> 3)] = 1.f / fmaxf(sqrtf(ss), 1e-12f);
            }
        }
    }
}
DI void ph_rkv_copy(const Prm& p) { PH_IDS
    const int lane = TID & 63, wid = TID >> 6;
    bf16_t* z = (bf16_t*)(p.ws + WS_Z); const bf16_t* tmp = (const bf16_t*)(p.ws + WS_RWA);
    for (int row = BID * 8 + wid; row < NTOK; row += NBLK * 8)
#pragma unroll
        for (int g = 0; g < 3; ++g) { const int ch = g * 512 + lane * 8; *(u32x4*)(z + (size_t)row * ZW + ZC_RR + ch) = *(const u32x4*)(tmp + (size_t)row * 1536 + ch); }
}
DI void ph_attn_prep(const Prm& p, int l) { PH_IDS
    const int lane = TID & 63, wid = TID >> 6, hw = lane >> 5, pp = lane & 31;
    bf16_t* z = (bf16_t*)(p.ws + WS_Z); const float* rope = (const float*)(p.ws + WS_ROPE); const float* qkn = p.a_qkn + l * 128;
    for (int row = BID * 8 + wid; row < NTOK; row += NBLK * 8) {
        const bool islat = row < NLAT; const int t = row & 8191;
        float cs = 1.f, sn = 0.f; if (islat) { cs = rope[((size_t)t * 32 + pp) * 2]; sn = rope[((size_t)t * 32 + pp) * 2 + 1]; }
#pragma unroll
        for (int it = 0; it < 8; ++it) {
            const int seg = it * 2 + hw, which = seg >> 3, col = (which ? ZC_AK : ZC_AQ) + (seg & 7) * 64 + 2 * pp;
            unsigned* zp = (unsigned*)(z + (size_t)row * ZW + col);
            const unsigned u = *zp; const float x1 = lo16(u), x2 = hi16(u);
            float ss = x1 * x1 + x2 * x2;
            ss += __shfl_xor(ss, 1); ss += __shfl_xor(ss, 2); ss += __shfl_xor(ss, 4); ss += __shfl_xor(ss, 8); ss += __shfl_xor(ss, 16);
            const float rinv = rsqrtf(ss * (1.f / 64.f) + 1e-6f) * (which ? 1.f : 0.125f);
            const float y1 = x1 * rinv * qkn[which * 64 + 2 * pp], y2 = x2 * rinv * qkn[which * 64 + 2 * pp + 1];
            *zp = pk2(y1 * cs - y2 * sn, y1 * sn + y2 * cs);
        }
    }
}

#define MFMA16(a, b, c) __builtin_amdgcn_mfma_f32_16x16x32_bf16((a), (b), (c), 0, 0, 0)
#define MFMA32(a, b, c) __builtin_amdgcn_mfma_f32_32x32x16_bf16((a), (b), (c), 0, 0, 0)
DI float wave_incl_scan_add(float v, int lane) {
#pragma unroll
    for (int o = 1; o < 64; o <<= 1) { const float t = __shfl_up(v, o); if (lane >= o) v += t; }
    return v;
}
DI float wave_incl_scan_max(float v, int lane) {
#pragma unroll
    for (int o = 1; o < 64; o <<= 1) { const float t = __shfl_up(v, o); if (lane >= o) v = fmaxf(v, t); }
    return v;
}
DI float mconv(const bf16_t* z, const float* cw, size_t row, int t, int L, int ch) {
    const bf16_t* zp = z + row * ZW + ch;
    float a = cw[512 + ch] * bf2f(zp[0]);
    if (t > 0) a += cw[ch] * bf2f(zp[-ZW]);
    if (t < L - 1) a += cw[1024 + ch] * bf2f(zp[ZW]);
    return siluf_(a);
}
DI void ph_mlstm_a(const Prm& p, int l, unsigned char* smem) { PH_IDS
    const int lane = TID & 63, wid = TID >> 6;
    const bf16_t* z = (const bf16_t*)(p.ws + WS_Z); bf16_t* mst = (bf16_t*)(p.ws + WS_MST); float* msc = (float*)(p.ws + WS_MSC); float* mn = (float*)(p.ws + WS_MN);
    const float* cw = p.m_conv + (size_t)l * 3 * 512; const float* gb = p.m_gb + l * 16;
    bf16_t* kT = (bf16_t*)smem; bf16_t* vT = (bf16_t*)(smem + 9216); float* wsl = (float*)(smem + 9216 + 18432);
    for (int u = BID; u < 2112; u += NBLK) {
        const int d = u / 1056, r = u % 1056, b = r / 528, h = (r % 528) / NCHK, c = r % NCHK;
        const int slot = ((d * 2 + b) * 4 + h) * NCHK + c;
        const bool isctx = c < 4; const int cs = isctx ? c : c - 4, nch = isctx ? 4 : 128, oc = d ? nch - 1 - cs : cs, L = isctx ? CTXL : SEQL;
        const size_t base = isctx ? (size_t)NLAT + b * CTXL + oc * 64 : (size_t)b * SEQL + oc * 64;
        __syncthreads();
        if (wid == 0) {
            const int o = d ? 63 - lane : lane; const bf16_t* zr = z + (base + o) * ZW + ZC_MG + 8 * d + h;
            const float ig = bf2f(zr[0]) + gb[(2 * d) * 4 + h], lf = logsigf_(bf2f(zr[4]) + gb[(2 * d + 1) * 4 + h]);
            const float bc = wave_incl_scan_add(lf, lane), bt = __shfl(bc, 63), wl = bt - bc + ig, ml = wave_max(wl);
            wsl[lane] = __expf(wl - ml);
            if (lane == 0) { msc[slot * 4] = bt; msc[slot * 4 + 1] = ml; }
        }
        __syncthreads();
#pragma unroll
        for (int i = 0; i < 8; ++i) {
            const int idx = TID + 512 * i, dq = idx & 63, pp = idx >> 6, o = d ? 63 - pp : pp;
            kT[dq * 72 + pp] = f2bf(mconv(z, cw, base + o, oc * 64 + o, L, 256 + h * 64 + dq) * 0.125f);
        }
#pragma unroll
        for (int i = 0; i < 16; ++i) {
            const int idx = TID + 512 * i, vv = idx & 127, pp = idx >> 7, o = d ? 63 - pp : pp;
            vT[vv * 72 + pp] = f2bf(bf2f(z[(base + o) * ZW + ZC_MV + h * 128 + vv]) * wsl[pp]);
        }
        __syncthreads();
        f32x4 acc[4];
#pragma unroll
        for (int nt = 0; nt < 4; ++nt) acc[nt] = (f32x4){0.f, 0.f, 0.f, 0.f};
#pragma unroll
        for (int ks = 0; ks < 2; ++ks) {
            const bf16x8 a = *(const bf16x8*)(vT + (16 * wid + (lane & 15)) * 72 + ks * 32 + (lane >> 4) * 8);
#pragma unroll
            for (int nt = 0; nt < 4; ++nt) { const bf16x8 bb = *(const bf16x8*)(kT + (16 * nt + (lane & 15)) * 72 + ks * 32 + (lane >> 4) * 8); acc[nt] = MFMA16(a, bb, acc[nt]); }
        }
#pragma unroll
        for (int nt = 0; nt < 4; ++nt)
#pragma unroll
            for (int j = 0; j < 4; ++j) mst[(size_t)slot * 8192 + (16 * wid + (lane >> 4) * 4 + j) * 64 + 16 * nt + (lane & 15)] = f2bf(acc[nt][j]);
        if (TID < 64) { float s = 0.f; for (int pp = 0; pp < 64; ++pp) s += wsl[pp] * bf2f(kT[TID * 72 + pp]); mn[slot * 64 + TID] = s; }
    }
    __syncthreads();
}
DI void ph_mlstm_b(const Prm& p) { PH_IDS
    bf16_t* mst = (bf16_t*)(p.ws + WS_MST); float* msc = (float*)(p.ws + WS_MSC); float* mn = (float*)(p.ws + WS_MN);
    for (int e = BID * 512 + TID; e < 16 * 8256; e += NBLK * 512) {
        const int chain = e / 8256, idx = e % 8256; float m = 0.f, C = 0.f;
        for (int c0 = 0; c0 < NCHK; c0 += 12) {
            float uu[12], bt[12], ml[12];
#pragma unroll
            for (int j = 0; j < 12; ++j) {
                const int slot = chain * NCHK + c0 + j; bt[j] = msc[slot * 4]; ml[j] = msc[slot * 4 + 1];
                uu[j] = idx < 8192 ? bf2f(mst[(size_t)slot * 8192 + idx]) : mn[slot * 64 + idx - 8192];
            }
#pragma unroll
            for (int j = 0; j < 12; ++j) {
                const int slot = chain * NCHK + c0 + j;
                if (idx < 8192) mst[(size_t)slot * 8192 + idx] = f2bf(C); else mn[slot * 64 + idx - 8192] = C;
                if (idx == 0) msc[slot * 4 + 2] = m;
                const float mnew = fmaxf(bt[j] + m, ml[j]);
                C = __expf(bt[j] + m - mnew) * C + __expf(ml[j] - mnew) * uu[j]; m = mnew;
            }
        }
    }
}
DI void ph_mlstm_c(const Prm& p, int l, unsigned char* smem, int ubeg, int ustride, int ucount = 1 << 30) { PH_IDS
    const int lane = TID & 63, wid = TID >> 6;
    bf16_t* z = (bf16_t*)(p.ws + WS_Z); const bf16_t* mst = (const bf16_t*)(p.ws + WS_MST); const float* msc = (const float*)(p.ws + WS_MSC); const float* mn = (const float*)(p.ws + WS_MN);
    const float* cw = p.m_conv + (size_t)l * 3 * 512; const float* gb = p.m_gb + l * 16;
    bf16_t* qs = (bf16_t*)smem; bf16_t* ks_ = (bf16_t*)(smem + 9216); bf16_t* vT = (bf16_t*)(smem + 18432); bf16_t* Sp = (bf16_t*)(smem + 36864);
    float* hsum = (float*)(smem + 46080); float* fa = (float*)(smem + 46080 + 33792);
    float *bcum = fa, *gg = fa + 64, *Mrow = fa + 128, *iw = fa + 192, *den = fa + 256, *nq = fa + 320;
    for (int u = ubeg, un = 0; u < 1056 && un < ucount; u += ustride, ++un) {
        const int b = u / 528, h = (u % 528) / NCHK, cc = u % NCHK;
        const bool isctx = cc < 4; const int oc = isctx ? cc : cc - 4, nch = isctx ? 4 : 128, L = isctx ? CTXL : SEQL;
        const size_t base = isctx ? (size_t)NLAT + b * CTXL + oc * 64 : (size_t)b * SEQL + oc * 64;
        for (int d = 0; d < 2; ++d) {
            const int cs = d ? nch - 1 - oc : oc, c = isctx ? cs : cs + 4, slot = ((d * 2 + b) * 4 + h) * NCHK + c;
            const float mst_m = msc[slot * 4 + 2];
            __syncthreads();
            if (wid == 0) {
                const int o = d ? 63 - lane : lane; const bf16_t* zr = z + (base + o) * ZW + ZC_MG + 8 * d + h;
                const float ig = bf2f(zr[0]) + gb[(2 * d) * 4 + h], lf = logsigf_(bf2f(zr[4]) + gb[(2 * d + 1) * 4 + h]);
                const float bc = wave_incl_scan_add(lf, lane), g = ig - bc, pm = wave_incl_scan_max(g, lane), M = fmaxf(mst_m, pm);
                bcum[lane] = bc; gg[lane] = g; Mrow[lane] = M; iw[lane] = __expf(mst_m - M);
            }
#pragma unroll 2
            for (int i = 0; i < 16; ++i) {
                const int idx = TID + 512 * i, chq = idx & 127, pp = idx >> 7, o = d ? 63 - pp : pp, isk = chq >> 6, dq = chq & 63;
                const float v = mconv(z, cw, base + o, oc * 64 + o, L, isk * 256 + h * 64 + dq);
                if (isk) ks_[pp * 72 + dq] = f2bf(v * 0.125f); else qs[pp * 72 + dq] = f2bf(v);
            }
#pragma unroll 4
            for (int i = 0; i < 16; ++i) {
                const int idx = TID + 512 * i, vv = idx & 127, pp = idx >> 7, o = d ? 63 - pp : pp;
                vT[vv * 72 + pp] = z[(base + o) * ZW + ZC_MV + h * 128 + vv];
            }
            __syncthreads();
            {
                const int mt = wid >> 1;
#pragma unroll
                for (int nn = 0; nn < 2; ++nn) {
                    const int nt = 2 * (wid & 1) + nn; f32x4 acc = {0.f, 0.f, 0.f, 0.f};
#pragma unroll
                    for (int ks = 0; ks < 2; ++ks) {
                        const bf16x8 a = *(const bf16x8*)(qs + (16 * mt + (lane & 15)) * 72 + ks * 32 + (lane >> 4) * 8);
                        const bf16x8 bb = *(const bf16x8*)(ks_ + (16 * nt + (lane & 15)) * 72 + ks * 32 + (lane >> 4) * 8);
                        acc = MFMA16(a, bb, acc);
                    }
                    const int s = 16 * nt + (lane & 15);
#pragma unroll
                    for (int j = 0; j < 4; ++j) { const int pp = 16 * mt + (lane >> 4) * 4 + j; const float v = s <= pp ? acc[j] * __expf(gg[s] - Mrow[pp]) : 0.f; Sp[pp * 72 + s] = f2bf(v); }
                }
                if (TID < 64) { float s = 0.f; for (int dq = 0; dq < 64; ++dq) s += mn[slot * 64 + dq] * bf2f(qs[TID * 72 + dq]); nq[TID] = s; }
            }
            __syncthreads();
            if (TID < 64) { float s = 0.f; for (int k = 0; k < 64; ++k) s += bf2f(Sp[TID * 72 + k]); den[TID] = s + iw[TID] * nq[TID]; }
            f32x4 a1[4], a2[4];
#pragma unroll
            for (int mt = 0; mt < 4; ++mt) { a1[mt] = (f32x4){0.f, 0.f, 0.f, 0.f}; a2[mt] = (f32x4){0.f, 0.f, 0.f, 0.f}; }
#pragma unroll
            for (int ks = 0; ks < 2; ++ks) {
                const bf16x8 bv = *(const bf16x8*)(vT + (16 * wid + (lane & 15)) * 72 + ks * 32 + (lane >> 4) * 8);
                const bf16x8 bc = *(const bf16x8*)(mst + (size_t)slot * 8192 + (16 * wid + (lane & 15)) * 64 + ks * 32 + (lane >> 4) * 8);
#pragma unroll
                for (int mt = 0; mt < 4; ++mt) {
                    const bf16x8 as = *(const bf16x8*)(Sp + (16 * mt + (lane & 15)) * 72 + ks * 32 + (lane >> 4) * 8);
                    const bf16x8 aq = *(const bf16x8*)(qs + (16 * mt + (lane & 15)) * 72 + ks * 32 + (lane >> 4) * 8);
                    a1[mt] = MFMA16(as, bv, a1[mt]); a2[mt] = MFMA16(aq, bc, a2[mt]);
                }
            }
            __syncthreads();
            {
                const int vv = 16 * wid + (lane & 15);
#pragma unroll
                for (int mt = 0; mt < 4; ++mt)
#pragma unroll
                    for (int j = 0; j < 4; ++j) {
                        const int pp = 16 * mt + (lane >> 4) * 4 + j, o = d ? 63 - pp : pp;
                        const float val = (a1[mt][j] + iw[pp] * a2[mt][j]) / fmaxf(fabsf(den[pp]), __expf(-(bcum[pp] + Mrow[pp])));
                        if (d == 0) hsum[o * 132 + vv] = val; else hsum[o * 132 + vv] += val;
                    }
            }
        }
        __syncthreads();
#pragma unroll
        for (int i = 0; i < 8; ++i) {
            const int o = wid * 8 + i; const float x0 = hsum[o * 132 + lane], x1 = hsum[o * 132 + lane + 64];
            const float ss = wave_sum(x0 * x0 + x1 * x1), rinv = rsqrtf(ss * (1.f / 128.f) + 1e-6f);
            bf16_t* zo = z + (base + o) * ZW + ZC_MO + h * 128; const float* on = p.m_on + l * 512 + h * 128;
            zo[lane] = f2bf(x0 * rinv * on[lane] * sigmoidf_(bf2f(zo[lane])));
            zo[lane + 64] = f2bf(x1 * rinv * on[lane + 64] * sigmoidf_(bf2f(zo[lane + 64])));
        }
    }
    __syncthreads();
}
DI int swap23(int s) { return (s & ~12) | ((s & 4) << 1) | ((s & 8) >> 1); }
DI void ph_attn(const Prm& p, int l, unsigned char* smem, int bh, int qfirst, int qstep, int nq, int qextra) { PH_IDS
    const int lane = TID & 63, wid = TID >> 6, q = lane & 31, hh = lane >> 5, qg = wid >> 1, mp = wid & 1;
    bf16_t* z = (bf16_t*)(p.ws + WS_Z);
    float lam; const float lam_init = 0.8f - 0.6f * expf(-0.3f * (float)l);
    { const float* lp = p.a_lam + l * 256; float s1 = 0.f, s2 = 0.f; for (int i = 0; i < 64; ++i) { s1 += lp[i] * lp[64 + i]; s2 += lp[128 + i] * lp[192 + i]; } lam = expf(s1) - expf(s2) + lam_init; }
    bf16_t* Qs = (bf16_t*)smem; float* ex = (float*)smem;
    constexpr int KB_OFF = 34816, VT_OFF = 69632;
    for (int ui = 0; ui < nq + (qextra >= 0 ? 1 : 0); ++ui) {
        const int qi = ui < nq ? qfirst + ui * qstep : qextra;
        const int b = bh >> 2, head = bh & 3; int nt; size_t qrow0;
        const bool lat = qi < 64;
        if (lat) { qrow0 = (size_t)b * SEQL + qi * 128; nt = 132; } else { qrow0 = (size_t)NLAT + b * CTXL + (qi - 64) * 128; nt = 4; }
        __syncthreads();
#pragma unroll
        for (int i = 0; i < 4; ++i) { const int idx = TID + 512 * i, r = idx >> 4, cp = idx & 15; *(u32x4*)(Qs + r * 136 + cp * 8) = *(const u32x4*)(z + (qrow0 + r) * ZW + ZC_AQ + head * 128 + cp * 8); }
        u32x4 kreg[2], vreg[2];
        const int kp = TID & 31, vg = TID >> 5;
#define ATT_KROW0(j) ((lat && (j) >= 4) ? (size_t)b * SEQL + 64 * ((j) - 4) : (size_t)NLAT + b * CTXL + 64 * (j))
#define ATT_LOAD(j) do { const size_t kr0 = ATT_KROW0(j); \
            _Pragma("unroll") for (int i = 0; i < 2; ++i) { const int idx = TID + 512 * i, r = idx >> 4, cp = idx & 15; kreg[i] = *(const u32x4*)(z + (kr0 + r) * ZW + ZC_AK + head * 128 + cp * 8); } \
            _Pragma("unroll") for (int i = 0; i < 2; ++i) vreg[i] = *(const u32x4*)(z + (kr0 + 2 * kp + i) * ZW + ZC_AV + head * 128 + 8 * vg); } while (0)
#define ATT_WRITE(buf) do { bf16_t* Kw = (bf16_t*)(smem + KB_OFF + (buf) * 17408); bf16_t* Vw = (bf16_t*)(smem + VT_OFF + (buf) * 18432); \
            _Pragma("unroll") for (int i = 0; i < 2; ++i) { const int idx = TID + 512 * i, r = idx >> 4, cp = idx & 15; *(u32x4*)(Kw + r * 136 + cp * 8) = kreg[i]; } \
            _Pragma("unroll") for (int w = 0; w < 4; ++w) { \
                *(unsigned*)(Vw + (8 * vg + 2 * w) * 72 + 2 * kp) = (vreg[0][w] & 0xffffu) | (vreg[1][w] << 16); \
                *(unsigned*)(Vw + (8 * vg + 2 * w + 1) * 72 + 2 * kp) = (vreg[0][w] >> 16) | (vreg[1][w] & 0xffff0000u); } } while (0)
        ATT_LOAD(0); ATT_WRITE(0);
        __syncthreads();
        f32x16 o[4]; float mrun = -1e30f, lrun = 0.f;
#pragma unroll
        for (int dvb = 0; dvb < 4; ++dvb)
#pragma unroll
            for (int i = 0; i < 16; ++i) o[dvb][i] = 0.f;
        for (int j = 0; j < nt; ++j) {
            const int cur = j & 1;
            if (j + 1 < nt) ATT_LOAD(j + 1);
            const bf16_t* Kb = (const bf16_t*)(smem + KB_OFF + cur * 17408); const bf16_t* Vt = (const bf16_t*)(smem + VT_OFF + cur * 18432);
            f32x16 s0, s1;
#pragma unroll
            for (int i = 0; i < 16; ++i) { s0[i] = 0.f; s1[i] = 0.f; }
#pragma unroll
            for (int kk = 0; kk < 4; ++kk) {
                const bf16x8 qf = *(const bf16x8*)(Qs + (32 * qg + q) * 136 + mp * 64 + kk * 16 + hh * 8);
                const bf16x8 k0 = *(const bf16x8*)(Kb + swap23(q) * 136 + mp * 64 + kk * 16 + hh * 8);
                const bf16x8 k1 = *(const bf16x8*)(Kb + (32 + swap23(q)) * 136 + mp * 64 + kk * 16 + hh * 8);
                s0 = MFMA32(k0, qf, s0); s1 = MFMA32(k1, qf, s1);
            }
            float mx = s0[0];
#pragma unroll
            for (int i = 1; i < 16; ++i) mx = fmaxf(mx, s0[i]);
#pragma unroll
            for (int i = 0; i < 16; ++i) mx = fmaxf(mx, s1[i]);
            mx = fmaxf(mx, __shfl_xor(mx, 32));
            const float mnew = fmaxf(mrun, mx), alpha = __expf(mrun - mnew); mrun = mnew;
            float ps = 0.f;
#pragma unroll
            for (int i = 0; i < 16; ++i) { s0[i] = __expf(s0[i] - mnew); s1[i] = __expf(s1[i] - mnew); ps += s0[i] + s1[i]; }
            lrun = lrun * alpha + ps;
#pragma unroll
            for (int dvb = 0; dvb < 4; ++dvb)
#pragma unroll
                for (int i = 0; i < 16; ++i) o[dvb][i] *= alpha;
            bf16x8 pf[4];
#pragma unroll
            for (int cc = 0; cc < 2; ++cc) {
                u32x4 a, c2;
                a.x = pk2(s0[8 * cc], s0[8 * cc + 1]); a.y = pk2(s0[8 * cc + 2], s0[8 * cc + 3]); a.z = pk2(s0[8 * cc + 4], s0[8 * cc + 5]); a.w = pk2(s0[8 * cc + 6], s0[8 * cc + 7]);
                c2.x = pk2(s1[8 * cc], s1[8 * cc + 1]); c2.y = pk2(s1[8 * cc + 2], s1[8 * cc + 3]); c2.z = pk2(s1[8 * cc + 4], s1[8 * cc + 5]); c2.w = pk2(s1[8 * cc + 6], s1[8 * cc + 7]);
                pf[cc] = __builtin_bit_cast(bf16x8, a); pf[2 + cc] = __builtin_bit_cast(bf16x8, c2);
            }
#pragma unroll
            for (int dvb = 0; dvb < 4; ++dvb)
#pragma unroll
                for (int c = 0; c < 4; ++c) {
                    const bf16x8 vf = *(const bf16x8*)(Vt + (dvb * 32 + q) * 72 + 16 * c + 8 * hh);
                    o[dvb] = MFMA32(vf, pf[c], o[dvb]);
                }
            if (j + 1 < nt) ATT_WRITE(cur ^ 1);
            __syncthreads();
        }
        const float lsum = lrun + __shfl_xor(lrun, 32);
        const float inv = (mp ? lam : 1.f) / lsum;
        if (mp) {
#pragma unroll
            for (int dvb = 0; dvb < 4; ++dvb)
#pragma unroll
                for (int i = 0; i < 16; ++i) ex[(qg * 64 + dvb * 16 + i) * 64 + lane] = o[dvb][i] * inv;
        }
        __syncthreads();
        if (!mp) {
            float ss = 0.f;
#pragma unroll
            for (int dvb = 0; dvb < 4; ++dvb)
#pragma unroll
                for (int i = 0; i < 16; ++i) { const float v = o[dvb][i] * inv - ex[(qg * 64 + dvb * 16 + i) * 64 + lane]; o[dvb][i] = v; ss += v * v; }
            ss += __shfl_xor(ss, 32);
            const float rinv = rsqrtf(ss * (1.f / 128.f) + 1e-6f) * (1.f - lam_init);
            bf16_t* orow = z + (qrow0 + 32 * qg + q) * ZW + ZC_AQ + head * 128; const float* sub = p.a_subln + l * 128;
#pragma unroll
            for (int dvb = 0; dvb < 4; ++dvb)
#pragma unroll
                for (int ig = 0; ig < 4; ++ig) {
                    const int dv0 = dvb * 32 + 8 * ig + 4 * hh; u32x2 w;
                    w.x = pk2(o[dvb][4 * ig] * rinv * sub[dv0], o[dvb][4 * ig + 1] * rinv * sub[dv0 + 1]);
                    w.y = pk2(o[dvb][4 * ig + 2] * rinv * sub[dv0 + 2], o[dvb][4 * ig + 3] * rinv * sub[dv0 + 3]);
                    *(u32x2*)(orow + dv0) = w;
                }
        }
    }
    __syncthreads();
}

__device__ unsigned long long g_pacc[4];
template <int CTRL> DI float dppf(float v) { return __int_as_float(__builtin_amdgcn_update_dpp(0, __float_as_int(v), CTRL, 0xf, 0xf, false)); }
DI float allreduce16(float x) { x += dppf<0x128>(x); x += dppf<0x124>(x); x += dppf<0x122>(x); x += dppf<0x121>(x); return x; }
DI void ph_rwkv_scan(const Prm& p, int l, unsigned char* smem, int ubeg, int ustride) { PH_IDS
    const int lane = TID & 63, wid = TID >> 6;
    const bf16_t* z = (const bf16_t*)(p.ws + WS_Z); const bf16_t* rwa = (const bf16_t*)(p.ws + WS_RWA); const float* invn = (const float*)(p.ws + WS_INVN);
    constexpr int TC = 32, OPW = 336, NC = 264, OPS_B = TC * OPW * 4, YP_OFF = 2 * OPS_B;
    for (int u = ubeg; u < 128; u += ustride) {
        const int chain = u >> 2, qr = u & 3, d = chain >> 4, b = (chain >> 3) & 1, h = chain & 7;
        const float ckk = p.r_kk[l * 512 + h * 64 + lane], cka = p.r_ka[l * 512 + h * 64 + lane];
        bf16_t* ydir = (bf16_t*)(p.ws + WS_YSUM) + (size_t)d * NTOK * 512;
#define RW_ROW(ck, i) ((ck) < 8 ? (size_t)NLAT + b * CTXL + (d ? CTXL - 1 - ((ck) * TC + (i)) : ((ck) * TC + (i))) : (size_t)b * SEQL + (d ? SEQL - 1 - (((ck) - 8) * TC + (i)) : (((ck) - 8) * TC + (i))))
        bf16_t g_r[8], g_k[8], g_u[8], g_a[8]; float g_i[8]; unsigned g_v;
        const int sw = wid - 4, st = TID - 256;
#define RW_LOAD(ck) do { _Pragma("unroll") for (int jj = 0; jj < 8; ++jj) { const size_t row = RW_ROW(ck, sw + 4 * jj); \
            g_r[jj] = z[row * ZW + ZC_RR + h * 64 + lane]; g_k[jj] = z[row * ZW + ZC_RK + h * 64 + lane]; \
            g_u[jj] = rwa[row * 2048 + d * 512 + h * 64 + lane]; g_a[jj] = rwa[row * 2048 + 1024 + d * 512 + h * 64 + lane]; g_i[jj] = invn[row * 8 + h]; } \
            g_v = *(const unsigned*)(z + RW_ROW(ck, st >> 3) * ZW + ZC_RV + h * 64 + qr * 16 + (st & 7) * 2); } while (0)
#define RW_WRITE(buf) do { float* ops = (float*)(smem + (buf) * OPS_B); _Pragma("unroll") for (int jj = 0; jj < 8; ++jj) { \
            const float k = bf2f(g_k[jj]), a = bf2f(g_a[jj]), kk = k * ckk * g_i[jj]; float* o = ops + (sw + 4 * jj) * OPW; \
            o[lane] = 1.f - bf2f(g_u[jj]); o[64 + lane] = kk; o[128 + lane] = kk * a; o[192 + lane] = k * (1.f + (a - 1.f) * cka); o[256 + lane] = bf2f(g_r[jj]); } \
            { float* o = ops + (st >> 3) * OPW + 320 + (st & 7) * 2; o[0] = lo16(g_v); o[1] = hi16(g_v); } } while (0)
        __syncthreads();
        if (wid >= 4) { RW_LOAD(0); RW_WRITE(0); RW_LOAD(1); }
        __syncthreads();
        f32x2 Sa = {0.f, 0.f}, Sb = {0.f, 0.f};
        const int rl = (wid & 3) * 4 + (lane >> 4), ksub = lane & 15;
        float* ypw = (float*)(smem + YP_OFF) + (wid & 3) * (TC * 64);
        for (int ck = 0; ck < NC; ++ck) {
            if (wid >= 4) {
                if (ck + 1 < NC) RW_WRITE((ck + 1) & 1);
                if (ck + 2 < NC) RW_LOAD(ck + 2);
            } else {
                const float* ops = (const float*)(smem + (ck & 1) * OPS_B);
#define RW_GET(X, i) do { const float* o_ = ops + (i) * OPW; w_##X = *(const f32x4*)(o_ + 4 * ksub); k_##X = *(const f32x4*)(o_ + 64 + 4 * ksub); b_##X = *(const f32x4*)(o_ + 128 + 4 * ksub); \
                d_##X = *(const f32x4*)(o_ + 192 + 4 * ksub); r_##X = *(const f32x4*)(o_ + 256 + 4 * ksub); v_##X = o_[320 + rl]; } while (0)
#define RW_STEP(X, i) do { const f32x2 ka = {k_##X[0], k_##X[1]}, kb = {k_##X[2], k_##X[3]}, ra = {r_##X[0], r_##X[1]}, rb = {r_##X[2], r_##X[3]}; \
                const f32x2 ba = {b_##X[0], b_##X[1]}, bb = {b_##X[2], b_##X[3]}, da = {d_##X[0], d_##X[1]}, db = {d_##X[2], d_##X[3]}, wa = {w_##X[0], w_##X[1]}, wb = {w_##X[2], w_##X[3]}; \
                const f32x2 dt2 = Sa * ka + Sb * kb; const f32x2 qa = Sa * wa + da * v_##X, qb = Sb * wb + db * v_##X; const float sa = -allreduce16(dt2.x + dt2.y); \
                Sa = ba * sa + qa; Sb = bb * sa + qb; \
                const f32x2 y2 = Sa * ra + Sb * rb; \
                ypw[(i) * 64 + lane] = y2.x + y2.y; } while (0)
                f32x4 w_A, k_A, b_A, d_A, r_A, w_B, k_B, b_B, d_B, r_B; float v_A, v_B;
                RW_GET(A, 0);
#pragma unroll 1
                for (int i = 0; i < TC; i += 2) {
                    RW_GET(B, i + 1);
                    RW_STEP(A, i);
                    if (i + 2 < TC) RW_GET(A, i + 2);
                    RW_STEP(B, i + 1);
                }
                {
                    const int i = lane >> 1, rw = (lane & 1) * 2;
                    const f32x4* y4 = (const f32x4*)(ypw + i * 64 + rw * 16);
                    const f32x4 s4 = (y4[0] + y4[1]) + (y4[2] + y4[3]), t4 = (y4[4] + y4[5]) + (y4[6] + y4[7]);
                    *(unsigned*)(ydir + RW_ROW(ck, i) * 512 + h * 64 + qr * 16 + wid * 4 + rw) = pk2((s4[0] + s4[1]) + (s4[2] + s4[3]), (t4[0] + t4[1]) + (t4[2] + t4[3]));
                }
            }
            asm volatile("s_waitcnt lgkmcnt(0)\n\ts_barrier" ::: "memory");
        }
    }
    __syncthreads();
}
DI void ph_rwkv_post(const Prm& p, int l) { PH_IDS
    const int lane = TID & 63, wid = TID >> 6, ch0 = lane * 8;
    bf16_t* z = (bf16_t*)(p.ws + WS_Z); const bf16_t* ysum = (const bf16_t*)(p.ws + WS_YSUM); const bf16_t* rg = (const bf16_t*)(p.ws + WS_RG);
    for (int row = BID * 8 + wid; row < NTOK; row += NBLK * 8) {
        float y[8], y2[8], r[8], k[8], v[8], g[8], o[8];
        unpack8(*(const u32x4*)(ysum + (size_t)row * 512 + ch0), y); unpack8(*(const u32x4*)(ysum + (size_t)(NTOK + row) * 512 + ch0), y2);
#pragma unroll
        for (int e = 0; e < 8; ++e) y[e] += y2[e];
        bf16_t* zr = z + (size_t)row * ZW + ZC_RR + ch0;
        unpack8(*(const u32x4*)zr, r); unpack8(*(const u32x4*)(zr + 512), k); unpack8(*(const u32x4*)(zr + 1024), v); unpack8(*(const u32x4*)(rg + (size_t)row * 512 + ch0), g);
        float s = 0.f, bs = 0.f;
#pragma unroll
        for (int e = 0; e < 8; ++e) { s += y[e]; bs += r[e] * k[e] * p.r_rk[l * 512 + ch0 + e]; }
        s += __shfl_xor(s, 1); s += __shfl_xor(s, 2); s += __shfl_xor(s, 4); bs += __shfl_xor(bs, 1); bs += __shfl_xor(bs, 2); bs += __shfl_xor(bs, 4);
        const float mu = s * (1.f / 64.f); float vs = 0.f;
#pragma unroll
        for (int e = 0; e < 8; ++e) { const float dlt = y[e] - mu; vs += dlt * dlt; }
        vs += __shfl_xor(vs, 1); vs += __shfl_xor(vs, 2); vs += __shfl_xor(vs, 4);
        const float rstd = rsqrtf(vs * (1.f / 64.f) + 64e-5f);
#pragma unroll
        for (int e = 0; e < 8; ++e) o[e] = ((y[e] - mu) * rstd * p.r_lnw[l * 512 + ch0 + e] + p.r_lnb[l * 512 + ch0 + e] + bs * v[e]) * g[e];
        *(u32x4*)zr = pack8(o);
    }
}

#ifndef PROBE_A
#define PROBE_A 0
#endif
#ifndef PROBE_B
#define PROBE_B 0
#endif
#ifndef PROBE_BLK
#define PROBE_BLK 0
#endif
#ifndef PROBE_ADIV
#define PROBE_ADIV 1
#endif
#ifndef PROBE_BDIV
#define PROBE_BDIV 1
#endif
#if PROBE_A || PROBE_B
#define PT(id, ...) do { unsigned long long t0_ = wall_clock64(); __VA_ARGS__; unsigned long long dt_ = wall_clock64() - t0_; if ((id) == PROBE_A) pacc1 += dt_; if ((id) == PROBE_B) pacc2 += dt_; } while (0)
#else
#define PT(id, ...) do { __VA_ARGS__; } while (0)
#endif
__global__ void __launch_bounds__(512) mega(Prm p0) {
    Prm p = p0; p.wv = __builtin_amdgcn_readfirstlane((int)threadIdx.x >> 6);
    const int BIDK = (int)blockIdx.x;
    extern __shared__ __attribute__((aligned(16))) unsigned char smem[];
    cg::grid_group grid = cg::this_grid();
    bf16_t* wt = (bf16_t*)(p.ws + WS_WT); bf16_t* zb = (bf16_t*)(p.ws + WS_Z); bf16_t* hb = (bf16_t*)(p.ws + WS_RWA); bf16_t* gtmp = hb + (size_t)NTOK * DM;
    bf16_t* zz = (bf16_t*)(p.ws + WS_MST); float* xc = (float*)(p.ws + WS_XC); const float* mods = (const float*)(p.ws + WS_MODS);
#if PROBE_A || PROBE_B
    unsigned long long pacc1 = 0, pacc2 = 0; const unsigned long long pstart = wall_clock64();
    if (PROBE_SCAN && blockIdx.x == 0 && threadIdx.x == 0) { g_pacc[0] = 0; g_pacc[1] = 0; }
#endif
    PT(15, ph_modpart(p, smem); ph_rope(p); conv_ffn(p, 0, 0, smem));
    PT(14, grid.sync());
    ph_modreduce(p);
    PT(14, grid.sync());
#define MERGE_B(l, b) do { \
                    { EpiGate E; E.G = gtmp; run_gemm(p.wv, smem, hb, DM, wt + WT_G + (size_t)(b) * DM * DM, (l) == 1 ? NLAT : NTOK, DM, DM, E); } \
                    { EpiBranch E; E.G = gtmp; E.ZZ = zz; E.first = ((b) == 0); const int yc = (b) == 0 ? ZC_MO : ((b) == 1 ? ZC_RR : ZC_AQ); \
                      run_gemm(p.wv, smem, zb + yc, ZW, wt + WT_P + (size_t)(b) * DM * 512, (l) == 1 ? NLAT : NTOK, DM, 512, E); } \
 } while (0)
#define MIXER_STAGE(l) do { const float* ml = mods + (size_t)(l) * 27648; \
                PT(13, ph_norm(p, l, 1, false); conv_mixer(p, l, smem);); \
                PT(14, grid.sync()); \
                PT(8, { EpiWin E; E.Z = zb; run_gemm(p.wv, smem, hb, DM, wt + WT_IN, NTOK, ZWP, DM, E); }); \
                PT(14, grid.sync()); \
                PT(4, ph_rkv_conv(p, l); ph_attn_prep(p, l)); PT(5, ph_mlstm_a(p, l, smem)); \
                PT(14, grid.sync()); \
                PT(6, ph_rkv_copy(p)); PT(7, ph_mlstm_b(p)); \
                PT(14, grid.sync()); \
                PT(16, { EpiLora E; E.RWA = hb; E.RG = (bf16_t*)(p.ws + WS_RG); E.w0 = p.r_w0 + l * 1024; E.a0 = p.r_a0 + l * 1024; run_gemm(p.wv, smem, zb + ZC_RL, ZW, wt + WT_L, NTOK, 2560, 384, E); }); \
                PT(14, grid.sync()); \
                { int sc_u = BIDK, sc_s = NBLK, bh0 = 0, bh1 = 8, qf = BIDK, qs = NBLK, nq = (66 - BIDK + NBLK - 1) / NBLK, qx = -1, mc_u = BIDK, mc_s = NBLK, mc_c = 1 << 30; \
                  if (NBLK == 256) { const int xi = BIDK >> 3, bh = BIDK & 7; bh0 = bh; bh1 = bh + 1; sc_s = 128; \
                      if (xi < 16) { sc_u = bh * 16 + xi; nq = 0; mc_u = 640 + bh * 16 + xi; mc_s = 128; } \
                      else { const int a = xi - 16; sc_u = 128; qf = a; qs = 16; nq = 4; qx = a < 2 ? 64 + a : -1; mc_u = (bh * 16 + a) * 5; mc_s = 1; mc_c = 5; } } \
                  PT(1, ph_rwkv_scan(p, l, smem, sc_u, sc_s)); \
                  PT(2, for (int bh = bh0; bh < bh1; ++bh) ph_attn(p, l, smem, bh, qf, qs, nq, qx)); \
                  PT(3, ph_mlstm_c(p, l, smem, mc_u, mc_s, mc_c)); } \
                PT(14, grid.sync()); \
                PT(12, ph_rwkv_post(p, l); ph_norm(p, l, 1, false)); \
                PT(14, grid.sync()); \
                PT(9, MERGE_B(l, 0); MERGE_B(l, 1); MERGE_B(l, 2)); \
                PT(14, grid.sync()); \
                PT(17, { EpiResid E; E.xlat = p.out; E.xc = xc; E.gate = ml + 5 * DM; E.coef = 1.f; run_gemm(p.wv, smem, zz, DM, wt + WT_O, (l) == 1 ? NLAT : NTOK, DM, DM, E); }); \
                PT(14, grid.sync()); \
 } while (0)
#define FFN_STAGE(l, f) do { const float* ml = mods + (size_t)(l) * 27648; \
            PT(18, ph_norm(p, l, f == 0 ? 0 : 2, l == 0 && f == 0); \
            if (!(l == 0 && f == 0)) conv_ffn(p, l, f, smem)); \
            PT(14, grid.sync()); \
            PT(10, { EpiSwiglu E; E.H = zb; run_gemm(p.wv, smem, hb, DM, wt + WT_GU, ((l) == 1 && (f) == 1) ? NLAT : NTOK, 2 * DFF, DM, E); }); \
            PT(14, grid.sync()); \
            PT(11, { EpiResid E; E.xlat = p.out; E.xc = xc; E.gate = ml + (f == 0 ? 2 : 8) * DM; E.coef = 0.5f; run_gemm(p.wv, smem, zb, DFF, wt + WT_DN, ((l) == 1 && (f) == 1) ? NLAT : NTOK, DM, DFF, E); }); \
            PT(14, grid.sync()); \
 } while (0)
    FFN_STAGE(0, 0); MIXER_STAGE(0); FFN_STAGE(0, 1); FFN_STAGE(1, 0); MIXER_STAGE(1); FFN_STAGE(1, 1);
#if PROBE_A || PROBE_B
    if (blockIdx.x == PROBE_BLK) {
        const unsigned long long pend = wall_clock64();
        if (PROBE_SCAN) { __syncthreads(); pacc1 = g_pacc[0]; pacc2 = g_pacc[1]; }
        if (PROBE_A == 99) pacc1 = pend - pstart;
        if (PROBE_B == 99) pacc2 = pend - pstart;
        unsigned long long q1 = pacc1 / (4000ull * PROBE_ADIV), q2 = pacc2 / (4000ull * PROBE_BDIV); if (q1 > 63) q1 = 63; if (q2 > 63) q2 = 63;
        const unsigned long long waitt = (q1 + 64 * q2) * 2000ull;
        while (wall_clock64() - pend < waitt) __builtin_amdgcn_s_sleep(32);
    }
#endif
}

extern "C" void kernel_launch(void* const* d_in, const int* in_sizes, int n_in, void* d_out, int out_size, void* d_ws, size_t ws_size, hipStream_t stream) {
    static int grid_blocks = 0;
    if (!grid_blocks) {
        int dev = 0, cus = 0, per_cu = 0;
        hipGetDevice(&dev);
        hipDeviceGetAttribute(&cus, hipDeviceAttributeMultiprocessorCount, dev);
        hipFuncSetAttribute((const void*)mega, hipFuncAttributeMaxDynamicSharedMemorySize, LDS_BYTES);
        hipOccupancyMaxActiveBlocksPerMultiprocessor(&per_cu, (const void*)mega, 512, LDS_BYTES);
        if (per_cu < 1) per_cu = 1;
        grid_blocks = cus * per_cu;
        if (ws_size < WS_END) fprintf(stderr, "kernel_launch: workspace too small: %zu < %zu\n", ws_size, (size_t)WS_END);
    }
    Prm p{};
    const float** pp = (const float**)&p;
    for (int i = 0; i < 31; ++i) pp[i] = (const float*)d_in[i];
    p.out = (float*)d_out; p.ws = (unsigned char*)d_ws;
    void* args[] = {&p};
    hipError_t e = hipLaunchCooperativeKernel((const void*)mega, dim3(grid_blocks), dim3(512), args, LDS_BYTES, stream);
    if (e != hipSuccess) fprintf(stderr, "cooperative launch failed: %s (grid %d)\n", hipGetErrorString(e), grid_blocks);
}
```

```cpp
#include <hip/hip_runtime.h>
#include <hip/hip_cooperative_groups.h>
#include <cstdio>
#include <cstdint>
namespace cg = cooperative_groups;
#ifndef PROBE_SCAN
#define PROBE_SCAN 0
#endif

#define LAS __attribute__((address_space(3)))
#define DI __device__ __forceinline__
typedef unsigned short bf16_t;
typedef short bf16x8 __attribute__((ext_vector_type(8)));
typedef float f32x4 __attribute__((ext_vector_type(4)));
typedef float f32x16 __attribute__((ext_vector_type(16)));
typedef float f32x2 __attribute__((ext_vector_type(2)));
typedef unsigned u32x4 __attribute__((ext_vector_type(4)));
typedef unsigned u32x2 __attribute__((ext_vector_type(2)));
typedef __bf16 bf16x2_t __attribute__((ext_vector_type(2)));

constexpr int DM = 1024, NLAT = 16384, NTOK = 16896, SEQL = 8192, CTXL = 256, DFF = 2816, DIN = 8080, ZW = 5008, ZWP = 5120;
constexpr int ZC_MQ = 0, ZC_MK = 256, ZC_MV = 512, ZC_MO = 1024, ZC_MG = 1536, ZC_RR = 1552, ZC_RK = 2064, ZC_RV = 2576, ZC_RL = 3088, ZC_AQ = 3472, ZC_AK = 3984, ZC_AV = 4496;
constexpr int NCHK = 132;
constexpr size_t WS_MODP = 0;
constexpr size_t WS_MODS = WS_MODP + (size_t)2 * 16 * 3 * 9216 * 4;
constexpr size_t WS_ROPE = WS_MODS + (size_t)2 * 3 * 9216 * 4;
constexpr size_t WS_XC   = WS_ROPE + (size_t)8192 * 64 * 4;
constexpr size_t WS_INVN = WS_XC + (size_t)512 * 1024 * 4;
constexpr size_t WS_MSC  = WS_INVN + (size_t)NTOK * 8 * 4;
constexpr size_t WS_MN   = WS_MSC + (size_t)2112 * 4 * 4;
constexpr size_t WS_WT   = WS_MN + (size_t)2112 * 64 * 4;
constexpr size_t WS_Z    = WS_WT + (size_t)25165824;
constexpr size_t WS_RWA  = WS_Z + (size_t)NTOK * ZW * 2;
constexpr size_t WS_RG   = WS_RWA + (size_t)NTOK * 2048 * 2;
constexpr size_t WS_MST  = WS_RG + (size_t)NTOK * 512 * 2;
constexpr size_t WS_YSUM = WS_MST + (size_t)2112 * 8192 * 2;
constexpr size_t WS_BAR  = WS_YSUM + (size_t)NTOK * 512 * 4;
constexpr size_t WS_END  = WS_BAR + 256;
constexpr size_t WT_GU = 0, WT_DN = (size_t)5632 * 1024;
constexpr size_t WT_IN = 0, WT_G = (size_t)5120 * 1024, WT_P = WT_G + (size_t)3072 * 1024, WT_O = WT_P + (size_t)3 * 1024 * 512, WT_L = WT_O + (size_t)1024 * 1024;
constexpr int LDS_BYTES = 155648;

DI float bf2f(bf16_t b) { return __uint_as_float(((unsigned)b) << 16); }
DI unsigned pk2(float lo, float hi) { f32x2 v = {lo, hi}; bf16x2_t b = __builtin_convertvector(v, bf16x2_t); return __builtin_bit_cast(unsigned, b); }
DI bf16_t f2bf(float f) { return (bf16_t)(pk2(f, 0.f) & 0xffffu); }
DI float lo16(unsigned u) { return __uint_as_float(u << 16); }
DI float hi16(unsigned u) { return __uint_as_float(u & 0xffff0000u); }
DI float sigmoidf_(float x) { return __builtin_amdgcn_rcpf(1.f + __expf(-x)); }
DI float siluf_(float x) { return x * __builtin_amdgcn_rcpf(1.f + __expf(-x)); }
DI float logsigf_(float x) { return x < 0.f ? x - log1pf(expf(x)) : -log1pf(expf(-x)); }
DI float wave_sum(float v) {
#pragma unroll
    for (int o = 1; o < 64; o <<= 1) v += __shfl_xor(v, o);
    return v;
}
DI float wave_max(float v) {
#pragma unroll
    for (int o = 1; o < 64; o <<= 1) v = fmaxf(v, __shfl_xor(v, o));
    return v;
}
DI void unpack8(const u32x4 u, float* f) { f[0] = lo16(u.x); f[1] = hi16(u.x); f[2] = lo16(u.y); f[3] = hi16(u.y); f[4] = lo16(u.z); f[5] = hi16(u.z); f[6] = lo16(u.w); f[7] = hi16(u.w); }
DI u32x4 pack8(const float* f) { u32x4 u; u.x = pk2(f[0], f[1]); u.y = pk2(f[2], f[3]); u.z = pk2(f[4], f[5]); u.w = pk2(f[6], f[7]); return u; }
DI int launder_v(int v) { asm volatile("" : "+v"(v)); return v; }
DI int launder_s(int v) { asm volatile("" : "+s"(v)); return v; }
DI int lane_id_() { return (int)__builtin_amdgcn_mbcnt_hi(~0u, __builtin_amdgcn_mbcnt_lo(~0u, 0u)); }
namespace pg8 {
#define PG8_LAS __attribute__((address_space(3)))
typedef unsigned short bf16_t;
typedef short bf16x8 __attribute__((ext_vector_type(8)));
typedef float f32x4 __attribute__((ext_vector_type(4)));
typedef unsigned u32x4 __attribute__((ext_vector_type(4)));
constexpr int BM = 256, BK = 64, HALF = 128, HTB = HALF * BK * 2  , STAGE_BYTES = 8 * HTB, NXCD = 8, WGM = 8;

__host__ __device__ __forceinline__ int lds_byte(int r, int c) { const int st = (r >> 4) * 2 + (c >> 5), rr = r & 15, cc = c & 31, ob = rr * 64 + cc * 2; return st * 1024 + (ob ^ (((ob >> 9) & 1) << 5)); }
__host__ __device__ __forceinline__ void stage_rc(int b, int& R, int& C) { const int st = b / 1024, sb = b % 1024, swz = sb ^ (((sb >> 9) & 1) << 5); R = (st >> 1) * 16 + swz / 64; C = (st & 1) * 32 + (swz % 64) / 2; }
__host__ __device__ __forceinline__ int perm32(int rho) { const int n = rho >> 4, i = rho & 15; return 8 * (i >> 2) + 4 * n + (i & 3); }

struct Unit { int pm, pn; size_t koff; };
struct Gemm { const bf16_t* A; const bf16_t* Bt; int M, N, K, lda, ldb, tid0; };

struct StaticOrder {
    int nM, nN, nwg, G, c;
    __host__ __device__ void init(int M, int N, int G_, int c_) { nM = M / BM; nN = N / BM; nwg = nM * nN; G = G_; c = c_; }
    __host__ __device__ bool next(int i, Unit& u) const {
        const long L = (long)i * G + c; if (L >= nwg) return false;
        int wgid = (int)L; { const int q = nwg / NXCD, r = nwg % NXCD, xcd = wgid % NXCD, off = wgid / NXCD; wgid = (xcd < r ? xcd * (q + 1) : r * (q + 1) + (xcd - r) * q) + off; }
        const int nig = WGM * nN, gid = wgid / nig, fm = gid * WGM, gsz = (nM - fm) < WGM ? (nM - fm) : WGM;
        u.pm = fm + ((wgid % nig) % gsz); u.pn = (wgid % nig) / gsz; u.koff = 0; return true;
    }
    __device__ __forceinline__ void a_ready(const Unit&) const {}
    __device__ __forceinline__ void done(const Unit&) const {}
};


template <class Epi, class Sched, bool ALIGN_EPI = false, bool SP2 = false>
__device__ __forceinline__ void gemm_phase(PG8_LAS unsigned char* lds, const Gemm g, const Sched& S, const Epi& E) {
    int tid = g.tid0; asm volatile("" : "+v"(tid)); const int wid = __builtin_amdgcn_readfirstlane(tid >> 6), lane = tid & 63, wr = wid >> 2, wc = wid & 3, fr = lane & 15, fq = lane >> 4;
    const int K = g.K, nt = K / BK;
    unsigned voffA[2], voffB[2];
#pragma unroll
    for (int i = 0; i < 2; ++i) { int R, C; stage_rc(tid * 16 + i * 8192, R, C); const int Rb = Epi::PERM ? ((R & ~31) + perm32(R & 31)) : R;
        voffA[i] = (unsigned)(R * g.lda + C) * 2u; voffB[i] = (unsigned)(Rb * g.ldb + C) * 2u; }
    const size_t kstep = (size_t)(BK * 2);
    const size_t hstepB = (size_t)HALF * g.ldb * 2, hstepA = (size_t)HALF * g.lda * 2;
    const size_t tstepA = 2 * hstepA, tstepB = 2 * hstepB;
    const unsigned ldsw = (unsigned)wid * 1024u;
    const int aoff = lds_byte(wr * 64 + fr, fq * 8), boff = lds_byte(wc * 32 + fr, fq * 8);
#define PG8_SA(b, h) (((b) * 2 + (h)) * HTB)
#define PG8_SB(b, h) ((4 + (b) * 2 + (h)) * HTB)
#define PG8_STAGE(bufoff, gbase, voff) do { _Pragma("unroll") for (int _i = 0; _i < 2; ++_i) \
        __builtin_amdgcn_global_load_lds((const unsigned*)((const char*)(gbase) + (voff)[_i]), (PG8_LAS unsigned*)(lds + (bufoff) + ldsw + _i * 8192), 16, 0, 0); } while (0)
#define PG8_LDA(dst, b, h) do { _Pragma("unroll") for (int m = 0; m < 4; ++m) _Pragma("unroll") for (int k = 0; k < 2; ++k) dst[m][k] = *(const PG8_LAS bf16x8*)(lds + PG8_SA(b, h) + aoff + m * 2048 + k * 1024); } while (0)
#define PG8_LDB(dst, b, h) do { _Pragma("unroll") for (int n = 0; n < 2; ++n) _Pragma("unroll") for (int k = 0; k < 2; ++k) dst[n][k] = *(const PG8_LAS bf16x8*)(lds + PG8_SB(b, h) + boff + n * 2048 + k * 1024); } while (0)
#define PG8_MMA(ai, bj, At, Bt) do { __builtin_amdgcn_s_setprio(1); _Pragma("unroll") for (int m = 0; m < 4; ++m) _Pragma("unroll") for (int n = 0; n < 2; ++n) _Pragma("unroll") for (int k = 0; k < 2; ++k) \
        acc[ai][bj][m][n] = __builtin_amdgcn_mfma_f32_16x16x32_bf16(Bt[n][k], At[m][k], acc[ai][bj][m][n], 0, 0, 0); __builtin_amdgcn_s_setprio(0); } while (0)
#define PG8_WAIT_V(n) asm volatile("s_waitcnt vmcnt(" #n ")" ::: "memory")
#define PG8_WAIT_L(n) asm volatile("s_waitcnt lgkmcnt(" #n ")" ::: "memory")
#define PG8_BAR __builtin_amdgcn_s_barrier()
#define PG8_SCHED __builtin_amdgcn_sched_barrier(0)
    Unit cur, nxt; int ui = 0;
    if (!S.next(0, cur)) return;
    f32x4 acc[2][2][4][2];
#pragma unroll
    for (int a = 0; a < 2; ++a)
#pragma unroll
        for (int b = 0; b < 2; ++b)
#pragma unroll
            for (int m = 0; m < 4; ++m)
#pragma unroll
                for (int n = 0; n < 2; ++n) acc[a][b][m][n] = (f32x4){0.f, 0.f, 0.f, 0.f};
    bf16x8 At[4][2], B0[2][2], B1[2][2];
    const char* cA = (const char*)g.A + (size_t)cur.pm * tstepA + cur.koff; const char* cB = (const char*)g.Bt + (size_t)cur.pn * tstepB + cur.koff;
    S.a_ready(cur);
    if constexpr (SP2) {
        PG8_STAGE(PG8_SB(0, 0), cB, voffB); PG8_STAGE(PG8_SB(0, 1), cB + hstepB, voffB); PG8_STAGE(PG8_SA(0, 0), cA, voffA); PG8_STAGE(PG8_SA(0, 1), cA + hstepA, voffA);
        if (wr == 1) PG8_BAR;
        PG8_WAIT_V(2); PG8_BAR;
        PG8_STAGE(PG8_SB(1, 0), cB + kstep, voffB); PG8_STAGE(PG8_SA(1, 0), cA + kstep, voffA); PG8_STAGE(PG8_SB(1, 1), cB + hstepB + kstep, voffB);
        PG8_WAIT_V(6); PG8_BAR;
    } else {
        PG8_STAGE(PG8_SB(0, 0), cB, voffB); PG8_STAGE(PG8_SA(0, 0), cA, voffA); PG8_STAGE(PG8_SB(0, 1), cB + hstepB, voffB); PG8_STAGE(PG8_SA(0, 1), cA + hstepA, voffA);
        if (wr == 1) PG8_BAR;
        PG8_WAIT_V(4); PG8_BAR;
        PG8_STAGE(PG8_SB(1, 0), cB + kstep, voffB); PG8_STAGE(PG8_SA(1, 0), cA + kstep, voffA); PG8_STAGE(PG8_SB(1, 1), cB + hstepB + kstep, voffB);
        PG8_WAIT_V(6); PG8_BAR;
    }
    for (;;) {
        const bool has_next = S.next(ui + 1, nxt);
        const char* nA = has_next ? (const char*)g.A + (size_t)nxt.pm * tstepA + nxt.koff : cA; const char* nB = has_next ? (const char*)g.Bt + (size_t)nxt.pn * tstepB + nxt.koff : cB;
        for (int t = 0; t < nt; t += 2) {
            const bool last = (t == nt - 2);
            const char* a1 = cA + (size_t)(t + 1) * kstep;
            const char* a2 = last ? nA : cA + (size_t)(t + 2) * kstep; const char* b2 = last ? nB : cB + (size_t)(t + 2) * kstep;
            const char* a3 = a2 + kstep; const char* b3 = b2 + kstep;
            if (last && has_next) S.a_ready(nxt);
            if constexpr (SP2) {
            PG8_LDB(B0, 0, 0); PG8_LDB(B1, 0, 1); PG8_SCHED; PG8_LDA(At, 0, 0); PG8_STAGE(PG8_SA(1, 1), a1 + hstepA, voffA);
            PG8_WAIT_V(8); PG8_WAIT_L(0); PG8_BAR; PG8_MMA(0, 0, At, B0); PG8_MMA(0, 1, At, B1); PG8_BAR; PG8_SCHED;
            PG8_LDA(At, 0, 1); PG8_STAGE(PG8_SB(0, 0), b2, voffB); PG8_STAGE(PG8_SB(0, 1), b2 + hstepB, voffB); PG8_STAGE(PG8_SA(0, 0), a2, voffA);
            PG8_WAIT_V(8); PG8_WAIT_L(0); PG8_BAR; PG8_MMA(1, 0, At, B0); PG8_MMA(1, 1, At, B1); PG8_BAR; PG8_SCHED;
            PG8_LDB(B0, 1, 0); PG8_LDB(B1, 1, 1); PG8_SCHED; PG8_LDA(At, 1, 0); PG8_STAGE(PG8_SA(0, 1), a2 + hstepA, voffA);
            PG8_WAIT_V(8); PG8_WAIT_L(0); PG8_BAR; PG8_MMA(0, 0, At, B0); PG8_MMA(0, 1, At, B1); PG8_BAR; PG8_SCHED;
            PG8_LDA(At, 1, 1); PG8_STAGE(PG8_SB(1, 0), b3, voffB); PG8_STAGE(PG8_SB(1, 1), b3 + hstepB, voffB); PG8_STAGE(PG8_SA(1, 0), a3, voffA);
            PG8_WAIT_V(8); PG8_WAIT_L(0); PG8_BAR; PG8_MMA(1, 0, At, B0); PG8_MMA(1, 1, At, B1); PG8_BAR; PG8_SCHED;
            } else {
            PG8_LDB(B0, 0, 0); PG8_SCHED; PG8_LDA(At, 0, 0); PG8_STAGE(PG8_SA(1, 1), a1 + hstepA, voffA);
            PG8_WAIT_L(8); PG8_BAR; PG8_WAIT_L(0); PG8_MMA(0, 0, At, B0); PG8_BAR; PG8_SCHED;
            PG8_LDB(B1, 0, 1); PG8_STAGE(PG8_SB(0, 0), b2, voffB);
            PG8_BAR; PG8_WAIT_L(0); PG8_MMA(0, 1, At, B1); PG8_BAR;
            PG8_LDA(At, 0, 1); PG8_STAGE(PG8_SA(0, 0), a2, voffA);
            PG8_BAR; PG8_WAIT_L(0); PG8_MMA(1, 0, At, B0); PG8_BAR; PG8_SCHED;
            PG8_STAGE(PG8_SB(0, 1), b2 + hstepB, voffB);
            PG8_WAIT_V(6); PG8_BAR; PG8_MMA(1, 1, At, B1); PG8_BAR;
            PG8_LDB(B0, 1, 0); PG8_SCHED; PG8_LDA(At, 1, 0); PG8_STAGE(PG8_SA(0, 1), a2 + hstepA, voffA);
            PG8_WAIT_L(8); PG8_BAR; PG8_WAIT_L(0); PG8_MMA(0, 0, At, B0); PG8_BAR; PG8_SCHED;
            PG8_LDB(B1, 1, 1); PG8_STAGE(PG8_SB(1, 0), b3, voffB);
            PG8_BAR; PG8_WAIT_L(0); PG8_MMA(0, 1, At, B1); PG8_BAR;
            PG8_LDA(At, 1, 1); PG8_STAGE(PG8_SA(1, 0), a3, voffA);
            PG8_BAR; PG8_WAIT_L(0); PG8_MMA(1, 0, At, B0); PG8_BAR; PG8_SCHED;
            PG8_STAGE(PG8_SB(1, 1), b3 + hstepB, voffB);
            PG8_WAIT_V(6); PG8_BAR; PG8_MMA(1, 1, At, B1); PG8_BAR;
            }
        }
        if constexpr (ALIGN_EPI) { if (wr == 0) PG8_BAR; }
        if constexpr (!Epi::AFTER_DRAIN) { E(acc, cur, wr, wc, fr, fq); S.done(cur); }
        if (!has_next) break;
#pragma unroll
        for (int a = 0; a < 2; ++a)
#pragma unroll
            for (int b = 0; b < 2; ++b)
#pragma unroll
                for (int m = 0; m < 4; ++m)
#pragma unroll
                    for (int n = 0; n < 2; ++n) acc[a][b][m][n] = (f32x4){0.f, 0.f, 0.f, 0.f};
        cur = nxt; cA = nA; cB = nB; ++ui;
        if constexpr (ALIGN_EPI) { if (wr == 1) PG8_BAR; }
    }
    PG8_WAIT_V(0);
    if constexpr (!ALIGN_EPI) { if (wr == 0) PG8_BAR; }
    PG8_BAR;
    if constexpr (Epi::AFTER_DRAIN) { E.fused(acc, cur, wr, wc, fr, fq, lds, wid, lane); S.done(cur); }
#undef PG8_SA
#undef PG8_SB
#undef PG8_STAGE
#undef PG8_LDA
#undef PG8_LDB
#undef PG8_MMA
#undef PG8_WAIT_V
#undef PG8_WAIT_L
#undef PG8_BAR
#undef PG8_SCHED
}
}

typedef const pg8::f32x4 (&AccRef)[2][2][4][2];
struct EpiSwiglu {
    static constexpr bool PERM = true, AFTER_DRAIN = false;
    bf16_t* H;
    DI void operator()(AccRef acc, const pg8::Unit& u, int wr, int wc, int fr, int fq) const {
        const int row0 = u.pm * 256 + wr * 64 + fr, col = u.pn * 128 + wc * 32 + 8 * fq;
#pragma unroll
        for (int ai = 0; ai < 2; ++ai)
#pragma unroll
            for (int m = 0; m < 4; ++m) {
                const int row = row0 + ai * 128 + m * 16; float f[8];
#pragma unroll
                for (int n = 0; n < 2; ++n)
#pragma unroll
                    for (int e = 0; e < 4; ++e) f[n * 4 + e] = siluf_(acc[ai][0][m][n][e]) * acc[ai][1][m][n][e];
                *(u32x4*)(H + (size_t)row * DFF + col) = pack8(f);
            }
    }
};
struct EpiResid {
    static constexpr bool PERM = true, AFTER_DRAIN = false;
    float* xlat; float* xc; const float* gate; float coef;
    DI void operator()(AccRef acc, const pg8::Unit& u, int wr, int wc, int fr, int fq) const {
        const int r0 = u.pm * 256; const int vec = r0 < NLAT ? (r0 >> 13) : 2;
        const float* gp = gate + vec * 9216;
        float* base = r0 < NLAT ? xlat + (size_t)r0 * DM : xc + (size_t)(r0 - NLAT) * DM;
#pragma unroll
        for (int bj = 0; bj < 2; ++bj) {
            const int col = u.pn * 256 + bj * 128 + wc * 32 + 8 * fq;
            const f32x4 g0 = *(const f32x4*)(gp + col) * coef, g1 = *(const f32x4*)(gp + col + 4) * coef;
#pragma unroll
            for (int ai = 0; ai < 2; ++ai)
#pragma unroll
                for (int m = 0; m < 4; ++m) {
                    float* xp = base + (size_t)(wr * 64 + fr + ai * 128 + m * 16) * DM + col;
                    f32x4 x0 = *(f32x4*)xp, x1 = *(f32x4*)(xp + 4);
                    x0 += g0 * acc[ai][bj][m][0]; x1 += g1 * acc[ai][bj][m][1];
                    *(f32x4*)xp = x0; *(f32x4*)(xp + 4) = x1;
                }
        }
    }
};
struct EpiWin {
    static constexpr bool PERM = true, AFTER_DRAIN = false;
    bf16_t* Z;
    DI void operator()(AccRef acc, const pg8::Unit& u, int wr, int wc, int fr, int fq) const {
        const int row0 = u.pm * 256 + wr * 64 + fr;
#pragma unroll
        for (int bj = 0; bj < 2; ++bj) {
            const int col = u.pn * 256 + bj * 128 + wc * 32 + 8 * fq;
            if (col >= ZW) continue;
            const int mode = (col >= ZC_RL && col < ZC_RL + 128) ? 1 : ((col >= ZC_RL + 256 && col < ZC_AQ) ? 2 : 0);
#pragma unroll
            for (int ai = 0; ai < 2; ++ai)
#pragma unroll
                for (int m = 0; m < 4; ++m) {
                    const int row = row0 + ai * 128 + m * 16; float f[8];
#pragma unroll
                    for (int n = 0; n < 2; ++n)
#pragma unroll
                        for (int e = 0; e < 4; ++e) { float v = acc[ai][bj][m][n][e]; if (mode == 1) v = 1.f - 2.f * __builtin_amdgcn_rcpf(1.f + __expf(2.f * v)); else if (mode == 2) v = sigmoidf_(v); f[n * 4 + e] = v; }
                    *(u32x4*)(Z + (size_t)row * ZW + col) = pack8(f);
                }
        }
    }
};
struct EpiLora {
    static constexpr bool PERM = true, AFTER_DRAIN = false;
    bf16_t* RWA; bf16_t* RG; const float* w0; const float* a0;
    DI void operator()(AccRef acc, const pg8::Unit& u, int wr, int wc, int fr, int fq) const {
        const int row0 = u.pm * 256 + wr * 64 + fr;
#pragma unroll
        for (int bj = 0; bj < 2; ++bj) {
            const int col = u.pn * 256 + bj * 128 + wc * 32 + 8 * fq; const int seg = col >> 9, cc = col & 511;
            const float* bp = seg < 2 ? w0 + seg * 512 + cc : a0 + (seg & 1) * 512 + cc;
#pragma unroll
            for (int ai = 0; ai < 2; ++ai)
#pragma unroll
                for (int m = 0; m < 4; ++m) {
                    const int row = row0 + ai * 128 + m * 16; float f[8];
#pragma unroll
                    for (int n = 0; n < 2; ++n)
#pragma unroll
                        for (int e = 0; e < 4; ++e) {
                            float v = acc[ai][bj][m][n][e] + (seg < 4 ? bp[n * 4 + e] : 0.f);
                            if (seg < 2) { const float ee = 0.60653066f * sigmoidf_(v); v = 1.f - __expf(-ee); } else if (seg < 4) v = sigmoidf_(v);
                            f[n * 4 + e] = v;
                        }
                    if (seg < 4) *(u32x4*)(RWA + (size_t)row * 2048 + col) = pack8(f); else *(u32x4*)(RG + (size_t)row * 512 + cc) = pack8(f);
                    __builtin_amdgcn_sched_barrier(0);
                }
        }
    }
};
struct EpiGate {
    static constexpr bool PERM = true, AFTER_DRAIN = false;
    bf16_t* G;
    DI void operator()(AccRef acc, const pg8::Unit& u, int wr, int wc, int fr, int fq) const {
        const int row0 = u.pm * 256 + wr * 64 + fr;
#pragma unroll
        for (int bj = 0; bj < 2; ++bj) {
            const int col = u.pn * 256 + bj * 128 + wc * 32 + 8 * fq;
#pragma unroll
            for (int ai = 0; ai < 2; ++ai)
#pragma unroll
                for (int m = 0; m < 4; ++m) {
                    const int row = row0 + ai * 128 + m * 16; float f[8];
#pragma unroll
                    for (int n = 0; n < 2; ++n)
#pragma unroll
                        for (int e = 0; e < 4; ++e) f[n * 4 + e] = sigmoidf_(acc[ai][bj][m][n][e]);
                    *(u32x4*)(G + (size_t)row * DM + col) = pack8(f);
                }
        }
    }
};
struct EpiBranch {
    static constexpr bool PERM = true, AFTER_DRAIN = false;
    const bf16_t* G; bf16_t* ZZ; int first;
    DI void operator()(AccRef acc, const pg8::Unit& u, int wr, int wc, int fr, int fq) const {
        const int row0 = u.pm * 256 + wr * 64 + fr;
#pragma unroll
        for (int bj = 0; bj < 2; ++bj) {
            const int col = u.pn * 256 + bj * 128 + wc * 32 + 8 * fq;
#pragma unroll
            for (int ai = 0; ai < 2; ++ai)
#pragma unroll
                for (int m = 0; m < 4; ++m) {
                    const size_t off = (size_t)(row0 + ai * 128 + m * 16) * DM + col; float g[8], o[8], f[8];
                    unpack8(*(const u32x4*)(G + off), g);
                    if (first) {
#pragma unroll
                        for (int e = 0; e < 8; ++e) o[e] = 0.f;
                    } else unpack8(*(const u32x4*)(ZZ + off), o);
#pragma unroll
                    for (int n = 0; n < 2; ++n)
#pragma unroll
                        for (int e = 0; e < 4; ++e) f[n * 4 + e] = o[n * 4 + e] + g[n * 4 + e] * acc[ai][bj][m][n][e];
                    *(u32x4*)(ZZ + off) = pack8(f);
                }
        }
    }
};
struct CtxSplitOrder {
    int nun, G, c, kslice_bytes;
    DI void init(int nslices, int ksl_bytes, int G_, int c_) { nun = nslices * 8; G = G_; c = c_; kslice_bytes = ksl_bytes; }
    DI bool next(int i, pg8::Unit& u) const {
        const long L = (long)i * G + c; if (L >= nun) return false;
        const int ks = (int)L >> 3, t = (int)L & 7; u.pm = 64 + (t >> 2); u.pn = t & 3; u.koff = (size_t)ks * kslice_bytes; return true;
    }
    DI void a_ready(const pg8::Unit&) const {}
    DI void done(const pg8::Unit&) const {}
};
struct EpiPartial {
    static constexpr bool PERM = true, AFTER_DRAIN = false;
    float* P; int kslice_bytes;
    DI void operator()(AccRef acc, const pg8::Unit& u, int wr, int wc, int fr, int fq) const {
        const int ks = (int)(u.koff / (size_t)kslice_bytes);
        float* base = P + ((size_t)ks * 512 + (size_t)(u.pm - 64) * 256) * DM;
#pragma unroll
        for (int bj = 0; bj < 2; ++bj) {
            const int col = u.pn * 256 + bj * 128 + wc * 32 + 8 * fq;
#pragma unroll
            for (int ai = 0; ai < 2; ++ai)
#pragma unroll
                for (int m = 0; m < 4; ++m) {
                    float* xp = base + (size_t)(wr * 64 + fr + ai * 128 + m * 16) * DM + col;
                    *(f32x4*)xp = acc[ai][bj][m][0]; *(f32x4*)(xp + 4) = acc[ai][bj][m][1];
                }
        }
    }
};
template <class Epi> DI void run_gemm_ctx(const int wv, unsigned char* smem, const bf16_t* A, int lda, const bf16_t* Bt, int ldb, int nslices, int kslice, const Epi& E) {
    pg8::Gemm g; g.A = A; g.Bt = Bt; g.M = NTOK; g.N = DM; g.K = launder_s(kslice); g.lda = launder_s(lda); g.ldb = launder_s(ldb); g.tid0 = wv * 64 + lane_id_();
    CtxSplitOrder S; S.init(nslices, kslice * 2, (int)gridDim.x, ((int)gridDim.x - 1) - launder_s((int)blockIdx.x));
    pg8::gemm_phase<Epi, CtxSplitOrder, true, true>((PG8_LAS unsigned char*)smem, g, S, E);
    __syncthreads();
}
template <class Epi> DI void run_gemm(const int wv, unsigned char* smem, const bf16_t* A, int lda, const bf16_t* Bt, int M, int N, int K, const Epi& E) {
    pg8::Gemm g; g.A = A; g.Bt = Bt; g.M = M; g.N = N; g.K = launder_s(K); g.lda = launder_s(lda); g.ldb = g.K; g.tid0 = wv * 64 + lane_id_();
    pg8::StaticOrder S; S.init(M, N, (int)gridDim.x, launder_s((int)blockIdx.x));
    pg8::gemm_phase<Epi, pg8::StaticOrder, true, true>((PG8_LAS unsigned char*)smem, g, S, E);
    __syncthreads();
}

struct Prm {
    const float *x, *c, *ctx, *cctx, *w_ada, *b_ada, *norm_g, *f1gu, *f1dn, *f2gu, *f2dn, *w_in, *m_conv, *m_gb, *m_on, *r_conv, *r_w0, *r_w2, *r_a0, *r_a2, *r_g2,
        *r_kk, *r_ka, *r_rk, *r_lnw, *r_lnb, *a_qkn, *a_lam, *a_subln, *w_br, *w_o;
    float* out; unsigned char* ws; int wv, pad;
};
#define PH_IDS const int tid_l = launder_v(p.wv * 64 + lane_id_()); const int bid_l = launder_s((int)blockIdx.x); (void)tid_l; (void)bid_l;
#define TID tid_l
#define BID bid_l
#define NBLK ((int)gridDim.x)

DI void ph_modpart(const Prm& p, unsigned char* smem) { PH_IDS
    float* sc = (float*)smem; float* modp = (float*)(p.ws + WS_MODP);
    for (int it = BID; it < 576; it += NBLK) {
        const int l = it / 288, r = it % 288, ks = r / 18, cb = r % 18;
        __syncthreads();
        if (TID < 192) { const int v = TID >> 6, k = ks * 64 + (TID & 63); const float cv = v < 2 ? p.c[v * DM + k] : p.cctx[k]; sc[TID] = siluf_(cv); }
        __syncthreads();
        const int col = cb * 512 + TID; float a0 = 0.f, a1 = 0.f, a2 = 0.f;
        const float* w = p.w_ada + ((size_t)l * DM + ks * 64) * 9216 + col;
#pragma unroll 8
        for (int k = 0; k < 64; ++k) { const float wv = w[(size_t)k * 9216]; a0 += sc[k] * wv; a1 += sc[64 + k] * wv; a2 += sc[128 + k] * wv; }
        float* o = modp + ((size_t)(l * 16 + ks) * 3) * 9216 + col; o[0] = a0; o[9216] = a1; o[2 * 9216] = a2;
    }
    __syncthreads();
}
DI void ph_rope(const Prm& p) { PH_IDS
    float* rope = (float*)(p.ws + WS_ROPE);
    for (int i = BID * 512 + TID; i < SEQL * 32; i += NBLK * 512) {
        const int t = i >> 5, pp = i & 31, j = pp & 15;
        const float inv = powf(10000.f, -(float)j / 16.f); const float pos = (float)(pp < 16 ? (t >> 6) : (t & 63)); const float ang = pos * inv;
        rope[2 * i] = cosf(ang); rope[2 * i + 1] = sinf(ang);
    }
}
DI void ph_modreduce(const Prm& p) { PH_IDS
    const float* modp = (const float*)(p.ws + WS_MODP); float* mods = (float*)(p.ws + WS_MODS);
    for (int i = BID * 512 + TID; i < 2 * 3 * 9216; i += NBLK * 512) {
        const int l = i / 27648, rem = i % 27648, v = rem / 9216, col = rem % 9216;
        float s = p.b_ada[l * 9216 + col];
        for (int ks = 0; ks < 16; ++ks) s += modp[((size_t)(l * 16 + ks) * 3 + v) * 9216 + col];
        mods[i] = s;
    }
}
template <int MODE> DI void conv_weight(const Prm& p, const float* src, int ld, int c0, int K, int ncols, bf16_t* dst, unsigned char* smem) { PH_IDS
    float* t = (float*)smem; const int ntk = K / 64, ntn = (ncols + 63) / 64, tx = TID & 63, ty = TID >> 6;
    for (int it = BID; it < ntk * ntn; it += NBLK) {
        const int kt = it % ntk, nt = it / ntk;
        __syncthreads();
#pragma unroll
        for (int i = 0; i < 8; ++i) { const int k = ty * 8 + i, j = nt * 64 + tx; t[k * 65 + tx] = j < ncols ? src[(size_t)(kt * 64 + k) * ld + c0 + j] : 0.f; }
        __syncthreads();
#pragma unroll
        for (int i = 0; i < 8; ++i) {
            const int n = ty * 8 + i, j = nt * 64 + n;
            if (j < ncols) {
                int drow = j;
                if (MODE == 1) drow = j < DFF ? ((j >> 7) * 256 + (j & 127)) : (((j - DFF) >> 7) * 256 + 128 + ((j - DFF) & 127));
                dst[(size_t)drow * K + kt * 64 + tx] = f2bf(t[tx * 65 + n]);
            }
        }
    }
    __syncthreads();
}
DI void conv_ffn(const Prm& p, int l, int which, unsigned char* smem) {
    bf16_t* wt = (bf16_t*)(p.ws + WS_WT);
    conv_weight<1>(p, (which ? p.f2gu : p.f1gu) + (size_t)l * DM * 2 * DFF, 2 * DFF, 0, DM, 2 * DFF, wt + WT_GU, smem);
    conv_weight<0>(p, (which ? p.f2dn : p.f1dn) + (size_t)l * DFF * DM, DM, 0, DFF, DM, wt + WT_DN, smem);
}
DI void conv_mixer(const Prm& p, int l, unsigned char* smem) { PH_IDS
    bf16_t* wt = (bf16_t*)(p.ws + WS_WT);
    conv_weight<0>(p, p.w_in + (size_t)l * DM * DIN, DIN, 0, DM, ZW, wt + WT_IN, smem);
    conv_weight<0>(p, p.w_in + (size_t)l * DM * DIN, DIN, ZW, DM, 3 * DM, wt + WT_G, smem);
    for (int b = 0; b < 3; ++b) conv_weight<0>(p, p.w_br + (size_t)(l * 3 + b) * 512 * DM, DM, 0, 512, DM, wt + WT_P + (size_t)b * DM * 512, smem);
    conv_weight<0>(p, p.w_o + (size_t)l * DM * DM, DM, 0, DM, DM, wt + WT_O, smem);
    bf16_t* wl = wt + WT_L;
    for (int i = BID * 512 + TID; i < 2560 * 384; i += NBLK * 512) {
        const int n = i / 384, k = i % 384, seg = n >> 9, cc = n & 511; float v = 0.f;
        if (seg < 2) { if ((k >> 6) == seg) v = p.r_w2[((size_t)(l * 2 + seg) * 64 + (k & 63)) * 512 + cc]; }
        else if (seg < 4) { if ((k >> 6) == seg) v = p.r_a2[((size_t)(l * 2 + seg - 2) * 64 + (k & 63)) * 512 + cc]; }
        else { if (k >= 256) v = p.r_g2[((size_t)l * 128 + (k - 256)) * 512 + cc]; }
        wl[i] = f2bf(v);
    }
}
DI void ph_norm(const Prm& p, int l, int which, bool first, int nfix = 0, const float* fixgate = nullptr, float fixcoef = 0.f) { PH_IDS
    const int lane = TID & 63, wid = TID >> 6;
    const float* g = p.norm_g + (l * 3 + which) * DM; const float* mods = (const float*)(p.ws + WS_MODS) + (size_t)l * 27648;
    bf16_t* hb = (bf16_t*)(p.ws + WS_RWA); float* xc = (float*)(p.ws + WS_XC);
    for (int row = BID * 8 + wid; row < NTOK; row += NBLK * 8) {
        const int vec = row < NLAT ? (row >> 13) : 2;
        const float* sh = mods + vec * 9216 + (3 * which) * DM; const float* scl = sh + DM;
        float* xd = row < NLAT ? p.out + (size_t)row * DM : xc + (size_t)(row - NLAT) * DM;
        const float* xr = first ? (row < NLAT ? p.x + (size_t)row * DM : p.ctx + (size_t)(row - NLAT) * DM) : xd;
        f32x4 xv[4]; float ss = 0.f;
#pragma unroll
        for (int i = 0; i < 4; ++i) xv[i] = *(const f32x4*)(xr + i * 256 + lane * 4);
        if (nfix > 0 && row >= NLAT) {
            const float* P = (const float*)((const bf16_t*)(p.ws + WS_RWA) + (size_t)NTOK * DM) + (size_t)(row - NLAT) * DM;
#pragma unroll
            for (int i = 0; i < 4; ++i) {
                const int col = i * 256 + lane * 4; f32x4 sp = {0.f, 0.f, 0.f, 0.f};
                for (int ks = 0; ks < nfix; ++ks) sp += *(const f32x4*)(P + (size_t)ks * 512 * DM + col);
                xv[i] += *(const f32x4*)(fixgate + 2 * 9216 + col) * fixcoef * sp;
                *(f32x4*)(xd + col) = xv[i];
            }
        }
#pragma unroll
        for (int i = 0; i < 4; ++i) ss += xv[i][0] * xv[i][0] + xv[i][1] * xv[i][1] + xv[i][2] * xv[i][2] + xv[i][3] * xv[i][3];
        ss = wave_sum(ss); const float rinv = rsqrtf(ss * (1.f / DM) + 1e-6f);
#pragma unroll
        for (int i = 0; i < 4; ++i) {
            const int col = i * 256 + lane * 4;
            if (first) *(f32x4*)(xd + col) = xv[i];
            const f32x4 gv = *(const f32x4*)(g + col), sv = *(const f32x4*)(scl + col), hv = *(const f32x4*)(sh + col);
            float h[4];
#pragma unroll
            for (int e = 0; e < 4; ++e) h[e] = xv[i][e] * rinv * gv[e] * (1.f + sv[e]) + hv[e];
            u32x2 o; o.x = pk2(h[0], h[1]); o.y = pk2(h[2], h[3]);
            *(u32x2*)(hb + (size_t)row * DM + col) = o;
        }
    }
}
DI void ph_zero_ysum(const Prm& p) { PH_IDS
    f32x4* y = (f32x4*)(p.ws + WS_YSUM); const f32x4 zr = {0.f, 0.f, 0.f, 0.f};
    for (int i = BID * 512 + TID; i < NTOK * 128; i += NBLK * 512) y[i] = zr;
}
DI void ph_rkv_conv(const Prm& p, int l) { PH_IDS
    const int lane = TID & 63, wid = TID >> 6;
    const bf16_t* z = (const bf16_t*)(p.ws + WS_Z); bf16_t* tmp = (bf16_t*)(p.ws + WS_RWA); float* invn = (float*)(p.ws + WS_INVN);
    const float* cw = p.r_conv + (size_t)l * 3 * 1536;
    for (int row = BID * 8 + wid; row < NTOK; row += NBLK * 8) {
        const int t = row < NLAT ? (row & 8191) : ((row - NLAT) & 255), L = row < NLAT ? SEQL : CTXL;
        const bool hp = t > 0, hn = t < L - 1;
#pragma unroll
        for (int g = 0; g < 3; ++g) {
            const int ch = g * 512 + lane * 8; const bf16_t* zp = z + (size_t)row * ZW + ZC_RR + ch;
            const u32x4 zero = {0u, 0u, 0u, 0u};
            const u32x4 uc = *(const u32x4*)zp, up = hp ? *(const u32x4*)(zp - ZW) : zero, un = hn ? *(const u32x4*)(zp + ZW) : zero;
            float c[8], pv[8], nx[8], o[8]; unpack8(uc, c); unpack8(up, pv); unpack8(un, nx);
#pragma unroll
            for (int e = 0; e < 8; ++e) o[e] = cw[ch + e] * pv[e] + cw[1536 + ch + e] * c[e] + cw[3072 + ch + e] * nx[e];
            *(u32x4*)(tmp + (size_t)row * 1536 + ch) = pack8(o);
            if (g == 1) {
                float ss = 0.f;
#pragma unroll
                for (int e = 0; e < 8; ++e) { const float kk = o[e] * p.r_kk[l * 512 + lane * 8 + e]; ss += kk * kk; }
                ss += __shfl_xor(ss, 1); ss += __shfl_xor(ss, 2); ss += __shfl_xor(ss, 4);
                if ((lane & 7) == 0) invn[(size_t)row * 8 + (lane >> 3)] = 1.f / fmaxf(sqrtf(ss), 1e-12f);
            }
        }
    }
}
DI void ph_rkv_copy(const Prm& p) { PH_IDS
    const int lane = TID & 63, wid = TID >> 6;
    bf16_t* z = (bf16_t*)(p.ws + WS_Z); const bf16_t* tmp = (const bf16_t*)(p.ws + WS_RWA);
    for (int row = BID * 8 + wid; row < NTOK; row += NBLK * 8)
#pragma unroll
        for (int g = 0; g < 3; ++g) { const int ch = g * 512 + lane * 8; *(u32x4*)(z + (size_t)row * ZW + ZC_RR + ch) = *(const u32x4*)(tmp + (size_t)row * 1536 + ch); }
}
DI void ph_attn_prep(const Prm& p, int l) { PH_IDS
    const int lane = TID & 63, wid = TID >> 6, hw = lane >> 5, pp = lane & 31;
    bf16_t* z = (bf16_t*)(p.ws + WS_Z); const float* rope = (const float*)(p.ws + WS_ROPE); const float* qkn = p.a_qkn + l * 128;
    for (int row = BID * 8 + wid; row < NTOK; row += NBLK * 8) {
        const bool islat = row < NLAT; const int t = row & 8191;
        float cs = 1.f, sn = 0.f; if (islat) { cs = rope[((size_t)t * 32 + pp) * 2]; sn = rope[((size_t)t * 32 + pp) * 2 + 1]; }
#pragma unroll
        for (int it = 0; it < 8; ++it) {
            const int seg = it * 2 + hw, which = seg >> 3, col = (which ? ZC_AK : ZC_AQ) + (seg & 7) * 64 + 2 * pp;
            unsigned* zp = (unsigned*)(z + (size_t)row * ZW + col);
            const unsigned u = *zp; const float x1 = lo16(u), x2 = hi16(u);
            float ss = x1 * x1 + x2 * x2;
            ss += __shfl_xor(ss, 1); ss += __shfl_xor(ss, 2); ss += __shfl_xor(ss, 4); ss += __shfl_xor(ss, 8); ss += __shfl_xor(ss, 16);
            const float rinv = rsqrtf(ss * (1.f / 64.f) + 1e-6f) * (which ? 1.f : 0.125f);
            const float y1 = x1 * rinv * qkn[which * 64 + 2 * pp], y2 = x2 * rinv * qkn[which * 64 + 2 * pp + 1];
            *zp = pk2(y1 * cs - y2 * sn, y1 * sn + y2 * cs);
        }
    }
}

#define MFMA16(a, b, c) __builtin_amdgcn_mfma_f32_16x16x32_bf16((a), (b), (c), 0, 0, 0)
#define MFMA32(a, b, c) __builtin_amdgcn_mfma_f32_32x32x16_bf16((a), (b), (c), 0, 0, 0)
DI float wave_incl_scan_add(float v, int lane) {
#pragma unroll
    for (int o = 1; o < 64; o <<= 1) { const float t = __shfl_up(v, o); if (lane >= o) v += t; }
    return v;
}
DI float wave_incl_scan_max(float v, int lane) {
#pragma unroll
    for (int o = 1; o < 64; o <<= 1) { const float t = __shfl_up(v, o); if (lane >= o) v = fmaxf(v, t); }
    return v;
}
DI float mconv(const bf16_t* z, const float* cw, size_t row, int t, int L, int ch) {
    const bf16_t* zp = z + row * ZW + ch;
    float a = cw[512 + ch] * bf2f(zp[0]);
    if (t > 0) a += cw[ch] * bf2f(zp[-ZW]);
    if (t < L - 1) a += cw[1024 + ch] * bf2f(zp[ZW]);
    return siluf_(a);
}
DI void ph_mlstm_a(const Prm& p, int l, unsigned char* smem) { PH_IDS
    const int lane = TID & 63, wid = TID >> 6;
    const bf16_t* z = (const bf16_t*)(p.ws + WS_Z); bf16_t* mst = (bf16_t*)(p.ws + WS_MST); float* msc = (float*)(p.ws + WS_MSC); float* mn = (float*)(p.ws + WS_MN);
    const float* cw = p.m_conv + (size_t)l * 3 * 512; const float* gb = p.m_gb + l * 16;
    bf16_t* kT = (bf16_t*)smem; bf16_t* vT = (bf16_t*)(smem + 9216); float* wsl = (float*)(smem + 9216 + 18432);
    for (int u = BID; u < 2112; u += NBLK) {
        const int d = u / 1056, r = u % 1056, b = r / 528, h = (r % 528) / NCHK, c = r % NCHK;
        const int slot = ((d * 2 + b) * 4 + h) * NCHK + c;
        const bool isctx = c < 4; const int cs = isctx ? c : c - 4, nch = isctx ? 4 : 128, oc = d ? nch - 1 - cs : cs, L = isctx ? CTXL : SEQL;
        const size_t base = isctx ? (size_t)NLAT + b * CTXL + oc * 64 : (size_t)b * SEQL + oc * 64;
        __syncthreads();
        if (wid == 0) {
            const int o = d ? 63 - lane : lane; const bf16_t* zr = z + (base + o) * ZW + ZC_MG + 8 * d + h;
            const float ig = bf2f(zr[0]) + gb[(2 * d) * 4 + h], lf = logsigf_(bf2f(zr[4]) + gb[(2 * d + 1) * 4 + h]);
            const float bc = wave_incl_scan_add(lf, lane), bt = __shfl(bc, 63), wl = bt - bc + ig, ml = wave_max(wl);
            wsl[lane] = __expf(wl - ml);
            if (lane == 0) { msc[slot * 4] = bt; msc[slot * 4 + 1] = ml; }
        }
        __syncthreads();
#pragma unroll
        for (int i = 0; i < 8; ++i) {
            const int idx = TID + 512 * i, dq = idx & 63, pp = idx >> 6, o = d ? 63 - pp : pp;
            kT[dq * 72 + pp] = f2bf(mconv(z, cw, base + o, oc * 64 + o, L, 256 + h * 64 + dq) * 0.125f);
        }
#pragma unroll
        for (int i = 0; i < 16; ++i) {
            const int idx = TID + 512 * i, vv = idx & 127, pp = idx >> 7, o = d ? 63 - pp : pp;
            vT[vv * 72 + pp] = f2bf(bf2f(z[(base + o) * ZW + ZC_MV + h * 128 + vv]) * wsl[pp]);
        }
        __syncthreads();
        f32x4 acc[4];
#pragma unroll
        for (int nt = 0; nt < 4; ++nt) acc[nt] = (f32x4){0.f, 0.f, 0.f, 0.f};
#pragma unroll
        for (int ks = 0; ks < 2; ++ks) {
            const bf16x8 a = *(const bf16x8*)(vT + (16 * wid + (lane & 15)) * 72 + ks * 32 + (lane >> 4) * 8);
#pragma unroll
            for (int nt = 0; nt < 4; ++nt) { const bf16x8 bb = *(const bf16x8*)(kT + (16 * nt + (lane & 15)) * 72 + ks * 32 + (lane >> 4) * 8); acc[nt] = MFMA16(a, bb, acc[nt]); }
        }
#pragma unroll
        for (int nt = 0; nt < 4; ++nt)
#pragma unroll
            for (int j = 0; j < 4; ++j) mst[(size_t)slot * 8192 + (16 * wid + (lane >> 4) * 4 + j) * 64 + 16 * nt + (lane & 15)] = f2bf(acc[nt][j]);
        if (TID < 64) { float s = 0.f; for (int pp = 0; pp < 64; ++pp) s += wsl[pp] * bf2f(kT[TID * 72 + pp]); mn[slot * 64 + TID] = s; }
    }
    __syncthreads();
}
DI void ph_mlstm_b(const Prm& p) { PH_IDS
    bf16_t* mst = (bf16_t*)(p.ws + WS_MST); float* msc = (float*)(p.ws + WS_MSC); float* mn = (float*)(p.ws + WS_MN);
    for (int e = BID * 512 + TID; e < 16 * 8256; e += NBLK * 512) {
        const int chain = e / 8256, idx = e % 8256; float m = 0.f, C = 0.f;
        for (int c0 = 0; c0 < NCHK; c0 += 22) {
            float uu[22], bt[22], ml[22];
#pragma unroll
            for (int j = 0; j < 22; ++j) {
                const int slot = chain * NCHK + c0 + j; bt[j] = msc[slot * 4]; ml[j] = msc[slot * 4 + 1];
                uu[j] = idx < 8192 ? bf2f(mst[(size_t)slot * 8192 + idx]) : mn[slot * 64 + idx - 8192];
            }
#pragma unroll
            for (int j = 0; j < 22; ++j) {
                const int slot = chain * NCHK + c0 + j;
                if (idx < 8192) mst[(size_t)slot * 8192 + idx] = f2bf(C); else mn[slot * 64 + idx - 8192] = C;
                if (idx == 0) msc[slot * 4 + 2] = m;
                const float mnew = fmaxf(bt[j] + m, ml[j]);
                C = __expf(bt[j] + m - mnew) * C + __expf(ml[j] - mnew) * uu[j]; m = mnew;
            }
        }
    }
}
DI void ph_mlstm_c(const Prm& p, int l, unsigned char* smem, int ubeg, int ustride, int ucount = 1 << 30) { PH_IDS
    const int lane = TID & 63, wid = TID >> 6;
    bf16_t* z = (bf16_t*)(p.ws + WS_Z); const bf16_t* mst = (const bf16_t*)(p.ws + WS_MST); const float* msc = (const float*)(p.ws + WS_MSC); const float* mn = (const float*)(p.ws + WS_MN);
    const float* cw = p.m_conv + (size_t)l * 3 * 512; const float* gb = p.m_gb + l * 16;
    bf16_t* qs = (bf16_t*)smem; bf16_t* ks_ = (bf16_t*)(smem + 9216); bf16_t* vT = (bf16_t*)(smem + 18432); bf16_t* Sp = (bf16_t*)(smem + 36864);
    float* hsum = (float*)(smem + 46080); float* fa = (float*)(smem + 46080 + 33792);
    float *bcum = fa, *gg = fa + 64, *Mrow = fa + 128, *iw = fa + 192, *den = fa + 256, *nq = fa + 320;
    for (int u = ubeg, un = 0; u < 1056 && un < ucount; u += ustride, ++un) {
        const int b = u / 528, h = (u % 528) / NCHK, cc = u % NCHK;
        const bool isctx = cc < 4; const int oc = isctx ? cc : cc - 4, nch = isctx ? 4 : 128, L = isctx ? CTXL : SEQL;
        const size_t base = isctx ? (size_t)NLAT + b * CTXL + oc * 64 : (size_t)b * SEQL + oc * 64;
        for (int d = 0; d < 2; ++d) {
            const int cs = d ? nch - 1 - oc : oc, c = isctx ? cs : cs + 4, slot = ((d * 2 + b) * 4 + h) * NCHK + c;
            const float mst_m = msc[slot * 4 + 2];
            __syncthreads();
            if (wid == 0) {
                const int o = d ? 63 - lane : lane; const bf16_t* zr = z + (base + o) * ZW + ZC_MG + 8 * d + h;
                const float ig = bf2f(zr[0]) + gb[(2 * d) * 4 + h], lf = logsigf_(bf2f(zr[4]) + gb[(2 * d + 1) * 4 + h]);
                const float bc = wave_incl_scan_add(lf, lane), g = ig - bc, pm = wave_incl_scan_max(g, lane), M = fmaxf(mst_m, pm);
                bcum[lane] = bc; gg[lane] = g; Mrow[lane] = M; iw[lane] = __expf(mst_m - M);
            }
#pragma unroll 2
            for (int i = 0; i < 16; ++i) {
                const int idx = TID + 512 * i, chq = idx & 127, pp = idx >> 7, o = d ? 63 - pp : pp, isk = chq >> 6, dq = chq & 63;
                const float v = mconv(z, cw, base + o, oc * 64 + o, L, isk * 256 + h * 64 + dq);
                if (isk) ks_[pp * 72 + dq] = f2bf(v * 0.125f); else qs[pp * 72 + dq] = f2bf(v);
            }
#pragma unroll 4
            for (int i = 0; i < 16; ++i) {
                const int idx = TID + 512 * i, vv = idx & 127, pp = idx >> 7, o = d ? 63 - pp : pp;
                vT[vv * 72 + pp] = z[(base + o) * ZW + ZC_MV + h * 128 + vv];
            }
            __syncthreads();
            {
                const int mt = wid >> 1;
#pragma unroll
                for (int nn = 0; nn < 2; ++nn) {
                    const int nt = 2 * (wid & 1) + nn; f32x4 acc = {0.f, 0.f, 0.f, 0.f};
#pragma unroll
                    for (int ks = 0; ks < 2; ++ks) {
                        const bf16x8 a = *(const bf16x8*)(qs + (16 * mt + (lane & 15)) * 72 + ks * 32 + (lane >> 4) * 8);
                        const bf16x8 bb = *(const bf16x8*)(ks_ + (16 * nt + (lane & 15)) * 72 + ks * 32 + (lane >> 4) * 8);
                        acc = MFMA16(a, bb, acc);
                    }
                    const int s = 16 * nt + (lane & 15);
#pragma unroll
                    for (int j = 0; j < 4; ++j) { const int pp = 16 * mt + (lane >> 4) * 4 + j; const float v = s <= pp ? acc[j] * __expf(gg[s] - Mrow[pp]) : 0.f; Sp[pp * 72 + s] = f2bf(v); }
                }
                if (TID < 64) { float s = 0.f; for (int dq = 0; dq < 64; ++dq) s += mn[slot * 64 + dq] * bf2f(qs[TID * 72 + dq]); nq[TID] = s; }
            }
            __syncthreads();
            if (TID < 64) { float s = 0.f; for (int k = 0; k < 64; ++k) s += bf2f(Sp[TID * 72 + k]); den[TID] = s + iw[TID] * nq[TID]; }
            f32x4 a1[4], a2[4];
#pragma unroll
            for (int mt = 0; mt < 4; ++mt) { a1[mt] = (f32x4){0.f, 0.f, 0.f, 0.f}; a2[mt] = (f32x4){0.f, 0.f, 0.f, 0.f}; }
#pragma unroll
            for (int ks = 0; ks < 2; ++ks) {
                const bf16x8 bv = *(const bf16x8*)(vT + (16 * wid + (lane & 15)) * 72 + ks * 32 + (lane >> 4) * 8);
                const bf16x8 bc = *(const bf16x8*)(mst + (size_t)slot * 8192 + (16 * wid + (lane & 15)) * 64 + ks * 32 + (lane >> 4) * 8);
#pragma unroll
                for (int mt = 0; mt < 4; ++mt) {
                    const bf16x8 as = *(const bf16x8*)(Sp + (16 * mt + (lane & 15)) * 72 + ks * 32 + (lane >> 4) * 8);
                    const bf16x8 aq = *(const bf16x8*)(qs + (16 * mt + (lane & 15)) * 72 + ks * 32 + (lane >> 4) * 8);
                    a1[mt] = MFMA16(as, bv, a1[mt]); a2[mt] = MFMA16(aq, bc, a2[mt]);
                }
            }
            __syncthreads();
            {
                const int vv = 16 * wid + (lane & 15);
#pragma unroll
                for (int mt = 0; mt < 4; ++mt)
#pragma unroll
                    for (int j = 0; j < 4; ++j) {
                        const int pp = 16 * mt + (lane >> 4) * 4 + j, o = d ? 63 - pp : pp;
                        const float val = (a1[mt][j] + iw[pp] * a2[mt][j]) / fmaxf(fabsf(den[pp]), __expf(-(bcum[pp] + Mrow[pp])));
                        if (d == 0) hsum[o * 132 + vv] = val; else hsum[o * 132 + vv] += val;
                    }
            }
        }
        __syncthreads();
#pragma unroll
        for (int i = 0; i < 8; ++i) {
            const int o = wid * 8 + i; const float x0 = hsum[o * 132 + lane], x1 = hsum[o * 132 + lane + 64];
            const float ss = wave_sum(x0 * x0 + x1 * x1), rinv = rsqrtf(ss * (1.f / 128.f) + 1e-6f);
            bf16_t* zo = z + (base + o) * ZW + ZC_MO + h * 128; const float* on = p.m_on + l * 512 + h * 128;
            zo[lane] = f2bf(x0 * rinv * on[lane] * sigmoidf_(bf2f(zo[lane])));
            zo[lane + 64] = f2bf(x1 * rinv * on[lane + 64] * sigmoidf_(bf2f(zo[lane + 64])));
        }
    }
    __syncthreads();
}
DI int swap23(int s) { return (s & ~12) | ((s & 4) << 1) | ((s & 8) >> 1); }
DI void ph_attn(const Prm& p, int l, unsigned char* smem, int bh, int qfirst, int qstep, int nq, int qextra) { PH_IDS
    const int lane = TID & 63, wid = TID >> 6, q = lane & 31, hh = lane >> 5, qg = wid >> 1, mp = wid & 1, grp = wid >> 2;
    bf16_t* z = (bf16_t*)(p.ws + WS_Z);
    float lam; const float lam_init = 0.8f - 0.6f * expf(-0.3f * (float)l);
    { const float* lp = p.a_lam + l * 256; float s1 = 0.f, s2 = 0.f; for (int i = 0; i < 64; ++i) { s1 += lp[i] * lp[64 + i]; s2 += lp[128 + i] * lp[192 + i]; } lam = expf(s1) - expf(s2) + lam_init; }
    bf16_t* Qs = (bf16_t*)smem; float* ex = (float*)smem;
    constexpr int KB_OFF = 34816, VT_OFF = 69632;
#define ATT_BAR asm volatile("s_waitcnt lgkmcnt(0)\n\ts_barrier" ::: "memory")
    for (int ui = 0; ui < nq + (qextra >= 0 ? 1 : 0); ++ui) {
        const int qi = ui < nq ? qfirst + ui * qstep : qextra;
        const int b = bh >> 2, head = bh & 3; int nt; size_t qrow0;
        const bool lat = qi < 64;
        if (lat) { qrow0 = (size_t)b * SEQL + qi * 128; nt = 132; } else { qrow0 = (size_t)NLAT + b * CTXL + (qi - 64) * 128; nt = 4; }
        __syncthreads();
#pragma unroll
        for (int i = 0; i < 4; ++i) { const int idx = TID + 512 * i, r = idx >> 4, cp = idx & 15; *(u32x4*)(Qs + r * 136 + cp * 8) = *(const u32x4*)(z + (qrow0 + r) * ZW + ZC_AQ + head * 128 + cp * 8); }
        u32x4 kreg[2], vreg[2];
        const int kp = TID & 31, vg = TID >> 5;
#define ATT_KROW0(j) ((lat && (j) >= 4) ? (size_t)b * SEQL + 64 * ((j) - 4) : (size_t)NLAT + b * CTXL + 64 * (j))
#define ATT_LOADK(j) do { const size_t kr0 = ATT_KROW0(j); \
            _Pragma("unroll") for (int i = 0; i < 2; ++i) { const int idx = TID + 512 * i, r = idx >> 4, cp = idx & 15; kreg[i] = *(const u32x4*)(z + (kr0 + r) * ZW + ZC_AK + head * 128 + cp * 8); } } while (0)
#define ATT_LOADV(j) do { const size_t kr0 = ATT_KROW0(j); \
            _Pragma("unroll") for (int i = 0; i < 2; ++i) vreg[i] = *(const u32x4*)(z + (kr0 + 2 * kp + i) * ZW + ZC_AV + head * 128 + 8 * vg); } while (0)
#define ATT_WRITEK(buf) do { bf16_t* Kw = (bf16_t*)(smem + KB_OFF + (buf) * 17408); \
            _Pragma("unroll") for (int i = 0; i < 2; ++i) { const int idx = TID + 512 * i, r = idx >> 4, cp = idx & 15; *(u32x4*)(Kw + r * 136 + cp * 8) = kreg[i]; } } while (0)
#define ATT_WRITEV(buf) do { bf16_t* Vw = (bf16_t*)(smem + VT_OFF + (buf) * 18432); \
            _Pragma("unroll") for (int w = 0; w < 4; ++w) { \
                *(unsigned*)(Vw + (8 * vg + 2 * w) * 72 + 2 * kp) = (vreg[0][w] & 0xffffu) | (vreg[1][w] << 16); \
                *(unsigned*)(Vw + (8 * vg + 2 * w + 1) * 72 + 2 * kp) = (vreg[0][w] >> 16) | (vreg[1][w] & 0xffff0000u); } } while (0)
        f32x16 o[4]; float mrun = -1e30f, lrun = 0.f; bf16x8 pf[4];
#pragma unroll
        for (int dvb = 0; dvb < 4; ++dvb)
#pragma unroll
            for (int i = 0; i < 16; ++i) o[dvb][i] = 0.f;
#define ATT_QK(j) do { const bf16_t* Kb = (const bf16_t*)(smem + KB_OFF + ((j) & 1) * 17408); \
            f32x16 s0, s1; \
            _Pragma("unroll") for (int i = 0; i < 16; ++i) { s0[i] = 0.f; s1[i] = 0.f; } \
            _Pragma("unroll") for (int kk = 0; kk < 4; ++kk) { \
                const bf16x8 qf = *(const bf16x8*)(Qs + (32 * qg + q) * 136 + mp * 64 + kk * 16 + hh * 8); \
                const bf16x8 k0 = *(const bf16x8*)(Kb + swap23(q) * 136 + mp * 64 + kk * 16 + hh * 8); \
                const bf16x8 k1 = *(const bf16x8*)(Kb + (32 + swap23(q)) * 136 + mp * 64 + kk * 16 + hh * 8); \
                s0 = MFMA32(k0, qf, s0); s1 = MFMA32(k1, qf, s1); } \
            float mx = fmaxf(fmaxf(s0[0], s0[1]), fmaxf(s1[0], s1[1])); \
            _Pragma("unroll") for (int i = 2; i < 16; i += 2) mx = fmaxf(mx, fmaxf(fmaxf(s0[i], s0[i + 1]), fmaxf(s1[i], s1[i + 1]))); \
            mx = fmaxf(mx, __shfl_xor(mx, 32)); \
            const float mnew = fmaxf(mrun, mx); \
            if (__any(mnew > mrun)) { const float alpha = __expf(mrun - mnew); lrun *= alpha; \
                _Pragma("unroll") for (int dvb = 0; dvb < 4; ++dvb) _Pragma("unroll") for (int i = 0; i < 16; ++i) o[dvb][i] *= alpha; } \
            mrun = mnew; \
            f32x2 ps = {0.f, 0.f}; \
            _Pragma("unroll") for (int i = 0; i < 16; i += 2) { s0[i] = __expf(s0[i] - mnew); s0[i + 1] = __expf(s0[i + 1] - mnew); s1[i] = __expf(s1[i] - mnew); s1[i + 1] = __expf(s1[i + 1] - mnew); \
                const f32x2 a2 = {s0[i], s0[i + 1]}, b2 = {s1[i], s1[i + 1]}; ps += a2 + b2; } \
            lrun += ps.x + ps.y; \
            _Pragma("unroll") for (int cc = 0; cc < 2; ++cc) { u32x4 a, c2; \
                a.x = pk2(s0[8 * cc], s0[8 * cc + 1]); a.y = pk2(s0[8 * cc + 2], s0[8 * cc + 3]); a.z = pk2(s0[8 * cc + 4], s0[8 * cc + 5]); a.w = pk2(s0[8 * cc + 6], s0[8 * cc + 7]); \
                c2.x = pk2(s1[8 * cc], s1[8 * cc + 1]); c2.y = pk2(s1[8 * cc + 2], s1[8 * cc + 3]); c2.z = pk2(s1[8 * cc + 4], s1[8 * cc + 5]); c2.w = pk2(s1[8 * cc + 6], s1[8 * cc + 7]); \
                pf[cc] = __builtin_bit_cast(bf16x8, a); pf[2 + cc] = __builtin_bit_cast(bf16x8, c2); } } while (0)
#define ATT_PV(j) do { const bf16_t* Vt = (const bf16_t*)(smem + VT_OFF + ((j) & 1) * 18432); \
            _Pragma("unroll") for (int dvb = 0; dvb < 4; ++dvb) _Pragma("unroll") for (int c = 0; c < 4; ++c) { \
                const bf16x8 vf = *(const bf16x8*)(Vt + (dvb * 32 + q) * 72 + 16 * c + 8 * hh); o[dvb] = MFMA32(vf, pf[c], o[dvb]); } } while (0)
        ATT_LOADK(0); ATT_LOADV(0); ATT_WRITEK(0); ATT_WRITEV(0);
        __syncthreads();
        for (int j = 0; j < nt; ++j) {
            if (j + 1 < nt) { ATT_LOADK(j + 1); ATT_LOADV(j + 1); }
            ATT_QK(j); ATT_PV(j);
            if (j + 1 < nt) { ATT_WRITEK((j + 1) & 1); ATT_WRITEV((j + 1) & 1); }
            __syncthreads();
        }
        const float lsum = lrun + __shfl_xor(lrun, 32);
        const float inv = (mp ? lam : 1.f) / lsum;
        if (mp) {
#pragma unroll
            for (int dvb = 0; dvb < 4; ++dvb)
#pragma unroll
                for (int i = 0; i < 16; ++i) ex[(qg * 64 + dvb * 16 + i) * 64 + lane] = o[dvb][i] * inv;
        }
        __syncthreads();
        if (!mp) {
            float ss = 0.f;
#pragma unroll
            for (int dvb = 0; dvb < 4; ++dvb)
#pragma unroll
                for (int i = 0; i < 16; ++i) { const float v = o[dvb][i] * inv - ex[(qg * 64 + dvb * 16 + i) * 64 + lane]; o[dvb][i] = v; ss += v * v; }
            ss += __shfl_xor(ss, 32);
            const float rinv = rsqrtf(ss * (1.f / 128.f) + 1e-6f) * (1.f - lam_init);
            bf16_t* orow = z + (qrow0 + 32 * qg + q) * ZW + ZC_AQ + head * 128; const float* sub = p.a_subln + l * 128;
#pragma unroll
            for (int dvb = 0; dvb < 4; ++dvb)
#pragma unroll
                for (int ig = 0; ig < 4; ++ig) {
                    const int dv0 = dvb * 32 + 8 * ig + 4 * hh; u32x2 w;
                    w.x = pk2(o[dvb][4 * ig] * rinv * sub[dv0], o[dvb][4 * ig + 1] * rinv * sub[dv0 + 1]);
                    w.y = pk2(o[dvb][4 * ig + 2] * rinv * sub[dv0 + 2], o[dvb][4 * ig + 3] * rinv * sub[dv0 + 3]);
                    *(u32x2*)(orow + dv0) = w;
                }
        }
    }
    __syncthreads();
}

__device__ unsigned long long g_pacc[4];
template <int CTRL> DI float dppf(float v) { return __int_as_float(__builtin_amdgcn_update_dpp(0, __float_as_int(v), CTRL, 0xf, 0xf, false)); }
DI float allreduce16(float x) { x += dppf<0x128>(x); x += dppf<0x124>(x); x += dppf<0x122>(x); x += dppf<0x121>(x); return x; }
DI void ph_rwkv_scan(const Prm& p, int l, unsigned char* smem, int ubeg, int ustride) { PH_IDS
    const int lane = TID & 63, wid = TID >> 6;
    const bf16_t* z = (const bf16_t*)(p.ws + WS_Z); const bf16_t* rwa = (const bf16_t*)(p.ws + WS_RWA); const float* invn = (const float*)(p.ws + WS_INVN);
    constexpr int TC = 32, OPW = 336, NC = 264, OPS_B = TC * OPW * 4, YP_OFF = 2 * OPS_B;
    for (int u = ubeg; u < 128; u += ustride) {
        const int chain = u >> 2, qr = u & 3, d = chain >> 4, b = (chain >> 3) & 1, h = chain & 7;
        const float ckk = p.r_kk[l * 512 + h * 64 + lane], cka = p.r_ka[l * 512 + h * 64 + lane];
        bf16_t* ydir = (bf16_t*)(p.ws + WS_YSUM) + (size_t)d * NTOK * 512;
#define RW_ROW(ck, i) ((ck) < 8 ? (size_t)NLAT + b * CTXL + (d ? CTXL - 1 - ((ck) * TC + (i)) : ((ck) * TC + (i))) : (size_t)b * SEQL + (d ? SEQL - 1 - (((ck) - 8) * TC + (i)) : (((ck) - 8) * TC + (i))))
        bf16_t g_r[8], g_k[8], g_u[8], g_a[8]; float g_i[8]; unsigned g_v;
        const int sw = wid - 4, st = TID - 256;
#define RW_LOAD(ck) do { _Pragma("unroll") for (int jj = 0; jj < 8; ++jj) { const size_t row = RW_ROW(ck, sw + 4 * jj); \
            g_r[jj] = z[row * ZW + ZC_RR + h * 64 + lane]; g_k[jj] = z[row * ZW + ZC_RK + h * 64 + lane]; \
            g_u[jj] = rwa[row * 2048 + d * 512 + h * 64 + lane]; g_a[jj] = rwa[row * 2048 + 1024 + d * 512 + h * 64 + lane]; g_i[jj] = invn[row * 8 + h]; } \
            g_v = *(const unsigned*)(z + RW_ROW(ck, st >> 3) * ZW + ZC_RV + h * 64 + qr * 16 + (st & 7) * 2); } while (0)
#define RW_WRITE(buf) do { float* ops = (float*)(smem + (buf) * OPS_B); _Pragma("unroll") for (int jj = 0; jj < 8; ++jj) { \
            const float k = bf2f(g_k[jj]), a = bf2f(g_a[jj]), kk = k * ckk * g_i[jj]; float* o = ops + (sw + 4 * jj) * OPW; \
            o[lane] = 1.f - bf2f(g_u[jj]); o[64 + lane] = kk; o[128 + lane] = kk * a; o[192 + lane] = k * (1.f + (a - 1.f) * cka); o[256 + lane] = bf2f(g_r[jj]); } \
            { float* o = ops + (st >> 3) * OPW + 320 + (st & 7) * 2; o[0] = lo16(g_v); o[1] = hi16(g_v); } } while (0)
        __syncthreads();
        if (wid >= 4) { RW_LOAD(0); RW_WRITE(0); RW_LOAD(1); }
        __syncthreads();
        f32x2 Sa = {0.f, 0.f}, Sb = {0.f, 0.f};
        const int rl = (wid & 3) * 4 + (lane >> 4), ksub = lane & 15;
        float* ypw = (float*)(smem + YP_OFF) + (wid & 3) * (TC * 64);
        for (int ck = 0; ck < NC; ++ck) {
            if (wid >= 4) {
                if (ck + 1 < NC) RW_WRITE((ck + 1) & 1);
                if (ck + 2 < NC) RW_LOAD(ck + 2);
            } else {
                const float* ops = (const float*)(smem + (ck & 1) * OPS_B);
#define RW_GET(X, i) do { const float* o_ = ops + (i) * OPW; w_##X = *(const f32x4*)(o_ + 4 * ksub); k_##X = *(const f32x4*)(o_ + 64 + 4 * ksub); b_##X = *(const f32x4*)(o_ + 128 + 4 * ksub); \
                d_##X = *(const f32x4*)(o_ + 192 + 4 * ksub); r_##X = *(const f32x4*)(o_ + 256 + 4 * ksub); v_##X = o_[320 + rl]; } while (0)
#define RW_STEP(X, i) do { const f32x2 ka = {k_##X[0], k_##X[1]}, kb = {k_##X[2], k_##X[3]}, ra = {r_##X[0], r_##X[1]}, rb = {r_##X[2], r_##X[3]}; \
                const f32x2 ba = {b_##X[0], b_##X[1]}, bb = {b_##X[2], b_##X[3]}, da = {d_##X[0], d_##X[1]}, db = {d_##X[2], d_##X[3]}, wa = {w_##X[0], w_##X[1]}, wb = {w_##X[2], w_##X[3]}; \
                const f32x2 dt2 = Sa * ka + Sb * kb; const f32x2 qa = Sa * wa + da * v_##X, qb = Sb * wb + db * v_##X; const float sa = -allreduce16(dt2.x + dt2.y); \
                Sa = ba * sa + qa; Sb = bb * sa + qb; \
                const f32x2 y2 = Sa * ra + Sb * rb; \
                ypw[(i) * 64 + lane] = y2.x + y2.y; } while (0)
                f32x4 w_A, k_A, b_A, d_A, r_A, w_B, k_B, b_B, d_B, r_B; float v_A, v_B;
                RW_GET(A, 0);
#pragma unroll 1
                for (int i = 0; i < TC; i += 2) {
                    RW_GET(B, i + 1);
                    RW_STEP(A, i);
                    if (i + 2 < TC) RW_GET(A, i + 2);
                    RW_STEP(B, i + 1);
                }
                {
                    const int i = lane >> 1, rw = (lane & 1) * 2;
                    const f32x4* y4 = (const f32x4*)(ypw + i * 64 + rw * 16);
                    const f32x4 s4 = (y4[0] + y4[1]) + (y4[2] + y4[3]), t4 = (y4[4] + y4[5]) + (y4[6] + y4[7]);
                    *(unsigned*)(ydir + RW_ROW(ck, i) * 512 + h * 64 + qr * 16 + wid * 4 + rw) = pk2((s4[0] + s4[1]) + (s4[2] + s4[3]), (t4[0] + t4[1]) + (t4[2] + t4[3]));
                }
            }
            asm volatile("s_waitcnt lgkmcnt(0)\n\ts_barrier" ::: "memory");
        }
    }
    __syncthreads();
}
DI void ph_rwkv_post(const Prm& p, int l) { PH_IDS
    const int lane = TID & 63, wid = TID >> 6, ch0 = lane * 8;
    bf16_t* z = (bf16_t*)(p.ws + WS_Z); const bf16_t* ysum = (const bf16_t*)(p.ws + WS_YSUM); const bf16_t* rg = (const bf16_t*)(p.ws + WS_RG);
    for (int row = BID * 8 + wid; row < NTOK; row += NBLK * 8) {
        float y[8], y2[8], r[8], k[8], v[8], g[8], o[8];
        unpack8(*(const u32x4*)(ysum + (size_t)row * 512 + ch0), y); unpack8(*(const u32x4*)(ysum + (size_t)(NTOK + row) * 512 + ch0), y2);
#pragma unroll
        for (int e = 0; e < 8; ++e) y[e] += y2[e];
        bf16_t* zr = z + (size_t)row * ZW + ZC_RR + ch0;
        unpack8(*(const u32x4*)zr, r); unpack8(*(const u32x4*)(zr + 512), k); unpack8(*(const u32x4*)(zr + 1024), v); unpack8(*(const u32x4*)(rg + (size_t)row * 512 + ch0), g);
        float s = 0.f, bs = 0.f;
#pragma unroll
        for (int e = 0; e < 8; ++e) { s += y[e]; bs += r[e] * k[e] * p.r_rk[l * 512 + ch0 + e]; }
        s += __shfl_xor(s, 1); s += __shfl_xor(s, 2); s += __shfl_xor(s, 4); bs += __shfl_xor(bs, 1); bs += __shfl_xor(bs, 2); bs += __shfl_xor(bs, 4);
        const float mu = s * (1.f / 64.f); float vs = 0.f;
#pragma unroll
        for (int e = 0; e < 8; ++e) { const float dlt = y[e] - mu; vs += dlt * dlt; }
        vs += __shfl_xor(vs, 1); vs += __shfl_xor(vs, 2); vs += __shfl_xor(vs, 4);
        const float rstd = rsqrtf(vs * (1.f / 64.f) + 64e-5f);
#pragma unroll
        for (int e = 0; e < 8; ++e) o[e] = ((y[e] - mu) * rstd * p.r_lnw[l * 512 + ch0 + e] + p.r_lnb[l * 512 + ch0 + e] + bs * v[e]) * g[e];
        *(u32x4*)zr = pack8(o);
    }
}

#ifndef PROBE_A
#define PROBE_A 0
#endif
#ifndef PROBE_B
#define PROBE_B 0
#endif
#ifndef PROBE_BLK
#define PROBE_BLK 0
#endif
#ifndef PROBE_ADIV
#define PROBE_ADIV 1
#endif
#ifndef PROBE_BDIV
#define PROBE_BDIV 1
#endif
#if PROBE_A || PROBE_B
#define PT(id, ...) do { unsigned long long t0_ = wall_clock64(); __VA_ARGS__; unsigned long long dt_ = wall_clock64() - t0_; if ((id) == PROBE_A) pacc1 += dt_; if ((id) == PROBE_B) pacc2 += dt_; } while (0)
#else
#define PT(id, ...) do { __VA_ARGS__; } while (0)
#endif
DI void grid_bar(unsigned* ctr, unsigned& target, unsigned nblk) {
    __syncthreads();
    if (threadIdx.x == 0) {
        __builtin_amdgcn_fence(__ATOMIC_RELEASE, "agent");
        target += nblk;
        __hip_atomic_fetch_add(ctr, 1u, __ATOMIC_RELAXED, __HIP_MEMORY_SCOPE_AGENT);
        while (__hip_atomic_load(ctr, __ATOMIC_RELAXED, __HIP_MEMORY_SCOPE_AGENT) < target) __builtin_amdgcn_s_sleep(2);
        __builtin_amdgcn_fence(__ATOMIC_ACQUIRE, "agent");
    }
    __syncthreads();
}
__global__ void __launch_bounds__(512) mega(Prm p0) {
    Prm p = p0; p.wv = __builtin_amdgcn_readfirstlane((int)threadIdx.x >> 6);
    const int BIDK = (int)blockIdx.x;
    extern __shared__ __attribute__((aligned(16))) unsigned char smem[];
    cg::grid_group grid = cg::this_grid();
    unsigned bar_target = 0; unsigned* bar_ctr = (unsigned*)(p0.ws + WS_BAR);
#define GSYNC() grid_bar(bar_ctr, bar_target, gridDim.x)
    bf16_t* wt = (bf16_t*)(p.ws + WS_WT); bf16_t* zb = (bf16_t*)(p.ws + WS_Z); bf16_t* hb = (bf16_t*)(p.ws + WS_RWA); bf16_t* gtmp = hb + (size_t)NTOK * DM;
    bf16_t* zz = (bf16_t*)(p.ws + WS_MST); float* xc = (float*)(p.ws + WS_XC); const float* mods = (const float*)(p.ws + WS_MODS);
#if PROBE_A || PROBE_B
    unsigned long long pacc1 = 0, pacc2 = 0; const unsigned long long pstart = wall_clock64();
    if (PROBE_SCAN && blockIdx.x == 0 && threadIdx.x == 0) { g_pacc[0] = 0; g_pacc[1] = 0; }
#endif
    PT(15, ph_modpart(p, smem); ph_rope(p); conv_ffn(p, 0, 0, smem));
    PT(14, grid.sync());
    ph_modreduce(p);
    PT(14, GSYNC());
#define MERGE_B(l, b) do { \
                    { EpiGate E; E.G = gtmp; run_gemm(p.wv, smem, hb, DM, wt + WT_G + (size_t)(b) * DM * DM, (l) == 1 ? NLAT : NTOK, DM, DM, E); } \
                    { EpiBranch E; E.G = gtmp; E.ZZ = zz; E.first = ((b) == 0); const int yc = (b) == 0 ? ZC_MO : ((b) == 1 ? ZC_RR : ZC_AQ); \
                      run_gemm(p.wv, smem, zb + yc, ZW, wt + WT_P + (size_t)(b) * DM * 512, (l) == 1 ? NLAT : NTOK, DM, 512, E); } \
 } while (0)
#define MIXER_STAGE(l) do { const float* ml = mods + (size_t)(l) * 27648; \
                PT(13, ph_norm(p, l, 1, false, 11, ml + 2 * DM, 0.5f); conv_mixer(p, l, smem);); \
                PT(14, GSYNC()); \
                PT(8, { EpiWin E; E.Z = zb; run_gemm(p.wv, smem, hb, DM, wt + WT_IN, NTOK, ZWP, DM, E); }); \
                PT(14, GSYNC()); \
                PT(4, ph_rkv_conv(p, l); ph_attn_prep(p, l)); PT(5, ph_mlstm_a(p, l, smem)); \
                PT(14, GSYNC()); \
                PT(6, ph_rkv_copy(p)); PT(7, ph_mlstm_b(p)); \
                PT(14, GSYNC()); \
                PT(16, { EpiLora E; E.RWA = hb; E.RG = (bf16_t*)(p.ws + WS_RG); E.w0 = p.r_w0 + l * 1024; E.a0 = p.r_a0 + l * 1024; run_gemm(p.wv, smem, zb + ZC_RL, ZW, wt + WT_L, NTOK, 2560, 384, E); }); \
                PT(14, GSYNC()); \
                { int sc_u = BIDK, sc_s = NBLK, bh0 = 0, bh1 = 8, qf = BIDK, qs = NBLK, nq = (66 - BIDK + NBLK - 1) / NBLK, qx = -1, mc_u = BIDK, mc_s = NBLK, mc_c = 1 << 30; \
                  if (NBLK == 256) { const int xi = BIDK >> 3, bh = BIDK & 7; bh0 = bh; bh1 = bh + 1; sc_s = 128; \
                      if (xi < 16) { sc_u = bh * 16 + xi; nq = 0; mc_u = 256 + bh * 16 + xi; mc_s = 128; } \
                      else { const int a = xi - 16; sc_u = 128; qf = a; qs = 16; nq = 4; qx = a < 2 ? 64 + a : -1; mc_u = (bh * 16 + a) * 2; mc_s = 1; mc_c = 2; } } \
                  PT(1, ph_rwkv_scan(p, l, smem, sc_u, sc_s)); \
                  PT(2, for (int bh = bh0; bh < bh1; ++bh) ph_attn(p, l, smem, bh, qf, qs, nq, qx)); \
                  PT(3, ph_mlstm_c(p, l, smem, mc_u, mc_s, mc_c)); } \
                PT(14, GSYNC()); \
                PT(12, ph_rwkv_post(p, l); ph_norm(p, l, 1, false)); \
                PT(14, GSYNC()); \
                PT(9, MERGE_B(l, 0); MERGE_B(l, 1); MERGE_B(l, 2)); \
                PT(14, GSYNC()); \
                PT(17, { EpiResid E; E.xlat = p.out; E.xc = xc; E.gate = ml + 5 * DM; E.coef = 1.f; run_gemm(p.wv, smem, zz, DM, wt + WT_O, NLAT, DM, DM, E); \
              if ((l) == 0) { EpiPartial E2; E2.P = (float*)gtmp; E2.kslice_bytes = 512; run_gemm_ctx(p.wv, smem, zz, DM, wt + WT_O, DM, 4, 256, E2); } }); \
                PT(14, GSYNC()); \
 } while (0)
#define FFN_STAGE(l, f) do { const float* ml = mods + (size_t)(l) * 27648; \
            PT(18, ph_norm(p, l, f == 0 ? 0 : 2, l == 0 && f == 0, (f) == 1 ? ((l) == 0 ? 4 : 0) : ((l) == 1 ? 11 : 0), (f) == 1 ? ml + 5 * DM : mods + 8 * DM, (f) == 1 ? 1.f : 0.5f); \
            if (!(l == 0 && f == 0)) conv_ffn(p, l, f, smem)); \
            PT(14, GSYNC()); \
            PT(10, { EpiSwiglu E; E.H = zb; run_gemm(p.wv, smem, hb, DM, wt + WT_GU, ((l) == 1 && (f) == 1) ? NLAT : NTOK, 2 * DFF, DM, E); }); \
            PT(14, GSYNC()); \
            PT(11, { EpiResid E; E.xlat = p.out; E.xc = xc; E.gate = ml + (f == 0 ? 2 : 8) * DM; E.coef = 0.5f; run_gemm(p.wv, smem, zb, DFF, wt + WT_DN, NLAT, DM, DFF, E); \
              if (!((l) == 1 && (f) == 1)) { EpiPartial E2; E2.P = (float*)gtmp; E2.kslice_bytes = 512; run_gemm_ctx(p.wv, smem, zb, DFF, wt + WT_DN, DFF, 11, 256, E2); } }); \
            PT(14, GSYNC()); \
 } while (0)
    FFN_STAGE(0, 0); MIXER_STAGE(0); FFN_STAGE(0, 1); FFN_STAGE(1, 0); MIXER_STAGE(1); FFN_STAGE(1, 1);
#if PROBE_A || PROBE_B
    if (blockIdx.x == PROBE_BLK) {
        const unsigned long long pend = wall_clock64();
        if (PROBE_SCAN) { __syncthreads(); pacc1 = g_pacc[0]; pacc2 = g_pacc[1]; }
        if (PROBE_A == 99) pacc1 = pend - pstart;
        if (PROBE_B == 99) pacc2 = pend - pstart;
        unsigned long long q1 = pacc1 / (4000ull * PROBE_ADIV), q2 = pacc2 / (4000ull * PROBE_BDIV); if (q1 > 63) q1 = 63; if (q2 > 63) q2 = 63;
        const unsigned long long waitt = (q1 + 64 * q2) * 2000ull;
        while (wall_clock64() - pend < waitt) __builtin_amdgcn_s_sleep(32);
    }
#endif
}

extern "C" void kernel_launch(void* const* d_in, const int* in_sizes, int n_in, void* d_out, int out_size, void* d_ws, size_t ws_size, hipStream_t stream) {
    static int grid_blocks = 0;
    if (!grid_blocks) {
        int dev = 0, cus = 0, per_cu = 0;
        hipGetDevice(&dev);
        hipDeviceGetAttribute(&cus, hipDeviceAttributeMultiprocessorCount, dev);
        hipFuncSetAttribute((const void*)mega, hipFuncAttributeMaxDynamicSharedMemorySize, LDS_BYTES);
        hipOccupancyMaxActiveBlocksPerMultiprocessor(&per_cu, (const void*)mega, 512, LDS_BYTES);
        if (per_cu < 1) per_cu = 1;
        grid_blocks = cus * per_cu;
        if (ws_size < WS_END) fprintf(stderr, "kernel_launch: workspace too small: %zu < %zu\n", ws_size, (size_t)WS_END);
    }
    Prm p{};
    const float** pp = (const float**)&p;
    for (int i = 0; i < 31; ++i) pp[i] = (const float*)d_in[i];
    p.out = (float*)d_out; p.ws = (unsigned char*)d_ws;
    (void)hipMemsetAsync((unsigned char*)d_ws + WS_BAR, 0, 256, stream);
    void* args[] = {&p};
    hipError_t e = hipLaunchCooperativeKernel((const void*)mega, dim3(grid_blocks), dim3(512), args, LDS_BYTES, stream);
    if (e != hipSuccess) fprintf(stderr, "cooperative launch failed: %s (grid %d)\n", hipGetErrorString(e), grid_blocks);
}
```

```cpp
#include <hip/hip_runtime.h>
#include <hip/hip_cooperative_groups.h>
#include <cstdio>
#include <cstdint>
namespace cg = cooperative_groups;
#ifndef PROBE_SCAN
#define PROBE_SCAN 0
#endif

#define LAS __attribute__((address_space(3)))
#define DI __device__ __forceinline__
typedef unsigned short bf16_t;
typedef short bf16x8 __attribute__((ext_vector_type(8)));
typedef float f32x4 __attribute__((ext_vector_type(4)));
typedef float f32x16 __attribute__((ext_vector_type(16)));
typedef float f32x2 __attribute__((ext_vector_type(2)));
typedef unsigned u32x4 __attribute__((ext_vector_type(4)));
typedef unsigned u32x2 __attribute__((ext_vector_type(2)));
typedef __bf16 bf16x2_t __attribute__((ext_vector_type(2)));

constexpr int DM = 1024, NLAT = 16384, NTOK = 16896, SEQL = 8192, CTXL = 256, DFF = 2816, DIN = 8080, ZW = 5008, ZWP = 5120;
constexpr int ZC_MQ = 0, ZC_MK = 256, ZC_MV = 512, ZC_MO = 1024, ZC_MG = 1536, ZC_RR = 1552, ZC_RK = 2064, ZC_RV = 2576, ZC_RL = 3088, ZC_AQ = 3472, ZC_AK = 3984, ZC_AV = 4496;
constexpr int NCHK = 132;
constexpr size_t WS_MODP = 0;
constexpr size_t WS_MODS = WS_MODP + (size_t)2 * 16 * 3 * 9216 * 4;
constexpr size_t WS_ROPE = WS_MODS + (size_t)2 * 3 * 9216 * 4;
constexpr size_t WS_XC   = WS_ROPE + (size_t)8192 * 64 * 4;
constexpr size_t WS_INVN = WS_XC + (size_t)512 * 1024 * 4;
constexpr size_t WS_MSC  = WS_INVN + (size_t)NTOK * 8 * 4;
constexpr size_t WS_MN   = WS_MSC + (size_t)2112 * 4 * 4;
constexpr size_t WS_WT   = WS_MN + (size_t)2112 * 64 * 4;
constexpr size_t WS_Z    = WS_WT + (size_t)25165824;
constexpr size_t WS_RWA  = WS_Z + (size_t)NTOK * ZW * 2;
constexpr size_t WS_RG   = WS_RWA + (size_t)NTOK * 2048 * 2;
constexpr size_t WS_MST  = WS_RG + (size_t)NTOK * 512 * 2;
constexpr size_t WS_YSUM = WS_MST + (size_t)2112 * 8192 * 2;
constexpr size_t WS_BAR  = WS_YSUM + (size_t)NTOK * 512 * 4;
constexpr size_t WS_END  = WS_BAR + 256;
constexpr size_t WT_GU = 0, WT_DN = (size_t)5632 * 1024;
constexpr size_t WT_IN = 0, WT_G = (size_t)5120 * 1024, WT_P = WT_G + (size_t)3072 * 1024, WT_O = WT_P + (size_t)3 * 1024 * 512, WT_L = WT_O + (size_t)1024 * 1024;
constexpr int LDS_BYTES = 155648;

DI float bf2f(bf16_t b) { return __uint_as_float(((unsigned)b) << 16); }
DI unsigned pk2(float lo, float hi) { f32x2 v = {lo, hi}; bf16x2_t b = __builtin_convertvector(v, bf16x2_t); return __builtin_bit_cast(unsigned, b); }
DI bf16_t f2bf(float f) { return (bf16_t)(pk2(f, 0.f) & 0xffffu); }
DI float lo16(unsigned u) { return __uint_as_float(u << 16); }
DI float hi16(unsigned u) { return __uint_as_float(u & 0xffff0000u); }
DI float sigmoidf_(float x) { return __builtin_amdgcn_rcpf(1.f + __expf(-x)); }
DI float siluf_(float x) { return x * __builtin_amdgcn_rcpf(1.f + __expf(-x)); }
DI float logsigf_(float x) { return x < 0.f ? x - log1pf(expf(x)) : -log1pf(expf(-x)); }
DI float wave_sum(float v) {
#pragma unroll
    for (int o = 1; o < 64; o <<= 1) v += __shfl_xor(v, o);
    return v;
}
DI float wave_max(float v) {
#pragma unroll
    for (int o = 1; o < 64; o <<= 1) v = fmaxf(v, __shfl_xor(v, o));
    return v;
}
DI void unpack8(const u32x4 u, float* f) { f[0] = lo16(u.x); f[1] = hi16(u.x); f[2] = lo16(u.y); f[3] = hi16(u.y); f[4] = lo16(u.z); f[5] = hi16(u.z); f[6] = lo16(u.w); f[7] = hi16(u.w); }
DI u32x4 pack8(const float* f) { u32x4 u; u.x = pk2(f[0], f[1]); u.y = pk2(f[2], f[3]); u.z = pk2(f[4], f[5]); u.w = pk2(f[6], f[7]); return u; }
DI int launder_v(int v) { asm volatile("" : "+v"(v)); return v; }
DI int launder_s(int v) { asm volatile("" : "+s"(v)); return v; }
DI int lane_id_() { return (int)__builtin_amdgcn_mbcnt_hi(~0u, __builtin_amdgcn_mbcnt_lo(~0u, 0u)); }
namespace pg8 {
#define PG8_LAS __attribute__((address_space(3)))
typedef unsigned short bf16_t;
typedef short bf16x8 __attribute__((ext_vector_type(8)));
typedef float f32x4 __attribute__((ext_vector_type(4)));
typedef unsigned u32x4 __attribute__((ext_vector_type(4)));
constexpr int BM = 256, BK = 64, HALF = 128, HTB = HALF * BK * 2  , STAGE_BYTES = 8 * HTB, NXCD = 8, WGM = 8;

__host__ __device__ __forceinline__ int lds_byte(int r, int c) { const int st = (r >> 4) * 2 + (c >> 5), rr = r & 15, cc = c & 31, ob = rr * 64 + cc * 2; return st * 1024 + (ob ^ (((ob >> 9) & 1) << 5)); }
__host__ __device__ __forceinline__ void stage_rc(int b, int& R, int& C) { const int st = b / 1024, sb = b % 1024, swz = sb ^ (((sb >> 9) & 1) << 5); R = (st >> 1) * 16 + swz / 64; C = (st & 1) * 32 + (swz % 64) / 2; }
__host__ __device__ __forceinline__ int perm32(int rho) { const int n = rho >> 4, i = rho & 15; return 8 * (i >> 2) + 4 * n + (i & 3); }

struct Unit { int pm, pn; size_t koff; };
struct Gemm { const bf16_t* A; const bf16_t* Bt; int M, N, K, lda, ldb, tid0; };

struct StaticOrder {
    int nM, nN, nwg, G, c;
    __host__ __device__ void init(int M, int N, int G_, int c_) { nM = M / BM; nN = N / BM; nwg = nM * nN; G = G_; c = c_; }
    __host__ __device__ bool next(int i, Unit& u) const {
        const long L = (long)i * G + c; if (L >= nwg) return false;
        int wgid = (int)L; { const int q = nwg / NXCD, r = nwg % NXCD, xcd = wgid % NXCD, off = wgid / NXCD; wgid = (xcd < r ? xcd * (q + 1) : r * (q + 1) + (xcd - r) * q) + off; }
        const int nig = WGM * nN, gid = wgid / nig, fm = gid * WGM, gsz = (nM - fm) < WGM ? (nM - fm) : WGM;
        u.pm = fm + ((wgid % nig) % gsz); u.pn = (wgid % nig) / gsz; u.koff = 0; return true;
    }
    __device__ __forceinline__ void a_ready(const Unit&) const {}
    __device__ __forceinline__ void done(const Unit&) const {}
};


template <class Epi, class Sched, bool ALIGN_EPI = false, bool SP2 = false>
__device__ __forceinline__ void gemm_phase(PG8_LAS unsigned char* lds, const Gemm g, const Sched& S, const Epi& E) {
    int tid = g.tid0; asm volatile("" : "+v"(tid)); const int wid = __builtin_amdgcn_readfirstlane(tid >> 6), lane = tid & 63, wr = wid >> 2, wc = wid & 3, fr = lane & 15, fq = lane >> 4;
    const int K = g.K, nt = K / BK;
    unsigned voffA[2], voffB[2];
#pragma unroll
    for (int i = 0; i < 2; ++i) { int R, C; stage_rc(tid * 16 + i * 8192, R, C); const int Rb = Epi::PERM ? ((R & ~31) + perm32(R & 31)) : R;
        voffA[i] = (unsigned)(R * g.lda + C) * 2u; voffB[i] = (unsigned)(Rb * g.ldb + C) * 2u; }
    const size_t kstep = (size_t)(BK * 2);
    const size_t hstepB = (size_t)HALF * g.ldb * 2, hstepA = (size_t)HALF * g.lda * 2;
    const size_t tstepA = 2 * hstepA, tstepB = 2 * hstepB;
    const unsigned ldsw = (unsigned)wid * 1024u;
    const int aoff = lds_byte(wr * 64 + fr, fq * 8), boff = lds_byte(wc * 32 + fr, fq * 8);
#define PG8_SA(b, h) (((b) * 2 + (h)) * HTB)
#define PG8_SB(b, h) ((4 + (b) * 2 + (h)) * HTB)
#define PG8_STAGE(bufoff, gbase, voff) do { _Pragma("unroll") for (int _i = 0; _i < 2; ++_i) \
        __builtin_amdgcn_global_load_lds((const unsigned*)((const char*)(gbase) + (voff)[_i]), (PG8_LAS unsigned*)(lds + (bufoff) + ldsw + _i * 8192), 16, 0, 0); } while (0)
#define PG8_LDA(dst, b, h) do { _Pragma("unroll") for (int m = 0; m < 4; ++m) _Pragma("unroll") for (int k = 0; k < 2; ++k) dst[m][k] = *(const PG8_LAS bf16x8*)(lds + PG8_SA(b, h) + aoff + m * 2048 + k * 1024); } while (0)
#define PG8_LDB(dst, b, h) do { _Pragma("unroll") for (int n = 0; n < 2; ++n) _Pragma("unroll") for (int k = 0; k < 2; ++k) dst[n][k] = *(const PG8_LAS bf16x8*)(lds + PG8_SB(b, h) + boff + n * 2048 + k * 1024); } while (0)
#define PG8_MMA(ai, bj, At, Bt) do { __builtin_amdgcn_s_setprio(1); _Pragma("unroll") for (int m = 0; m < 4; ++m) _Pragma("unroll") for (int n = 0; n < 2; ++n) _Pragma("unroll") for (int k = 0; k < 2; ++k) \
        acc[ai][bj][m][n] = __builtin_amdgcn_mfma_f32_16x16x32_bf16(Bt[n][k], At[m][k], acc[ai][bj][m][n], 0, 0, 0); __builtin_amdgcn_s_setprio(0); } while (0)
#define PG8_WAIT_V(n) asm volatile("s_waitcnt vmcnt(" #n ")" ::: "memory")
#define PG8_WAIT_L(n) asm volatile("s_waitcnt lgkmcnt(" #n ")" ::: "memory")
#define PG8_BAR __builtin_amdgcn_s_barrier()
#define PG8_SCHED __builtin_amdgcn_sched_barrier(0)
    Unit cur, nxt; int ui = 0;
    if (!S.next(0, cur)) return;
    f32x4 acc[2][2][4][2];
#pragma unroll
    for (int a = 0; a < 2; ++a)
#pragma unroll
        for (int b = 0; b < 2; ++b)
#pragma unroll
            for (int m = 0; m < 4; ++m)
#pragma unroll
                for (int n = 0; n < 2; ++n) acc[a][b][m][n] = (f32x4){0.f, 0.f, 0.f, 0.f};
    bf16x8 At[4][2], B0[2][2], B1[2][2];
    const char* cA = (const char*)g.A + (size_t)cur.pm * tstepA + cur.koff; const char* cB = (const char*)g.Bt + (size_t)cur.pn * tstepB + cur.koff;
    S.a_ready(cur);
    if constexpr (SP2) {
        PG8_STAGE(PG8_SB(0, 0), cB, voffB); PG8_STAGE(PG8_SB(0, 1), cB + hstepB, voffB); PG8_STAGE(PG8_SA(0, 0), cA, voffA); PG8_STAGE(PG8_SA(0, 1), cA + hstepA, voffA);
        if (wr == 1) PG8_BAR;
        PG8_WAIT_V(2); PG8_BAR;
        PG8_STAGE(PG8_SB(1, 0), cB + kstep, voffB); PG8_STAGE(PG8_SA(1, 0), cA + kstep, voffA); PG8_STAGE(PG8_SB(1, 1), cB + hstepB + kstep, voffB);
        PG8_WAIT_V(6); PG8_BAR;
    } else {
        PG8_STAGE(PG8_SB(0, 0), cB, voffB); PG8_STAGE(PG8_SA(0, 0), cA, voffA); PG8_STAGE(PG8_SB(0, 1), cB + hstepB, voffB); PG8_STAGE(PG8_SA(0, 1), cA + hstepA, voffA);
        if (wr == 1) PG8_BAR;
        PG8_WAIT_V(4); PG8_BAR;
        PG8_STAGE(PG8_SB(1, 0), cB + kstep, voffB); PG8_STAGE(PG8_SA(1, 0), cA + kstep, voffA); PG8_STAGE(PG8_SB(1, 1), cB + hstepB + kstep, voffB);
        PG8_WAIT_V(6); PG8_BAR;
    }
    for (;;) {
        const bool has_next = S.next(ui + 1, nxt);
        const char* nA = has_next ? (const char*)g.A + (size_t)nxt.pm * tstepA + nxt.koff : cA; const char* nB = has_next ? (const char*)g.Bt + (size_t)nxt.pn * tstepB + nxt.koff : cB;
        for (int t = 0; t < nt; t += 2) {
            const bool last = (t == nt - 2);
            const char* a1 = cA + (size_t)(t + 1) * kstep;
            const char* a2 = last ? nA : cA + (size_t)(t + 2) * kstep; const char* b2 = last ? nB : cB + (size_t)(t + 2) * kstep;
            const char* a3 = a2 + kstep; const char* b3 = b2 + kstep;
            if (last && has_next) S.a_ready(nxt);
            if constexpr (SP2) {
            PG8_LDB(B0, 0, 0); PG8_LDB(B1, 0, 1); PG8_SCHED; PG8_LDA(At, 0, 0); PG8_STAGE(PG8_SA(1, 1), a1 + hstepA, voffA);
            PG8_WAIT_V(8); PG8_WAIT_L(0); PG8_BAR; PG8_MMA(0, 0, At, B0); PG8_MMA(0, 1, At, B1); PG8_BAR; PG8_SCHED;
            PG8_LDA(At, 0, 1); PG8_STAGE(PG8_SB(0, 0), b2, voffB); PG8_STAGE(PG8_SB(0, 1), b2 + hstepB, voffB); PG8_STAGE(PG8_SA(0, 0), a2, voffA);
            PG8_WAIT_V(8); PG8_WAIT_L(0); PG8_BAR; PG8_MMA(1, 0, At, B0); PG8_MMA(1, 1, At, B1); PG8_BAR; PG8_SCHED;
            PG8_LDB(B0, 1, 0); PG8_LDB(B1, 1, 1); PG8_SCHED; PG8_LDA(At, 1, 0); PG8_STAGE(PG8_SA(0, 1), a2 + hstepA, voffA);
            PG8_WAIT_V(8); PG8_WAIT_L(0); PG8_BAR; PG8_MMA(0, 0, At, B0); PG8_MMA(0, 1, At, B1); PG8_BAR; PG8_SCHED;
            PG8_LDA(At, 1, 1); PG8_STAGE(PG8_SB(1, 0), b3, voffB); PG8_STAGE(PG8_SB(1, 1), b3 + hstepB, voffB); PG8_STAGE(PG8_SA(1, 0), a3, voffA);
            PG8_WAIT_V(8); PG8_WAIT_L(0); PG8_BAR; PG8_MMA(1, 0, At, B0); PG8_MMA(1, 1, At, B1); PG8_BAR; PG8_SCHED;
            } else {
            PG8_LDB(B0, 0, 0); PG8_SCHED; PG8_LDA(At, 0, 0); PG8_STAGE(PG8_SA(1, 1), a1 + hstepA, voffA);
            PG8_WAIT_L(8); PG8_BAR; PG8_WAIT_L(0); PG8_MMA(0, 0, At, B0); PG8_BAR; PG8_SCHED;
            PG8_LDB(B1, 0, 1); PG8_STAGE(PG8_SB(0, 0), b2, voffB);
            PG8_BAR; PG8_WAIT_L(0); PG8_MMA(0, 1, At, B1); PG8_BAR;
            PG8_LDA(At, 0, 1); PG8_STAGE(PG8_SA(0, 0), a2, voffA);
            PG8_BAR; PG8_WAIT_L(0); PG8_MMA(1, 0, At, B0); PG8_BAR; PG8_SCHED;
            PG8_STAGE(PG8_SB(0, 1), b2 + hstepB, voffB);
            PG8_WAIT_V(6); PG8_BAR; PG8_MMA(1, 1, At, B1); PG8_BAR;
            PG8_LDB(B0, 1, 0); PG8_SCHED; PG8_LDA(At, 1, 0); PG8_STAGE(PG8_SA(0, 1), a2 + hstepA, voffA);
            PG8_WAIT_L(8); PG8_BAR; PG8_WAIT_L(0); PG8_MMA(0, 0, At, B0); PG8_BAR; PG8_SCHED;
            PG8_LDB(B1, 1, 1); PG8_STAGE(PG8_SB(1, 0), b3, voffB);
            PG8_BAR; PG8_WAIT_L(0); PG8_MMA(0, 1, At, B1); PG8_BAR;
            PG8_LDA(At, 1, 1); PG8_STAGE(PG8_SA(1, 0), a3, voffA);
            PG8_BAR; PG8_WAIT_L(0); PG8_MMA(1, 0, At, B0); PG8_BAR; PG8_SCHED;
            PG8_STAGE(PG8_SB(1, 1), b3 + hstepB, voffB);
            PG8_WAIT_V(6); PG8_BAR; PG8_MMA(1, 1, At, B1); PG8_BAR;
            }
        }
        if constexpr (ALIGN_EPI) { if (wr == 0) PG8_BAR; }
        if constexpr (!Epi::AFTER_DRAIN) { E(acc, cur, wr, wc, fr, fq); S.done(cur); }
        if (!has_next) break;
#pragma unroll
        for (int a = 0; a < 2; ++a)
#pragma unroll
            for (int b = 0; b < 2; ++b)
#pragma unroll
                for (int m = 0; m < 4; ++m)
#pragma unroll
                    for (int n = 0; n < 2; ++n) acc[a][b][m][n] = (f32x4){0.f, 0.f, 0.f, 0.f};
        cur = nxt; cA = nA; cB = nB; ++ui;
        if constexpr (ALIGN_EPI) { if (wr == 1) PG8_BAR; }
    }
    PG8_WAIT_V(0);
    if constexpr (!ALIGN_EPI) { if (wr == 0) PG8_BAR; }
    PG8_BAR;
    if constexpr (Epi::AFTER_DRAIN) { E.fused(acc, cur, wr, wc, fr, fq, lds, wid, lane); S.done(cur); }
#undef PG8_SA
#undef PG8_SB
#undef PG8_STAGE
#undef PG8_LDA
#undef PG8_LDB
#undef PG8_MMA
#undef PG8_WAIT_V
#undef PG8_WAIT_L
#undef PG8_BAR
#undef PG8_SCHED
}
}

typedef const pg8::f32x4 (&AccRef)[2][2][4][2];
struct EpiSwiglu {
    static constexpr bool PERM = true, AFTER_DRAIN = false;
    bf16_t* H;
    DI void operator()(AccRef acc, const pg8::Unit& u, int wr, int wc, int fr, int fq) const {
        const int row0 = u.pm * 256 + wr * 64 + fr, col = u.pn * 128 + wc * 32 + 8 * fq;
#pragma unroll
        for (int ai = 0; ai < 2; ++ai)
#pragma unroll
            for (int m = 0; m < 4; ++m) {
                const int row = row0 + ai * 128 + m * 16; float f[8];
#pragma unroll
                for (int n = 0; n < 2; ++n)
#pragma unroll
                    for (int e = 0; e < 4; ++e) f[n * 4 + e] = siluf_(acc[ai][0][m][n][e]) * acc[ai][1][m][n][e];
                *(u32x4*)(H + (size_t)row * DFF + col) = pack8(f);
            }
    }
};
struct EpiResid {
    static constexpr bool PERM = true, AFTER_DRAIN = false;
    float* xlat; float* xc; const float* gate; float coef;
    DI void operator()(AccRef acc, const pg8::Unit& u, int wr, int wc, int fr, int fq) const {
        const int r0 = u.pm * 256; const int vec = r0 < NLAT ? (r0 >> 13) : 2;
        const float* gp = gate + vec * 9216;
        float* base = r0 < NLAT ? xlat + (size_t)r0 * DM : xc + (size_t)(r0 - NLAT) * DM;
#pragma unroll
        for (int bj = 0; bj < 2; ++bj) {
            const int col = u.pn * 256 + bj * 128 + wc * 32 + 8 * fq;
            const f32x4 g0 = *(const f32x4*)(gp + col) * coef, g1 = *(const f32x4*)(gp + col + 4) * coef;
#pragma unroll
            for (int ai = 0; ai < 2; ++ai)
#pragma unroll
                for (int m = 0; m < 4; ++m) {
                    float* xp = base + (size_t)(wr * 64 + fr + ai * 128 + m * 16) * DM + col;
                    f32x4 x0 = *(f32x4*)xp, x1 = *(f32x4*)(xp + 4);
                    x0 += g0 * acc[ai][bj][m][0]; x1 += g1 * acc[ai][bj][m][1];
                    *(f32x4*)xp = x0; *(f32x4*)(xp + 4) = x1;
                }
        }
    }
};
struct EpiWin {
    static constexpr bool PERM = true, AFTER_DRAIN = false;
    bf16_t* Z;
    DI void operator()(AccRef acc, const pg8::Unit& u, int wr, int wc, int fr, int fq) const {
        const int row0 = u.pm * 256 + wr * 64 + fr;
#pragma unroll
        for (int bj = 0; bj < 2; ++bj) {
            const int col = u.pn * 256 + bj * 128 + wc * 32 + 8 * fq;
            if (col >= ZW) continue;
            const int mode = (col >= ZC_RL && col < ZC_RL + 128) ? 1 : ((col >= ZC_RL + 256 && col < ZC_AQ) ? 2 : 0);
#pragma unroll
            for (int ai = 0; ai < 2; ++ai)
#pragma unroll
                for (int m = 0; m < 4; ++m) {
                    const int row = row0 + ai * 128 + m * 16; float f[8];
#pragma unroll
                    for (int n = 0; n < 2; ++n)
#pragma unroll
                        for (int e = 0; e < 4; ++e) { float v = acc[ai][bj][m][n][e]; if (mode == 1) v = 1.f - 2.f * __builtin_amdgcn_rcpf(1.f + __expf(2.f * v)); else if (mode == 2) v = sigmoidf_(v); f[n * 4 + e] = v; }
                    *(u32x4*)(Z + (size_t)row * ZW + col) = pack8(f);
                }
        }
    }
};
struct EpiLora {
    static constexpr bool PERM = true, AFTER_DRAIN = false;
    bf16_t* RWA; bf16_t* RG; const float* w0; const float* a0;
    DI void operator()(AccRef acc, const pg8::Unit& u, int wr, int wc, int fr, int fq) const {
        const int row0 = u.pm * 256 + wr * 64 + fr;
#pragma unroll
        for (int bj = 0; bj < 2; ++bj) {
            const int col = u.pn * 256 + bj * 128 + wc * 32 + 8 * fq; const int seg = col >> 9, cc = col & 511;
            const float* bp = seg < 2 ? w0 + seg * 512 + cc : a0 + (seg & 1) * 512 + cc;
#pragma unroll
            for (int ai = 0; ai < 2; ++ai)
#pragma unroll
                for (int m = 0; m < 4; ++m) {
                    const int row = row0 + ai * 128 + m * 16; float f[8];
#pragma unroll
                    for (int n = 0; n < 2; ++n)
#pragma unroll
                        for (int e = 0; e < 4; ++e) {
                            float v = acc[ai][bj][m][n][e] + (seg < 4 ? bp[n * 4 + e] : 0.f);
                            if (seg < 2) { const float ee = 0.60653066f * sigmoidf_(v); v = 1.f - __expf(-ee); } else if (seg < 4) v = sigmoidf_(v);
                            f[n * 4 + e] = v;
                        }
                    if (seg < 4) *(u32x4*)(RWA + (size_t)row * 2048 + col) = pack8(f); else *(u32x4*)(RG + (size_t)row * 512 + cc) = pack8(f);
                    __builtin_amdgcn_sched_barrier(0);
                }
        }
    }
};
struct EpiGate {
    static constexpr bool PERM = true, AFTER_DRAIN = false;
    bf16_t* G;
    DI void operator()(AccRef acc, const pg8::Unit& u, int wr, int wc, int fr, int fq) const {
        const int row0 = u.pm * 256 + wr * 64 + fr;
#pragma unroll
        for (int bj = 0; bj < 2; ++bj) {
            const int col = u.pn * 256 + bj * 128 + wc * 32 + 8 * fq;
#pragma unroll
            for (int ai = 0; ai < 2; ++ai)
#pragma unroll
                for (int m = 0; m < 4; ++m) {
                    const int row = row0 + ai * 128 + m * 16; float f[8];
#pragma unroll
                    for (int n = 0; n < 2; ++n)
#pragma unroll
                        for (int e = 0; e < 4; ++e) f[n * 4 + e] = sigmoidf_(acc[ai][bj][m][n][e]);
                    *(u32x4*)(G + (size_t)row * DM + col) = pack8(f);
                }
        }
    }
};
struct EpiBranch {
    static constexpr bool PERM = true, AFTER_DRAIN = false;
    const bf16_t* G; bf16_t* ZZ; int first;
    DI void operator()(AccRef acc, const pg8::Unit& u, int wr, int wc, int fr, int fq) const {
        const int row0 = u.pm * 256 + wr * 64 + fr;
#pragma unroll
        for (int bj = 0; bj < 2; ++bj) {
            const int col = u.pn * 256 + bj * 128 + wc * 32 + 8 * fq;
#pragma unroll
            for (int ai = 0; ai < 2; ++ai)
#pragma unroll
                for (int m = 0; m < 4; ++m) {
                    const size_t off = (size_t)(row0 + ai * 128 + m * 16) * DM + col; float g[8], o[8], f[8];
                    unpack8(*(const u32x4*)(G + off), g);
                    if (first) {
#pragma unroll
                        for (int e = 0; e < 8; ++e) o[e] = 0.f;
                    } else unpack8(*(const u32x4*)(ZZ + off), o);
#pragma unroll
                    for (int n = 0; n < 2; ++n)
#pragma unroll
                        for (int e = 0; e < 4; ++e) f[n * 4 + e] = o[n * 4 + e] + g[n * 4 + e] * acc[ai][bj][m][n][e];
                    *(u32x4*)(ZZ + off) = pack8(f);
                }
        }
    }
};
struct CtxSplitOrder {
    int nun, G, c, kslice_bytes;
    DI void init(int nslices, int ksl_bytes, int G_, int c_) { nun = nslices * 8; G = G_; c = c_; kslice_bytes = ksl_bytes; }
    DI bool next(int i, pg8::Unit& u) const {
        const long L = (long)i * G + c; if (L >= nun) return false;
        const int ks = (int)L >> 3, t = (int)L & 7; u.pm = 64 + (t >> 2); u.pn = t & 3; u.koff = (size_t)ks * kslice_bytes; return true;
    }
    DI void a_ready(const pg8::Unit&) const {}
    DI void done(const pg8::Unit&) const {}
};
struct EpiPartial {
    static constexpr bool PERM = true, AFTER_DRAIN = false;
    float* P; int kslice_bytes;
    DI void operator()(AccRef acc, const pg8::Unit& u, int wr, int wc, int fr, int fq) const {
        const int ks = (int)(u.koff / (size_t)kslice_bytes);
        float* base = P + ((size_t)ks * 512 + (size_t)(u.pm - 64) * 256) * DM;
#pragma unroll
        for (int bj = 0; bj < 2; ++bj) {
            const int col = u.pn * 256 + bj * 128 + wc * 32 + 8 * fq;
#pragma unroll
            for (int ai = 0; ai < 2; ++ai)
#pragma unroll
                for (int m = 0; m < 4; ++m) {
                    float* xp = base + (size_t)(wr * 64 + fr + ai * 128 + m * 16) * DM + col;
                    *(f32x4*)xp = acc[ai][bj][m][0]; *(f32x4*)(xp + 4) = acc[ai][bj][m][1];
                }
        }
    }
};
template <class Epi> DI void run_gemm_ctx(const int wv, unsigned char* smem, const bf16_t* A, int lda, const bf16_t* Bt, int ldb, int nslices, int kslice, const Epi& E) {
    pg8::Gemm g; g.A = A; g.Bt = Bt; g.M = NTOK; g.N = DM; g.K = launder_s(kslice); g.lda = launder_s(lda); g.ldb = launder_s(ldb); g.tid0 = wv * 64 + lane_id_();
    CtxSplitOrder S; S.init(nslices, kslice * 2, (int)gridDim.x, ((int)gridDim.x - 1) - launder_s((int)blockIdx.x));
    pg8::gemm_phase<Epi, CtxSplitOrder, true, true>((PG8_LAS unsigned char*)smem, g, S, E);
    __syncthreads();
}
template <class Epi> DI void run_gemm(const int wv, unsigned char* smem, const bf16_t* A, int lda, const bf16_t* Bt, int M, int N, int K, const Epi& E) {
    pg8::Gemm g; g.A = A; g.Bt = Bt; g.M = M; g.N = N; g.K = launder_s(K); g.lda = launder_s(lda); g.ldb = g.K; g.tid0 = wv * 64 + lane_id_();
    pg8::StaticOrder S; S.init(M, N, (int)gridDim.x, launder_s((int)blockIdx.x));
    pg8::gemm_phase<Epi, pg8::StaticOrder, true, true>((PG8_LAS unsigned char*)smem, g, S, E);
    __syncthreads();
}

struct Prm {
    const float *x, *c, *ctx, *cctx, *w_ada, *b_ada, *norm_g, *f1gu, *f1dn, *f2gu, *f2dn, *w_in, *m_conv, *m_gb, *m_on, *r_conv, *r_w0, *r_w2, *r_a0, *r_a2, *r_g2,
        *r_kk, *r_ka, *r_rk, *r_lnw, *r_lnb, *a_qkn, *a_lam, *a_subln, *w_br, *w_o;
    float* out; unsigned char* ws; int wv, pad;
};
#define PH_IDS const int tid_l = launder_v(p.wv * 64 + lane_id_()); const int bid_l = launder_s((int)blockIdx.x); (void)tid_l; (void)bid_l;
#define TID tid_l
#define BID bid_l
#define NBLK ((int)gridDim.x)

DI void ph_modpart(const Prm& p, unsigned char* smem) { PH_IDS
    float* sc = (float*)smem; float* modp = (float*)(p.ws + WS_MODP);
    for (int it = BID; it < 576; it += NBLK) {
        const int l = it / 288, r = it % 288, ks = r / 18, cb = r % 18;
        __syncthreads();
        if (TID < 192) { const int v = TID >> 6, k = ks * 64 + (TID & 63); const float cv = v < 2 ? p.c[v * DM + k] : p.cctx[k]; sc[TID] = siluf_(cv); }
        __syncthreads();
        const int col = cb * 512 + TID; float a0 = 0.f, a1 = 0.f, a2 = 0.f;
        const float* w = p.w_ada + ((size_t)l * DM + ks * 64) * 9216 + col;
#pragma unroll 8
        for (int k = 0; k < 64; ++k) { const float wv = w[(size_t)k * 9216]; a0 += sc[k] * wv; a1 += sc[64 + k] * wv; a2 += sc[128 + k] * wv; }
        float* o = modp + ((size_t)(l * 16 + ks) * 3) * 9216 + col; o[0] = a0; o[9216] = a1; o[2 * 9216] = a2;
    }
    __syncthreads();
}
DI void ph_rope(const Prm& p) { PH_IDS
    float* rope = (float*)(p.ws + WS_ROPE);
    for (int i = BID * 512 + TID; i < SEQL * 32; i += NBLK * 512) {
        const int t = i >> 5, pp = i & 31, j = pp & 15;
        const float inv = powf(10000.f, -(float)j / 16.f); const float pos = (float)(pp < 16 ? (t >> 6) : (t & 63)); const float ang = pos * inv;
        rope[2 * i] = cosf(ang); rope[2 * i + 1] = sinf(ang);
    }
}
DI void ph_modreduce(const Prm& p) { PH_IDS
    const float* modp = (const float*)(p.ws + WS_MODP); float* mods = (float*)(p.ws + WS_MODS);
    for (int i = BID * 512 + TID; i < 2 * 3 * 9216; i += NBLK * 512) {
        const int l = i / 27648, rem = i % 27648, v = rem / 9216, col = rem % 9216;
        float s = p.b_ada[l * 9216 + col];
        for (int ks = 0; ks < 16; ++ks) s += modp[((size_t)(l * 16 + ks) * 3 + v) * 9216 + col];
        mods[i] = s;
    }
}
template <int MODE> DI void conv_weight(const Prm& p, const float* src, int ld, int c0, int K, int ncols, bf16_t* dst, unsigned char* smem) { PH_IDS
    float* t = (float*)smem; const int ntk = K / 64, ntn = (ncols + 63) / 64, tx = TID & 63, ty = TID >> 6;
    for (int it = BID; it < ntk * ntn; it += NBLK) {
        const int kt = it % ntk, nt = it / ntk;
        __syncthreads();
#pragma unroll
        for (int i = 0; i < 8; ++i) { const int k = ty * 8 + i, j = nt * 64 + tx; t[k * 65 + tx] = j < ncols ? src[(size_t)(kt * 64 + k) * ld + c0 + j] : 0.f; }
        __syncthreads();
#pragma unroll
        for (int i = 0; i < 8; ++i) {
            const int n = ty * 8 + i, j = nt * 64 + n;
            if (j < ncols) {
                int drow = j;
                if (MODE == 1) drow = j < DFF ? ((j >> 7) * 256 + (j & 127)) : (((j - DFF) >> 7) * 256 + 128 + ((j - DFF) & 127));
                dst[(size_t)drow * K + kt * 64 + tx] = f2bf(t[tx * 65 + n]);
            }
        }
    }
    __syncthreads();
}
DI void conv_ffn(const Prm& p, int l, int which, unsigned char* smem) {
    bf16_t* wt = (bf16_t*)(p.ws + WS_WT);
    conv_weight<1>(p, (which ? p.f2gu : p.f1gu) + (size_t)l * DM * 2 * DFF, 2 * DFF, 0, DM, 2 * DFF, wt + WT_GU, smem);
    conv_weight<0>(p, (which ? p.f2dn : p.f1dn) + (size_t)l * DFF * DM, DM, 0, DFF, DM, wt + WT_DN, smem);
}
DI void conv_mixer(const Prm& p, int l, unsigned char* smem) { PH_IDS
    bf16_t* wt = (bf16_t*)(p.ws + WS_WT);
    conv_weight<0>(p, p.w_in + (size_t)l * DM * DIN, DIN, 0, DM, ZW, wt + WT_IN, smem);
    conv_weight<0>(p, p.w_in + (size_t)l * DM * DIN, DIN, ZW, DM, 3 * DM, wt + WT_G, smem);
    for (int b = 0; b < 3; ++b) conv_weight<0>(p, p.w_br + (size_t)(l * 3 + b) * 512 * DM, DM, 0, 512, DM, wt + WT_P + (size_t)b * DM * 512, smem);
    conv_weight<0>(p, p.w_o + (size_t)l * DM * DM, DM, 0, DM, DM, wt + WT_O, smem);
    bf16_t* wl = wt + WT_L;
    for (int i = BID * 512 + TID; i < 2560 * 384; i += NBLK * 512) {
        const int n = i / 384, k = i % 384, seg = n >> 9, cc = n & 511; float v = 0.f;
        if (seg < 2) { if ((k >> 6) == seg) v = p.r_w2[((size_t)(l * 2 + seg) * 64 + (k & 63)) * 512 + cc]; }
        else if (seg < 4) { if ((k >> 6) == seg) v = p.r_a2[((size_t)(l * 2 + seg - 2) * 64 + (k & 63)) * 512 + cc]; }
        else { if (k >= 256) v = p.r_g2[((size_t)l * 128 + (k - 256)) * 512 + cc]; }
        wl[i] = f2bf(v);
    }
}
DI void ph_norm(const Prm& p, int l, int which, bool first, int nfix = 0, const float* fixgate = nullptr, float fixcoef = 0.f) { PH_IDS
    const int lane = TID & 63, wid = TID >> 6;
    const float* g = p.norm_g + (l * 3 + which) * DM; const float* mods = (const float*)(p.ws + WS_MODS) + (size_t)l * 27648;
    bf16_t* hb = (bf16_t*)(p.ws + WS_RWA); float* xc = (float*)(p.ws + WS_XC);
    for (int row = BID * 8 + wid; row < NTOK; row += NBLK * 8) {
        const int vec = row < NLAT ? (row >> 13) : 2;
        const float* sh = mods + vec * 9216 + (3 * which) * DM; const float* scl = sh + DM;
        float* xd = row < NLAT ? p.out + (size_t)row * DM : xc + (size_t)(row - NLAT) * DM;
        const float* xr = first ? (row < NLAT ? p.x + (size_t)row * DM : p.ctx + (size_t)(row - NLAT) * DM) : xd;
        f32x4 xv[4]; float ss = 0.f;
#pragma unroll
        for (int i = 0; i < 4; ++i) xv[i] = *(const f32x4*)(xr + i * 256 + lane * 4);
        if (nfix > 0 && row >= NLAT) {
            const float* P = (const float*)((const bf16_t*)(p.ws + WS_RWA) + (size_t)NTOK * DM) + (size_t)(row - NLAT) * DM;
#pragma unroll
            for (int i = 0; i < 4; ++i) {
                const int col = i * 256 + lane * 4; f32x4 sp = {0.f, 0.f, 0.f, 0.f};
                for (int ks = 0; ks < nfix; ++ks) sp += *(const f32x4*)(P + (size_t)ks * 512 * DM + col);
                xv[i] += *(const f32x4*)(fixgate + 2 * 9216 + col) * fixcoef * sp;
                *(f32x4*)(xd + col) = xv[i];
            }
        }
#pragma unroll
        for (int i = 0; i < 4; ++i) ss += xv[i][0] * xv[i][0] + xv[i][1] * xv[i][1] + xv[i][2] * xv[i][2] + xv[i][3] * xv[i][3];
        ss = wave_sum(ss); const float rinv = rsqrtf(ss * (1.f / DM) + 1e-6f);
#pragma unroll
        for (int i = 0; i < 4; ++i) {
            const int col = i * 256 + lane * 4;
            if (first) *(f32x4*)(xd + col) = xv[i];
            const f32x4 gv = *(const f32x4*)(g + col), sv = *(const f32x4*)(scl + col), hv = *(const f32x4*)(sh + col);
            float h[4];
#pragma unroll
            for (int e = 0; e < 4; ++e) h[e] = xv[i][e] * rinv * gv[e] * (1.f + sv[e]) + hv[e];
            u32x2 o; o.x = pk2(h[0], h[1]); o.y = pk2(h[2], h[3]);
            *(u32x2*)(hb + (size_t)row * DM + col) = o;
        }
    }
}
DI void ph_zero_ysum(const Prm& p) { PH_IDS
    f32x4* y = (f32x4*)(p.ws + WS_YSUM); const f32x4 zr = {0.f, 0.f, 0.f, 0.f};
    for (int i = BID * 512 + TID; i < NTOK * 128; i += NBLK * 512) y[i] = zr;
}
DI void ph_rkv_conv(const Prm& p, int l) { PH_IDS
    const int lane = TID & 63, wid = TID >> 6;
    const bf16_t* z = (const bf16_t*)(p.ws + WS_Z); bf16_t* tmp = (bf16_t*)(p.ws + WS_RWA); float* invn = (float*)(p.ws + WS_INVN);
    const float* cw = p.r_conv + (size_t)l * 3 * 1536;
    for (int row = BID * 8 + wid; row < NTOK; row += NBLK * 8) {
        const int t = row < NLAT ? (row & 8191) : ((row - NLAT) & 255), L = row < NLAT ? SEQL : CTXL;
        const bool hp = t > 0, hn = t < L - 1;
#pragma unroll
        for (int g = 0; g < 3; ++g) {
            const int ch = g * 512 + lane * 8; const bf16_t* zp = z + (size_t)row * ZW + ZC_RR + ch;
            const u32x4 zero = {0u, 0u, 0u, 0u};
            const u32x4 uc = *(const u32x4*)zp, up = hp ? *(const u32x4*)(zp - ZW) : zero, un = hn ? *(const u32x4*)(zp + ZW) : zero;
            float c[8], pv[8], nx[8], o[8]; unpack8(uc, c); unpack8(up, pv); unpack8(un, nx);
#pragma unroll
            for (int e = 0; e < 8; ++e) o[e] = cw[ch + e] * pv[e] + cw[1536 + ch + e] * c[e] + cw[3072 + ch + e] * nx[e];
            *(u32x4*)(tmp + (size_t)row * 1536 + ch) = pack8(o);
            if (g == 1) {
                float ss = 0.f;
#pragma unroll
                for (int e = 0; e < 8; ++e) { const float kk = o[e] * p.r_kk[l * 512 + lane * 8 + e]; ss += kk * kk; }
                ss += __shfl_xor(ss, 1); ss += __shfl_xor(ss, 2); ss += __shfl_xor(ss, 4);
                if ((lane & 7) == 0) invn[(size_t)row * 8 + (lane >> 3)] = 1.f / fmaxf(sqrtf(ss), 1e-12f);
            }
        }
    }
}
DI void ph_rkv_copy(const Prm& p) { PH_IDS
    const int lane = TID & 63, wid = TID >> 6;
    bf16_t* z = (bf16_t*)(p.ws + WS_Z); const bf16_t* tmp = (const bf16_t*)(p.ws + WS_RWA);
    for (int row = BID * 8 + wid; row < NTOK; row += NBLK * 8)
#pragma unroll
        for (int g = 0; g < 3; ++g) { const int ch = g * 512 + lane * 8; *(u32x4*)(z + (size_t)row * ZW + ZC_RR + ch) = *(const u32x4*)(tmp + (size_t)row * 1536 + ch); }
}
DI void ph_attn_prep(const Prm& p, int l) { PH_IDS
    const int lane = TID & 63, wid = TID >> 6, hw = lane >> 5, pp = lane & 31;
    bf16_t* z = (bf16_t*)(p.ws + WS_Z); const float* rope = (const float*)(p.ws + WS_ROPE); const float* qkn = p.a_qkn + l * 128;
    for (int row = BID * 8 + wid; row < NTOK; row += NBLK * 8) {
        const bool islat = row < NLAT; const int t = row & 8191;
        float cs = 1.f, sn = 0.f; if (islat) { cs = rope[((size_t)t * 32 + pp) * 2]; sn = rope[((size_t)t * 32 + pp) * 2 + 1]; }
#pragma unroll
        for (int it = 0; it < 8; ++it) {
            const int seg = it * 2 + hw, which = seg >> 3, col = (which ? ZC_AK : ZC_AQ) + (seg & 7) * 64 + 2 * pp;
            unsigned* zp = (unsigned*)(z + (size_t)row * ZW + col);
            const unsigned u = *zp; const float x1 = lo16(u), x2 = hi16(u);
            float ss = x1 * x1 + x2 * x2;
            ss += __shfl_xor(ss, 1); ss += __shfl_xor(ss, 2); ss += __shfl_xor(ss, 4); ss += __shfl_xor(ss, 8); ss += __shfl_xor(ss, 16);
            const float rinv = rsqrtf(ss * (1.f / 64.f) + 1e-6f) * (which ? 1.f : 0.125f * 1.4426950408889634f);
            const float y1 = x1 * rinv * qkn[which * 64 + 2 * pp], y2 = x2 * rinv * qkn[which * 64 + 2 * pp + 1];
            *zp = pk2(y1 * cs - y2 * sn, y1 * sn + y2 * cs);
        }
    }
}

#define MFMA16(a, b, c) __builtin_amdgcn_mfma_f32_16x16x32_bf16((a), (b), (c), 0, 0, 0)
#define MFMA32(a, b, c) __builtin_amdgcn_mfma_f32_32x32x16_bf16((a), (b), (c), 0, 0, 0)
DI float wave_incl_scan_add(float v, int lane) {
#pragma unroll
    for (int o = 1; o < 64; o <<= 1) { const float t = __shfl_up(v, o); if (lane >= o) v += t; }
    return v;
}
DI float wave_incl_scan_max(float v, int lane) {
#pragma unroll
    for (int o = 1; o < 64; o <<= 1) { const float t = __shfl_up(v, o); if (lane >= o) v = fmaxf(v, t); }
    return v;
}
DI float mconv(const bf16_t* z, const float* cw, size_t row, int t, int L, int ch) {
    const bf16_t* zp = z + row * ZW + ch;
    float a = cw[512 + ch] * bf2f(zp[0]);
    if (t > 0) a += cw[ch] * bf2f(zp[-ZW]);
    if (t < L - 1) a += cw[1024 + ch] * bf2f(zp[ZW]);
    return siluf_(a);
}
DI void ph_mlstm_a(const Prm& p, int l, unsigned char* smem) { PH_IDS
    const int lane = TID & 63, wid = TID >> 6;
    const bf16_t* z = (const bf16_t*)(p.ws + WS_Z); bf16_t* mst = (bf16_t*)(p.ws + WS_MST); float* msc = (float*)(p.ws + WS_MSC); float* mn = (float*)(p.ws + WS_MN);
    const float* cw = p.m_conv + (size_t)l * 3 * 512; const float* gb = p.m_gb + l * 16;
    bf16_t* kT = (bf16_t*)smem; bf16_t* vT = (bf16_t*)(smem + 9216); float* wsl = (float*)(smem + 9216 + 18432);
    for (int u = BID; u < 2112; u += NBLK) {
        const int d = u / 1056, r = u % 1056, b = r / 528, h = (r % 528) / NCHK, c = r % NCHK;
        const int slot = ((d * 2 + b) * 4 + h) * NCHK + c;
        const bool isctx = c < 4; const int cs = isctx ? c : c - 4, nch = isctx ? 4 : 128, oc = d ? nch - 1 - cs : cs, L = isctx ? CTXL : SEQL;
        const size_t base = isctx ? (size_t)NLAT + b * CTXL + oc * 64 : (size_t)b * SEQL + oc * 64;
        __syncthreads();
        if (wid == 0) {
            const int o = d ? 63 - lane : lane; const bf16_t* zr = z + (base + o) * ZW + ZC_MG + 8 * d + h;
            const float ig = bf2f(zr[0]) + gb[(2 * d) * 4 + h], lf = logsigf_(bf2f(zr[4]) + gb[(2 * d + 1) * 4 + h]);
            const float bc = wave_incl_scan_add(lf, lane), bt = __shfl(bc, 63), wl = bt - bc + ig, ml = wave_max(wl);
            wsl[lane] = __expf(wl - ml);
            if (lane == 0) { msc[slot * 4] = bt; msc[slot * 4 + 1] = ml; }
        }
        __syncthreads();
#pragma unroll
        for (int i = 0; i < 8; ++i) {
            const int idx = TID + 512 * i, dq = idx & 63, pp = idx >> 6, o = d ? 63 - pp : pp;
            kT[dq * 72 + pp] = f2bf(mconv(z, cw, base + o, oc * 64 + o, L, 256 + h * 64 + dq) * 0.125f);
        }
#pragma unroll
        for (int i = 0; i < 16; ++i) {
            const int idx = TID + 512 * i, vv = idx & 127, pp = idx >> 7, o = d ? 63 - pp : pp;
            vT[vv * 72 + pp] = f2bf(bf2f(z[(base + o) * ZW + ZC_MV + h * 128 + vv]) * wsl[pp]);
        }
        __syncthreads();
        f32x4 acc[4];
#pragma unroll
        for (int nt = 0; nt < 4; ++nt) acc[nt] = (f32x4){0.f, 0.f, 0.f, 0.f};
#pragma unroll
        for (int ks = 0; ks < 2; ++ks) {
            const bf16x8 a = *(const bf16x8*)(vT + (16 * wid + (lane & 15)) * 72 + ks * 32 + (lane >> 4) * 8);
#pragma unroll
            for (int nt = 0; nt < 4; ++nt) { const bf16x8 bb = *(const bf16x8*)(kT + (16 * nt + (lane & 15)) * 72 + ks * 32 + (lane >> 4) * 8); acc[nt] = MFMA16(a, bb, acc[nt]); }
        }
#pragma unroll
        for (int nt = 0; nt < 4; ++nt)
#pragma unroll
            for (int j = 0; j < 4; ++j) mst[(size_t)slot * 8192 + (16 * wid + (lane >> 4) * 4 + j) * 64 + 16 * nt + (lane & 15)] = f2bf(acc[nt][j]);
        if (TID < 64) { float s = 0.f; for (int pp = 0; pp < 64; ++pp) s += wsl[pp] * bf2f(kT[TID * 72 + pp]); mn[slot * 64 + TID] = s; }
    }
    __syncthreads();
}
DI void ph_mlstm_b(const Prm& p) { PH_IDS
    bf16_t* mst = (bf16_t*)(p.ws + WS_MST); float* msc = (float*)(p.ws + WS_MSC); float* mn = (float*)(p.ws + WS_MN);
    for (int e = BID * 512 + TID; e < 16 * 8256; e += NBLK * 512) {
        const int chain = e / 8256, idx = e % 8256; float m = 0.f, C = 0.f;
        for (int c0 = 0; c0 < NCHK; c0 += 22) {
            float uu[22], bt[22], ml[22];
#pragma unroll
            for (int j = 0; j < 22; ++j) {
                const int slot = chain * NCHK + c0 + j; bt[j] = msc[slot * 4]; ml[j] = msc[slot * 4 + 1];
                uu[j] = idx < 8192 ? bf2f(mst[(size_t)slot * 8192 + idx]) : mn[slot * 64 + idx - 8192];
            }
#pragma unroll
            for (int j = 0; j < 22; ++j) {
                const int slot = chain * NCHK + c0 + j;
                if (idx < 8192) mst[(size_t)slot * 8192 + idx] = f2bf(C); else mn[slot * 64 + idx - 8192] = C;
                if (idx == 0) msc[slot * 4 + 2] = m;
                const float mnew = fmaxf(bt[j] + m, ml[j]);
                C = __expf(bt[j] + m - mnew) * C + __expf(ml[j] - mnew) * uu[j]; m = mnew;
            }
        }
    }
}
DI void ph_mlstm_c(const Prm& p, int l, unsigned char* smem, int ubeg, int ustride, int ucount = 1 << 30) { PH_IDS
    const int lane = TID & 63, wid = TID >> 6;
    bf16_t* z = (bf16_t*)(p.ws + WS_Z); const bf16_t* mst = (const bf16_t*)(p.ws + WS_MST); const float* msc = (const float*)(p.ws + WS_MSC); const float* mn = (const float*)(p.ws + WS_MN);
    const float* cw = p.m_conv + (size_t)l * 3 * 512; const float* gb = p.m_gb + l * 16;
    bf16_t* qs = (bf16_t*)smem; bf16_t* ks_ = (bf16_t*)(smem + 9216); bf16_t* vT = (bf16_t*)(smem + 18432); bf16_t* Sp = (bf16_t*)(smem + 36864);
    float* hsum = (float*)(smem + 46080); float* fa = (float*)(smem + 46080 + 33792);
    float *bcum = fa, *gg = fa + 64, *Mrow = fa + 128, *iw = fa + 192, *den = fa + 256, *nq = fa + 320;
    for (int u = ubeg, un = 0; u < 1056 && un < ucount; u += ustride, ++un) {
        const int b = u / 528, h = (u % 528) / NCHK, cc = u % NCHK;
        const bool isctx = cc < 4; const int oc = isctx ? cc : cc - 4, nch = isctx ? 4 : 128, L = isctx ? CTXL : SEQL;
        const size_t base = isctx ? (size_t)NLAT + b * CTXL + oc * 64 : (size_t)b * SEQL + oc * 64;
        for (int d = 0; d < 2; ++d) {
            const int cs = d ? nch - 1 - oc : oc, c = isctx ? cs : cs + 4, slot = ((d * 2 + b) * 4 + h) * NCHK + c;
            const float mst_m = msc[slot * 4 + 2];
            __syncthreads();
            if (wid == 0) {
                const int o = d ? 63 - lane : lane; const bf16_t* zr = z + (base + o) * ZW + ZC_MG + 8 * d + h;
                const float ig = bf2f(zr[0]) + gb[(2 * d) * 4 + h], lf = logsigf_(bf2f(zr[4]) + gb[(2 * d + 1) * 4 + h]);
                const float bc = wave_incl_scan_add(lf, lane), g = ig - bc, pm = wave_incl_scan_max(g, lane), M = fmaxf(mst_m, pm);
                bcum[lane] = bc; gg[lane] = g; Mrow[lane] = M; iw[lane] = __expf(mst_m - M);
            }
#pragma unroll 2
            for (int i = 0; i < 16; ++i) {
                const int idx = TID + 512 * i, chq = idx & 127, pp = idx >> 7, o = d ? 63 - pp : pp, isk = chq >> 6, dq = chq & 63;
                const float v = mconv(z, cw, base + o, oc * 64 + o, L, isk * 256 + h * 64 + dq);
                if (isk) ks_[pp * 72 + dq] = f2bf(v * 0.125f); else qs[pp * 72 + dq] = f2bf(v);
            }
#pragma unroll 4
            for (int i = 0; i < 16; ++i) {
                const int idx = TID + 512 * i, vv = idx & 127, pp = idx >> 7, o = d ? 63 - pp : pp;
                vT[vv * 72 + pp] = z[(base + o) * ZW + ZC_MV + h * 128 + vv];
            }
            __syncthreads();
            {
                const int mt = wid >> 1;
#pragma unroll
                for (int nn = 0; nn < 2; ++nn) {
                    const int nt = 2 * (wid & 1) + nn; f32x4 acc = {0.f, 0.f, 0.f, 0.f};
#pragma unroll
                    for (int ks = 0; ks < 2; ++ks) {
                        const bf16x8 a = *(const bf16x8*)(qs + (16 * mt + (lane & 15)) * 72 + ks * 32 + (lane >> 4) * 8);
                        const bf16x8 bb = *(const bf16x8*)(ks_ + (16 * nt + (lane & 15)) * 72 + ks * 32 + (lane >> 4) * 8);
                        acc = MFMA16(a, bb, acc);
                    }
                    const int s = 16 * nt + (lane & 15);
#pragma unroll
                    for (int j = 0; j < 4; ++j) { const int pp = 16 * mt + (lane >> 4) * 4 + j; const float v = s <= pp ? acc[j] * __expf(gg[s] - Mrow[pp]) : 0.f; Sp[pp * 72 + s] = f2bf(v); }
                }
                if (TID < 64) { float s = 0.f; for (int dq = 0; dq < 64; ++dq) s += mn[slot * 64 + dq] * bf2f(qs[TID * 72 + dq]); nq[TID] = s; }
            }
            __syncthreads();
            if (TID < 64) { float s = 0.f; for (int k = 0; k < 64; ++k) s += bf2f(Sp[TID * 72 + k]); den[TID] = s + iw[TID] * nq[TID]; }
            f32x4 a1[4], a2[4];
#pragma unroll
            for (int mt = 0; mt < 4; ++mt) { a1[mt] = (f32x4){0.f, 0.f, 0.f, 0.f}; a2[mt] = (f32x4){0.f, 0.f, 0.f, 0.f}; }
#pragma unroll
            for (int ks = 0; ks < 2; ++ks) {
                const bf16x8 bv = *(const bf16x8*)(vT + (16 * wid + (lane & 15)) * 72 + ks * 32 + (lane >> 4) * 8);
                const bf16x8 bc = *(const bf16x8*)(mst + (size_t)slot * 8192 + (16 * wid + (lane & 15)) * 64 + ks * 32 + (lane >> 4) * 8);
#pragma unroll
                for (int mt = 0; mt < 4; ++mt) {
                    const bf16x8 as = *(const bf16x8*)(Sp + (16 * mt + (lane & 15)) * 72 + ks * 32 + (lane >> 4) * 8);
                    const bf16x8 aq = *(const bf16x8*)(qs + (16 * mt + (lane & 15)) * 72 + ks * 32 + (lane >> 4) * 8);
                    a1[mt] = MFMA16(as, bv, a1[mt]); a2[mt] = MFMA16(aq, bc, a2[mt]);
                }
            }
            __syncthreads();
            {
                const int vv = 16 * wid + (lane & 15);
#pragma unroll
                for (int mt = 0; mt < 4; ++mt)
#pragma unroll
                    for (int j = 0; j < 4; ++j) {
                        const int pp = 16 * mt + (lane >> 4) * 4 + j, o = d ? 63 - pp : pp;
                        const float val = (a1[mt][j] + iw[pp] * a2[mt][j]) / fmaxf(fabsf(den[pp]), __expf(-(bcum[pp] + Mrow[pp])));
                        if (d == 0) hsum[o * 132 + vv] = val; else hsum[o * 132 + vv] += val;
                    }
            }
        }
        __syncthreads();
#pragma unroll
        for (int i = 0; i < 8; ++i) {
            const int o = wid * 8 + i; const float x0 = hsum[o * 132 + lane], x1 = hsum[o * 132 + lane + 64];
            const float ss = wave_sum(x0 * x0 + x1 * x1), rinv = rsqrtf(ss * (1.f / 128.f) + 1e-6f);
            bf16_t* zo = z + (base + o) * ZW + ZC_MO + h * 128; const float* on = p.m_on + l * 512 + h * 128;
            zo[lane] = f2bf(x0 * rinv * on[lane] * sigmoidf_(bf2f(zo[lane])));
            zo[lane + 64] = f2bf(x1 * rinv * on[lane + 64] * sigmoidf_(bf2f(zo[lane + 64])));
        }
    }
    __syncthreads();
}
DI int swap23(int s) { return (s & ~12) | ((s & 4) << 1) | ((s & 8) >> 1); }
DI void ph_attn(const Prm& p, int l, unsigned char* smem, int bh, int qfirst, int qstep, int nq, int qextra) { PH_IDS
    const int lane = TID & 63, wid = TID >> 6, q = lane & 31, hh = lane >> 5, qg = wid >> 1, mp = wid & 1, grp = wid >> 2;
    bf16_t* z = (bf16_t*)(p.ws + WS_Z);
    float lam; const float lam_init = 0.8f - 0.6f * expf(-0.3f * (float)l);
    { const float* lp = p.a_lam + l * 256; float s1 = 0.f, s2 = 0.f; for (int i = 0; i < 64; ++i) { s1 += lp[i] * lp[64 + i]; s2 += lp[128 + i] * lp[192 + i]; } lam = expf(s1) - expf(s2) + lam_init; }
    bf16_t* Qs = (bf16_t*)smem; float* ex = (float*)smem;
    constexpr int KB_OFF = 34816, VT_OFF = 69632;
#define ATT_BAR asm volatile("s_waitcnt lgkmcnt(0)\n\ts_barrier" ::: "memory")
    for (int ui = 0; ui < nq + (qextra >= 0 ? 1 : 0); ++ui) {
        const int qi = ui < nq ? qfirst + ui * qstep : qextra;
        const int b = bh >> 2, head = bh & 3; int nt; size_t qrow0;
        const bool lat = qi < 64;
        if (lat) { qrow0 = (size_t)b * SEQL + qi * 128; nt = 132; } else { qrow0 = (size_t)NLAT + b * CTXL + (qi - 64) * 128; nt = 4; }
        __syncthreads();
#pragma unroll
        for (int i = 0; i < 4; ++i) { const int idx = TID + 512 * i, r = idx >> 4, cp = idx & 15; *(u32x4*)(Qs + r * 136 + cp * 8) = *(const u32x4*)(z + (qrow0 + r) * ZW + ZC_AQ + head * 128 + cp * 8); }
        u32x4 kreg[2], vreg[2];
        const int kp = TID & 31, vg = TID >> 5;
#define ATT_KROW0(j) ((lat && (j) >= 4) ? (size_t)b * SEQL + 64 * ((j) - 4) : (size_t)NLAT + b * CTXL + 64 * (j))
#define ATT_LOADK(j) do { const size_t kr0 = ATT_KROW0(j); \
            _Pragma("unroll") for (int i = 0; i < 2; ++i) { const int idx = TID + 512 * i, r = idx >> 4, cp = idx & 15; kreg[i] = *(const u32x4*)(z + (kr0 + r) * ZW + ZC_AK + head * 128 + cp * 8); } } while (0)
#define ATT_LOADV(j) do { const size_t kr0 = ATT_KROW0(j); \
            _Pragma("unroll") for (int i = 0; i < 2; ++i) vreg[i] = *(const u32x4*)(z + (kr0 + 2 * kp + i) * ZW + ZC_AV + head * 128 + 8 * vg); } while (0)
#define ATT_WRITEK(buf) do { bf16_t* Kw = (bf16_t*)(smem + KB_OFF + (buf) * 17408); \
            _Pragma("unroll") for (int i = 0; i < 2; ++i) { const int idx = TID + 512 * i, r = idx >> 4, cp = idx & 15; *(u32x4*)(Kw + r * 136 + cp * 8) = kreg[i]; } } while (0)
#define ATT_WRITEV(buf) do { bf16_t* Vw = (bf16_t*)(smem + VT_OFF + (buf) * 18432); \
            _Pragma("unroll") for (int w = 0; w < 4; ++w) { \
                *(unsigned*)(Vw + (8 * vg + 2 * w) * 72 + 2 * kp) = (vreg[0][w] & 0xffffu) | (vreg[1][w] << 16); \
                *(unsigned*)(Vw + (8 * vg + 2 * w + 1) * 72 + 2 * kp) = (vreg[0][w] >> 16) | (vreg[1][w] & 0xffff0000u); } } while (0)
        f32x16 o[4]; float mrun = -1e30f, lrun = 0.f; bf16x8 pf[4];
#pragma unroll
        for (int dvb = 0; dvb < 4; ++dvb)
#pragma unroll
            for (int i = 0; i < 16; ++i) o[dvb][i] = 0.f;
#define ATT_QK(j) do { const bf16_t* Kb = (const bf16_t*)(smem + KB_OFF + ((j) & 1) * 17408); \
            f32x16 s0, s1; \
            _Pragma("unroll") for (int i = 0; i < 16; ++i) { s0[i] = 0.f; s1[i] = 0.f; } \
            _Pragma("unroll") for (int kk = 0; kk < 4; ++kk) { \
                const bf16x8 qf = *(const bf16x8*)(Qs + (32 * qg + q) * 136 + mp * 64 + kk * 16 + hh * 8); \
                const bf16x8 k0 = *(const bf16x8*)(Kb + swap23(q) * 136 + mp * 64 + kk * 16 + hh * 8); \
                const bf16x8 k1 = *(const bf16x8*)(Kb + (32 + swap23(q)) * 136 + mp * 64 + kk * 16 + hh * 8); \
                s0 = MFMA32(k0, qf, s0); s1 = MFMA32(k1, qf, s1); } \
            float mx = fmaxf(fmaxf(s0[0], s0[1]), fmaxf(s1[0], s1[1])); \
            _Pragma("unroll") for (int i = 2; i < 16; i += 2) mx = fmaxf(mx, fmaxf(fmaxf(s0[i], s0[i + 1]), fmaxf(s1[i], s1[i + 1]))); \
            mx = fmaxf(mx, __shfl_xor(mx, 32)); \
            const float mnew = fmaxf(mrun, mx); \
            if (__any(mnew > mrun)) { const float alpha = __builtin_amdgcn_exp2f(mrun - mnew); lrun *= alpha; \
                _Pragma("unroll") for (int dvb = 0; dvb < 4; ++dvb) _Pragma("unroll") for (int i = 0; i < 16; ++i) o[dvb][i] *= alpha; } \
            mrun = mnew; \
            f32x2 ps = {0.f, 0.f}; \
            _Pragma("unroll") for (int i = 0; i < 16; i += 2) { s0[i] = __builtin_amdgcn_exp2f(s0[i] - mnew); s0[i + 1] = __builtin_amdgcn_exp2f(s0[i + 1] - mnew); s1[i] = __builtin_amdgcn_exp2f(s1[i] - mnew); s1[i + 1] = __builtin_amdgcn_exp2f(s1[i + 1] - mnew); \
                const f32x2 a2 = {s0[i], s0[i + 1]}, b2 = {s1[i], s1[i + 1]}; ps += a2 + b2; } \
            lrun += ps.x + ps.y; \
            _Pragma("unroll") for (int cc = 0; cc < 2; ++cc) { u32x4 a, c2; \
                a.x = pk2(s0[8 * cc], s0[8 * cc + 1]); a.y = pk2(s0[8 * cc + 2], s0[8 * cc + 3]); a.z = pk2(s0[8 * cc + 4], s0[8 * cc + 5]); a.w = pk2(s0[8 * cc + 6], s0[8 * cc + 7]); \
                c2.x = pk2(s1[8 * cc], s1[8 * cc + 1]); c2.y = pk2(s1[8 * cc + 2], s1[8 * cc + 3]); c2.z = pk2(s1[8 * cc + 4], s1[8 * cc + 5]); c2.w = pk2(s1[8 * cc + 6], s1[8 * cc + 7]); \
                pf[cc] = __builtin_bit_cast(bf16x8, a); pf[2 + cc] = __builtin_bit_cast(bf16x8, c2); } } while (0)
#define ATT_PV(j) do { const bf16_t* Vt = (const bf16_t*)(smem + VT_OFF + ((j) & 1) * 18432); \
            _Pragma("unroll") for (int dvb = 0; dvb < 4; ++dvb) _Pragma("unroll") for (int c = 0; c < 4; ++c) { \
                const bf16x8 vf = *(const bf16x8*)(Vt + (dvb * 32 + q) * 72 + 16 * c + 8 * hh); o[dvb] = MFMA32(vf, pf[c], o[dvb]); } } while (0)
        ATT_LOADK(0); ATT_LOADV(0); ATT_WRITEK(0); ATT_WRITEV(0);
        __syncthreads();
        for (int j = 0; j < nt; ++j) {
            if (j + 1 < nt) { ATT_LOADK(j + 1); ATT_LOADV(j + 1); }
            ATT_QK(j); ATT_PV(j);
            if (j + 1 < nt) { ATT_WRITEK((j + 1) & 1); ATT_WRITEV((j + 1) & 1); }
            __syncthreads();
        }
        const float lsum = lrun + __shfl_xor(lrun, 32);
        const float inv = (mp ? lam : 1.f) / lsum;
        if (mp) {
#pragma unroll
            for (int dvb = 0; dvb < 4; ++dvb)
#pragma unroll
                for (int i = 0; i < 16; ++i) ex[(qg * 64 + dvb * 16 + i) * 64 + lane] = o[dvb][i] * inv;
        }
        __syncthreads();
        if (!mp) {
            float ss = 0.f;
#pragma unroll
            for (int dvb = 0; dvb < 4; ++dvb)
#pragma unroll
                for (int i = 0; i < 16; ++i) { const float v = o[dvb][i] * inv - ex[(qg * 64 + dvb * 16 + i) * 64 + lane]; o[dvb][i] = v; ss += v * v; }
            ss += __shfl_xor(ss, 32);
            const float rinv = rsqrtf(ss * (1.f / 128.f) + 1e-6f) * (1.f - lam_init);
            bf16_t* orow = z + (qrow0 + 32 * qg + q) * ZW + ZC_AQ + head * 128; const float* sub = p.a_subln + l * 128;
#pragma unroll
            for (int dvb = 0; dvb < 4; ++dvb)
#pragma unroll
                for (int ig = 0; ig < 4; ++ig) {
                    const int dv0 = dvb * 32 + 8 * ig + 4 * hh; u32x2 w;
                    w.x = pk2(o[dvb][4 * ig] * rinv * sub[dv0], o[dvb][4 * ig + 1] * rinv * sub[dv0 + 1]);
                    w.y = pk2(o[dvb][4 * ig + 2] * rinv * sub[dv0 + 2], o[dvb][4 * ig + 3] * rinv * sub[dv0 + 3]);
                    *(u32x2*)(orow + dv0) = w;
                }
        }
    }
    __syncthreads();
}

__device__ unsigned long long g_pacc[4];
template <int CTRL> DI float dppf(float v) { return __int_as_float(__builtin_amdgcn_update_dpp(0, __float_as_int(v), CTRL, 0xf, 0xf, false)); }
DI float allreduce16(float x) { x += dppf<0x128>(x); x += dppf<0x124>(x); x += dppf<0x122>(x); x += dppf<0x121>(x); return x; }
DI void ph_rwkv_scan(const Prm& p, int l, unsigned char* smem, int ubeg, int ustride) { PH_IDS
    const int lane = TID & 63, wid = TID >> 6;
    const bf16_t* z = (const bf16_t*)(p.ws + WS_Z); const bf16_t* rwa = (const bf16_t*)(p.ws + WS_RWA); const float* invn = (const float*)(p.ws + WS_INVN);
    constexpr int TC = 32, OPW = 336, NC = 264, OPS_B = TC * OPW * 4, YP_OFF = 2 * OPS_B;
    for (int u = ubeg; u < 128; u += ustride) {
        const int chain = u >> 2, qr = u & 3, d = chain >> 4, b = (chain >> 3) & 1, h = chain & 7;
        const float ckk = p.r_kk[l * 512 + h * 64 + lane], cka = p.r_ka[l * 512 + h * 64 + lane];
        bf16_t* ydir = (bf16_t*)(p.ws + WS_YSUM) + (size_t)d * NTOK * 512;
#define RW_ROW(ck, i) ((ck) < 8 ? (size_t)NLAT + b * CTXL + (d ? CTXL - 1 - ((ck) * TC + (i)) : ((ck) * TC + (i))) : (size_t)b * SEQL + (d ? SEQL - 1 - (((ck) - 8) * TC + (i)) : (((ck) - 8) * TC + (i))))
        bf16_t g_r[8], g_k[8], g_u[8], g_a[8]; float g_i[8]; unsigned g_v;
        const int sw = wid - 4, st = TID - 256;
#define RW_LOAD(ck) do { _Pragma("unroll") for (int jj = 0; jj < 8; ++jj) { const size_t row = RW_ROW(ck, sw + 4 * jj); \
            g_r[jj] = z[row * ZW + ZC_RR + h * 64 + lane]; g_k[jj] = z[row * ZW + ZC_RK + h * 64 + lane]; \
            g_u[jj] = rwa[row * 2048 + d * 512 + h * 64 + lane]; g_a[jj] = rwa[row * 2048 + 1024 + d * 512 + h * 64 + lane]; g_i[jj] = invn[row * 8 + h]; } \
            g_v = *(const unsigned*)(z + RW_ROW(ck, st >> 3) * ZW + ZC_RV + h * 64 + qr * 16 + (st & 7) * 2); } while (0)
#define RW_WRITE(buf) do { float* ops = (float*)(smem + (buf) * OPS_B); _Pragma("unroll") for (int jj = 0; jj < 8; ++jj) { \
            const float k = bf2f(g_k[jj]), a = bf2f(g_a[jj]), kk = k * ckk * g_i[jj]; float* o = ops + (sw + 4 * jj) * OPW; \
            o[lane] = 1.f - bf2f(g_u[jj]); o[64 + lane] = kk; o[128 + lane] = kk * a; o[192 + lane] = k * (1.f + (a - 1.f) * cka); o[256 + lane] = bf2f(g_r[jj]); } \
            { float* o = ops + (st >> 3) * OPW + 320 + (st & 7) * 2; o[0] = lo16(g_v); o[1] = hi16(g_v); } } while (0)
        __syncthreads();
        if (wid >= 4) { RW_LOAD(0); RW_WRITE(0); RW_LOAD(1); }
        __syncthreads();
        f32x2 Sa = {0.f, 0.f}, Sb = {0.f, 0.f};
        const int rl = (wid & 3) * 4 + (lane >> 4), ksub = lane & 15;
        float* ypw = (float*)(smem + YP_OFF) + (wid & 3) * (TC * 64);
        for (int ck = 0; ck < NC; ++ck) {
            if (wid >= 4) {
                if (ck + 1 < NC) RW_WRITE((ck + 1) & 1);
                if (ck + 2 < NC) RW_LOAD(ck + 2);
            } else {
                const float* ops = (const float*)(smem + (ck & 1) * OPS_B);
#define RW_GET(X, i) do { const float* o_ = ops + (i) * OPW; w_##X = *(const f32x4*)(o_ + 4 * ksub); k_##X = *(const f32x4*)(o_ + 64 + 4 * ksub); b_##X = *(const f32x4*)(o_ + 128 + 4 * ksub); \
                d_##X = *(const f32x4*)(o_ + 192 + 4 * ksub); r_##X = *(const f32x4*)(o_ + 256 + 4 * ksub); v_##X = o_[320 + rl]; } while (0)
#define RW_STEP(X, i) do { const f32x2 ka = {k_##X[0], k_##X[1]}, kb = {k_##X[2], k_##X[3]}, ra = {r_##X[0], r_##X[1]}, rb = {r_##X[2], r_##X[3]}; \
                const f32x2 ba = {b_##X[0], b_##X[1]}, bb = {b_##X[2], b_##X[3]}, da = {d_##X[0], d_##X[1]}, db = {d_##X[2], d_##X[3]}, wa = {w_##X[0], w_##X[1]}, wb = {w_##X[2], w_##X[3]}; \
                const f32x2 dt2 = Sa * ka + Sb * kb; const f32x2 qa = Sa * wa + da * v_##X, qb = Sb * wb + db * v_##X; const float sa = -allreduce16(dt2.x + dt2.y); \
                Sa = ba * sa + qa; Sb = bb * sa + qb; \
                const f32x2 y2 = Sa * ra + Sb * rb; \
                ypw[(i) * 64 + lane] = y2.x + y2.y; } while (0)
                f32x4 w_A, k_A, b_A, d_A, r_A, w_B, k_B, b_B, d_B, r_B, w_C, k_C, b_C, d_C, r_C, w_D, k_D, b_D, d_D, r_D; float v_A, v_B, v_C, v_D;
                RW_GET(A, 0); RW_GET(B, 1);
#pragma unroll 1
                for (int i = 0; i < TC; i += 4) {
                    RW_GET(C, i + 2);
                    RW_STEP(A, i);
                    RW_GET(D, i + 3);
                    RW_STEP(B, i + 1);
                    if (i + 4 < TC) RW_GET(A, i + 4);
                    RW_STEP(C, i + 2);
                    if (i + 4 < TC) RW_GET(B, i + 5);
                    RW_STEP(D, i + 3);
                }
                {
                    const int i = lane >> 1, rw = (lane & 1) * 2;
                    const f32x4* y4 = (const f32x4*)(ypw + i * 64 + rw * 16);
                    const f32x4 s4 = (y4[0] + y4[1]) + (y4[2] + y4[3]), t4 = (y4[4] + y4[5]) + (y4[6] + y4[7]);
                    *(unsigned*)(ydir + RW_ROW(ck, i) * 512 + h * 64 + qr * 16 + wid * 4 + rw) = pk2((s4[0] + s4[1]) + (s4[2] + s4[3]), (t4[0] + t4[1]) + (t4[2] + t4[3]));
                }
            }
            asm volatile("s_waitcnt lgkmcnt(0)\n\ts_barrier" ::: "memory");
        }
    }
    __syncthreads();
}
DI void ph_rwkv_post(const Prm& p, int l) { PH_IDS
    const int lane = TID & 63, wid = TID >> 6, ch0 = lane * 8;
    bf16_t* z = (bf16_t*)(p.ws + WS_Z); const bf16_t* ysum = (const bf16_t*)(p.ws + WS_YSUM); const bf16_t* rg = (const bf16_t*)(p.ws + WS_RG);
    for (int row = BID * 8 + wid; row < NTOK; row += NBLK * 8) {
        float y[8], y2[8], r[8], k[8], v[8], g[8], o[8];
        unpack8(*(const u32x4*)(ysum + (size_t)row * 512 + ch0), y); unpack8(*(const u32x4*)(ysum + (size_t)(NTOK + row) * 512 + ch0), y2);
#pragma unroll
        for (int e = 0; e < 8; ++e) y[e] += y2[e];
        bf16_t* zr = z + (size_t)row * ZW + ZC_RR + ch0;
        unpack8(*(const u32x4*)zr, r); unpack8(*(const u32x4*)(zr + 512), k); unpack8(*(const u32x4*)(zr + 1024), v); unpack8(*(const u32x4*)(rg + (size_t)row * 512 + ch0), g);
        float s = 0.f, bs = 0.f;
#pragma unroll
        for (int e = 0; e < 8; ++e) { s += y[e]; bs += r[e] * k[e] * p.r_rk[l * 512 + ch0 + e]; }
        s += __shfl_xor(s, 1); s += __shfl_xor(s, 2); s += __shfl_xor(s, 4); bs += __shfl_xor(bs, 1); bs += __shfl_xor(bs, 2); bs += __shfl_xor(bs, 4);
        const float mu = s * (1.f / 64.f); float vs = 0.f;
#pragma unroll
        for (int e = 0; e < 8; ++e) { const float dlt = y[e] - mu; vs += dlt * dlt; }
        vs += __shfl_xor(vs, 1); vs += __shfl_xor(vs, 2); vs += __shfl_xor(vs, 4);
        const float rstd = rsqrtf(vs * (1.f / 64.f) + 64e-5f);
#pragma unroll
        for (int e = 0; e < 8; ++e) o[e] = ((y[e] - mu) * rstd * p.r_lnw[l * 512 + ch0 + e] + p.r_lnb[l * 512 + ch0 + e] + bs * v[e]) * g[e];
        *(u32x4*)zr = pack8(o);
    }
}

#ifndef PROBE_A
#define PROBE_A 0
#endif
#ifndef PROBE_B
#define PROBE_B 0
#endif
#ifndef PROBE_BLK
#define PROBE_BLK 0
#endif
#ifndef PROBE_ADIV
#define PROBE_ADIV 1
#endif
#ifndef PROBE_BDIV
#define PROBE_BDIV 1
#endif
#if PROBE_A || PROBE_B
#define PT(id, ...) do { unsigned long long t0_ = wall_clock64(); __VA_ARGS__; unsigned long long dt_ = wall_clock64() - t0_; if ((id) == PROBE_A) pacc1 += dt_; if ((id) == PROBE_B) pacc2 += dt_; } while (0)
#else
#define PT(id, ...) do { __VA_ARGS__; } while (0)
#endif
DI void grid_bar(unsigned* ctr, unsigned& target, unsigned nblk) {
    __syncthreads();
    if (threadIdx.x == 0) {
        __builtin_amdgcn_fence(__ATOMIC_RELEASE, "agent");
        target += nblk;
        __hip_atomic_fetch_add(ctr, 1u, __ATOMIC_RELAXED, __HIP_MEMORY_SCOPE_AGENT);
        while (__hip_atomic_load(ctr, __ATOMIC_RELAXED, __HIP_MEMORY_SCOPE_AGENT) < target) __builtin_amdgcn_s_sleep(2);
        __builtin_amdgcn_fence(__ATOMIC_ACQUIRE, "agent");
    }
    __syncthreads();
}
__global__ void __launch_bounds__(512) mega(Prm p0) {
    Prm p = p0; p.wv = __builtin_amdgcn_readfirstlane((int)threadIdx.x >> 6);
    const int BIDK = (int)blockIdx.x;
    extern __shared__ __attribute__((aligned(16))) unsigned char smem[];
    cg::grid_group grid = cg::this_grid();
    unsigned bar_target = 0; unsigned* bar_ctr = (unsigned*)(p0.ws + WS_BAR);
#define GSYNC() grid_bar(bar_ctr, bar_target, gridDim.x)
    bf16_t* wt = (bf16_t*)(p.ws + WS_WT); bf16_t* zb = (bf16_t*)(p.ws + WS_Z); bf16_t* hb = (bf16_t*)(p.ws + WS_RWA); bf16_t* gtmp = hb + (size_t)NTOK * DM;
    bf16_t* zz = (bf16_t*)(p.ws + WS_MST); float* xc = (float*)(p.ws + WS_XC); const float* mods = (const float*)(p.ws + WS_MODS);
#if PROBE_A || PROBE_B
    unsigned long long pacc1 = 0, pacc2 = 0; const unsigned long long pstart = wall_clock64();
    if (PROBE_SCAN && blockIdx.x == 0 && threadIdx.x == 0) { g_pacc[0] = 0; g_pacc[1] = 0; }
#endif
    PT(15, ph_modpart(p, smem); ph_rope(p); conv_ffn(p, 0, 0, smem));
    PT(14, grid.sync());
    ph_modreduce(p);
    PT(14, GSYNC());
#define MERGE_B(l, b) do { \
                    { EpiGate E; E.G = gtmp; run_gemm(p.wv, smem, hb, DM, wt + WT_G + (size_t)(b) * DM * DM, (l) == 1 ? NLAT : NTOK, DM, DM, E); } \
                    { EpiBranch E; E.G = gtmp; E.ZZ = zz; E.first = ((b) == 0); const int yc = (b) == 0 ? ZC_MO : ((b) == 1 ? ZC_RR : ZC_AQ); \
                      run_gemm(p.wv, smem, zb + yc, ZW, wt + WT_P + (size_t)(b) * DM * 512, (l) == 1 ? NLAT : NTOK, DM, 512, E); } \
 } while (0)
#define MIXER_STAGE(l) do { const float* ml = mods + (size_t)(l) * 27648; \
                PT(13, ph_norm(p, l, 1, false, 11, ml + 2 * DM, 0.5f); conv_mixer(p, l, smem);); \
                PT(14, GSYNC()); \
                PT(8, { EpiWin E; E.Z = zb; run_gemm(p.wv, smem, hb, DM, wt + WT_IN, NTOK, ZWP, DM, E); }); \
                PT(14, GSYNC()); \
                PT(4, ph_rkv_conv(p, l); ph_attn_prep(p, l)); PT(5, ph_mlstm_a(p, l, smem)); \
                PT(14, GSYNC()); \
                PT(6, ph_rkv_copy(p)); PT(7, ph_mlstm_b(p)); \
                PT(14, GSYNC()); \
                PT(16, { EpiLora E; E.RWA = hb; E.RG = (bf16_t*)(p.ws + WS_RG); E.w0 = p.r_w0 + l * 1024; E.a0 = p.r_a0 + l * 1024; run_gemm(p.wv, smem, zb + ZC_RL, ZW, wt + WT_L, NTOK, 2560, 384, E); }); \
                PT(14, GSYNC()); \
                { int sc_u = BIDK, sc_s = NBLK, bh0 = 0, bh1 = 8, qf = BIDK, qs = NBLK, nq = (66 - BIDK + NBLK - 1) / NBLK, qx = -1, mc_u = BIDK, mc_s = NBLK, mc_c = 1 << 30; \
                  if (NBLK == 256) { const int xi = BIDK >> 3, bh = BIDK & 7; bh0 = bh; bh1 = bh + 1; sc_s = 128; \
                      if (xi < 16) { sc_u = bh * 16 + xi; nq = 0; mc_u = 256 + bh * 16 + xi; mc_s = 128; } \
                      else { const int a = xi - 16; sc_u = 128; qf = a; qs = 16; nq = 4; qx = a < 2 ? 64 + a : -1; mc_u = (bh * 16 + a) * 2; mc_s = 1; mc_c = 2; } } \
                  PT(1, ph_rwkv_scan(p, l, smem, sc_u, sc_s)); \
                  PT(2, for (int bh = bh0; bh < bh1; ++bh) ph_attn(p, l, smem, bh, qf, qs, nq, qx)); \
                  PT(3, ph_mlstm_c(p, l, smem, mc_u, mc_s, mc_c)); } \
                PT(14, GSYNC()); \
                PT(12, ph_rwkv_post(p, l); ph_norm(p, l, 1, false)); \
                PT(14, GSYNC()); \
                PT(9, MERGE_B(l, 0); MERGE_B(l, 1); MERGE_B(l, 2)); \
                PT(14, GSYNC()); \
                PT(17, { EpiResid E; E.xlat = p.out; E.xc = xc; E.gate = ml + 5 * DM; E.coef = 1.f; run_gemm(p.wv, smem, zz, DM, wt + WT_O, NLAT, DM, DM, E); \
              if ((l) == 0) { EpiPartial E2; E2.P = (float*)gtmp; E2.kslice_bytes = 512; run_gemm_ctx(p.wv, smem, zz, DM, wt + WT_O, DM, 4, 256, E2); } }); \
                PT(14, GSYNC()); \
 } while (0)
#define FFN_STAGE(l, f) do { const float* ml = mods + (size_t)(l) * 27648; \
            PT(18, ph_norm(p, l, f == 0 ? 0 : 2, l == 0 && f == 0, (f) == 1 ? ((l) == 0 ? 4 : 0) : ((l) == 1 ? 11 : 0), (f) == 1 ? ml + 5 * DM : mods + 8 * DM, (f) == 1 ? 1.f : 0.5f); \
            if (!(l == 0 && f == 0)) conv_ffn(p, l, f, smem)); \
            PT(14, GSYNC()); \
            PT(10, { EpiSwiglu E; E.H = zb; run_gemm(p.wv, smem, hb, DM, wt + WT_GU, ((l) == 1 && (f) == 1) ? NLAT : NTOK, 2 * DFF, DM, E); }); \
            PT(14, GSYNC()); \
            PT(11, { EpiResid E; E.xlat = p.out; E.xc = xc; E.gate = ml + (f == 0 ? 2 : 8) * DM; E.coef = 0.5f; run_gemm(p.wv, smem, zb, DFF, wt + WT_DN, NLAT, DM, DFF, E); \
              if (!((l) == 1 && (f) == 1)) { EpiPartial E2; E2.P = (float*)gtmp; E2.kslice_bytes = 512; run_gemm_ctx(p.wv, smem, zb, DFF, wt + WT_DN, DFF, 11, 256, E2); } }); \
            PT(14, GSYNC()); \
 } while (0)
    FFN_STAGE(0, 0); MIXER_STAGE(0); FFN_STAGE(0, 1); FFN_STAGE(1, 0); MIXER_STAGE(1); FFN_STAGE(1, 1);
#if PROBE_A || PROBE_B
    if (blockIdx.x == PROBE_BLK) {
        const unsigned long long pend = wall_clock64();
        if (PROBE_SCAN) { __syncthreads(); pacc1 = g_pacc[0]; pacc2 = g_pacc[1]; }
        if (PROBE_A == 99) pacc1 = pend - pstart;
        if (PROBE_B == 99) pacc2 = pend - pstart;
        unsigned long long q1 = pacc1 / (4000ull * PROBE_ADIV), q2 = pacc2 / (4000ull * PROBE_BDIV); if (q1 > 63) q1 = 63; if (q2 > 63) q2 = 63;
        const unsigned long long waitt = (q1 + 64 * q2) * 2000ull;
        while (wall_clock64() - pend < waitt) __builtin_amdgcn_s_sleep(32);
    }
#endif
}

extern "C" void kernel_launch(void* const* d_in, const int* in_sizes, int n_in, void* d_out, int out_size, void* d_ws, size_t ws_size, hipStream_t stream) {
    static int grid_blocks = 0;
    if (!grid_blocks) {
        int dev = 0, cus = 0, per_cu = 0;
        hipGetDevice(&dev);
        hipDeviceGetAttribute(&cus, hipDeviceAttributeMultiprocessorCount, dev);
        hipFuncSetAttribute((const void*)mega, hipFuncAttributeMaxDynamicSharedMemorySize, LDS_BYTES);
        hipOccupancyMaxActiveBlocksPerMultiprocessor(&per_cu, (const void*)mega, 512, LDS_BYTES);
        if (per_cu < 1) per_cu = 1;
        grid_blocks = cus * per_cu;
        if (ws_size < WS_END) fprintf(stderr, "kernel_launch: workspace too small: %zu < %zu\n", ws_size, (size_t)WS_END);
    }
    Prm p{};
    const float** pp = (const float**)&p;
    for (int i = 0; i < 31; ++i) pp[i] = (const float*)d_in[i];
    p.out = (float*)d_out; p.ws = (unsigned char*)d_ws;
    (void)hipMemsetAsync((unsigned char*)d_ws + WS_BAR, 0, 256, stream);
    void* args[] = {&p};
    hipError_t e = hipLaunchCooperativeKernel((const void*)mega, dim3(grid_blocks), dim3(512), args, LDS_BYTES, stream);
    if (e != hipSuccess) fprintf(stderr, "cooperative launch failed: %s (grid %d)\n", hipGetErrorString(e), grid_blocks);
}
```

```cpp
#include <hip/hip_runtime.h>
#include <hip/hip_cooperative_groups.h>
#include <cstdio>
#include <cstdint>
namespace cg = cooperative_groups;
#ifndef PROBE_SCAN
#define PROBE_SCAN 0
#endif

#define LAS __attribute__((address_space(3)))
#define DI __device__ __forceinline__
typedef unsigned short bf16_t;
typedef short bf16x8 __attribute__((ext_vector_type(8)));
typedef float f32x4 __attribute__((ext_vector_type(4)));
typedef float f32x16 __attribute__((ext_vector_type(16)));
typedef float f32x2 __attribute__((ext_vector_type(2)));
typedef unsigned u32x4 __attribute__((ext_vector_type(4)));
typedef unsigned u32x2 __attribute__((ext_vector_type(2)));
typedef __bf16 bf16x2_t __attribute__((ext_vector_type(2)));

constexpr int DM = 1024, NLAT = 16384, NTOK = 16896, SEQL = 8192, CTXL = 256, DFF = 2816, DIN = 8080, ZW = 5008, ZWP = 5120;
constexpr int ZC_MQ = 0, ZC_MK = 256, ZC_MV = 512, ZC_MO = 1024, ZC_MG = 1536, ZC_RR = 1552, ZC_RK = 2064, ZC_RV = 2576, ZC_RL = 3088, ZC_AQ = 3472, ZC_AK = 3984, ZC_AV = 4496;
constexpr int NCHK = 132;
constexpr size_t WS_MODP = 0;
constexpr size_t WS_MODS = WS_MODP + (size_t)2 * 16 * 3 * 9216 * 4;
constexpr size_t WS_ROPE = WS_MODS + (size_t)2 * 3 * 9216 * 4;
constexpr size_t WS_XC   = WS_ROPE + (size_t)8192 * 64 * 4;
constexpr size_t WS_INVN = WS_XC + (size_t)512 * 1024 * 4;
constexpr size_t WS_MSC  = WS_INVN + (size_t)NTOK * 8 * 4;
constexpr size_t WS_MN   = WS_MSC + (size_t)2112 * 4 * 4;
constexpr size_t WS_WT   = WS_MN + (size_t)2112 * 64 * 4;
constexpr size_t WS_Z    = WS_WT + (size_t)25165824;
constexpr size_t WS_RWA  = WS_Z + (size_t)NTOK * ZW * 2;
constexpr size_t WS_RG   = WS_RWA + (size_t)NTOK * 2048 * 2;
constexpr size_t WS_MST  = WS_RG + (size_t)NTOK * 512 * 2;
constexpr size_t WS_YSUM = WS_MST + (size_t)2112 * 8192 * 2;
constexpr size_t WS_BAR  = WS_YSUM + (size_t)NTOK * 512 * 4;
constexpr size_t WS_END  = WS_BAR + 256;
constexpr size_t WT_GU = 0, WT_DN = (size_t)5632 * 1024;
constexpr size_t WT_IN = 0, WT_G = (size_t)5120 * 1024, WT_P = WT_G + (size_t)3072 * 1024, WT_O = WT_P + (size_t)3 * 1024 * 512, WT_L = WT_O + (size_t)1024 * 1024;
constexpr int LDS_BYTES = 155648;

DI float bf2f(bf16_t b) { return __uint_as_float(((unsigned)b) << 16); }
DI unsigned pk2(float lo, float hi) { f32x2 v = {lo, hi}; bf16x2_t b = __builtin_convertvector(v, bf16x2_t); return __builtin_bit_cast(unsigned, b); }
DI bf16_t f2bf(float f) { return (bf16_t)(pk2(f, 0.f) & 0xffffu); }
DI float lo16(unsigned u) { return __uint_as_float(u << 16); }
DI float hi16(unsigned u) { return __uint_as_float(u & 0xffff0000u); }
DI float sigmoidf_(float x) { return __builtin_amdgcn_rcpf(1.f + __expf(-x)); }
DI float siluf_(float x) { return x * __builtin_amdgcn_rcpf(1.f + __expf(-x)); }
DI float logsigf_(float x) { return x < 0.f ? x - log1pf(expf(x)) : -log1pf(expf(-x)); }
DI float wave_sum(float v) {
#pragma unroll
    for (int o = 1; o < 64; o <<= 1) v += __shfl_xor(v, o);
    return v;
}
DI float wave_max(float v) {
#pragma unroll
    for (int o = 1; o < 64; o <<= 1) v = fmaxf(v, __shfl_xor(v, o));
    return v;
}
DI void unpack8(const u32x4 u, float* f) { f[0] = lo16(u.x); f[1] = hi16(u.x); f[2] = lo16(u.y); f[3] = hi16(u.y); f[4] = lo16(u.z); f[5] = hi16(u.z); f[6] = lo16(u.w); f[7] = hi16(u.w); }
DI u32x4 pack8(const float* f) { u32x4 u; u.x = pk2(f[0], f[1]); u.y = pk2(f[2], f[3]); u.z = pk2(f[4], f[5]); u.w = pk2(f[6], f[7]); return u; }
DI int launder_v(int v) { asm volatile("" : "+v"(v)); return v; }
DI int launder_s(int v) { asm volatile("" : "+s"(v)); return v; }
DI int lane_id_() { return (int)__builtin_amdgcn_mbcnt_hi(~0u, __builtin_amdgcn_mbcnt_lo(~0u, 0u)); }
namespace pg8 {
#define PG8_LAS __attribute__((address_space(3)))
typedef unsigned short bf16_t;
typedef short bf16x8 __attribute__((ext_vector_type(8)));
typedef float f32x4 __attribute__((ext_vector_type(4)));
typedef unsigned u32x4 __attribute__((ext_vector_type(4)));
constexpr int BM = 256, BK = 64, HALF = 128, HTB = HALF * BK * 2  , STAGE_BYTES = 8 * HTB, NXCD = 8, WGM = 8;

__host__ __device__ __forceinline__ int lds_byte(int r, int c) { const int st = (r >> 4) * 2 + (c >> 5), rr = r & 15, cc = c & 31, ob = rr * 64 + cc * 2; return st * 1024 + (ob ^ (((ob >> 9) & 1) << 5)); }
__host__ __device__ __forceinline__ void stage_rc(int b, int& R, int& C) { const int st = b / 1024, sb = b % 1024, swz = sb ^ (((sb >> 9) & 1) << 5); R = (st >> 1) * 16 + swz / 64; C = (st & 1) * 32 + (swz % 64) / 2; }
__host__ __device__ __forceinline__ int perm32(int rho) { const int n = rho >> 4, i = rho & 15; return 8 * (i >> 2) + 4 * n + (i & 3); }

struct Unit { int pm, pn; size_t koff; };
struct Gemm { const bf16_t* A; const bf16_t* Bt; int M, N, K, lda, ldb, tid0; };

struct StaticOrder {
    int nM, nN, nwg, G, c;
    __host__ __device__ void init(int M, int N, int G_, int c_) { nM = M / BM; nN = N / BM; nwg = nM * nN; G = G_; c = c_; }
    __host__ __device__ bool next(int i, Unit& u) const {
        const long L = (long)i * G + c; if (L >= nwg) return false;
        int wgid = (int)L; { const int q = nwg / NXCD, r = nwg % NXCD, xcd = wgid % NXCD, off = wgid / NXCD; wgid = (xcd < r ? xcd * (q + 1) : r * (q + 1) + (xcd - r) * q) + off; }
        const int nig = WGM * nN, gid = wgid / nig, fm = gid * WGM, gsz = (nM - fm) < WGM ? (nM - fm) : WGM;
        u.pm = fm + ((wgid % nig) % gsz); u.pn = (wgid % nig) / gsz; u.koff = 0; return true;
    }
    __device__ __forceinline__ void a_ready(const Unit&) const {}
    __device__ __forceinline__ void done(const Unit&) const {}
};


template <class Epi, class Sched, bool ALIGN_EPI = false, bool SP2 = false>
__device__ __forceinline__ void gemm_phase(PG8_LAS unsigned char* lds, const Gemm g, const Sched& S, const Epi& E) {
    int tid = g.tid0; asm volatile("" : "+v"(tid)); const int wid = __builtin_amdgcn_readfirstlane(tid >> 6), lane = tid & 63, wr = wid >> 2, wc = wid & 3, fr = lane & 15, fq = lane >> 4;
    const int K = g.K, nt = K / BK;
    unsigned voffA[2], voffB[2];
#pragma unroll
    for (int i = 0; i < 2; ++i) { int R, C; stage_rc(tid * 16 + i * 8192, R, C); const int Rb = Epi::PERM ? ((R & ~31) + perm32(R & 31)) : R;
        voffA[i] = (unsigned)(R * g.lda + C) * 2u; voffB[i] = (unsigned)(Rb * g.ldb + C) * 2u; }
    const size_t kstep = (size_t)(BK * 2);
    const size_t hstepB = (size_t)HALF * g.ldb * 2, hstepA = (size_t)HALF * g.lda * 2;
    const size_t tstepA = 2 * hstepA, tstepB = 2 * hstepB;
    const unsigned ldsw = (unsigned)wid * 1024u;
    const int aoff = lds_byte(wr * 64 + fr, fq * 8), boff = lds_byte(wc * 32 + fr, fq * 8);
#define PG8_SA(b, h) (((b) * 2 + (h)) * HTB)
#define PG8_SB(b, h) ((4 + (b) * 2 + (h)) * HTB)
#define PG8_STAGE(bufoff, gbase, voff) do { _Pragma("unroll") for (int _i = 0; _i < 2; ++_i) \
        __builtin_amdgcn_global_load_lds((const unsigned*)((const char*)(gbase) + (voff)[_i]), (PG8_LAS unsigned*)(lds + (bufoff) + ldsw + _i * 8192), 16, 0, 0); } while (0)
#define PG8_LDA(dst, b, h) do { _Pragma("unroll") for (int m = 0; m < 4; ++m) _Pragma("unroll") for (int k = 0; k < 2; ++k) dst[m][k] = *(const PG8_LAS bf16x8*)(lds + PG8_SA(b, h) + aoff + m * 2048 + k * 1024); } while (0)
#define PG8_LDB(dst, b, h) do { _Pragma("unroll") for (int n = 0; n < 2; ++n) _Pragma("unroll") for (int k = 0; k < 2; ++k) dst[n][k] = *(const PG8_LAS bf16x8*)(lds + PG8_SB(b, h) + boff + n * 2048 + k * 1024); } while (0)
#define PG8_MMA(ai, bj, At, Bt) do { __builtin_amdgcn_s_setprio(1); _Pragma("unroll") for (int m = 0; m < 4; ++m) _Pragma("unroll") for (int n = 0; n < 2; ++n) _Pragma("unroll") for (int k = 0; k < 2; ++k) \
        acc[ai][bj][m][n] = __builtin_amdgcn_mfma_f32_16x16x32_bf16(Bt[n][k], At[m][k], acc[ai][bj][m][n], 0, 0, 0); __builtin_amdgcn_s_setprio(0); } while (0)
#define PG8_WAIT_V(n) asm volatile("s_waitcnt vmcnt(" #n ")" ::: "memory")
#define PG8_WAIT_L(n) asm volatile("s_waitcnt lgkmcnt(" #n ")" ::: "memory")
#define PG8_BAR __builtin_amdgcn_s_barrier()
#define PG8_SCHED __builtin_amdgcn_sched_barrier(0)
    Unit cur, nxt; int ui = 0;
    if (!S.next(0, cur)) return;
    f32x4 acc[2][2][4][2];
#pragma unroll
    for (int a = 0; a < 2; ++a)
#pragma unroll
        for (int b = 0; b < 2; ++b)
#pragma unroll
            for (int m = 0; m < 4; ++m)
#pragma unroll
                for (int n = 0; n < 2; ++n) acc[a][b][m][n] = (f32x4){0.f, 0.f, 0.f, 0.f};
    bf16x8 At[4][2], B0[2][2], B1[2][2];
    const char* cA = (const char*)g.A + (size_t)cur.pm * tstepA + cur.koff; const char* cB = (const char*)g.Bt + (size_t)cur.pn * tstepB + cur.koff;
    S.a_ready(cur);
    if constexpr (SP2) {
        PG8_STAGE(PG8_SB(0, 0), cB, voffB); PG8_STAGE(PG8_SB(0, 1), cB + hstepB, voffB); PG8_STAGE(PG8_SA(0, 0), cA, voffA); PG8_STAGE(PG8_SA(0, 1), cA + hstepA, voffA);
        if (wr == 1) PG8_BAR;
        PG8_WAIT_V(2); PG8_BAR;
        PG8_STAGE(PG8_SB(1, 0), cB + kstep, voffB); PG8_STAGE(PG8_SA(1, 0), cA + kstep, voffA); PG8_STAGE(PG8_SB(1, 1), cB + hstepB + kstep, voffB);
        PG8_WAIT_V(6); PG8_BAR;
    } else {
        PG8_STAGE(PG8_SB(0, 0), cB, voffB); PG8_STAGE(PG8_SA(0, 0), cA, voffA); PG8_STAGE(PG8_SB(0, 1), cB + hstepB, voffB); PG8_STAGE(PG8_SA(0, 1), cA + hstepA, voffA);
        if (wr == 1) PG8_BAR;
        PG8_WAIT_V(4); PG8_BAR;
        PG8_STAGE(PG8_SB(1, 0), cB + kstep, voffB); PG8_STAGE(PG8_SA(1, 0), cA + kstep, voffA); PG8_STAGE(PG8_SB(1, 1), cB + hstepB + kstep, voffB);
        PG8_WAIT_V(6); PG8_BAR;
    }
    for (;;) {
        const bool has_next = S.next(ui + 1, nxt);
        const char* nA = has_next ? (const char*)g.A + (size_t)nxt.pm * tstepA + nxt.koff : cA; const char* nB = has_next ? (const char*)g.Bt + (size_t)nxt.pn * tstepB + nxt.koff : cB;
        for (int t = 0; t < nt; t += 2) {
            const bool last = (t == nt - 2);
            const char* a1 = cA + (size_t)(t + 1) * kstep;
            const char* a2 = last ? nA : cA + (size_t)(t + 2) * kstep; const char* b2 = last ? nB : cB + (size_t)(t + 2) * kstep;
            const char* a3 = a2 + kstep; const char* b3 = b2 + kstep;
            if (last && has_next) S.a_ready(nxt);
            if constexpr (SP2) {
            PG8_LDB(B0, 0, 0); PG8_LDB(B1, 0, 1); PG8_SCHED; PG8_LDA(At, 0, 0); PG8_STAGE(PG8_SA(1, 1), a1 + hstepA, voffA);
            PG8_WAIT_V(8); PG8_WAIT_L(0); PG8_BAR; PG8_MMA(0, 0, At, B0); PG8_MMA(0, 1, At, B1); PG8_BAR; PG8_SCHED;
            PG8_LDA(At, 0, 1); PG8_STAGE(PG8_SB(0, 0), b2, voffB); PG8_STAGE(PG8_SB(0, 1), b2 + hstepB, voffB); PG8_STAGE(PG8_SA(0, 0), a2, voffA);
            PG8_WAIT_V(8); PG8_WAIT_L(0); PG8_BAR; PG8_MMA(1, 0, At, B0); PG8_MMA(1, 1, At, B1); PG8_BAR; PG8_SCHED;
            PG8_LDB(B0, 1, 0); PG8_LDB(B1, 1, 1); PG8_SCHED; PG8_LDA(At, 1, 0); PG8_STAGE(PG8_SA(0, 1), a2 + hstepA, voffA);
            PG8_WAIT_V(8); PG8_WAIT_L(0); PG8_BAR; PG8_MMA(0, 0, At, B0); PG8_MMA(0, 1, At, B1); PG8_BAR; PG8_SCHED;
            PG8_LDA(At, 1, 1); PG8_STAGE(PG8_SB(1, 0), b3, voffB); PG8_STAGE(PG8_SB(1, 1), b3 + hstepB, voffB); PG8_STAGE(PG8_SA(1, 0), a3, voffA);
            PG8_WAIT_V(8); PG8_WAIT_L(0); PG8_BAR; PG8_MMA(1, 0, At, B0); PG8_MMA(1, 1, At, B1); PG8_BAR; PG8_SCHED;
            } else {
            PG8_LDB(B0, 0, 0); PG8_SCHED; PG8_LDA(At, 0, 0); PG8_STAGE(PG8_SA(1, 1), a1 + hstepA, voffA);
            PG8_WAIT_L(8); PG8_BAR; PG8_WAIT_L(0); PG8_MMA(0, 0, At, B0); PG8_BAR; PG8_SCHED;
            PG8_LDB(B1, 0, 1); PG8_STAGE(PG8_SB(0, 0), b2, voffB);
            PG8_BAR; PG8_WAIT_L(0); PG8_MMA(0, 1, At, B1); PG8_BAR;
            PG8_LDA(At, 0, 1); PG8_STAGE(PG8_SA(0, 0), a2, voffA);
            PG8_BAR; PG8_WAIT_L(0); PG8_MMA(1, 0, At, B0); PG8_BAR; PG8_SCHED;
            PG8_STAGE(PG8_SB(0, 1), b2 + hstepB, voffB);
            PG8_WAIT_V(6); PG8_BAR; PG8_MMA(1, 1, At, B1); PG8_BAR;
            PG8_LDB(B0, 1, 0); PG8_SCHED; PG8_LDA(At, 1, 0); PG8_STAGE(PG8_SA(0, 1), a2 + hstepA, voffA);
            PG8_WAIT_L(8); PG8_BAR; PG8_WAIT_L(0); PG8_MMA(0, 0, At, B0); PG8_BAR; PG8_SCHED;
            PG8_LDB(B1, 1, 1); PG8_STAGE(PG8_SB(1, 0), b3, voffB);
            PG8_BAR; PG8_WAIT_L(0); PG8_MMA(0, 1, At, B1); PG8_BAR;
            PG8_LDA(At, 1, 1); PG8_STAGE(PG8_SA(1, 0), a3, voffA);
            PG8_BAR; PG8_WAIT_L(0); PG8_MMA(1, 0, At, B0); PG8_BAR; PG8_SCHED;
            PG8_STAGE(PG8_SB(1, 1), b3 + hstepB, voffB);
            PG8_WAIT_V(6); PG8_BAR; PG8_MMA(1, 1, At, B1); PG8_BAR;
            }
        }
        if constexpr (ALIGN_EPI) { if (wr == 0) PG8_BAR; }
        if constexpr (!Epi::AFTER_DRAIN) { E(acc, cur, wr, wc, fr, fq); S.done(cur); }
        if (!has_next) break;
#pragma unroll
        for (int a = 0; a < 2; ++a)
#pragma unroll
            for (int b = 0; b < 2; ++b)
#pragma unroll
                for (int m = 0; m < 4; ++m)
#pragma unroll
                    for (int n = 0; n < 2; ++n) acc[a][b][m][n] = (f32x4){0.f, 0.f, 0.f, 0.f};
        cur = nxt; cA = nA; cB = nB; ++ui;
        if constexpr (ALIGN_EPI) { if (wr == 1) PG8_BAR; }
    }
    PG8_WAIT_V(0);
    if constexpr (!ALIGN_EPI) { if (wr == 0) PG8_BAR; }
    PG8_BAR;
    if constexpr (Epi::AFTER_DRAIN) { E.fused(acc, cur, wr, wc, fr, fq, lds, wid, lane); S.done(cur); }
#undef PG8_SA
#undef PG8_SB
#undef PG8_STAGE
#undef PG8_LDA
#undef PG8_LDB
#undef PG8_MMA
#undef PG8_WAIT_V
#undef PG8_WAIT_L
#undef PG8_BAR
#undef PG8_SCHED
}
}

typedef const pg8::f32x4 (&AccRef)[2][2][4][2];
struct EpiSwiglu {
    static constexpr bool PERM = true, AFTER_DRAIN = false;
    bf16_t* H;
    DI void operator()(AccRef acc, const pg8::Unit& u, int wr, int wc, int fr, int fq) const {
        const int row0 = u.pm * 256 + wr * 64 + fr, col = u.pn * 128 + wc * 32 + 8 * fq;
#pragma unroll
        for (int ai = 0; ai < 2; ++ai)
#pragma unroll
            for (int m = 0; m < 4; ++m) {
                const int row = row0 + ai * 128 + m * 16; float f[8];
#pragma unroll
                for (int n = 0; n < 2; ++n)
#pragma unroll
                    for (int e = 0; e < 4; ++e) f[n * 4 + e] = siluf_(acc[ai][0][m][n][e]) * acc[ai][1][m][n][e];
                *(u32x4*)(H + (size_t)row * DFF + col) = pack8(f);
            }
    }
};
struct EpiResid {
    static constexpr bool PERM = true, AFTER_DRAIN = false;
    float* xlat; float* xc; const float* gate; float coef;
    DI void operator()(AccRef acc, const pg8::Unit& u, int wr, int wc, int fr, int fq) const {
        const int r0 = u.pm * 256; const int vec = r0 < NLAT ? (r0 >> 13) : 2;
        const float* gp = gate + vec * 9216;
        float* base = r0 < NLAT ? xlat + (size_t)r0 * DM : xc + (size_t)(r0 - NLAT) * DM;
#pragma unroll
        for (int bj = 0; bj < 2; ++bj) {
            const int col = u.pn * 256 + bj * 128 + wc * 32 + 8 * fq;
            const f32x4 g0 = *(const f32x4*)(gp + col) * coef, g1 = *(const f32x4*)(gp + col + 4) * coef;
#pragma unroll
            for (int ai = 0; ai < 2; ++ai)
#pragma unroll
                for (int m = 0; m < 4; ++m) {
                    float* xp = base + (size_t)(wr * 64 + fr + ai * 128 + m * 16) * DM + col;
                    f32x4 x0 = *(f32x4*)xp, x1 = *(f32x4*)(xp + 4);
                    x0 += g0 * acc[ai][bj][m][0]; x1 += g1 * acc[ai][bj][m][1];
                    *(f32x4*)xp = x0; *(f32x4*)(xp + 4) = x1;
                }
        }
    }
};
struct EpiWin {
    static constexpr bool PERM = true, AFTER_DRAIN = false;
    bf16_t* Z;
    DI void operator()(AccRef acc, const pg8::Unit& u, int wr, int wc, int fr, int fq) const {
        const int row0 = u.pm * 256 + wr * 64 + fr;
#pragma unroll
        for (int bj = 0; bj < 2; ++bj) {
            const int col = u.pn * 256 + bj * 128 + wc * 32 + 8 * fq;
            if (col >= ZW) continue;
            const int mode = (col >= ZC_RL && col < ZC_RL + 128) ? 1 : ((col >= ZC_RL + 256 && col < ZC_AQ) ? 2 : 0);
#pragma unroll
            for (int ai = 0; ai < 2; ++ai)
#pragma unroll
                for (int m = 0; m < 4; ++m) {
                    const int row = row0 + ai * 128 + m * 16; float f[8];
#pragma unroll
                    for (int n = 0; n < 2; ++n)
#pragma unroll
                        for (int e = 0; e < 4; ++e) { float v = acc[ai][bj][m][n][e]; if (mode == 1) v = 1.f - 2.f * __builtin_amdgcn_rcpf(1.f + __expf(2.f * v)); else if (mode == 2) v = sigmoidf_(v); f[n * 4 + e] = v; }
                    *(u32x4*)(Z + (size_t)row * ZW + col) = pack8(f);
                }
        }
    }
};
struct EpiLora {
    static constexpr bool PERM = true, AFTER_DRAIN = false;
    bf16_t* RWA; bf16_t* RG; const float* w0; const float* a0;
    DI void operator()(AccRef acc, const pg8::Unit& u, int wr, int wc, int fr, int fq) const {
        const int row0 = u.pm * 256 + wr * 64 + fr;
#pragma unroll
        for (int bj = 0; bj < 2; ++bj) {
            const int col = u.pn * 256 + bj * 128 + wc * 32 + 8 * fq; const int seg = col >> 9, cc = col & 511;
            const float* bp = seg < 2 ? w0 + seg * 512 + cc : a0 + (seg & 1) * 512 + cc;
#pragma unroll
            for (int ai = 0; ai < 2; ++ai)
#pragma unroll
                for (int m = 0; m < 4; ++m) {
                    const int row = row0 + ai * 128 + m * 16; float f[8];
#pragma unroll
                    for (int n = 0; n < 2; ++n)
#pragma unroll
                        for (int e = 0; e < 4; ++e) {
                            float v = acc[ai][bj][m][n][e] + (seg < 4 ? bp[n * 4 + e] : 0.f);
                            if (seg < 2) { const float ee = 0.60653066f * sigmoidf_(v); v = 1.f - __expf(-ee); } else if (seg < 4) v = sigmoidf_(v);
                            f[n * 4 + e] = v;
                        }
                    if (seg < 4) *(u32x4*)(RWA + (size_t)row * 2048 + col) = pack8(f); else *(u32x4*)(RG + (size_t)row * 512 + cc) = pack8(f);
                    __builtin_amdgcn_sched_barrier(0);
                }
        }
    }
};
struct EpiGate {
    static constexpr bool PERM = true, AFTER_DRAIN = false;
    bf16_t* G;
    DI void operator()(AccRef acc, const pg8::Unit& u, int wr, int wc, int fr, int fq) const {
        const int row0 = u.pm * 256 + wr * 64 + fr;
#pragma unroll
        for (int bj = 0; bj < 2; ++bj) {
            const int col = u.pn * 256 + bj * 128 + wc * 32 + 8 * fq;
#pragma unroll
            for (int ai = 0; ai < 2; ++ai)
#pragma unroll
                for (int m = 0; m < 4; ++m) {
                    const int row = row0 + ai * 128 + m * 16; float f[8];
#pragma unroll
                    for (int n = 0; n < 2; ++n)
#pragma unroll
                        for (int e = 0; e < 4; ++e) f[n * 4 + e] = sigmoidf_(acc[ai][bj][m][n][e]);
                    *(u32x4*)(G + (size_t)row * DM + col) = pack8(f);
                }
        }
    }
};
struct EpiBranch {
    static constexpr bool PERM = true, AFTER_DRAIN = false;
    const bf16_t* G; bf16_t* ZZ; int first;
    DI void operator()(AccRef acc, const pg8::Unit& u, int wr, int wc, int fr, int fq) const {
        const int row0 = u.pm * 256 + wr * 64 + fr;
#pragma unroll
        for (int bj = 0; bj < 2; ++bj) {
            const int col = u.pn * 256 + bj * 128 + wc * 32 + 8 * fq;
#pragma unroll
            for (int ai = 0; ai < 2; ++ai)
#pragma unroll
                for (int m = 0; m < 4; ++m) {
                    const size_t off = (size_t)(row0 + ai * 128 + m * 16) * DM + col; float g[8], o[8], f[8];
                    unpack8(*(const u32x4*)(G + off), g);
                    if (first) {
#pragma unroll
                        for (int e = 0; e < 8; ++e) o[e] = 0.f;
                    } else unpack8(*(const u32x4*)(ZZ + off), o);
#pragma unroll
                    for (int n = 0; n < 2; ++n)
#pragma unroll
                        for (int e = 0; e < 4; ++e) f[n * 4 + e] = o[n * 4 + e] + g[n * 4 + e] * acc[ai][bj][m][n][e];
                    *(u32x4*)(ZZ + off) = pack8(f);
                }
        }
    }
};
struct CtxSplitOrder {
    int nun, G, c, kslice_bytes;
    DI void init(int nslices, int ksl_bytes, int G_, int c_) { nun = nslices * 8; G = G_; c = c_; kslice_bytes = ksl_bytes; }
    DI bool next(int i, pg8::Unit& u) const {
        const long L = (long)i * G + c; if (L >= nun) return false;
        const int ks = (int)L >> 3, t = (int)L & 7; u.pm = 64 + (t >> 2); u.pn = t & 3; u.koff = (size_t)ks * kslice_bytes; return true;
    }
    DI void a_ready(const pg8::Unit&) const {}
    DI void done(const pg8::Unit&) const {}
};
struct EpiPartial {
    static constexpr bool PERM = true, AFTER_DRAIN = false;
    float* P; int kslice_bytes;
    DI void operator()(AccRef acc, const pg8::Unit& u, int wr, int wc, int fr, int fq) const {
        const int ks = (int)(u.koff / (size_t)kslice_bytes);
        float* base = P + ((size_t)ks * 512 + (size_t)(u.pm - 64) * 256) * DM;
#pragma unroll
        for (int bj = 0; bj < 2; ++bj) {
            const int col = u.pn * 256 + bj * 128 + wc * 32 + 8 * fq;
#pragma unroll
            for (int ai = 0; ai < 2; ++ai)
#pragma unroll
                for (int m = 0; m < 4; ++m) {
                    float* xp = base + (size_t)(wr * 64 + fr + ai * 128 + m * 16) * DM + col;
                    *(f32x4*)xp = acc[ai][bj][m][0]; *(f32x4*)(xp + 4) = acc[ai][bj][m][1];
                }
        }
    }
};
template <class Epi> DI void run_gemm_ctx(const int wv, unsigned char* smem, const bf16_t* A, int lda, const bf16_t* Bt, int ldb, int nslices, int kslice, const Epi& E) {
    pg8::Gemm g; g.A = A; g.Bt = Bt; g.M = NTOK; g.N = DM; g.K = launder_s(kslice); g.lda = launder_s(lda); g.ldb = launder_s(ldb); g.tid0 = wv * 64 + lane_id_();
    CtxSplitOrder S; S.init(nslices, kslice * 2, (int)gridDim.x, ((int)gridDim.x - 1) - launder_s((int)blockIdx.x));
    pg8::gemm_phase<Epi, CtxSplitOrder, true, true>((PG8_LAS unsigned char*)smem, g, S, E);
    __syncthreads();
}
template <class Epi> DI void run_gemm(const int wv, unsigned char* smem, const bf16_t* A, int lda, const bf16_t* Bt, int M, int N, int K, const Epi& E) {
    pg8::Gemm g; g.A = A; g.Bt = Bt; g.M = M; g.N = N; g.K = launder_s(K); g.lda = launder_s(lda); g.ldb = g.K; g.tid0 = wv * 64 + lane_id_();
    pg8::StaticOrder S; S.init(M, N, (int)gridDim.x, launder_s((int)blockIdx.x));
    pg8::gemm_phase<Epi, pg8::StaticOrder, true, true>((PG8_LAS unsigned char*)smem, g, S, E);
    __syncthreads();
}

struct Prm {
    const float *x, *c, *ctx, *cctx, *w_ada, *b_ada, *norm_g, *f1gu, *f1dn, *f2gu, *f2dn, *w_in, *m_conv, *m_gb, *m_on, *r_conv, *r_w0, *r_w2, *r_a0, *r_a2, *r_g2,
        *r_kk, *r_ka, *r_rk, *r_lnw, *r_lnb, *a_qkn, *a_lam, *a_subln, *w_br, *w_o;
    float* out; unsigned char* ws; int wv, pad;
};
#define PH_IDS const int tid_l = launder_v(p.wv * 64 + lane_id_()); const int bid_l = launder_s((int)blockIdx.x); (void)tid_l; (void)bid_l;
#define TID tid_l
#define BID bid_l
#define NBLK ((int)gridDim.x)

DI void ph_modpart(const Prm& p, unsigned char* smem) { PH_IDS
    float* sc = (float*)smem; float* modp = (float*)(p.ws + WS_MODP);
    for (int it = BID; it < 576; it += NBLK) {
        const int l = it / 288, r = it % 288, ks = r / 18, cb = r % 18;
        __syncthreads();
        if (TID < 192) { const int v = TID >> 6, k = ks * 64 + (TID & 63); const float cv = v < 2 ? p.c[v * DM + k] : p.cctx[k]; sc[TID] = siluf_(cv); }
        __syncthreads();
        const int col = cb * 512 + TID; float a0 = 0.f, a1 = 0.f, a2 = 0.f;
        const float* w = p.w_ada + ((size_t)l * DM + ks * 64) * 9216 + col;
#pragma unroll 8
        for (int k = 0; k < 64; ++k) { const float wv = w[(size_t)k * 9216]; a0 += sc[k] * wv; a1 += sc[64 + k] * wv; a2 += sc[128 + k] * wv; }
        float* o = modp + ((size_t)(l * 16 + ks) * 3) * 9216 + col; o[0] = a0; o[9216] = a1; o[2 * 9216] = a2;
    }
    __syncthreads();
}
DI void ph_rope(const Prm& p) { PH_IDS
    float* rope = (float*)(p.ws + WS_ROPE);
    for (int i = BID * 512 + TID; i < SEQL * 32; i += NBLK * 512) {
        const int t = i >> 5, pp = i & 31, j = pp & 15;
        const float inv = powf(10000.f, -(float)j / 16.f); const float pos = (float)(pp < 16 ? (t >> 6) : (t & 63)); const float ang = pos * inv;
        rope[2 * i] = cosf(ang); rope[2 * i + 1] = sinf(ang);
    }
}
DI void ph_modreduce(const Prm& p) { PH_IDS
    const float* modp = (const float*)(p.ws + WS_MODP); float* mods = (float*)(p.ws + WS_MODS);
    for (int i = BID * 512 + TID; i < 2 * 3 * 9216; i += NBLK * 512) {
        const int l = i / 27648, rem = i % 27648, v = rem / 9216, col = rem % 9216;
        float s = p.b_ada[l * 9216 + col];
        for (int ks = 0; ks < 16; ++ks) s += modp[((size_t)(l * 16 + ks) * 3 + v) * 9216 + col];
        mods[i] = s;
    }
}
template <int MODE> DI void conv_weight(const Prm& p, const float* src, int ld, int c0, int K, int ncols, bf16_t* dst, unsigned char* smem) { PH_IDS
    float* t = (float*)smem; const int ntk = K / 64, ntn = (ncols + 63) / 64, tx = TID & 63, ty = TID >> 6;
    for (int it = BID; it < ntk * ntn; it += NBLK) {
        const int kt = it % ntk, nt = it / ntk;
        __syncthreads();
#pragma unroll
        for (int i = 0; i < 8; ++i) { const int k = ty * 8 + i, j = nt * 64 + tx; t[k * 65 + tx] = j < ncols ? src[(size_t)(kt * 64 + k) * ld + c0 + j] : 0.f; }
        __syncthreads();
#pragma unroll
        for (int i = 0; i < 8; ++i) {
            const int n = ty * 8 + i, j = nt * 64 + n;
            if (j < ncols) {
                int drow = j;
                if (MODE == 1) drow = j < DFF ? ((j >> 7) * 256 + (j & 127)) : (((j - DFF) >> 7) * 256 + 128 + ((j - DFF) & 127));
                dst[(size_t)drow * K + kt * 64 + tx] = f2bf(t[tx * 65 + n]);
            }
        }
    }
    __syncthreads();
}
DI void conv_ffn(const Prm& p, int l, int which, unsigned char* smem) {
    bf16_t* wt = (bf16_t*)(p.ws + WS_WT);
    conv_weight<1>(p, (which ? p.f2gu : p.f1gu) + (size_t)l * DM * 2 * DFF, 2 * DFF, 0, DM, 2 * DFF, wt + WT_GU, smem);
    conv_weight<0>(p, (which ? p.f2dn : p.f1dn) + (size_t)l * DFF * DM, DM, 0, DFF, DM, wt + WT_DN, smem);
}
DI void conv_mixer(const Prm& p, int l, unsigned char* smem) { PH_IDS
    bf16_t* wt = (bf16_t*)(p.ws + WS_WT);
    conv_weight<0>(p, p.w_in + (size_t)l * DM * DIN, DIN, 0, DM, ZW, wt + WT_IN, smem);
    conv_weight<0>(p, p.w_in + (size_t)l * DM * DIN, DIN, ZW, DM, 3 * DM, wt + WT_G, smem);
    for (int b = 0; b < 3; ++b) conv_weight<0>(p, p.w_br + (size_t)(l * 3 + b) * 512 * DM, DM, 0, 512, DM, wt + WT_P + (size_t)b * DM * 512, smem);
    conv_weight<0>(p, p.w_o + (size_t)l * DM * DM, DM, 0, DM, DM, wt + WT_O, smem);
    bf16_t* wl = wt + WT_L;
    for (int i = BID * 512 + TID; i < 2560 * 384; i += NBLK * 512) {
        const int n = i / 384, k = i % 384, seg = n >> 9, cc = n & 511; float v = 0.f;
        if (seg < 2) { if ((k >> 6) == seg) v = p.r_w2[((size_t)(l * 2 + seg) * 64 + (k & 63)) * 512 + cc]; }
        else if (seg < 4) { if ((k >> 6) == seg) v = p.r_a2[((size_t)(l * 2 + seg - 2) * 64 + (k & 63)) * 512 + cc]; }
        else { if (k >= 256) v = p.r_g2[((size_t)l * 128 + (k - 256)) * 512 + cc]; }
        wl[i] = f2bf(v);
    }
}
DI void ph_norm(const Prm& p, int l, int which, bool first, int nfix = 0, const float* fixgate = nullptr, float fixcoef = 0.f) { PH_IDS
    const int lane = TID & 63, wid = TID >> 6;
    const float* g = p.norm_g + (l * 3 + which) * DM; const float* mods = (const float*)(p.ws + WS_MODS) + (size_t)l * 27648;
    bf16_t* hb = (bf16_t*)(p.ws + WS_RWA); float* xc = (float*)(p.ws + WS_XC);
    for (int row = BID * 8 + wid; row < NTOK; row += NBLK * 8) {
        const int vec = row < NLAT ? (row >> 13) : 2;
        const float* sh = mods + vec * 9216 + (3 * which) * DM; const float* scl = sh + DM;
        float* xd = row < NLAT ? p.out + (size_t)row * DM : xc + (size_t)(row - NLAT) * DM;
        const float* xr = first ? (row < NLAT ? p.x + (size_t)row * DM : p.ctx + (size_t)(row - NLAT) * DM) : xd;
        f32x4 xv[4]; float ss = 0.f;
#pragma unroll
        for (int i = 0; i < 4; ++i) xv[i] = *(const f32x4*)(xr + i * 256 + lane * 4);
        if (nfix > 0 && row >= NLAT) {
            const float* P = (const float*)((const bf16_t*)(p.ws + WS_RWA) + (size_t)NTOK * DM) + (size_t)(row - NLAT) * DM;
#pragma unroll
            for (int i = 0; i < 4; ++i) {
                const int col = i * 256 + lane * 4; f32x4 sp = {0.f, 0.f, 0.f, 0.f};
                for (int ks = 0; ks < nfix; ++ks) sp += *(const f32x4*)(P + (size_t)ks * 512 * DM + col);
                xv[i] += *(const f32x4*)(fixgate + 2 * 9216 + col) * fixcoef * sp;
                *(f32x4*)(xd + col) = xv[i];
            }
        }
#pragma unroll
        for (int i = 0; i < 4; ++i) ss += xv[i][0] * xv[i][0] + xv[i][1] * xv[i][1] + xv[i][2] * xv[i][2] + xv[i][3] * xv[i][3];
        ss = wave_sum(ss); const float rinv = rsqrtf(ss * (1.f / DM) + 1e-6f);
#pragma unroll
        for (int i = 0; i < 4; ++i) {
            const int col = i * 256 + lane * 4;
            if (first) *(f32x4*)(xd + col) = xv[i];
            const f32x4 gv = *(const f32x4*)(g + col), sv = *(const f32x4*)(scl + col), hv = *(const f32x4*)(sh + col);
            float h[4];
#pragma unroll
            for (int e = 0; e < 4; ++e) h[e] = xv[i][e] * rinv * gv[e] * (1.f + sv[e]) + hv[e];
            u32x2 o; o.x = pk2(h[0], h[1]); o.y = pk2(h[2], h[3]);
            *(u32x2*)(hb + (size_t)row * DM + col) = o;
        }
    }
}
DI void ph_zero_ysum(const Prm& p) { PH_IDS
    f32x4* y = (f32x4*)(p.ws + WS_YSUM); const f32x4 zr = {0.f, 0.f, 0.f, 0.f};
    for (int i = BID * 512 + TID; i < NTOK * 128; i += NBLK * 512) y[i] = zr;
}
DI void ph_rkv_conv(const Prm& p, int l) { PH_IDS
    const int lane = TID & 63, wid = TID >> 6;
    const bf16_t* z = (const bf16_t*)(p.ws + WS_Z); bf16_t* tmp = (bf16_t*)(p.ws + WS_RWA); float* invn = (float*)(p.ws + WS_INVN);
    const float* cw = p.r_conv + (size_t)l * 3 * 1536;
    for (int row = BID * 8 + wid; row < NTOK; row += NBLK * 8) {
        const int t = row < NLAT ? (row & 8191) : ((row - NLAT) & 255), L = row < NLAT ? SEQL : CTXL;
        const bool hp = t > 0, hn = t < L - 1;
#pragma unroll
        for (int g = 0; g < 3; ++g) {
            const int ch = g * 512 + lane * 8; const bf16_t* zp = z + (size_t)row * ZW + ZC_RR + ch;
            const u32x4 zero = {0u, 0u, 0u, 0u};
            const u32x4 uc = *(const u32x4*)zp, up = hp ? *(const u32x4*)(zp - ZW) : zero, un = hn ? *(const u32x4*)(zp + ZW) : zero;
            float c[8], pv[8], nx[8], o[8]; unpack8(uc, c); unpack8(up, pv); unpack8(un, nx);
#pragma unroll
            for (int e = 0; e < 8; ++e) o[e] = cw[ch + e] * pv[e] + cw[1536 + ch + e] * c[e] + cw[3072 + ch + e] * nx[e];
            *(u32x4*)(tmp + (size_t)row * 1536 + ch) = pack8(o);
            if (g == 1) {
                float ss = 0.f;
#pragma unroll
                for (int e = 0; e < 8; ++e) { const float kk = o[e] * p.r_kk[l * 512 + lane * 8 + e]; ss += kk * kk; }
                ss += __shfl_xor(ss, 1); ss += __shfl_xor(ss, 2); ss += __shfl_xor(ss, 4);
                if ((lane & 7) == 0) invn[(size_t)row * 8 + (lane >> 3)] = 1.f / fmaxf(sqrtf(ss), 1e-12f);
            }
        }
    }
}
DI void ph_rkv_copy(const Prm& p) { PH_IDS
    const int lane = TID & 63, wid = TID >> 6;
    bf16_t* z = (bf16_t*)(p.ws + WS_Z); const bf16_t* tmp = (const bf16_t*)(p.ws + WS_RWA);
    for (int row = BID * 8 + wid; row < NTOK; row += NBLK * 8)
#pragma unroll
        for (int g = 0; g < 3; ++g) { const int ch = g * 512 + lane * 8; *(u32x4*)(z + (size_t)row * ZW + ZC_RR + ch) = *(const u32x4*)(tmp + (size_t)row * 1536 + ch); }
}
DI void ph_attn_prep(const Prm& p, int l) { PH_IDS
    const int lane = TID & 63, wid = TID >> 6, hw = lane >> 5, pp = lane & 31;
    bf16_t* z = (bf16_t*)(p.ws + WS_Z); const float* rope = (const float*)(p.ws + WS_ROPE); const float* qkn = p.a_qkn + l * 128;
    for (int row = BID * 8 + wid; row < NTOK; row += NBLK * 8) {
        const bool islat = row < NLAT; const int t = row & 8191;
        float cs = 1.f, sn = 0.f; if (islat) { cs = rope[((size_t)t * 32 + pp) * 2]; sn = rope[((size_t)t * 32 + pp) * 2 + 1]; }
#pragma unroll
        for (int it = 0; it < 8; ++it) {
            const int seg = it * 2 + hw, which = seg >> 3, col = (which ? ZC_AK : ZC_AQ) + (seg & 7) * 64 + 2 * pp;
            unsigned* zp = (unsigned*)(z + (size_t)row * ZW + col);
            const unsigned u = *zp; const float x1 = lo16(u), x2 = hi16(u);
            float ss = x1 * x1 + x2 * x2;
            ss += __shfl_xor(ss, 1); ss += __shfl_xor(ss, 2); ss += __shfl_xor(ss, 4); ss += __shfl_xor(ss, 8); ss += __shfl_xor(ss, 16);
            const float rinv = rsqrtf(ss * (1.f / 64.f) + 1e-6f) * (which ? 1.f : 0.125f * 1.4426950408889634f);
            const float y1 = x1 * rinv * qkn[which * 64 + 2 * pp], y2 = x2 * rinv * qkn[which * 64 + 2 * pp + 1];
            *zp = pk2(y1 * cs - y2 * sn, y1 * sn + y2 * cs);
        }
    }
}

#define MFMA16(a, b, c) __builtin_amdgcn_mfma_f32_16x16x32_bf16((a), (b), (c), 0, 0, 0)
#define MFMA32(a, b, c) __builtin_amdgcn_mfma_f32_32x32x16_bf16((a), (b), (c), 0, 0, 0)
DI float wave_incl_scan_add(float v, int lane) {
#pragma unroll
    for (int o = 1; o < 64; o <<= 1) { const float t = __shfl_up(v, o); if (lane >= o) v += t; }
    return v;
}
DI float wave_incl_scan_max(float v, int lane) {
#pragma unroll
    for (int o = 1; o < 64; o <<= 1) { const float t = __shfl_up(v, o); if (lane >= o) v = fmaxf(v, t); }
    return v;
}
DI float mconv(const bf16_t* z, const float* cw, size_t row, int t, int L, int ch) {
    const bf16_t* zp = z + row * ZW + ch;
    float a = cw[512 + ch] * bf2f(zp[0]);
    if (t > 0) a += cw[ch] * bf2f(zp[-ZW]);
    if (t < L - 1) a += cw[1024 + ch] * bf2f(zp[ZW]);
    return siluf_(a);
}
DI void mconv8(const bf16_t* z, const float* cw, size_t row, int t, int L, int ch, float* out) {
    const bf16_t* zp = z + row * ZW + ch; const u32x4 zero = {0u, 0u, 0u, 0u};
    const u32x4 uc = *(const u32x4*)zp, up = t > 0 ? *(const u32x4*)(zp - ZW) : zero, un = t < L - 1 ? *(const u32x4*)(zp + ZW) : zero;
    float c[8], pv[8], nx[8]; unpack8(uc, c); unpack8(up, pv); unpack8(un, nx);
#pragma unroll
    for (int e = 0; e < 8; ++e) out[e] = siluf_(cw[ch + e] * pv[e] + cw[512 + ch + e] * c[e] + cw[1024 + ch + e] * nx[e]);
}
DI void ph_mlstm_a(const Prm& p, int l, unsigned char* smem) { PH_IDS
    const int lane = TID & 63, wid = TID >> 6;
    const bf16_t* z = (const bf16_t*)(p.ws + WS_Z); bf16_t* mst = (bf16_t*)(p.ws + WS_MST); float* msc = (float*)(p.ws + WS_MSC); float* mn = (float*)(p.ws + WS_MN);
    const float* cw = p.m_conv + (size_t)l * 3 * 512; const float* gb = p.m_gb + l * 16;
    bf16_t* kT = (bf16_t*)smem; bf16_t* vT = (bf16_t*)(smem + 9216); float* wsl = (float*)(smem + 9216 + 18432);
    for (int u = BID; u < 2112; u += NBLK) {
        const int d = u / 1056, r = u % 1056, b = r / 528, h = (r % 528) / NCHK, c = r % NCHK;
        const int slot = ((d * 2 + b) * 4 + h) * NCHK + c;
        const bool isctx = c < 4; const int cs = isctx ? c : c - 4, nch = isctx ? 4 : 128, oc = d ? nch - 1 - cs : cs, L = isctx ? CTXL : SEQL;
        const size_t base = isctx ? (size_t)NLAT + b * CTXL + oc * 64 : (size_t)b * SEQL + oc * 64;
        __syncthreads();
        if (wid == 0) {
            const int o = d ? 63 - lane : lane; const bf16_t* zr = z + (base + o) * ZW + ZC_MG + 8 * d + h;
            const float ig = bf2f(zr[0]) + gb[(2 * d) * 4 + h], lf = logsigf_(bf2f(zr[4]) + gb[(2 * d + 1) * 4 + h]);
            const float bc = wave_incl_scan_add(lf, lane), bt = __shfl(bc, 63), wl = bt - bc + ig, ml = wave_max(wl);
            wsl[lane] = __expf(wl - ml);
            if (lane == 0) { msc[slot * 4] = bt; msc[slot * 4 + 1] = ml; }
        }
        __syncthreads();
        {
            const int pp = TID >> 3, g = TID & 7, o = d ? 63 - pp : pp; float kv[8];
            mconv8(z, cw, base + o, oc * 64 + o, L, 256 + h * 64 + g * 8, kv);
#pragma unroll
            for (int e = 0; e < 8; ++e) kT[(g * 8 + e) * 72 + pp] = f2bf(kv[e] * 0.125f);
        }
#pragma unroll
        for (int i = 0; i < 2; ++i) {
            const int idx = TID + 512 * i, pp = idx >> 4, g = idx & 15, o = d ? 63 - pp : pp; float vv8[8];
            unpack8(*(const u32x4*)(z + (base + o) * ZW + ZC_MV + h * 128 + g * 8), vv8); const float wv = wsl[pp];
#pragma unroll
            for (int e = 0; e < 8; ++e) vT[(g * 8 + e) * 72 + pp] = f2bf(vv8[e] * wv);
        }
        __syncthreads();
        f32x4 acc[4];
#pragma unroll
        for (int nt = 0; nt < 4; ++nt) acc[nt] = (f32x4){0.f, 0.f, 0.f, 0.f};
#pragma unroll
        for (int ks = 0; ks < 2; ++ks) {
            const bf16x8 a = *(const bf16x8*)(vT + (16 * wid + (lane & 15)) * 72 + ks * 32 + (lane >> 4) * 8);
#pragma unroll
            for (int nt = 0; nt < 4; ++nt) { const bf16x8 bb = *(const bf16x8*)(kT + (16 * nt + (lane & 15)) * 72 + ks * 32 + (lane >> 4) * 8); acc[nt] = MFMA16(a, bb, acc[nt]); }
        }
#pragma unroll
        for (int nt = 0; nt < 4; ++nt)
#pragma unroll
            for (int j = 0; j < 4; ++j) mst[(size_t)slot * 8192 + (16 * wid + (lane >> 4) * 4 + j) * 64 + 16 * nt + (lane & 15)] = f2bf(acc[nt][j]);
        if (TID < 64) { float s = 0.f; for (int pp = 0; pp < 64; ++pp) s += wsl[pp] * bf2f(kT[TID * 72 + pp]); mn[slot * 64 + TID] = s; }
    }
    __syncthreads();
}
DI void ph_mlstm_b(const Prm& p) { PH_IDS
    bf16_t* mst = (bf16_t*)(p.ws + WS_MST); float* msc = (float*)(p.ws + WS_MSC); float* mn = (float*)(p.ws + WS_MN);
    for (int e = BID * 512 + TID; e < 16 * 8256; e += NBLK * 512) {
        const int chain = e / 8256, idx = e % 8256; float m = 0.f, C = 0.f;
        for (int c0 = 0; c0 < NCHK; c0 += 22) {
            float uu[22], bt[22], ml[22];
#pragma unroll
            for (int j = 0; j < 22; ++j) {
                const int slot = chain * NCHK + c0 + j; bt[j] = msc[slot * 4]; ml[j] = msc[slot * 4 + 1];
                uu[j] = idx < 8192 ? bf2f(mst[(size_t)slot * 8192 + idx]) : mn[slot * 64 + idx - 8192];
            }
#pragma unroll
            for (int j = 0; j < 22; ++j) {
                const int slot = chain * NCHK + c0 + j;
                if (idx < 8192) mst[(size_t)slot * 8192 + idx] = f2bf(C); else mn[slot * 64 + idx - 8192] = C;
                if (idx == 0) msc[slot * 4 + 2] = m;
                const float mnew = fmaxf(bt[j] + m, ml[j]);
                C = __expf(bt[j] + m - mnew) * C + __expf(ml[j] - mnew) * uu[j]; m = mnew;
            }
        }
    }
}
DI void ph_mlstm_c(const Prm& p, int l, unsigned char* smem, int ubeg, int ustride, int ucount = 1 << 30) { PH_IDS
    const int lane = TID & 63, wid = TID >> 6;
    bf16_t* z = (bf16_t*)(p.ws + WS_Z); const bf16_t* mst = (const bf16_t*)(p.ws + WS_MST); const float* msc = (const float*)(p.ws + WS_MSC); const float* mn = (const float*)(p.ws + WS_MN);
    const float* cw = p.m_conv + (size_t)l * 3 * 512; const float* gb = p.m_gb + l * 16;
    bf16_t* qs = (bf16_t*)smem; bf16_t* ks_ = (bf16_t*)(smem + 9216); bf16_t* vT = (bf16_t*)(smem + 18432); bf16_t* Sp = (bf16_t*)(smem + 36864);
    float* hsum = (float*)(smem + 46080); float* fa = (float*)(smem + 46080 + 33792);
    float *bcum = fa, *gg = fa + 64, *Mrow = fa + 128, *iw = fa + 192, *den = fa + 256, *nq = fa + 320;
    for (int u = ubeg, un = 0; u < 1056 && un < ucount; u += ustride, ++un) {
        const int b = u / 528, h = (u % 528) / NCHK, cc = u % NCHK;
        const bool isctx = cc < 4; const int oc = isctx ? cc : cc - 4, nch = isctx ? 4 : 128, L = isctx ? CTXL : SEQL;
        const size_t base = isctx ? (size_t)NLAT + b * CTXL + oc * 64 : (size_t)b * SEQL + oc * 64;
        for (int d = 0; d < 2; ++d) {
            const int cs = d ? nch - 1 - oc : oc, c = isctx ? cs : cs + 4, slot = ((d * 2 + b) * 4 + h) * NCHK + c;
            const float mst_m = msc[slot * 4 + 2];
            __syncthreads();
            if (wid == 0) {
                const int o = d ? 63 - lane : lane; const bf16_t* zr = z + (base + o) * ZW + ZC_MG + 8 * d + h;
                const float ig = bf2f(zr[0]) + gb[(2 * d) * 4 + h], lf = logsigf_(bf2f(zr[4]) + gb[(2 * d + 1) * 4 + h]);
                const float bc = wave_incl_scan_add(lf, lane), g = ig - bc, pm = wave_incl_scan_max(g, lane), M = fmaxf(mst_m, pm);
                bcum[lane] = bc; gg[lane] = g; Mrow[lane] = M; iw[lane] = __expf(mst_m - M);
            }
#pragma unroll
            for (int i = 0; i < 2; ++i) {
                const int idx = TID + 512 * i, pp = idx >> 4, g = idx & 15, isk = g >> 3, dq0 = (g & 7) * 8, o = d ? 63 - pp : pp; float qv[8];
                mconv8(z, cw, base + o, oc * 64 + o, L, isk * 256 + h * 64 + dq0, qv);
                if (isk) {
#pragma unroll
                    for (int e = 0; e < 8; ++e) qv[e] *= 0.125f;
                }
                *(u32x4*)((isk ? ks_ : qs) + pp * 72 + dq0) = pack8(qv);
            }
#pragma unroll
            for (int i = 0; i < 2; ++i) {
                const int idx = TID + 512 * i, pp = idx >> 4, g = idx & 15, o = d ? 63 - pp : pp;
                const u32x4 uv = *(const u32x4*)(z + (base + o) * ZW + ZC_MV + h * 128 + g * 8);
                vT[(g * 8 + 0) * 72 + pp] = (bf16_t)(uv.x & 0xffffu); vT[(g * 8 + 1) * 72 + pp] = (bf16_t)(uv.x >> 16);
                vT[(g * 8 + 2) * 72 + pp] = (bf16_t)(uv.y & 0xffffu); vT[(g * 8 + 3) * 72 + pp] = (bf16_t)(uv.y >> 16);
                vT[(g * 8 + 4) * 72 + pp] = (bf16_t)(uv.z & 0xffffu); vT[(g * 8 + 5) * 72 + pp] = (bf16_t)(uv.z >> 16);
                vT[(g * 8 + 6) * 72 + pp] = (bf16_t)(uv.w & 0xffffu); vT[(g * 8 + 7) * 72 + pp] = (bf16_t)(uv.w >> 16);
            }
            __syncthreads();
            {
                const int mt = wid >> 1;
#pragma unroll
                for (int nn = 0; nn < 2; ++nn) {
                    const int nt = 2 * (wid & 1) + nn; f32x4 acc = {0.f, 0.f, 0.f, 0.f};
#pragma unroll
                    for (int ks = 0; ks < 2; ++ks) {
                        const bf16x8 a = *(const bf16x8*)(qs + (16 * mt + (lane & 15)) * 72 + ks * 32 + (lane >> 4) * 8);
                        const bf16x8 bb = *(const bf16x8*)(ks_ + (16 * nt + (lane & 15)) * 72 + ks * 32 + (lane >> 4) * 8);
                        acc = MFMA16(a, bb, acc);
                    }
                    const int s = 16 * nt + (lane & 15);
#pragma unroll
                    for (int j = 0; j < 4; ++j) { const int pp = 16 * mt + (lane >> 4) * 4 + j; const float v = s <= pp ? acc[j] * __expf(gg[s] - Mrow[pp]) : 0.f; Sp[pp * 72 + s] = f2bf(v); }
                }
                if (TID < 64) { float s = 0.f; for (int dq = 0; dq < 64; ++dq) s += mn[slot * 64 + dq] * bf2f(qs[TID * 72 + dq]); nq[TID] = s; }
            }
            __syncthreads();
            if (TID < 64) { float s = 0.f; for (int k = 0; k < 64; ++k) s += bf2f(Sp[TID * 72 + k]); den[TID] = s + iw[TID] * nq[TID]; }
            f32x4 a1[4], a2[4];
#pragma unroll
            for (int mt = 0; mt < 4; ++mt) { a1[mt] = (f32x4){0.f, 0.f, 0.f, 0.f}; a2[mt] = (f32x4){0.f, 0.f, 0.f, 0.f}; }
#pragma unroll
            for (int ks = 0; ks < 2; ++ks) {
                const bf16x8 bv = *(const bf16x8*)(vT + (16 * wid + (lane & 15)) * 72 + ks * 32 + (lane >> 4) * 8);
                const bf16x8 bc = *(const bf16x8*)(mst + (size_t)slot * 8192 + (16 * wid + (lane & 15)) * 64 + ks * 32 + (lane >> 4) * 8);
#pragma unroll
                for (int mt = 0; mt < 4; ++mt) {
                    const bf16x8 as = *(const bf16x8*)(Sp + (16 * mt + (lane & 15)) * 72 + ks * 32 + (lane >> 4) * 8);
                    const bf16x8 aq = *(const bf16x8*)(qs + (16 * mt + (lane & 15)) * 72 + ks * 32 + (lane >> 4) * 8);
                    a1[mt] = MFMA16(as, bv, a1[mt]); a2[mt] = MFMA16(aq, bc, a2[mt]);
                }
            }
            __syncthreads();
            {
                const int vv = 16 * wid + (lane & 15);
#pragma unroll
                for (int mt = 0; mt < 4; ++mt)
#pragma unroll
                    for (int j = 0; j < 4; ++j) {
                        const int pp = 16 * mt + (lane >> 4) * 4 + j, o = d ? 63 - pp : pp;
                        const float val = (a1[mt][j] + iw[pp] * a2[mt][j]) / fmaxf(fabsf(den[pp]), __expf(-(bcum[pp] + Mrow[pp])));
                        if (d == 0) hsum[o * 132 + vv] = val; else hsum[o * 132 + vv] += val;
                    }
            }
        }
        __syncthreads();
#pragma unroll
        for (int i = 0; i < 8; ++i) {
            const int o = wid * 8 + i; const float x0 = hsum[o * 132 + lane], x1 = hsum[o * 132 + lane + 64];
            const float ss = wave_sum(x0 * x0 + x1 * x1), rinv = rsqrtf(ss * (1.f / 128.f) + 1e-6f);
            bf16_t* zo = z + (base + o) * ZW + ZC_MO + h * 128; const float* on = p.m_on + l * 512 + h * 128;
            zo[lane] = f2bf(x0 * rinv * on[lane] * sigmoidf_(bf2f(zo[lane])));
            zo[lane + 64] = f2bf(x1 * rinv * on[lane + 64] * sigmoidf_(bf2f(zo[lane + 64])));
        }
    }
    __syncthreads();
}
DI int swap23(int s) { return (s & ~12) | ((s & 4) << 1) | ((s & 8) >> 1); }
DI void ph_attn(const Prm& p, int l, unsigned char* smem, int bh, int qfirst, int qstep, int nq, int qextra) { PH_IDS
    const int lane = TID & 63, wid = TID >> 6, q = lane & 31, hh = lane >> 5, qg = wid >> 1, mp = wid & 1, grp = wid >> 2;
    bf16_t* z = (bf16_t*)(p.ws + WS_Z);
    float lam; const float lam_init = 0.8f - 0.6f * expf(-0.3f * (float)l);
    { const float* lp = p.a_lam + l * 256; float s1 = 0.f, s2 = 0.f; for (int i = 0; i < 64; ++i) { s1 += lp[i] * lp[64 + i]; s2 += lp[128 + i] * lp[192 + i]; } lam = expf(s1) - expf(s2) + lam_init; }
    bf16_t* Qs = (bf16_t*)smem; float* ex = (float*)smem;
    constexpr int KB_OFF = 34816, VT_OFF = 69632;
#define ATT_BAR asm volatile("s_waitcnt lgkmcnt(0)\n\ts_barrier" ::: "memory")
    for (int ui = 0; ui < nq + (qextra >= 0 ? 1 : 0); ++ui) {
        const int qi = ui < nq ? qfirst + ui * qstep : qextra;
        const int b = bh >> 2, head = bh & 3; int nt; size_t qrow0;
        const bool lat = qi < 64;
        if (lat) { qrow0 = (size_t)b * SEQL + qi * 128; nt = 132; } else { qrow0 = (size_t)NLAT + b * CTXL + (qi - 64) * 128; nt = 4; }
        __syncthreads();
#pragma unroll
        for (int i = 0; i < 4; ++i) { const int idx = TID + 512 * i, r = idx >> 4, cp = idx & 15; *(u32x4*)(Qs + r * 136 + cp * 8) = *(const u32x4*)(z + (qrow0 + r) * ZW + ZC_AQ + head * 128 + cp * 8); }
        u32x4 kreg[2], vreg[2];
        const int kp = TID & 31, vg = TID >> 5;
#define ATT_KROW0(j) ((lat && (j) >= 4) ? (size_t)b * SEQL + 64 * ((j) - 4) : (size_t)NLAT + b * CTXL + 64 * (j))
#define ATT_LOADK(j) do { const size_t kr0 = ATT_KROW0(j); \
            _Pragma("unroll") for (int i = 0; i < 2; ++i) { const int idx = TID + 512 * i, r = idx >> 4, cp = idx & 15; kreg[i] = *(const u32x4*)(z + (kr0 + r) * ZW + ZC_AK + head * 128 + cp * 8); } } while (0)
#define ATT_LOADV(j) do { const size_t kr0 = ATT_KROW0(j); \
            _Pragma("unroll") for (int i = 0; i < 2; ++i) vreg[i] = *(const u32x4*)(z + (kr0 + 2 * kp + i) * ZW + ZC_AV + head * 128 + 8 * vg); } while (0)
#define ATT_WRITEK(buf) do { bf16_t* Kw = (bf16_t*)(smem + KB_OFF + (buf) * 17408); \
            _Pragma("unroll") for (int i = 0; i < 2; ++i) { const int idx = TID + 512 * i, r = idx >> 4, cp = idx & 15; *(u32x4*)(Kw + r * 136 + cp * 8) = kreg[i]; } } while (0)
#define ATT_WRITEV(buf) do { bf16_t* Vw = (bf16_t*)(smem + VT_OFF + (buf) * 18432); \
            _Pragma("unroll") for (int w = 0; w < 4; ++w) { \
                *(unsigned*)(Vw + (8 * vg + 2 * w) * 72 + 2 * kp) = (vreg[0][w] & 0xffffu) | (vreg[1][w] << 16); \
                *(unsigned*)(Vw + (8 * vg + 2 * w + 1) * 72 + 2 * kp) = (vreg[0][w] >> 16) | (vreg[1][w] & 0xffff0000u); } } while (0)
        f32x16 o[4]; float mrun = -1e30f, lrun = 0.f; bf16x8 pf[4];
#pragma unroll
        for (int dvb = 0; dvb < 4; ++dvb)
#pragma unroll
            for (int i = 0; i < 16; ++i) o[dvb][i] = 0.f;
#define ATT_QK(j) do { const bf16_t* Kb = (const bf16_t*)(smem + KB_OFF + ((j) & 1) * 17408); \
            f32x16 s0, s1; \
            _Pragma("unroll") for (int i = 0; i < 16; ++i) { s0[i] = 0.f; s1[i] = 0.f; } \
            _Pragma("unroll") for (int kk = 0; kk < 4; ++kk) { \
                const bf16x8 qf = *(const bf16x8*)(Qs + (32 * qg + q) * 136 + mp * 64 + kk * 16 + hh * 8); \
                const bf16x8 k0 = *(const bf16x8*)(Kb + swap23(q) * 136 + mp * 64 + kk * 16 + hh * 8); \
                const bf16x8 k1 = *(const bf16x8*)(Kb + (32 + swap23(q)) * 136 + mp * 64 + kk * 16 + hh * 8); \
                s0 = MFMA32(k0, qf, s0); s1 = MFMA32(k1, qf, s1); } \
            float mx = fmaxf(fmaxf(s0[0], s0[1]), fmaxf(s1[0], s1[1])); \
            _Pragma("unroll") for (int i = 2; i < 16; i += 2) mx = fmaxf(mx, fmaxf(fmaxf(s0[i], s0[i + 1]), fmaxf(s1[i], s1[i + 1]))); \
            mx = fmaxf(mx, __shfl_xor(mx, 32)); \
            const float mnew = fmaxf(mrun, mx); \
            if (__any(mnew > mrun)) { const float alpha = __builtin_amdgcn_exp2f(mrun - mnew); lrun *= alpha; \
                _Pragma("unroll") for (int dvb = 0; dvb < 4; ++dvb) _Pragma("unroll") for (int i = 0; i < 16; ++i) o[dvb][i] *= alpha; } \
            mrun = mnew; \
            f32x2 ps = {0.f, 0.f}; \
            _Pragma("unroll") for (int i = 0; i < 16; i += 2) { s0[i] = __builtin_amdgcn_exp2f(s0[i] - mnew); s0[i + 1] = __builtin_amdgcn_exp2f(s0[i + 1] - mnew); s1[i] = __builtin_amdgcn_exp2f(s1[i] - mnew); s1[i + 1] = __builtin_amdgcn_exp2f(s1[i + 1] - mnew); \
                const f32x2 a2 = {s0[i], s0[i + 1]}, b2 = {s1[i], s1[i + 1]}; ps += a2 + b2; } \
            lrun += ps.x + ps.y; \
            _Pragma("unroll") for (int cc = 0; cc < 2; ++cc) { u32x4 a, c2; \
                a.x = pk2(s0[8 * cc], s0[8 * cc + 1]); a.y = pk2(s0[8 * cc + 2], s0[8 * cc + 3]); a.z = pk2(s0[8 * cc + 4], s0[8 * cc + 5]); a.w = pk2(s0[8 * cc + 6], s0[8 * cc + 7]); \
                c2.x = pk2(s1[8 * cc], s1[8 * cc + 1]); c2.y = pk2(s1[8 * cc + 2], s1[8 * cc + 3]); c2.z = pk2(s1[8 * cc + 4], s1[8 * cc + 5]); c2.w = pk2(s1[8 * cc + 6], s1[8 * cc + 7]); \
                pf[cc] = __builtin_bit_cast(bf16x8, a); pf[2 + cc] = __builtin_bit_cast(bf16x8, c2); } } while (0)
#define ATT_PV(j) do { const bf16_t* Vt = (const bf16_t*)(smem + VT_OFF + ((j) & 1) * 18432); \
            _Pragma("unroll") for (int dvb = 0; dvb < 4; ++dvb) _Pragma("unroll") for (int c = 0; c < 4; ++c) { \
                const bf16x8 vf = *(const bf16x8*)(Vt + (dvb * 32 + q) * 72 + 16 * c + 8 * hh); o[dvb] = MFMA32(vf, pf[c], o[dvb]); } } while (0)
        ATT_LOADK(0); ATT_LOADV(0); ATT_WRITEK(0); ATT_WRITEV(0);
        __syncthreads();
        for (int j = 0; j < nt; ++j) {
            if (j + 1 < nt) { ATT_LOADK(j + 1); ATT_LOADV(j + 1); }
            ATT_QK(j); ATT_PV(j);
            if (j + 1 < nt) { ATT_WRITEK((j + 1) & 1); ATT_WRITEV((j + 1) & 1); }
            __syncthreads();
        }
        const float lsum = lrun + __shfl_xor(lrun, 32);
        const float inv = (mp ? lam : 1.f) / lsum;
        if (mp) {
#pragma unroll
            for (int dvb = 0; dvb < 4; ++dvb)
#pragma unroll
                for (int i = 0; i < 16; ++i) ex[(qg * 64 + dvb * 16 + i) * 64 + lane] = o[dvb][i] * inv;
        }
        __syncthreads();
        if (!mp) {
            float ss = 0.f;
#pragma unroll
            for (int dvb = 0; dvb < 4; ++dvb)
#pragma unroll
                for (int i = 0; i < 16; ++i) { const float v = o[dvb][i] * inv - ex[(qg * 64 + dvb * 16 + i) * 64 + lane]; o[dvb][i] = v; ss += v * v; }
            ss += __shfl_xor(ss, 32);
            const float rinv = rsqrtf(ss * (1.f / 128.f) + 1e-6f) * (1.f - lam_init);
            bf16_t* orow = z + (qrow0 + 32 * qg + q) * ZW + ZC_AQ + head * 128; const float* sub = p.a_subln + l * 128;
#pragma unroll
            for (int dvb = 0; dvb < 4; ++dvb)
#pragma unroll
                for (int ig = 0; ig < 4; ++ig) {
                    const int dv0 = dvb * 32 + 8 * ig + 4 * hh; u32x2 w;
                    w.x = pk2(o[dvb][4 * ig] * rinv * sub[dv0], o[dvb][4 * ig + 1] * rinv * sub[dv0 + 1]);
                    w.y = pk2(o[dvb][4 * ig + 2] * rinv * sub[dv0 + 2], o[dvb][4 * ig + 3] * rinv * sub[dv0 + 3]);
                    *(u32x2*)(orow + dv0) = w;
                }
        }
    }
    __syncthreads();
}

__device__ unsigned long long g_pacc[4];
template <int CTRL> DI float dppf(float v) { return __int_as_float(__builtin_amdgcn_update_dpp(0, __float_as_int(v), CTRL, 0xf, 0xf, false)); }
DI float allreduce16(float x) { x += dppf<0x128>(x); x += dppf<0x124>(x); x += dppf<0x122>(x); x += dppf<0x121>(x); return x; }
DI void ph_rwkv_scan(const Prm& p, int l, unsigned char* smem, int ubeg, int ustride) { PH_IDS
    const int lane = TID & 63, wid = TID >> 6;
    const bf16_t* z = (const bf16_t*)(p.ws + WS_Z); const bf16_t* rwa = (const bf16_t*)(p.ws + WS_RWA); const float* invn = (const float*)(p.ws + WS_INVN);
    constexpr int TC = 32, OPW = 336, NC = 264, OPS_B = TC * OPW * 4, YP_OFF = 2 * OPS_B;
    for (int u = ubeg; u < 128; u += ustride) {
        const int chain = u >> 2, qr = u & 3, d = chain >> 4, b = (chain >> 3) & 1, h = chain & 7;
        const float ckk = p.r_kk[l * 512 + h * 64 + lane], cka = p.r_ka[l * 512 + h * 64 + lane];
        bf16_t* ydir = (bf16_t*)(p.ws + WS_YSUM) + (size_t)d * NTOK * 512;
#define RW_ROW(ck, i) ((ck) < 8 ? (size_t)NLAT + b * CTXL + (d ? CTXL - 1 - ((ck) * TC + (i)) : ((ck) * TC + (i))) : (size_t)b * SEQL + (d ? SEQL - 1 - (((ck) - 8) * TC + (i)) : (((ck) - 8) * TC + (i))))
        bf16_t g_r[8], g_k[8], g_u[8], g_a[8]; float g_i[8]; unsigned g_v;
        const int sw = wid - 4, st = TID - 256;
#define RW_LOAD(ck) do { _Pragma("unroll") for (int jj = 0; jj < 8; ++jj) { const size_t row = RW_ROW(ck, sw + 4 * jj); \
            g_r[jj] = z[row * ZW + ZC_RR + h * 64 + lane]; g_k[jj] = z[row * ZW + ZC_RK + h * 64 + lane]; \
            g_u[jj] = rwa[row * 2048 + d * 512 + h * 64 + lane]; g_a[jj] = rwa[row * 2048 + 1024 + d * 512 + h * 64 + lane]; g_i[jj] = invn[row * 8 + h]; } \
            g_v = *(const unsigned*)(z + RW_ROW(ck, st >> 3) * ZW + ZC_RV + h * 64 + qr * 16 + (st & 7) * 2); } while (0)
#define RW_WRITE(buf) do { float* ops = (float*)(smem + (buf) * OPS_B); _Pragma("unroll") for (int jj = 0; jj < 8; ++jj) { \
            const float k = bf2f(g_k[jj]), a = bf2f(g_a[jj]), kk = k * ckk * g_i[jj]; float* o = ops + (sw + 4 * jj) * OPW; \
            o[lane] = 1.f - bf2f(g_u[jj]); o[64 + lane] = kk; o[128 + lane] = kk * a; o[192 + lane] = k * (1.f + (a - 1.f) * cka); o[256 + lane] = bf2f(g_r[jj]); } \
            { float* o = ops + (st >> 3) * OPW + 320 + (st & 7) * 2; o[0] = lo16(g_v); o[1] = hi16(g_v); } } while (0)
        __syncthreads();
        if (wid >= 4) { RW_LOAD(0); RW_WRITE(0); RW_LOAD(1); }
        __syncthreads();
        f32x2 Sa = {0.f, 0.f}, Sb = {0.f, 0.f};
        const int rl = (wid & 3) * 4 + (lane >> 4), ksub = lane & 15;
        float* ypw = (float*)(smem + YP_OFF) + (wid & 3) * (TC * 64);
        for (int ck = 0; ck < NC; ++ck) {
            if (wid >= 4) {
                if (ck + 1 < NC) RW_WRITE((ck + 1) & 1);
                if (ck + 2 < NC) RW_LOAD(ck + 2);
            } else {
                const float* ops = (const float*)(smem + (ck & 1) * OPS_B);
#define RW_GET(X, i) do { const float* o_ = ops + (i) * OPW; w_##X = *(const f32x4*)(o_ + 4 * ksub); k_##X = *(const f32x4*)(o_ + 64 + 4 * ksub); b_##X = *(const f32x4*)(o_ + 128 + 4 * ksub); \
                d_##X = *(const f32x4*)(o_ + 192 + 4 * ksub); r_##X = *(const f32x4*)(o_ + 256 + 4 * ksub); v_##X = o_[320 + rl]; } while (0)
#define RW_STEP(X, i) do { const f32x2 ka = {k_##X[0], k_##X[1]}, kb = {k_##X[2], k_##X[3]}, ra = {r_##X[0], r_##X[1]}, rb = {r_##X[2], r_##X[3]}; \
                const f32x2 ba = {b_##X[0], b_##X[1]}, bb = {b_##X[2], b_##X[3]}, da = {d_##X[0], d_##X[1]}, db = {d_##X[2], d_##X[3]}, wa = {w_##X[0], w_##X[1]}, wb = {w_##X[2], w_##X[3]}; \
                const f32x2 dt2 = Sa * ka + Sb * kb; const f32x2 qa = Sa * wa + da * v_##X, qb = Sb * wb + db * v_##X; const float sa = -allreduce16(dt2.x + dt2.y); \
                Sa = ba * sa + qa; Sb = bb * sa + qb; \
                const f32x2 y2 = Sa * ra + Sb * rb; \
                ypw[(i) * 64 + lane] = y2.x + y2.y; } while (0)
                f32x4 w_A, k_A, b_A, d_A, r_A, w_B, k_B, b_B, d_B, r_B, w_C, k_C, b_C, d_C, r_C, w_D, k_D, b_D, d_D, r_D; float v_A, v_B, v_C, v_D;
                RW_GET(A, 0); RW_GET(B, 1);
#pragma unroll 1
                for (int i = 0; i < TC; i += 4) {
                    RW_GET(C, i + 2);
                    RW_STEP(A, i);
                    RW_GET(D, i + 3);
                    RW_STEP(B, i + 1);
                    if (i + 4 < TC) RW_GET(A, i + 4);
                    RW_STEP(C, i + 2);
                    if (i + 4 < TC) RW_GET(B, i + 5);
                    RW_STEP(D, i + 3);
                }
                {
                    const int i = lane >> 1, rw = (lane & 1) * 2;
                    const f32x4* y4 = (const f32x4*)(ypw + i * 64 + rw * 16);
                    const f32x4 s4 = (y4[0] + y4[1]) + (y4[2] + y4[3]), t4 = (y4[4] + y4[5]) + (y4[6] + y4[7]);
                    *(unsigned*)(ydir + RW_ROW(ck, i) * 512 + h * 64 + qr * 16 + wid * 4 + rw) = pk2((s4[0] + s4[1]) + (s4[2] + s4[3]), (t4[0] + t4[1]) + (t4[2] + t4[3]));
                }
            }
            asm volatile("s_waitcnt lgkmcnt(0)\n\ts_barrier" ::: "memory");
        }
    }
    __syncthreads();
}
DI void ph_rwkv_post(const Prm& p, int l) { PH_IDS
    const int lane = TID & 63, wid = TID >> 6, ch0 = lane * 8;
    bf16_t* z = (bf16_t*)(p.ws + WS_Z); const bf16_t* ysum = (const bf16_t*)(p.ws + WS_YSUM); const bf16_t* rg = (const bf16_t*)(p.ws + WS_RG);
    for (int row = BID * 8 + wid; row < NTOK; row += NBLK * 8) {
        float y[8], y2[8], r[8], k[8], v[8], g[8], o[8];
        unpack8(*(const u32x4*)(ysum + (size_t)row * 512 + ch0), y); unpack8(*(const u32x4*)(ysum + (size_t)(NTOK + row) * 512 + ch0), y2);
#pragma unroll
        for (int e = 0; e < 8; ++e) y[e] += y2[e];
        bf16_t* zr = z + (size_t)row * ZW + ZC_RR + ch0;
        unpack8(*(const u32x4*)zr, r); unpack8(*(const u32x4*)(zr + 512), k); unpack8(*(const u32x4*)(zr + 1024), v); unpack8(*(const u32x4*)(rg + (size_t)row * 512 + ch0), g);
        float s = 0.f, bs = 0.f;
#pragma unroll
        for (int e = 0; e < 8; ++e) { s += y[e]; bs += r[e] * k[e] * p.r_rk[l * 512 + ch0 + e]; }
        s += __shfl_xor(s, 1); s += __shfl_xor(s, 2); s += __shfl_xor(s, 4); bs += __shfl_xor(bs, 1); bs += __shfl_xor(bs, 2); bs += __shfl_xor(bs, 4);
        const float mu = s * (1.f / 64.f); float vs = 0.f;
#pragma unroll
        for (int e = 0; e < 8; ++e) { const float dlt = y[e] - mu; vs += dlt * dlt; }
        vs += __shfl_xor(vs, 1); vs += __shfl_xor(vs, 2); vs += __shfl_xor(vs, 4);
        const float rstd = rsqrtf(vs * (1.f / 64.f) + 64e-5f);
#pragma unroll
        for (int e = 0; e < 8; ++e) o[e] = ((y[e] - mu) * rstd * p.r_lnw[l * 512 + ch0 + e] + p.r_lnb[l * 512 + ch0 + e] + bs * v[e]) * g[e];
        *(u32x4*)zr = pack8(o);
    }
}

#ifndef PROBE_A
#define PROBE_A 0
#endif
#ifndef PROBE_B
#define PROBE_B 0
#endif
#ifndef PROBE_BLK
#define PROBE_BLK 0
#endif
#ifndef PROBE_ADIV
#define PROBE_ADIV 1
#endif
#ifndef PROBE_BDIV
#define PROBE_BDIV 1
#endif
#if PROBE_A || PROBE_B
#define PT(id, ...) do { unsigned long long t0_ = wall_clock64(); __VA_ARGS__; unsigned long long dt_ = wall_clock64() - t0_; if ((id) == PROBE_A) pacc1 += dt_; if ((id) == PROBE_B) pacc2 += dt_; } while (0)
#else
#define PT(id, ...) do { __VA_ARGS__; } while (0)
#endif
DI void grid_bar(unsigned* ctr, unsigned& target, unsigned nblk) {
    __syncthreads();
    if (threadIdx.x == 0) {
        __builtin_amdgcn_fence(__ATOMIC_RELEASE, "agent");
        target += nblk;
        __hip_atomic_fetch_add(ctr, 1u, __ATOMIC_RELAXED, __HIP_MEMORY_SCOPE_AGENT);
        while (__hip_atomic_load(ctr, __ATOMIC_RELAXED, __HIP_MEMORY_SCOPE_AGENT) < target) __builtin_amdgcn_s_sleep(2);
        __builtin_amdgcn_fence(__ATOMIC_ACQUIRE, "agent");
    }
    __syncthreads();
}
__global__ void __launch_bounds__(512) mega(Prm p0) {
    Prm p = p0; p.wv = __builtin_amdgcn_readfirstlane((int)threadIdx.x >> 6);
    const int BIDK = (int)blockIdx.x;
    extern __shared__ __attribute__((aligned(16))) unsigned char smem[];
    cg::grid_group grid = cg::this_grid();
    unsigned bar_target = 0; unsigned* bar_ctr = (unsigned*)(p0.ws + WS_BAR);
#define GSYNC() grid_bar(bar_ctr, bar_target, gridDim.x)
    bf16_t* wt = (bf16_t*)(p.ws + WS_WT); bf16_t* zb = (bf16_t*)(p.ws + WS_Z); bf16_t* hb = (bf16_t*)(p.ws + WS_RWA); bf16_t* gtmp = hb + (size_t)NTOK * DM;
    bf16_t* zz = (bf16_t*)(p.ws + WS_MST); float* xc = (float*)(p.ws + WS_XC); const float* mods = (const float*)(p.ws + WS_MODS);
#if PROBE_A || PROBE_B
    unsigned long long pacc1 = 0, pacc2 = 0; const unsigned long long pstart = wall_clock64();
    if (PROBE_SCAN && blockIdx.x == 0 && threadIdx.x == 0) { g_pacc[0] = 0; g_pacc[1] = 0; }
#endif
    PT(15, ph_modpart(p, smem); ph_rope(p); conv_ffn(p, 0, 0, smem));
    PT(14, grid.sync());
    ph_modreduce(p);
    PT(14, GSYNC());
#define MERGE_B(l, b) do { \
                    { EpiGate E; E.G = gtmp; run_gemm(p.wv, smem, hb, DM, wt + WT_G + (size_t)(b) * DM * DM, (l) == 1 ? NLAT : NTOK, DM, DM, E); } \
                    { EpiBranch E; E.G = gtmp; E.ZZ = zz; E.first = ((b) == 0); const int yc = (b) == 0 ? ZC_MO : ((b) == 1 ? ZC_RR : ZC_AQ); \
                      run_gemm(p.wv, smem, zb + yc, ZW, wt + WT_P + (size_t)(b) * DM * 512, (l) == 1 ? NLAT : NTOK, DM, 512, E); } \
 } while (0)
#define MIXER_STAGE(l) do { const float* ml = mods + (size_t)(l) * 27648; \
                PT(13, ph_norm(p, l, 1, false, 11, ml + 2 * DM, 0.5f); conv_mixer(p, l, smem);); \
                PT(14, GSYNC()); \
                PT(8, { EpiWin E; E.Z = zb; run_gemm(p.wv, smem, hb, DM, wt + WT_IN, NTOK, ZWP, DM, E); }); \
                PT(14, GSYNC()); \
                PT(4, ph_rkv_conv(p, l); ph_attn_prep(p, l)); PT(5, ph_mlstm_a(p, l, smem)); \
                PT(14, GSYNC()); \
                PT(6, ph_rkv_copy(p)); PT(7, ph_mlstm_b(p)); \
                PT(14, GSYNC()); \
                PT(16, { EpiLora E; E.RWA = hb; E.RG = (bf16_t*)(p.ws + WS_RG); E.w0 = p.r_w0 + l * 1024; E.a0 = p.r_a0 + l * 1024; run_gemm(p.wv, smem, zb + ZC_RL, ZW, wt + WT_L, NTOK, 2560, 384, E); }); \
                PT(14, GSYNC()); \
                { int sc_u = BIDK, sc_s = NBLK, bh0 = 0, bh1 = 8, qf = BIDK, qs = NBLK, nq = (66 - BIDK + NBLK - 1) / NBLK, qx = -1, mc_u = BIDK, mc_s = NBLK, mc_c = 1 << 30; \
                  if (NBLK == 256) { const int xi = BIDK >> 3, bh = BIDK & 7; bh0 = bh; bh1 = bh + 1; sc_s = 128; \
                      if (xi < 16) { sc_u = bh * 16 + xi; nq = 0; mc_u = bh * 16 + xi; mc_s = 128; } \
                      else { const int a = xi - 16; sc_u = 128; qf = a; qs = 16; nq = 4; qx = a < 2 ? 64 + a : -1; mc_u = 1056; mc_s = 1; mc_c = 0; } } \
                  PT(1, ph_rwkv_scan(p, l, smem, sc_u, sc_s)); \
                  PT(2, for (int bh = bh0; bh < bh1; ++bh) ph_attn(p, l, smem, bh, qf, qs, nq, qx)); \
                  PT(3, ph_mlstm_c(p, l, smem, mc_u, mc_s, mc_c)); } \
                PT(14, GSYNC()); \
                PT(12, ph_rwkv_post(p, l); ph_norm(p, l, 1, false)); \
                PT(14, GSYNC()); \
                PT(9, MERGE_B(l, 0); MERGE_B(l, 1); MERGE_B(l, 2)); \
                PT(14, GSYNC()); \
                PT(17, { EpiResid E; E.xlat = p.out; E.xc = xc; E.gate = ml + 5 * DM; E.coef = 1.f; run_gemm(p.wv, smem, zz, DM, wt + WT_O, NLAT, DM, DM, E); \
              if ((l) == 0) { EpiPartial E2; E2.P = (float*)gtmp; E2.kslice_bytes = 512; run_gemm_ctx(p.wv, smem, zz, DM, wt + WT_O, DM, 4, 256, E2); } }); \
                PT(14, GSYNC()); \
 } while (0)
#define FFN_STAGE(l, f) do { const float* ml = mods + (size_t)(l) * 27648; \
            PT(18, ph_norm(p, l, f == 0 ? 0 : 2, l == 0 && f == 0, (f) == 1 ? ((l) == 0 ? 4 : 0) : ((l) == 1 ? 11 : 0), (f) == 1 ? ml + 5 * DM : mods + 8 * DM, (f) == 1 ? 1.f : 0.5f); \
            if (!(l == 0 && f == 0)) conv_ffn(p, l, f, smem)); \
            PT(14, GSYNC()); \
            PT(10, { EpiSwiglu E; E.H = zb; run_gemm(p.wv, smem, hb, DM, wt + WT_GU, ((l) == 1 && (f) == 1) ? NLAT : NTOK, 2 * DFF, DM, E); }); \
            PT(14, GSYNC()); \
            PT(11, { EpiResid E; E.xlat = p.out; E.xc = xc; E.gate = ml + (f == 0 ? 2 : 8) * DM; E.coef = 0.5f; run_gemm(p.wv, smem, zb, DFF, wt + WT_DN, NLAT, DM, DFF, E); \
              if (!((l) == 1 && (f) == 1)) { EpiPartial E2; E2.P = (float*)gtmp; E2.kslice_bytes = 512; run_gemm_ctx(p.wv, smem, zb, DFF, wt + WT_DN, DFF, 11, 256, E2); } }); \
            PT(14, GSYNC()); \
 } while (0)
    FFN_STAGE(0, 0); MIXER_STAGE(0); FFN_STAGE(0, 1); FFN_STAGE(1, 0); MIXER_STAGE(1); FFN_STAGE(1, 1);
#if PROBE_A || PROBE_B
    if (blockIdx.x == PROBE_BLK) {
        const unsigned long long pend = wall_clock64();
        if (PROBE_SCAN) { __syncthreads(); pacc1 = g_pacc[0]; pacc2 = g_pacc[1]; }
        if (PROBE_A == 99) pacc1 = pend - pstart;
        if (PROBE_B == 99) pacc2 = pend - pstart;
        unsigned long long q1 = pacc1 / (4000ull * PROBE_ADIV), q2 = pacc2 / (4000ull * PROBE_BDIV); if (q1 > 63) q1 = 63; if (q2 > 63) q2 = 63;
        const unsigned long long waitt = (q1 + 64 * q2) * 2000ull;
        while (wall_clock64() - pend < waitt) __builtin_amdgcn_s_sleep(32);
    }
#endif
}

extern "C" void kernel_launch(void* const* d_in, const int* in_sizes, int n_in, void* d_out, int out_size, void* d_ws, size_t ws_size, hipStream_t stream) {
    static int grid_blocks = 0;
    if (!grid_blocks) {
        int dev = 0, cus = 0, per_cu = 0;
        hipGetDevice(&dev);
        hipDeviceGetAttribute(&cus, hipDeviceAttributeMultiprocessorCount, dev);
        hipFuncSetAttribute((const void*)mega, hipFuncAttributeMaxDynamicSharedMemorySize, LDS_BYTES);
        hipOccupancyMaxActiveBlocksPerMultiprocessor(&per_cu, (const void*)mega, 512, LDS_BYTES);
        if (per_cu < 1) per_cu = 1;
        grid_blocks = cus * per_cu;
        if (ws_size < WS_END) fprintf(stderr, "kernel_launch: workspace too small: %zu < %zu\n", ws_size, (size_t)WS_END);
    }
    Prm p{};
    const float** pp = (const float**)&p;
    for (int i = 0; i < 31; ++i) pp[i] = (const float*)d_in[i];
    p.out = (float*)d_out; p.ws = (unsigned char*)d_ws;
    (void)hipMemsetAsync((unsigned char*)d_ws + WS_BAR, 0, 256, stream);
    void* args[] = {&p};
    hipError_t e = hipLaunchCooperativeKernel((const void*)mega, dim3(grid_blocks), dim3(512), args, LDS_BYTES, stream);
    if (e != hipSuccess) fprintf(stderr, "cooperative launch failed: %s (grid %d)\n", hipGetErrorString(e), grid_blocks);
}
```

```cpp
#include <hip/hip_runtime.h>
#include <hip/hip_cooperative_groups.h>
#include <cstdio>
#include <cstdint>
namespace cg = cooperative_groups;
#ifndef PROBE_SCAN
#define PROBE_SCAN 0
#endif

#define LAS __attribute__((address_space(3)))
#define DI __device__ __forceinline__
typedef unsigned short bf16_t;
typedef short bf16x8 __attribute__((ext_vector_type(8)));
typedef float f32x4 __attribute__((ext_vector_type(4)));
typedef float f32x16 __attribute__((ext_vector_type(16)));
typedef float f32x2 __attribute__((ext_vector_type(2)));
typedef unsigned u32x4 __attribute__((ext_vector_type(4)));
typedef unsigned u32x2 __attribute__((ext_vector_type(2)));
typedef __bf16 bf16x2_t __attribute__((ext_vector_type(2)));

constexpr int DM = 1024, NLAT = 16384, NTOK = 16896, SEQL = 8192, CTXL = 256, DFF = 2816, DIN = 8080, ZW = 5008, ZWP = 5120;
constexpr int ZC_MQ = 0, ZC_MK = 256, ZC_MV = 512, ZC_MO = 1024, ZC_MG = 1536, ZC_RR = 1552, ZC_RK = 2064, ZC_RV = 2576, ZC_RL = 3088, ZC_AQ = 3472, ZC_AK = 3984, ZC_AV = 4496;
constexpr int NCHK = 132;
constexpr size_t WS_MODP = 0;
constexpr size_t WS_MODS = WS_MODP + (size_t)2 * 16 * 3 * 9216 * 4;
constexpr size_t WS_ROPE = WS_MODS + (size_t)2 * 3 * 9216 * 4;
constexpr size_t WS_XC   = WS_ROPE + (size_t)8192 * 64 * 4;
constexpr size_t WS_INVN = WS_XC + (size_t)512 * 1024 * 4;
constexpr size_t WS_MSC  = WS_INVN + (size_t)NTOK * 8 * 4;
constexpr size_t WS_MN   = WS_MSC + (size_t)2112 * 4 * 4;
constexpr size_t WS_WT   = WS_MN + (size_t)2112 * 64 * 4;
constexpr size_t WS_Z    = WS_WT + (size_t)25165824;
constexpr size_t WS_RWA  = WS_Z + (size_t)NTOK * ZW * 2;
constexpr size_t WS_RG   = WS_RWA + (size_t)NTOK * 2048 * 2;
constexpr size_t WS_MST  = WS_RG + (size_t)NTOK * 512 * 2;
constexpr size_t WS_YSUM = WS_MST + (size_t)2112 * 8192 * 2;
constexpr size_t WS_BAR  = WS_YSUM + (size_t)NTOK * 512 * 4;
constexpr size_t WS_END  = WS_BAR + 256;
constexpr size_t WT_GU = 0, WT_DN = (size_t)5632 * 1024;
constexpr size_t WT_IN = 0, WT_G = (size_t)5120 * 1024, WT_P = WT_G + (size_t)3072 * 1024, WT_O = WT_P + (size_t)3 * 1024 * 512, WT_L = WT_O + (size_t)1024 * 1024;
constexpr int LDS_BYTES = 155648;

DI float bf2f(bf16_t b) { return __uint_as_float(((unsigned)b) << 16); }
DI unsigned pk2(float lo, float hi) { f32x2 v = {lo, hi}; bf16x2_t b = __builtin_convertvector(v, bf16x2_t); return __builtin_bit_cast(unsigned, b); }
DI bf16_t f2bf(float f) { return (bf16_t)(pk2(f, 0.f) & 0xffffu); }
DI float lo16(unsigned u) { return __uint_as_float(u << 16); }
DI float hi16(unsigned u) { return __uint_as_float(u & 0xffff0000u); }
DI float sigmoidf_(float x) { return __builtin_amdgcn_rcpf(1.f + __expf(-x)); }
DI float siluf_(float x) { return x * __builtin_amdgcn_rcpf(1.f + __expf(-x)); }
DI float logsigf_(float x) { return x < 0.f ? x - log1pf(expf(x)) : -log1pf(expf(-x)); }
DI float wave_sum(float v) {
#pragma unroll
    for (int o = 1; o < 64; o <<= 1) v += __shfl_xor(v, o);
    return v;
}
DI float wave_max(float v) {
#pragma unroll
    for (int o = 1; o < 64; o <<= 1) v = fmaxf(v, __shfl_xor(v, o));
    return v;
}
DI void unpack8(const u32x4 u, float* f) { f[0] = lo16(u.x); f[1] = hi16(u.x); f[2] = lo16(u.y); f[3] = hi16(u.y); f[4] = lo16(u.z); f[5] = hi16(u.z); f[6] = lo16(u.w); f[7] = hi16(u.w); }
DI u32x4 pack8(const float* f) { u32x4 u; u.x = pk2(f[0], f[1]); u.y = pk2(f[2], f[3]); u.z = pk2(f[4], f[5]); u.w = pk2(f[6], f[7]); return u; }
DI int launder_v(int v) { asm volatile("" : "+v"(v)); return v; }
DI int launder_s(int v) { asm volatile("" : "+s"(v)); return v; }
DI int lane_id_() { return (int)__builtin_amdgcn_mbcnt_hi(~0u, __builtin_amdgcn_mbcnt_lo(~0u, 0u)); }
namespace pg8 {
#define PG8_LAS __attribute__((address_space(3)))
typedef unsigned short bf16_t;
typedef short bf16x8 __attribute__((ext_vector_type(8)));
typedef float f32x4 __attribute__((ext_vector_type(4)));
typedef unsigned u32x4 __attribute__((ext_vector_type(4)));
constexpr int BM = 256, BK = 64, HALF = 128, HTB = HALF * BK * 2  , STAGE_BYTES = 8 * HTB, NXCD = 8, WGM = 8;

__host__ __device__ __forceinline__ int lds_byte(int r, int c) { const int st = (r >> 4) * 2 + (c >> 5), rr = r & 15, cc = c & 31, ob = rr * 64 + cc * 2; return st * 1024 + (ob ^ (((ob >> 9) & 1) << 5)); }
__host__ __device__ __forceinline__ void stage_rc(int b, int& R, int& C) { const int st = b / 1024, sb = b % 1024, swz = sb ^ (((sb >> 9) & 1) << 5); R = (st >> 1) * 16 + swz / 64; C = (st & 1) * 32 + (swz % 64) / 2; }
__host__ __device__ __forceinline__ int perm32(int rho) { const int n = rho >> 4, i = rho & 15; return 8 * (i >> 2) + 4 * n + (i & 3); }

struct Unit { int pm, pn; size_t koff; };
struct Gemm { const bf16_t* A; const bf16_t* Bt; int M, N, K, lda, ldb, tid0; };

struct StaticOrder {
    int nM, nN, nwg, G, c;
    __host__ __device__ void init(int M, int N, int G_, int c_) { nM = M / BM; nN = N / BM; nwg = nM * nN; G = G_; c = c_; }
    __host__ __device__ bool next(int i, Unit& u) const {
        const long L = (long)i * G + c; if (L >= nwg) return false;
        int wgid = (int)L; { const int q = nwg / NXCD, r = nwg % NXCD, xcd = wgid % NXCD, off = wgid / NXCD; wgid = (xcd < r ? xcd * (q + 1) : r * (q + 1) + (xcd - r) * q) + off; }
        const int nig = WGM * nN, gid = wgid / nig, fm = gid * WGM, gsz = (nM - fm) < WGM ? (nM - fm) : WGM;
        u.pm = fm + ((wgid % nig) % gsz); u.pn = (wgid % nig) / gsz; u.koff = 0; return true;
    }
    __device__ __forceinline__ void a_ready(const Unit&) const {}
    __device__ __forceinline__ void done(const Unit&) const {}
};


template <class Epi, class Sched, bool ALIGN_EPI = false, bool SP2 = false>
__device__ __forceinline__ void gemm_phase(PG8_LAS unsigned char* lds, const Gemm g, const Sched& S, const Epi& E) {
    int tid = g.tid0; asm volatile("" : "+v"(tid)); const int wid = __builtin_amdgcn_readfirstlane(tid >> 6), lane = tid & 63, wr = wid >> 2, wc = wid & 3, fr = lane & 15, fq = lane >> 4;
    const int K = g.K, nt = K / BK;
    unsigned voffA[2], voffB[2];
#pragma unroll
    for (int i = 0; i < 2; ++i) { int R, C; stage_rc(tid * 16 + i * 8192, R, C); const int Rb = Epi::PERM ? ((R & ~31) + perm32(R & 31)) : R;
        voffA[i] = (unsigned)(R * g.lda + C) * 2u; voffB[i] = (unsigned)(Rb * g.ldb + C) * 2u; }
    const size_t kstep = (size_t)(BK * 2);
    const size_t hstepB = (size_t)HALF * g.ldb * 2, hstepA = (size_t)HALF * g.lda * 2;
    const size_t tstepA = 2 * hstepA, tstepB = 2 * hstepB;
    const unsigned ldsw = (unsigned)wid * 1024u;
    const int aoff = lds_byte(wr * 64 + fr, fq * 8), boff = lds_byte(wc * 32 + fr, fq * 8);
#define PG8_SA(b, h) (((b) * 2 + (h)) * HTB)
#define PG8_SB(b, h) ((4 + (b) * 2 + (h)) * HTB)
#define PG8_STAGE(bufoff, gbase, voff) do { _Pragma("unroll") for (int _i = 0; _i < 2; ++_i) \
        __builtin_amdgcn_global_load_lds((const unsigned*)((const char*)(gbase) + (voff)[_i]), (PG8_LAS unsigned*)(lds + (bufoff) + ldsw + _i * 8192), 16, 0, 0); } while (0)
#define PG8_LDA(dst, b, h) do { _Pragma("unroll") for (int m = 0; m < 4; ++m) _Pragma("unroll") for (int k = 0; k < 2; ++k) dst[m][k] = *(const PG8_LAS bf16x8*)(lds + PG8_SA(b, h) + aoff + m * 2048 + k * 1024); } while (0)
#define PG8_LDB(dst, b, h) do { _Pragma("unroll") for (int n = 0; n < 2; ++n) _Pragma("unroll") for (int k = 0; k < 2; ++k) dst[n][k] = *(const PG8_LAS bf16x8*)(lds + PG8_SB(b, h) + boff + n * 2048 + k * 1024); } while (0)
#define PG8_MMA(ai, bj, At, Bt) do { __builtin_amdgcn_s_setprio(1); _Pragma("unroll") for (int m = 0; m < 4; ++m) _Pragma("unroll") for (int n = 0; n < 2; ++n) _Pragma("unroll") for (int k = 0; k < 2; ++k) \
        acc[ai][bj][m][n] = __builtin_amdgcn_mfma_f32_16x16x32_bf16(Bt[n][k], At[m][k], acc[ai][bj][m][n], 0, 0, 0); __builtin_amdgcn_s_setprio(0); } while (0)
#define PG8_WAIT_V(n) asm volatile("s_waitcnt vmcnt(" #n ")" ::: "memory")
#define PG8_WAIT_L(n) asm volatile("s_waitcnt lgkmcnt(" #n ")" ::: "memory")
#define PG8_BAR __builtin_amdgcn_s_barrier()
#define PG8_SCHED __builtin_amdgcn_sched_barrier(0)
    Unit cur, nxt; int ui = 0;
    if (!S.next(0, cur)) return;
    f32x4 acc[2][2][4][2];
#pragma unroll
    for (int a = 0; a < 2; ++a)
#pragma unroll
        for (int b = 0; b < 2; ++b)
#pragma unroll
            for (int m = 0; m < 4; ++m)
#pragma unroll
                for (int n = 0; n < 2; ++n) acc[a][b][m][n] = (f32x4){0.f, 0.f, 0.f, 0.f};
    bf16x8 At[4][2], B0[2][2], B1[2][2];
    const char* cA = (const char*)g.A + (size_t)cur.pm * tstepA + cur.koff; const char* cB = (const char*)g.Bt + (size_t)cur.pn * tstepB + cur.koff;
    S.a_ready(cur);
    if constexpr (SP2) {
        PG8_STAGE(PG8_SB(0, 0), cB, voffB); PG8_STAGE(PG8_SB(0, 1), cB + hstepB, voffB); PG8_STAGE(PG8_SA(0, 0), cA, voffA); PG8_STAGE(PG8_SA(0, 1), cA + hstepA, voffA);
        if (wr == 1) PG8_BAR;
        PG8_WAIT_V(2); PG8_BAR;
        PG8_STAGE(PG8_SB(1, 0), cB + kstep, voffB); PG8_STAGE(PG8_SA(1, 0), cA + kstep, voffA); PG8_STAGE(PG8_SB(1, 1), cB + hstepB + kstep, voffB);
        PG8_WAIT_V(6); PG8_BAR;
    } else {
        PG8_STAGE(PG8_SB(0, 0), cB, voffB); PG8_STAGE(PG8_SA(0, 0), cA, voffA); PG8_STAGE(PG8_SB(0, 1), cB + hstepB, voffB); PG8_STAGE(PG8_SA(0, 1), cA + hstepA, voffA);
        if (wr == 1) PG8_BAR;
        PG8_WAIT_V(4); PG8_BAR;
        PG8_STAGE(PG8_SB(1, 0), cB + kstep, voffB); PG8_STAGE(PG8_SA(1, 0), cA + kstep, voffA); PG8_STAGE(PG8_SB(1, 1), cB + hstepB + kstep, voffB);
        PG8_WAIT_V(6); PG8_BAR;
    }
    for (;;) {
        const bool has_next = S.next(ui + 1, nxt);
        const char* nA = has_next ? (const char*)g.A + (size_t)nxt.pm * tstepA + nxt.koff : cA; const char* nB = has_next ? (const char*)g.Bt + (size_t)nxt.pn * tstepB + nxt.koff : cB;
        for (int t = 0; t < nt; t += 2) {
            const bool last = (t == nt - 2);
            const char* a1 = cA + (size_t)(t + 1) * kstep;
            const char* a2 = last ? nA : cA + (size_t)(t + 2) * kstep; const char* b2 = last ? nB : cB + (size_t)(t + 2) * kstep;
            const char* a3 = a2 + kstep; const char* b3 = b2 + kstep;
            if (last && has_next) S.a_ready(nxt);
            if constexpr (SP2) {
            PG8_LDB(B0, 0, 0); PG8_LDB(B1, 0, 1); PG8_SCHED; PG8_LDA(At, 0, 0); PG8_STAGE(PG8_SA(1, 1), a1 + hstepA, voffA);
            PG8_WAIT_V(8); PG8_WAIT_L(0); PG8_BAR; PG8_MMA(0, 0, At, B0); PG8_MMA(0, 1, At, B1); PG8_BAR; PG8_SCHED;
            PG8_LDA(At, 0, 1); PG8_STAGE(PG8_SB(0, 0), b2, voffB); PG8_STAGE(PG8_SB(0, 1), b2 + hstepB, voffB); PG8_STAGE(PG8_SA(0, 0), a2, voffA);
            PG8_WAIT_V(8); PG8_WAIT_L(0); PG8_BAR; PG8_MMA(1, 0, At, B0); PG8_MMA(1, 1, At, B1); PG8_BAR; PG8_SCHED;
            PG8_LDB(B0, 1, 0); PG8_LDB(B1, 1, 1); PG8_SCHED; PG8_LDA(At, 1, 0); PG8_STAGE(PG8_SA(0, 1), a2 + hstepA, voffA);
            PG8_WAIT_V(8); PG8_WAIT_L(0); PG8_BAR; PG8_MMA(0, 0, At, B0); PG8_MMA(0, 1, At, B1); PG8_BAR; PG8_SCHED;
            PG8_LDA(At, 1, 1); PG8_STAGE(PG8_SB(1, 0), b3, voffB); PG8_STAGE(PG8_SB(1, 1), b3 + hstepB, voffB); PG8_STAGE(PG8_SA(1, 0), a3, voffA);
            PG8_WAIT_V(8); PG8_WAIT_L(0); PG8_BAR; PG8_MMA(1, 0, At, B0); PG8_MMA(1, 1, At, B1); PG8_BAR; PG8_SCHED;
            } else {
            PG8_LDB(B0, 0, 0); PG8_SCHED; PG8_LDA(At, 0, 0); PG8_STAGE(PG8_SA(1, 1), a1 + hstepA, voffA);
            PG8_WAIT_L(8); PG8_BAR; PG8_WAIT_L(0); PG8_MMA(0, 0, At, B0); PG8_BAR; PG8_SCHED;
            PG8_LDB(B1, 0, 1); PG8_STAGE(PG8_SB(0, 0), b2, voffB);
            PG8_BAR; PG8_WAIT_L(0); PG8_MMA(0, 1, At, B1); PG8_BAR;
            PG8_LDA(At, 0, 1); PG8_STAGE(PG8_SA(0, 0), a2, voffA);
            PG8_BAR; PG8_WAIT_L(0); PG8_MMA(1, 0, At, B0); PG8_BAR; PG8_SCHED;
            PG8_STAGE(PG8_SB(0, 1), b2 + hstepB, voffB);
            PG8_WAIT_V(6); PG8_BAR; PG8_MMA(1, 1, At, B1); PG8_BAR;
            PG8_LDB(B0, 1, 0); PG8_SCHED; PG8_LDA(At, 1, 0); PG8_STAGE(PG8_SA(0, 1), a2 + hstepA, voffA);
            PG8_WAIT_L(8); PG8_BAR; PG8_WAIT_L(0); PG8_MMA(0, 0, At, B0); PG8_BAR; PG8_SCHED;
            PG8_LDB(B1, 1, 1); PG8_STAGE(PG8_SB(1, 0), b3, voffB);
            PG8_BAR; PG8_WAIT_L(0); PG8_MMA(0, 1, At, B1); PG8_BAR;
            PG8_LDA(At, 1, 1); PG8_STAGE(PG8_SA(1, 0), a3, voffA);
            PG8_BAR; PG8_WAIT_L(0); PG8_MMA(1, 0, At, B0); PG8_BAR; PG8_SCHED;
            PG8_STAGE(PG8_SB(1, 1), b3 + hstepB, voffB);
            PG8_WAIT_V(6); PG8_BAR; PG8_MMA(1, 1, At, B1); PG8_BAR;
            }
        }
        if constexpr (ALIGN_EPI) { if (wr == 0) PG8_BAR; }
        if constexpr (!Epi::AFTER_DRAIN) { E(acc, cur, wr, wc, fr, fq); S.done(cur); }
        if (!has_next) break;
#pragma unroll
        for (int a = 0; a < 2; ++a)
#pragma unroll
            for (int b = 0; b < 2; ++b)
#pragma unroll
                for (int m = 0; m < 4; ++m)
#pragma unroll
                    for (int n = 0; n < 2; ++n) acc[a][b][m][n] = (f32x4){0.f, 0.f, 0.f, 0.f};
        cur = nxt; cA = nA; cB = nB; ++ui;
        if constexpr (ALIGN_EPI) { if (wr == 1) PG8_BAR; }
    }
    PG8_WAIT_V(0);
    if constexpr (!ALIGN_EPI) { if (wr == 0) PG8_BAR; }
    PG8_BAR;
    if constexpr (Epi::AFTER_DRAIN) { E.fused(acc, cur, wr, wc, fr, fq, lds, wid, lane); S.done(cur); }
#undef PG8_SA
#undef PG8_SB
#undef PG8_STAGE
#undef PG8_LDA
#undef PG8_LDB
#undef PG8_MMA
#undef PG8_WAIT_V
#undef PG8_WAIT_L
#undef PG8_BAR
#undef PG8_SCHED
}
}

typedef const pg8::f32x4 (&AccRef)[2][2][4][2];
struct EpiSwiglu {
    static constexpr bool PERM = true, AFTER_DRAIN = false;
    bf16_t* H;
    DI void operator()(AccRef acc, const pg8::Unit& u, int wr, int wc, int fr, int fq) const {
        const int row0 = u.pm * 256 + wr * 64 + fr, col = u.pn * 128 + wc * 32 + 8 * fq;
#pragma unroll
        for (int ai = 0; ai < 2; ++ai)
#pragma unroll
            for (int m = 0; m < 4; ++m) {
                const int row = row0 + ai * 128 + m * 16; float f[8];
#pragma unroll
                for (int n = 0; n < 2; ++n)
#pragma unroll
                    for (int e = 0; e < 4; ++e) f[n * 4 + e] = siluf_(acc[ai][0][m][n][e]) * acc[ai][1][m][n][e];
                *(u32x4*)(H + (size_t)row * DFF + col) = pack8(f);
            }
    }
};
struct EpiResid {
    static constexpr bool PERM = true, AFTER_DRAIN = false;
    float* xlat; float* xc; const float* gate; float coef;
    DI void operator()(AccRef acc, const pg8::Unit& u, int wr, int wc, int fr, int fq) const {
        const int r0 = u.pm * 256; const int vec = r0 < NLAT ? (r0 >> 13) : 2;
        const float* gp = gate + vec * 9216;
        float* base = r0 < NLAT ? xlat + (size_t)r0 * DM : xc + (size_t)(r0 - NLAT) * DM;
#pragma unroll
        for (int bj = 0; bj < 2; ++bj) {
            const int col = u.pn * 256 + bj * 128 + wc * 32 + 8 * fq;
            const f32x4 g0 = *(const f32x4*)(gp + col) * coef, g1 = *(const f32x4*)(gp + col + 4) * coef;
#pragma unroll
            for (int ai = 0; ai < 2; ++ai)
#pragma unroll
                for (int m = 0; m < 4; ++m) {
                    float* xp = base + (size_t)(wr * 64 + fr + ai * 128 + m * 16) * DM + col;
                    f32x4 x0 = *(f32x4*)xp, x1 = *(f32x4*)(xp + 4);
                    x0 += g0 * acc[ai][bj][m][0]; x1 += g1 * acc[ai][bj][m][1];
                    *(f32x4*)xp = x0; *(f32x4*)(xp + 4) = x1;
                }
        }
    }
};
struct EpiWin {
    static constexpr bool PERM = true, AFTER_DRAIN = false;
    bf16_t* Z;
    DI void operator()(AccRef acc, const pg8::Unit& u, int wr, int wc, int fr, int fq) const {
        const int row0 = u.pm * 256 + wr * 64 + fr;
#pragma unroll
        for (int bj = 0; bj < 2; ++bj) {
            const int col = u.pn * 256 + bj * 128 + wc * 32 + 8 * fq;
            if (col >= ZW) continue;
            const int mode = (col >= ZC_RL && col < ZC_RL + 128) ? 1 : ((col >= ZC_RL + 256 && col < ZC_AQ) ? 2 : 0);
#pragma unroll
            for (int ai = 0; ai < 2; ++ai)
#pragma unroll
                for (int m = 0; m < 4; ++m) {
                    const int row = row0 + ai * 128 + m * 16; float f[8];
#pragma unroll
                    for (int n = 0; n < 2; ++n)
#pragma unroll
                        for (int e = 0; e < 4; ++e) { float v = acc[ai][bj][m][n][e]; if (mode == 1) v = 1.f - 2.f * __builtin_amdgcn_rcpf(1.f + __expf(2.f * v)); else if (mode == 2) v = sigmoidf_(v); f[n * 4 + e] = v; }
                    *(u32x4*)(Z + (size_t)row * ZW + col) = pack8(f);
                }
        }
    }
};
struct EpiLora {
    static constexpr bool PERM = true, AFTER_DRAIN = false;
    bf16_t* RWA; bf16_t* RG; const float* w0; const float* a0;
    DI void operator()(AccRef acc, const pg8::Unit& u, int wr, int wc, int fr, int fq) const {
        const int row0 = u.pm * 256 + wr * 64 + fr;
#pragma unroll
        for (int bj = 0; bj < 2; ++bj) {
            const int col = u.pn * 256 + bj * 128 + wc * 32 + 8 * fq; const int seg = col >> 9, cc = col & 511;
            const float* bp = seg < 2 ? w0 + seg * 512 + cc : a0 + (seg & 1) * 512 + cc;
#pragma unroll
            for (int ai = 0; ai < 2; ++ai)
#pragma unroll
                for (int m = 0; m < 4; ++m) {
                    const int row = row0 + ai * 128 + m * 16; float f[8];
#pragma unroll
                    for (int n = 0; n < 2; ++n)
#pragma unroll
                        for (int e = 0; e < 4; ++e) {
                            float v = acc[ai][bj][m][n][e] + (seg < 4 ? bp[n * 4 + e] : 0.f);
                            if (seg < 2) { const float ee = 0.60653066f * sigmoidf_(v); v = 1.f - __expf(-ee); } else if (seg < 4) v = sigmoidf_(v);
                            f[n * 4 + e] = v;
                        }
                    if (seg < 4) *(u32x4*)(RWA + (size_t)row * 2048 + col) = pack8(f); else *(u32x4*)(RG + (size_t)row * 512 + cc) = pack8(f);
                    __builtin_amdgcn_sched_barrier(0);
                }
        }
    }
};
struct EpiGate {
    static constexpr bool PERM = true, AFTER_DRAIN = false;
    bf16_t* G;
    DI void operator()(AccRef acc, const pg8::Unit& u, int wr, int wc, int fr, int fq) const {
        const int row0 = u.pm * 256 + wr * 64 + fr;
#pragma unroll
        for (int bj = 0; bj < 2; ++bj) {
            const int col = u.pn * 256 + bj * 128 + wc * 32 + 8 * fq;
#pragma unroll
            for (int ai = 0; ai < 2; ++ai)
#pragma unroll
                for (int m = 0; m < 4; ++m) {
                    const int row = row0 + ai * 128 + m * 16; float f[8];
#pragma unroll
                    for (int n = 0; n < 2; ++n)
#pragma unroll
                        for (int e = 0; e < 4; ++e) f[n * 4 + e] = sigmoidf_(acc[ai][bj][m][n][e]);
                    *(u32x4*)(G + (size_t)row * DM + col) = pack8(f);
                }
        }
    }
};
struct EpiBranch {
    static constexpr bool PERM = true, AFTER_DRAIN = false;
    const bf16_t* G; bf16_t* ZZ; int first;
    DI void operator()(AccRef acc, const pg8::Unit& u, int wr, int wc, int fr, int fq) const {
        const int row0 = u.pm * 256 + wr * 64 + fr;
#pragma unroll
        for (int bj = 0; bj < 2; ++bj) {
            const int col = u.pn * 256 + bj * 128 + wc * 32 + 8 * fq;
#pragma unroll
            for (int ai = 0; ai < 2; ++ai)
#pragma unroll
                for (int m = 0; m < 4; ++m) {
                    const size_t off = (size_t)(row0 + ai * 128 + m * 16) * DM + col; float g[8], o[8], f[8];
                    unpack8(*(const u32x4*)(G + off), g);
                    if (first) {
#pragma unroll
                        for (int e = 0; e < 8; ++e) o[e] = 0.f;
                    } else unpack8(*(const u32x4*)(ZZ + off), o);
#pragma unroll
                    for (int n = 0; n < 2; ++n)
#pragma unroll
                        for (int e = 0; e < 4; ++e) f[n * 4 + e] = o[n * 4 + e] + g[n * 4 + e] * acc[ai][bj][m][n][e];
                    *(u32x4*)(ZZ + off) = pack8(f);
                }
        }
    }
};
struct CtxSplitOrder {
    int nun, G, c, kslice_bytes;
    DI void init(int nslices, int ksl_bytes, int G_, int c_) { nun = nslices * 8; G = G_; c = c_; kslice_bytes = ksl_bytes; }
    DI bool next(int i, pg8::Unit& u) const {
        const long L = (long)i * G + c; if (L >= nun) return false;
        const int ks = (int)L >> 3, t = (int)L & 7; u.pm = 64 + (t >> 2); u.pn = t & 3; u.koff = (size_t)ks * kslice_bytes; return true;
    }
    DI void a_ready(const pg8::Unit&) const {}
    DI void done(const pg8::Unit&) const {}
};
struct EpiPartial {
    static constexpr bool PERM = true, AFTER_DRAIN = false;
    float* P; int kslice_bytes;
    DI void operator()(AccRef acc, const pg8::Unit& u, int wr, int wc, int fr, int fq) const {
        const int ks = (int)(u.koff / (size_t)kslice_bytes);
        float* base = P + ((size_t)ks * 512 + (size_t)(u.pm - 64) * 256) * DM;
#pragma unroll
        for (int bj = 0; bj < 2; ++bj) {
            const int col = u.pn * 256 + bj * 128 + wc * 32 + 8 * fq;
#pragma unroll
            for (int ai = 0; ai < 2; ++ai)
#pragma unroll
                for (int m = 0; m < 4; ++m) {
                    float* xp = base + (size_t)(wr * 64 + fr + ai * 128 + m * 16) * DM + col;
                    *(f32x4*)xp = acc[ai][bj][m][0]; *(f32x4*)(xp + 4) = acc[ai][bj][m][1];
                }
        }
    }
};
template <class Epi> DI void run_gemm_ctx(const int wv, unsigned char* smem, const bf16_t* A, int lda, const bf16_t* Bt, int ldb, int nslices, int kslice, const Epi& E) {
    pg8::Gemm g; g.A = A; g.Bt = Bt; g.M = NTOK; g.N = DM; g.K = launder_s(kslice); g.lda = launder_s(lda); g.ldb = launder_s(ldb); g.tid0 = wv * 64 + lane_id_();
    CtxSplitOrder S; S.init(nslices, kslice * 2, (int)gridDim.x, ((int)gridDim.x - 1) - launder_s((int)blockIdx.x));
    pg8::gemm_phase<Epi, CtxSplitOrder, true, true>((PG8_LAS unsigned char*)smem, g, S, E);
    __syncthreads();
}
template <class Epi> DI void run_gemm(const int wv, unsigned char* smem, const bf16_t* A, int lda, const bf16_t* Bt, int M, int N, int K, const Epi& E) {
    pg8::Gemm g; g.A = A; g.Bt = Bt; g.M = M; g.N = N; g.K = launder_s(K); g.lda = launder_s(lda); g.ldb = g.K; g.tid0 = wv * 64 + lane_id_();
    pg8::StaticOrder S; S.init(M, N, (int)gridDim.x, launder_s((int)blockIdx.x));
    pg8::gemm_phase<Epi, pg8::StaticOrder, true, true>((PG8_LAS unsigned char*)smem, g, S, E);
    __syncthreads();
}

struct Prm {
    const float *x, *c, *ctx, *cctx, *w_ada, *b_ada, *norm_g, *f1gu, *f1dn, *f2gu, *f2dn, *w_in, *m_conv, *m_gb, *m_on, *r_conv, *r_w0, *r_w2, *r_a0, *r_a2, *r_g2,
        *r_kk, *r_ka, *r_rk, *r_lnw, *r_lnb, *a_qkn, *a_lam, *a_subln, *w_br, *w_o;
    float* out; unsigned char* ws; int wv, pad;
};
#define PH_IDS const int tid_l = launder_v(p.wv * 64 + lane_id_()); const int bid_l = launder_s((int)blockIdx.x); (void)tid_l; (void)bid_l;
#define TID tid_l
#define BID bid_l
#define NBLK ((int)gridDim.x)

DI void ph_modpart(const Prm& p, unsigned char* smem) { PH_IDS
    float* sc = (float*)smem; float* modp = (float*)(p.ws + WS_MODP);
    for (int it = BID; it < 576; it += NBLK) {
        const int l = it / 288, r = it % 288, ks = r / 18, cb = r % 18;
        __syncthreads();
        if (TID < 192) { const int v = TID >> 6, k = ks * 64 + (TID & 63); const float cv = v < 2 ? p.c[v * DM + k] : p.cctx[k]; sc[TID] = siluf_(cv); }
        __syncthreads();
        const int col = cb * 512 + TID; float a0 = 0.f, a1 = 0.f, a2 = 0.f;
        const float* w = p.w_ada + ((size_t)l * DM + ks * 64) * 9216 + col;
#pragma unroll 8
        for (int k = 0; k < 64; ++k) { const float wv = w[(size_t)k * 9216]; a0 += sc[k] * wv; a1 += sc[64 + k] * wv; a2 += sc[128 + k] * wv; }
        float* o = modp + ((size_t)(l * 16 + ks) * 3) * 9216 + col; o[0] = a0; o[9216] = a1; o[2 * 9216] = a2;
    }
    __syncthreads();
}
DI void ph_rope(const Prm& p) { PH_IDS
    float* rope = (float*)(p.ws + WS_ROPE);
    for (int i = BID * 512 + TID; i < SEQL * 32; i += NBLK * 512) {
        const int t = i >> 5, pp = i & 31, j = pp & 15;
        const float inv = powf(10000.f, -(float)j / 16.f); const float pos = (float)(pp < 16 ? (t >> 6) : (t & 63)); const float ang = pos * inv;
        rope[2 * i] = cosf(ang); rope[2 * i + 1] = sinf(ang);
    }
}
DI void ph_modreduce(const Prm& p) { PH_IDS
    const float* modp = (const float*)(p.ws + WS_MODP); float* mods = (float*)(p.ws + WS_MODS);
    for (int i = BID * 512 + TID; i < 2 * 3 * 9216; i += NBLK * 512) {
        const int l = i / 27648, rem = i % 27648, v = rem / 9216, col = rem % 9216;
        float s = p.b_ada[l * 9216 + col];
        for (int ks = 0; ks < 16; ++ks) s += modp[((size_t)(l * 16 + ks) * 3 + v) * 9216 + col];
        mods[i] = s;
    }
}
template <int MODE> DI void conv_weight(const Prm& p, const float* src, int ld, int c0, int K, int ncols, bf16_t* dst, unsigned char* smem) { PH_IDS
    float* t = (float*)smem; const int ntk = K / 64, ntn = (ncols + 63) / 64, tx = TID & 63, ty = TID >> 6;
    for (int it = BID; it < ntk * ntn; it += NBLK) {
        const int kt = it % ntk, nt = it / ntk;
        __syncthreads();
#pragma unroll
        for (int i = 0; i < 8; ++i) { const int k = ty * 8 + i, j = nt * 64 + tx; t[k * 65 + tx] = j < ncols ? src[(size_t)(kt * 64 + k) * ld + c0 + j] : 0.f; }
        __syncthreads();
#pragma unroll
        for (int i = 0; i < 8; ++i) {
            const int n = ty * 8 + i, j = nt * 64 + n;
            if (j < ncols) {
                int drow = j;
                if (MODE == 1) drow = j < DFF ? ((j >> 7) * 256 + (j & 127)) : (((j - DFF) >> 7) * 256 + 128 + ((j - DFF) & 127));
                dst[(size_t)drow * K + kt * 64 + tx] = f2bf(t[tx * 65 + n]);
            }
        }
    }
    __syncthreads();
}
DI void conv_ffn(const Prm& p, int l, int which, unsigned char* smem) {
    bf16_t* wt = (bf16_t*)(p.ws + WS_WT);
    conv_weight<1>(p, (which ? p.f2gu : p.f1gu) + (size_t)l * DM * 2 * DFF, 2 * DFF, 0, DM, 2 * DFF, wt + WT_GU, smem);
    conv_weight<0>(p, (which ? p.f2dn : p.f1dn) + (size_t)l * DFF * DM, DM, 0, DFF, DM, wt + WT_DN, smem);
}
DI void conv_mixer(const Prm& p, int l, unsigned char* smem) { PH_IDS
    bf16_t* wt = (bf16_t*)(p.ws + WS_WT);
    conv_weight<0>(p, p.w_in + (size_t)l * DM * DIN, DIN, 0, DM, ZW, wt + WT_IN, smem);
    conv_weight<0>(p, p.w_in + (size_t)l * DM * DIN, DIN, ZW, DM, 3 * DM, wt + WT_G, smem);
    for (int b = 0; b < 3; ++b) conv_weight<0>(p, p.w_br + (size_t)(l * 3 + b) * 512 * DM, DM, 0, 512, DM, wt + WT_P + (size_t)b * DM * 512, smem);
    conv_weight<0>(p, p.w_o + (size_t)l * DM * DM, DM, 0, DM, DM, wt + WT_O, smem);
    bf16_t* wl = wt + WT_L;
    for (int i = BID * 512 + TID; i < 2560 * 384; i += NBLK * 512) {
        const int n = i / 384, k = i % 384, seg = n >> 9, cc = n & 511; float v = 0.f;
        if (seg < 2) { if ((k >> 6) == seg) v = p.r_w2[((size_t)(l * 2 + seg) * 64 + (k & 63)) * 512 + cc]; }
        else if (seg < 4) { if ((k >> 6) == seg) v = p.r_a2[((size_t)(l * 2 + seg - 2) * 64 + (k & 63)) * 512 + cc]; }
        else { if (k >= 256) v = p.r_g2[((size_t)l * 128 + (k - 256)) * 512 + cc]; }
        wl[i] = f2bf(v);
    }
}
DI void ph_norm(const Prm& p, int l, int which, bool first, int nfix = 0, const float* fixgate = nullptr, float fixcoef = 0.f) { PH_IDS
    const int lane = TID & 63, wid = TID >> 6;
    const float* g = p.norm_g + (l * 3 + which) * DM; const float* mods = (const float*)(p.ws + WS_MODS) + (size_t)l * 27648;
    bf16_t* hb = (bf16_t*)(p.ws + WS_RWA); float* xc = (float*)(p.ws + WS_XC);
    for (int row = BID * 8 + wid; row < NTOK; row += NBLK * 8) {
        const int vec = row < NLAT ? (row >> 13) : 2;
        const float* sh = mods + vec * 9216 + (3 * which) * DM; const float* scl = sh + DM;
        float* xd = row < NLAT ? p.out + (size_t)row * DM : xc + (size_t)(row - NLAT) * DM;
        const float* xr = first ? (row < NLAT ? p.x + (size_t)row * DM : p.ctx + (size_t)(row - NLAT) * DM) : xd;
        f32x4 xv[4]; float ss = 0.f;
#pragma unroll
        for (int i = 0; i < 4; ++i) xv[i] = *(const f32x4*)(xr + i * 256 + lane * 4);
        if (nfix > 0 && row >= NLAT) {
            const float* P = (const float*)((const bf16_t*)(p.ws + WS_RWA) + (size_t)NTOK * DM) + (size_t)(row - NLAT) * DM;
#pragma unroll
            for (int i = 0; i < 4; ++i) {
                const int col = i * 256 + lane * 4; f32x4 sp = {0.f, 0.f, 0.f, 0.f};
                for (int ks = 0; ks < nfix; ++ks) sp += *(const f32x4*)(P + (size_t)ks * 512 * DM + col);
                xv[i] += *(const f32x4*)(fixgate + 2 * 9216 + col) * fixcoef * sp;
                *(f32x4*)(xd + col) = xv[i];
            }
        }
#pragma unroll
        for (int i = 0; i < 4; ++i) ss += xv[i][0] * xv[i][0] + xv[i][1] * xv[i][1] + xv[i][2] * xv[i][2] + xv[i][3] * xv[i][3];
        ss = wave_sum(ss); const float rinv = rsqrtf(ss * (1.f / DM) + 1e-6f);
#pragma unroll
        for (int i = 0; i < 4; ++i) {
            const int col = i * 256 + lane * 4;
            if (first) *(f32x4*)(xd + col) = xv[i];
            const f32x4 gv = *(const f32x4*)(g + col), sv = *(const f32x4*)(scl + col), hv = *(const f32x4*)(sh + col);
            float h[4];
#pragma unroll
            for (int e = 0; e < 4; ++e) h[e] = xv[i][e] * rinv * gv[e] * (1.f + sv[e]) + hv[e];
            u32x2 o; o.x = pk2(h[0], h[1]); o.y = pk2(h[2], h[3]);
            *(u32x2*)(hb + (size_t)row * DM + col) = o;
        }
    }
}
DI void ph_zero_ysum(const Prm& p) { PH_IDS
    f32x4* y = (f32x4*)(p.ws + WS_YSUM); const f32x4 zr = {0.f, 0.f, 0.f, 0.f};
    for (int i = BID * 512 + TID; i < NTOK * 128; i += NBLK * 512) y[i] = zr;
}
DI void ph_rkv_conv(const Prm& p, int l) { PH_IDS
    const int lane = TID & 63, wid = TID >> 6;
    const bf16_t* z = (const bf16_t*)(p.ws + WS_Z); bf16_t* tmp = (bf16_t*)(p.ws + WS_RWA); float* invn = (float*)(p.ws + WS_INVN);
    const float* cw = p.r_conv + (size_t)l * 3 * 1536;
    for (int row = BID * 8 + wid; row < NTOK; row += NBLK * 8) {
        const int t = row < NLAT ? (row & 8191) : ((row - NLAT) & 255), L = row < NLAT ? SEQL : CTXL;
        const bool hp = t > 0, hn = t < L - 1;
#pragma unroll
        for (int g = 0; g < 3; ++g) {
            const int ch = g * 512 + lane * 8; const bf16_t* zp = z + (size_t)row * ZW + ZC_RR + ch;
            const u32x4 zero = {0u, 0u, 0u, 0u};
            const u32x4 uc = *(const u32x4*)zp, up = hp ? *(const u32x4*)(zp - ZW) : zero, un = hn ? *(const u32x4*)(zp + ZW) : zero;
            float c[8], pv[8], nx[8], o[8]; unpack8(uc, c); unpack8(up, pv); unpack8(un, nx);
#pragma unroll
            for (int e = 0; e < 8; ++e) o[e] = cw[ch + e] * pv[e] + cw[1536 + ch + e] * c[e] + cw[3072 + ch + e] * nx[e];
            *(u32x4*)(tmp + (size_t)row * 1536 + ch) = pack8(o);
            if (g == 1) {
                float ss = 0.f;
#pragma unroll
                for (int e = 0; e < 8; ++e) { const float kk = o[e] * p.r_kk[l * 512 + lane * 8 + e]; ss += kk * kk; }
                ss += __shfl_xor(ss, 1); ss += __shfl_xor(ss, 2); ss += __shfl_xor(ss, 4);
                if ((lane & 7) == 0) invn[(size_t)row * 8 + (lane >> 3)] = 1.f / fmaxf(sqrtf(ss), 1e-12f);
            }
        }
    }
}
DI void ph_rkv_copy(const Prm& p) { PH_IDS
    const int lane = TID & 63, wid = TID >> 6;
    bf16_t* z = (bf16_t*)(p.ws + WS_Z); const bf16_t* tmp = (const bf16_t*)(p.ws + WS_RWA);
    for (int row = BID * 8 + wid; row < NTOK; row += NBLK * 8)
#pragma unroll
        for (int g = 0; g < 3; ++g) { const int ch = g * 512 + lane * 8; *(u32x4*)(z + (size_t)row * ZW + ZC_RR + ch) = *(const u32x4*)(tmp + (size_t)row * 1536 + ch); }
}
DI void ph_attn_prep(const Prm& p, int l) { PH_IDS
    const int lane = TID & 63, wid = TID >> 6, hw = lane >> 5, pp = lane & 31;
    bf16_t* z = (bf16_t*)(p.ws + WS_Z); const float* rope = (const float*)(p.ws + WS_ROPE); const float* qkn = p.a_qkn + l * 128;
    for (int row = BID * 8 + wid; row < NTOK; row += NBLK * 8) {
        const bool islat = row < NLAT; const int t = row & 8191;
        float cs = 1.f, sn = 0.f; if (islat) { cs = rope[((size_t)t * 32 + pp) * 2]; sn = rope[((size_t)t * 32 + pp) * 2 + 1]; }
#pragma unroll
        for (int it = 0; it < 8; ++it) {
            const int seg = it * 2 + hw, which = seg >> 3, col = (which ? ZC_AK : ZC_AQ) + (seg & 7) * 64 + 2 * pp;
            unsigned* zp = (unsigned*)(z + (size_t)row * ZW + col);
            const unsigned u = *zp; const float x1 = lo16(u), x2 = hi16(u);
            float ss = x1 * x1 + x2 * x2;
            ss += __shfl_xor(ss, 1); ss += __shfl_xor(ss, 2); ss += __shfl_xor(ss, 4); ss += __shfl_xor(ss, 8); ss += __shfl_xor(ss, 16);
            const float rinv = rsqrtf(ss * (1.f / 64.f) + 1e-6f) * (which ? 1.f : 0.125f * 1.4426950408889634f);
            const float y1 = x1 * rinv * qkn[which * 64 + 2 * pp], y2 = x2 * rinv * qkn[which * 64 + 2 * pp + 1];
            *zp = pk2(y1 * cs - y2 * sn, y1 * sn + y2 * cs);
        }
    }
}

#define MFMA16(a, b, c) __builtin_amdgcn_mfma_f32_16x16x32_bf16((a), (b), (c), 0, 0, 0)
#define MFMA32(a, b, c) __builtin_amdgcn_mfma_f32_32x32x16_bf16((a), (b), (c), 0, 0, 0)
DI float wave_incl_scan_add(float v, int lane) {
#pragma unroll
    for (int o = 1; o < 64; o <<= 1) { const float t = __shfl_up(v, o); if (lane >= o) v += t; }
    return v;
}
DI float wave_incl_scan_max(float v, int lane) {
#pragma unroll
    for (int o = 1; o < 64; o <<= 1) { const float t = __shfl_up(v, o); if (lane >= o) v = fmaxf(v, t); }
    return v;
}
DI float mconv(const bf16_t* z, const float* cw, size_t row, int t, int L, int ch) {
    const bf16_t* zp = z + row * ZW + ch;
    float a = cw[512 + ch] * bf2f(zp[0]);
    if (t > 0) a += cw[ch] * bf2f(zp[-ZW]);
    if (t < L - 1) a += cw[1024 + ch] * bf2f(zp[ZW]);
    return siluf_(a);
}
DI void mconv8(const bf16_t* z, const float* cw, size_t row, int t, int L, int ch, float* out) {
    const bf16_t* zp = z + row * ZW + ch; const u32x4 zero = {0u, 0u, 0u, 0u};
    const u32x4 uc = *(const u32x4*)zp, up = t > 0 ? *(const u32x4*)(zp - ZW) : zero, un = t < L - 1 ? *(const u32x4*)(zp + ZW) : zero;
    float c[8], pv[8], nx[8]; unpack8(uc, c); unpack8(up, pv); unpack8(un, nx);
#pragma unroll
    for (int e = 0; e < 8; ++e) out[e] = siluf_(cw[ch + e] * pv[e] + cw[512 + ch + e] * c[e] + cw[1024 + ch + e] * nx[e]);
}
DI void ph_mlstm_a(const Prm& p, int l, unsigned char* smem) { PH_IDS
    const int lane = TID & 63, wid = TID >> 6;
    const bf16_t* z = (const bf16_t*)(p.ws + WS_Z); bf16_t* mst = (bf16_t*)(p.ws + WS_MST); float* msc = (float*)(p.ws + WS_MSC); float* mn = (float*)(p.ws + WS_MN);
    const float* cw = p.m_conv + (size_t)l * 3 * 512; const float* gb = p.m_gb + l * 16;
    bf16_t* kT = (bf16_t*)smem; bf16_t* vT = (bf16_t*)(smem + 9216); float* wsl = (float*)(smem + 9216 + 18432);
    for (int u = BID; u < 2112; u += NBLK) {
        const int d = u / 1056, r = u % 1056, b = r / 528, h = (r % 528) / NCHK, c = r % NCHK;
        const int slot = ((d * 2 + b) * 4 + h) * NCHK + c;
        const bool isctx = c < 4; const int cs = isctx ? c : c - 4, nch = isctx ? 4 : 128, oc = d ? nch - 1 - cs : cs, L = isctx ? CTXL : SEQL;
        const size_t base = isctx ? (size_t)NLAT + b * CTXL + oc * 64 : (size_t)b * SEQL + oc * 64;
        __syncthreads();
        if (wid == 0) {
            const int o = d ? 63 - lane : lane; const bf16_t* zr = z + (base + o) * ZW + ZC_MG + 8 * d + h;
            const float ig = bf2f(zr[0]) + gb[(2 * d) * 4 + h], lf = logsigf_(bf2f(zr[4]) + gb[(2 * d + 1) * 4 + h]);
            const float bc = wave_incl_scan_add(lf, lane), bt = __shfl(bc, 63), wl = bt - bc + ig, ml = wave_max(wl);
            wsl[lane] = __expf(wl - ml);
            if (lane == 0) { msc[slot * 4] = bt; msc[slot * 4 + 1] = ml; }
        }
        __syncthreads();
        {
            const int pp = TID >> 3, g = TID & 7, o = d ? 63 - pp : pp; float kv[8];
            mconv8(z, cw, base + o, oc * 64 + o, L, 256 + h * 64 + g * 8, kv);
#pragma unroll
            for (int e = 0; e < 8; ++e) kT[(g * 8 + e) * 72 + pp] = f2bf(kv[e] * 0.125f);
        }
#pragma unroll
        for (int i = 0; i < 2; ++i) {
            const int idx = TID + 512 * i, pp = idx >> 4, g = idx & 15, o = d ? 63 - pp : pp; float vv8[8];
            unpack8(*(const u32x4*)(z + (base + o) * ZW + ZC_MV + h * 128 + g * 8), vv8); const float wv = wsl[pp];
#pragma unroll
            for (int e = 0; e < 8; ++e) vT[(g * 8 + e) * 72 + pp] = f2bf(vv8[e] * wv);
        }
        __syncthreads();
        f32x4 acc[4];
#pragma unroll
        for (int nt = 0; nt < 4; ++nt) acc[nt] = (f32x4){0.f, 0.f, 0.f, 0.f};
#pragma unroll
        for (int ks = 0; ks < 2; ++ks) {
            const bf16x8 a = *(const bf16x8*)(vT + (16 * wid + (lane & 15)) * 72 + ks * 32 + (lane >> 4) * 8);
#pragma unroll
            for (int nt = 0; nt < 4; ++nt) { const bf16x8 bb = *(const bf16x8*)(kT + (16 * nt + (lane & 15)) * 72 + ks * 32 + (lane >> 4) * 8); acc[nt] = MFMA16(a, bb, acc[nt]); }
        }
#pragma unroll
        for (int nt = 0; nt < 4; ++nt)
#pragma unroll
            for (int j = 0; j < 4; ++j) mst[(size_t)slot * 8192 + (16 * wid + (lane >> 4) * 4 + j) * 64 + 16 * nt + (lane & 15)] = f2bf(acc[nt][j]);
        if (TID < 64) { float s = 0.f; for (int pp = 0; pp < 64; ++pp) s += wsl[pp] * bf2f(kT[TID * 72 + pp]); mn[slot * 64 + TID] = s; }
    }
    __syncthreads();
}
DI void ph_mlstm_b(const Prm& p) { PH_IDS
    bf16_t* mst = (bf16_t*)(p.ws + WS_MST); float* msc = (float*)(p.ws + WS_MSC); float* mn = (float*)(p.ws + WS_MN);
    for (int e = BID * 512 + TID; e < 16 * 8256; e += NBLK * 512) {
        const int chain = e / 8256, idx = e % 8256; float m = 0.f, C = 0.f;
        for (int c0 = 0; c0 < NCHK; c0 += 22) {
            float uu[22], bt[22], ml[22];
#pragma unroll
            for (int j = 0; j < 22; ++j) {
                const int slot = chain * NCHK + c0 + j; bt[j] = msc[slot * 4]; ml[j] = msc[slot * 4 + 1];
                uu[j] = idx < 8192 ? bf2f(mst[(size_t)slot * 8192 + idx]) : mn[slot * 64 + idx - 8192];
            }
#pragma unroll
            for (int j = 0; j < 22; ++j) {
                const int slot = chain * NCHK + c0 + j;
                if (idx < 8192) mst[(size_t)slot * 8192 + idx] = f2bf(C); else mn[slot * 64 + idx - 8192] = C;
                if (idx == 0) msc[slot * 4 + 2] = m;
                const float mnew = fmaxf(bt[j] + m, ml[j]);
                C = __expf(bt[j] + m - mnew) * C + __expf(ml[j] - mnew) * uu[j]; m = mnew;
            }
        }
    }
}
DI void ph_mlstm_c(const Prm& p, int l, unsigned char* smem, int ubeg, int ustride, int ucount = 1 << 30) { PH_IDS
    const int lane = TID & 63, wid = TID >> 6;
    bf16_t* z = (bf16_t*)(p.ws + WS_Z); const bf16_t* mst = (const bf16_t*)(p.ws + WS_MST); const float* msc = (const float*)(p.ws + WS_MSC); const float* mn = (const float*)(p.ws + WS_MN);
    const float* cw = p.m_conv + (size_t)l * 3 * 512; const float* gb = p.m_gb + l * 16;
    bf16_t* qs = (bf16_t*)smem; bf16_t* ks_ = (bf16_t*)(smem + 9216); bf16_t* vT = (bf16_t*)(smem + 18432); bf16_t* Sp = (bf16_t*)(smem + 36864);
    float* hsum = (float*)(smem + 46080); float* fa = (float*)(smem + 46080 + 33792);
    float *bcum = fa, *gg = fa + 64, *Mrow = fa + 128, *iw = fa + 192, *den = fa + 256, *nq = fa + 320;
    for (int u = ubeg, un = 0; u < 1056 && un < ucount; u += ustride, ++un) {
        const int b = u / 528, h = (u % 528) / NCHK, cc = u % NCHK;
        const bool isctx = cc < 4; const int oc = isctx ? cc : cc - 4, nch = isctx ? 4 : 128, L = isctx ? CTXL : SEQL;
        const size_t base = isctx ? (size_t)NLAT + b * CTXL + oc * 64 : (size_t)b * SEQL + oc * 64;
        for (int d = 0; d < 2; ++d) {
            const int cs = d ? nch - 1 - oc : oc, c = isctx ? cs : cs + 4, slot = ((d * 2 + b) * 4 + h) * NCHK + c;
            const float mst_m = msc[slot * 4 + 2];
            __syncthreads();
            if (wid == 0) {
                const int o = d ? 63 - lane : lane; const bf16_t* zr = z + (base + o) * ZW + ZC_MG + 8 * d + h;
                const float ig = bf2f(zr[0]) + gb[(2 * d) * 4 + h], lf = logsigf_(bf2f(zr[4]) + gb[(2 * d + 1) * 4 + h]);
                const float bc = wave_incl_scan_add(lf, lane), g = ig - bc, pm = wave_incl_scan_max(g, lane), M = fmaxf(mst_m, pm);
                bcum[lane] = bc; gg[lane] = g; Mrow[lane] = M; iw[lane] = __expf(mst_m - M);
            }
#pragma unroll
            for (int i = 0; i < 2; ++i) {
                const int idx = TID + 512 * i, pp = idx >> 4, g = idx & 15, isk = g >> 3, dq0 = (g & 7) * 8, o = d ? 63 - pp : pp; float qv[8];
                mconv8(z, cw, base + o, oc * 64 + o, L, isk * 256 + h * 64 + dq0, qv);
                if (isk) {
#pragma unroll
                    for (int e = 0; e < 8; ++e) qv[e] *= 0.125f;
                }
                *(u32x4*)((isk ? ks_ : qs) + pp * 72 + dq0) = pack8(qv);
            }
#pragma unroll
            for (int i = 0; i < 2; ++i) {
                const int idx = TID + 512 * i, pp = idx >> 4, g = idx & 15, o = d ? 63 - pp : pp;
                const u32x4 uv = *(const u32x4*)(z + (base + o) * ZW + ZC_MV + h * 128 + g * 8);
                vT[(g * 8 + 0) * 72 + pp] = (bf16_t)(uv.x & 0xffffu); vT[(g * 8 + 1) * 72 + pp] = (bf16_t)(uv.x >> 16);
                vT[(g * 8 + 2) * 72 + pp] = (bf16_t)(uv.y & 0xffffu); vT[(g * 8 + 3) * 72 + pp] = (bf16_t)(uv.y >> 16);
                vT[(g * 8 + 4) * 72 + pp] = (bf16_t)(uv.z & 0xffffu); vT[(g * 8 + 5) * 72 + pp] = (bf16_t)(uv.z >> 16);
                vT[(g * 8 + 6) * 72 + pp] = (bf16_t)(uv.w & 0xffffu); vT[(g * 8 + 7) * 72 + pp] = (bf16_t)(uv.w >> 16);
            }
            __syncthreads();
            {
                const int mt = wid >> 1;
#pragma unroll
                for (int nn = 0; nn < 2; ++nn) {
                    const int nt = 2 * (wid & 1) + nn; f32x4 acc = {0.f, 0.f, 0.f, 0.f};
#pragma unroll
                    for (int ks = 0; ks < 2; ++ks) {
                        const bf16x8 a = *(const bf16x8*)(qs + (16 * mt + (lane & 15)) * 72 + ks * 32 + (lane >> 4) * 8);
                        const bf16x8 bb = *(const bf16x8*)(ks_ + (16 * nt + (lane & 15)) * 72 + ks * 32 + (lane >> 4) * 8);
                        acc = MFMA16(a, bb, acc);
                    }
                    const int s = 16 * nt + (lane & 15);
#pragma unroll
                    for (int j = 0; j < 4; ++j) { const int pp = 16 * mt + (lane >> 4) * 4 + j; const float v = s <= pp ? acc[j] * __expf(gg[s] - Mrow[pp]) : 0.f; Sp[pp * 72 + s] = f2bf(v); }
                }
                if (TID < 64) { float s = 0.f; for (int dq = 0; dq < 64; ++dq) s += mn[slot * 64 + dq] * bf2f(qs[TID * 72 + dq]); nq[TID] = s; }
            }
            __syncthreads();
            if (TID < 64) { float s = 0.f; for (int k = 0; k < 64; ++k) s += bf2f(Sp[TID * 72 + k]); den[TID] = s + iw[TID] * nq[TID]; }
            f32x4 a1[4], a2[4];
#pragma unroll
            for (int mt = 0; mt < 4; ++mt) { a1[mt] = (f32x4){0.f, 0.f, 0.f, 0.f}; a2[mt] = (f32x4){0.f, 0.f, 0.f, 0.f}; }
#pragma unroll
            for (int ks = 0; ks < 2; ++ks) {
                const bf16x8 bv = *(const bf16x8*)(vT + (16 * wid + (lane & 15)) * 72 + ks * 32 + (lane >> 4) * 8);
                const bf16x8 bc = *(const bf16x8*)(mst + (size_t)slot * 8192 + (16 * wid + (lane & 15)) * 64 + ks * 32 + (lane >> 4) * 8);
#pragma unroll
                for (int mt = 0; mt < 4; ++mt) {
                    const bf16x8 as = *(const bf16x8*)(Sp + (16 * mt + (lane & 15)) * 72 + ks * 32 + (lane >> 4) * 8);
                    const bf16x8 aq = *(const bf16x8*)(qs + (16 * mt + (lane & 15)) * 72 + ks * 32 + (lane >> 4) * 8);
                    a1[mt] = MFMA16(as, bv, a1[mt]); a2[mt] = MFMA16(aq, bc, a2[mt]);
                }
            }
            __syncthreads();
            {
                const int vv = 16 * wid + (lane & 15);
#pragma unroll
                for (int mt = 0; mt < 4; ++mt)
#pragma unroll
                    for (int j = 0; j < 4; ++j) {
                        const int pp = 16 * mt + (lane >> 4) * 4 + j, o = d ? 63 - pp : pp;
                        const float val = (a1[mt][j] + iw[pp] * a2[mt][j]) / fmaxf(fabsf(den[pp]), __expf(-(bcum[pp] + Mrow[pp])));
                        if (d == 0) hsum[o * 132 + vv] = val; else hsum[o * 132 + vv] += val;
                    }
            }
        }
        __syncthreads();
#pragma unroll
        for (int i = 0; i < 8; ++i) {
            const int o = wid * 8 + i; const float x0 = hsum[o * 132 + lane], x1 = hsum[o * 132 + lane + 64];
            const float ss = wave_sum(x0 * x0 + x1 * x1), rinv = rsqrtf(ss * (1.f / 128.f) + 1e-6f);
            bf16_t* zo = z + (base + o) * ZW + ZC_MO + h * 128; const float* on = p.m_on + l * 512 + h * 128;
            zo[lane] = f2bf(x0 * rinv * on[lane] * sigmoidf_(bf2f(zo[lane])));
            zo[lane + 64] = f2bf(x1 * rinv * on[lane + 64] * sigmoidf_(bf2f(zo[lane + 64])));
        }
    }
    __syncthreads();
}
DI int swap23(int s) { return (s & ~12) | ((s & 4) << 1) | ((s & 8) >> 1); }
DI void ph_attn(const Prm& p, int l, unsigned char* smem, int bh, int qfirst, int qstep, int nq, int qextra) { PH_IDS
    const int lane = TID & 63, wid = TID >> 6, q = lane & 31, hh = lane >> 5, qg = wid >> 1, mp = wid & 1, grp = wid >> 2;
    bf16_t* z = (bf16_t*)(p.ws + WS_Z);
    float lam; const float lam_init = 0.8f - 0.6f * expf(-0.3f * (float)l);
    { const float* lp = p.a_lam + l * 256; float s1 = 0.f, s2 = 0.f; for (int i = 0; i < 64; ++i) { s1 += lp[i] * lp[64 + i]; s2 += lp[128 + i] * lp[192 + i]; } lam = expf(s1) - expf(s2) + lam_init; }
    bf16_t* Qs = (bf16_t*)smem; float* ex = (float*)smem;
    constexpr int KB_OFF = 34816, VT_OFF = 69632;
    float kmax = 0.f; { const float* gk = p.a_qkn + l * 128 + 64; for (int i = 0; i < 64; ++i) kmax = fmaxf(kmax, fabsf(gk[i])); kmax *= 8.f; }
#define ATT_BAR asm volatile("s_waitcnt lgkmcnt(0)\n\ts_barrier" ::: "memory")
    for (int ui = 0; ui < nq + (qextra >= 0 ? 1 : 0); ++ui) {
        const int qi = ui < nq ? qfirst + ui * qstep : qextra;
        const int b = bh >> 2, head = bh & 3; int nt; size_t qrow0;
        const bool lat = qi < 64;
        if (lat) { qrow0 = (size_t)b * SEQL + qi * 128; nt = 132; } else { qrow0 = (size_t)NLAT + b * CTXL + (qi - 64) * 128; nt = 4; }
        __syncthreads();
#pragma unroll
        for (int i = 0; i < 4; ++i) { const int idx = TID + 512 * i, r = idx >> 4, cp = idx & 15; *(u32x4*)(Qs + r * 136 + cp * 8) = *(const u32x4*)(z + (qrow0 + r) * ZW + ZC_AQ + head * 128 + cp * 8); }
        u32x4 kreg[2], vreg[2];
        const int kp = TID & 31, vg = TID >> 5;
#define ATT_KROW0(j) ((lat && (j) >= 4) ? (size_t)b * SEQL + 64 * ((j) - 4) : (size_t)NLAT + b * CTXL + 64 * (j))
#define ATT_LOADK(j) do { const size_t kr0 = ATT_KROW0(j); \
            _Pragma("unroll") for (int i = 0; i < 2; ++i) { const int idx = TID + 512 * i, r = idx >> 4, cp = idx & 15; kreg[i] = *(const u32x4*)(z + (kr0 + r) * ZW + ZC_AK + head * 128 + cp * 8); } } while (0)
#define ATT_LOADV(j) do { const size_t kr0 = ATT_KROW0(j); \
            _Pragma("unroll") for (int i = 0; i < 2; ++i) vreg[i] = *(const u32x4*)(z + (kr0 + 2 * kp + i) * ZW + ZC_AV + head * 128 + 8 * vg); } while (0)
#define ATT_WRITEK(buf) do { bf16_t* Kw = (bf16_t*)(smem + KB_OFF + (buf) * 17408); \
            _Pragma("unroll") for (int i = 0; i < 2; ++i) { const int idx = TID + 512 * i, r = idx >> 4, cp = idx & 15; *(u32x4*)(Kw + r * 136 + cp * 8) = kreg[i]; } } while (0)
#define ATT_WRITEV(buf) do { bf16_t* Vw = (bf16_t*)(smem + VT_OFF + (buf) * 18432); \
            _Pragma("unroll") for (int w = 0; w < 4; ++w) { \
                *(unsigned*)(Vw + (8 * vg + 2 * w) * 72 + 2 * kp) = (vreg[0][w] & 0xffffu) | (vreg[1][w] << 16); \
                *(unsigned*)(Vw + (8 * vg + 2 * w + 1) * 72 + 2 * kp) = (vreg[0][w] >> 16) | (vreg[1][w] & 0xffff0000u); } } while (0)
        f32x16 o[4]; float lrun = 0.f; bf16x8 pf[4];
        float mfix;
        { __syncthreads(); float qq = 0.f;
#pragma unroll
          for (int c8 = 0; c8 < 8; ++c8) { float f8[8]; unpack8(*(const u32x4*)(Qs + (32 * qg + q) * 136 + mp * 64 + c8 * 8), f8);
#pragma unroll
              for (int e = 0; e < 8; ++e) qq += f8[e] * f8[e]; }
          mfix = sqrtf(qq) * kmax * 1.01f + 0.01f; }
#pragma unroll
        for (int dvb = 0; dvb < 4; ++dvb)
#pragma unroll
            for (int i = 0; i < 16; ++i) o[dvb][i] = 0.f;
#define ATT_QK(j) do { const bf16_t* Kb = (const bf16_t*)(smem + KB_OFF + ((j) & 1) * 17408); \
            f32x16 s0, s1; \
            _Pragma("unroll") for (int i = 0; i < 16; ++i) { s0[i] = 0.f; s1[i] = 0.f; } \
            _Pragma("unroll") for (int kk = 0; kk < 4; ++kk) { \
                const bf16x8 qf = *(const bf16x8*)(Qs + (32 * qg + q) * 136 + mp * 64 + kk * 16 + hh * 8); \
                const bf16x8 k0 = *(const bf16x8*)(Kb + swap23(q) * 136 + mp * 64 + kk * 16 + hh * 8); \
                const bf16x8 k1 = *(const bf16x8*)(Kb + (32 + swap23(q)) * 136 + mp * 64 + kk * 16 + hh * 8); \
                s0 = MFMA32(k0, qf, s0); s1 = MFMA32(k1, qf, s1); } \
            const float mnew = mfix; \
            f32x2 ps = {0.f, 0.f}; \
            _Pragma("unroll") for (int i = 0; i < 16; i += 2) { s0[i] = __builtin_amdgcn_exp2f(s0[i] - mnew); s0[i + 1] = __builtin_amdgcn_exp2f(s0[i + 1] - mnew); s1[i] = __builtin_amdgcn_exp2f(s1[i] - mnew); s1[i + 1] = __builtin_amdgcn_exp2f(s1[i + 1] - mnew); \
                const f32x2 a2 = {s0[i], s0[i + 1]}, b2 = {s1[i], s1[i + 1]}; ps += a2 + b2; } \
            lrun += ps.x + ps.y; \
            _Pragma("unroll") for (int cc = 0; cc < 2; ++cc) { u32x4 a, c2; \
                a.x = pk2(s0[8 * cc], s0[8 * cc + 1]); a.y = pk2(s0[8 * cc + 2], s0[8 * cc + 3]); a.z = pk2(s0[8 * cc + 4], s0[8 * cc + 5]); a.w = pk2(s0[8 * cc + 6], s0[8 * cc + 7]); \
                c2.x = pk2(s1[8 * cc], s1[8 * cc + 1]); c2.y = pk2(s1[8 * cc + 2], s1[8 * cc + 3]); c2.z = pk2(s1[8 * cc + 4], s1[8 * cc + 5]); c2.w = pk2(s1[8 * cc + 6], s1[8 * cc + 7]); \
                pf[cc] = __builtin_bit_cast(bf16x8, a); pf[2 + cc] = __builtin_bit_cast(bf16x8, c2); } } while (0)
#define ATT_PV(j) do { const bf16_t* Vt = (const bf16_t*)(smem + VT_OFF + ((j) & 1) * 18432); \
            _Pragma("unroll") for (int dvb = 0; dvb < 4; ++dvb) _Pragma("unroll") for (int c = 0; c < 4; ++c) { \
                const bf16x8 vf = *(const bf16x8*)(Vt + (dvb * 32 + q) * 72 + 16 * c + 8 * hh); o[dvb] = MFMA32(vf, pf[c], o[dvb]); } } while (0)
        ATT_LOADK(0); ATT_LOADV(0); ATT_WRITEK(0); ATT_WRITEV(0);
        __syncthreads();
        for (int j = 0; j < nt; ++j) {
            if (j + 1 < nt) { ATT_LOADK(j + 1); ATT_LOADV(j + 1); }
            ATT_QK(j); ATT_PV(j);
            if (j + 1 < nt) { ATT_WRITEK((j + 1) & 1); ATT_WRITEV((j + 1) & 1); }
            __syncthreads();
        }
        const float lsum = lrun + __shfl_xor(lrun, 32);
        const float inv = (mp ? lam : 1.f) / lsum;
        if (mp) {
#pragma unroll
            for (int dvb = 0; dvb < 4; ++dvb)
#pragma unroll
                for (int i = 0; i < 16; ++i) ex[(qg * 64 + dvb * 16 + i) * 64 + lane] = o[dvb][i] * inv;
        }
        __syncthreads();
        if (!mp) {
            float ss = 0.f;
#pragma unroll
            for (int dvb = 0; dvb < 4; ++dvb)
#pragma unroll
                for (int i = 0; i < 16; ++i) { const float v = o[dvb][i] * inv - ex[(qg * 64 + dvb * 16 + i) * 64 + lane]; o[dvb][i] = v; ss += v * v; }
            ss += __shfl_xor(ss, 32);
            const float rinv = rsqrtf(ss * (1.f / 128.f) + 1e-6f) * (1.f - lam_init);
            bf16_t* orow = z + (qrow0 + 32 * qg + q) * ZW + ZC_AQ + head * 128; const float* sub = p.a_subln + l * 128;
#pragma unroll
            for (int dvb = 0; dvb < 4; ++dvb)
#pragma unroll
                for (int ig = 0; ig < 4; ++ig) {
                    const int dv0 = dvb * 32 + 8 * ig + 4 * hh; u32x2 w;
                    w.x = pk2(o[dvb][4 * ig] * rinv * sub[dv0], o[dvb][4 * ig + 1] * rinv * sub[dv0 + 1]);
                    w.y = pk2(o[dvb][4 * ig + 2] * rinv * sub[dv0 + 2], o[dvb][4 * ig + 3] * rinv * sub[dv0 + 3]);
                    *(u32x2*)(orow + dv0) = w;
                }
        }
    }
    __syncthreads();
}

__device__ unsigned long long g_pacc[4];
template <int CTRL> DI float dppf(float v) { return __int_as_float(__builtin_amdgcn_update_dpp(0, __float_as_int(v), CTRL, 0xf, 0xf, false)); }
DI float allreduce16(float x) { x += dppf<0x128>(x); x += dppf<0x124>(x); x += dppf<0x122>(x); x += dppf<0x121>(x); return x; }
DI void ph_rwkv_scan(const Prm& p, int l, unsigned char* smem, int ubeg, int ustride) { PH_IDS
    const int lane = TID & 63, wid = TID >> 6;
    const bf16_t* z = (const bf16_t*)(p.ws + WS_Z); const bf16_t* rwa = (const bf16_t*)(p.ws + WS_RWA); const float* invn = (const float*)(p.ws + WS_INVN);
    constexpr int TC = 32, OPW = 336, NC = 264, OPS_B = TC * OPW * 4, YP_OFF = 2 * OPS_B;
    for (int u = ubeg; u < 128; u += ustride) {
        const int chain = u >> 2, qr = u & 3, d = chain >> 4, b = (chain >> 3) & 1, h = chain & 7;
        const float ckk = p.r_kk[l * 512 + h * 64 + lane], cka = p.r_ka[l * 512 + h * 64 + lane];
        bf16_t* ydir = (bf16_t*)(p.ws + WS_YSUM) + (size_t)d * NTOK * 512;
#define RW_ROW(ck, i) ((ck) < 8 ? (size_t)NLAT + b * CTXL + (d ? CTXL - 1 - ((ck) * TC + (i)) : ((ck) * TC + (i))) : (size_t)b * SEQL + (d ? SEQL - 1 - (((ck) - 8) * TC + (i)) : (((ck) - 8) * TC + (i))))
        bf16_t g_r[8], g_k[8], g_u[8], g_a[8]; float g_i[8]; unsigned g_v;
        const int sw = wid - 4, st = TID - 256;
#define RW_LOAD(ck) do { _Pragma("unroll") for (int jj = 0; jj < 8; ++jj) { const size_t row = RW_ROW(ck, sw + 4 * jj); \
            g_r[jj] = z[row * ZW + ZC_RR + h * 64 + lane]; g_k[jj] = z[row * ZW + ZC_RK + h * 64 + lane]; \
            g_u[jj] = rwa[row * 2048 + d * 512 + h * 64 + lane]; g_a[jj] = rwa[row * 2048 + 1024 + d * 512 + h * 64 + lane]; g_i[jj] = invn[row * 8 + h]; } \
            g_v = *(const unsigned*)(z + RW_ROW(ck, st >> 3) * ZW + ZC_RV + h * 64 + qr * 16 + (st & 7) * 2); } while (0)
#define RW_WRITE(buf) do { float* ops = (float*)(smem + (buf) * OPS_B); _Pragma("unroll") for (int jj = 0; jj < 8; ++jj) { \
            const float k = bf2f(g_k[jj]), a = bf2f(g_a[jj]), kk = k * ckk * g_i[jj]; float* o = ops + (sw + 4 * jj) * OPW; \
            o[lane] = 1.f - bf2f(g_u[jj]); o[64 + lane] = kk; o[128 + lane] = kk * a; o[192 + lane] = k * (1.f + (a - 1.f) * cka); o[256 + lane] = bf2f(g_r[jj]); } \
            { float* o = ops + (st >> 3) * OPW + 320 + (st & 7) * 2; o[0] = lo16(g_v); o[1] = hi16(g_v); } } while (0)
        __syncthreads();
        if (wid >= 4) { RW_LOAD(0); RW_WRITE(0); RW_LOAD(1); }
        __syncthreads();
        f32x2 Sa = {0.f, 0.f}, Sb = {0.f, 0.f};
        const int rl = (wid & 3) * 4 + (lane >> 4), ksub = lane & 15;
        float* ypw = (float*)(smem + YP_OFF) + (wid & 3) * (TC * 64);
        for (int ck = 0; ck < NC; ++ck) {
            if (wid >= 4) {
                if (ck + 1 < NC) RW_WRITE((ck + 1) & 1);
                if (ck + 2 < NC) RW_LOAD(ck + 2);
            } else {
                const float* ops = (const float*)(smem + (ck & 1) * OPS_B);
#define RW_GET(X, i) do { const float* o_ = ops + (i) * OPW; w_##X = *(const f32x4*)(o_ + 4 * ksub); k_##X = *(const f32x4*)(o_ + 64 + 4 * ksub); b_##X = *(const f32x4*)(o_ + 128 + 4 * ksub); \
                d_##X = *(const f32x4*)(o_ + 192 + 4 * ksub); r_##X = *(const f32x4*)(o_ + 256 + 4 * ksub); v_##X = o_[320 + rl]; } while (0)
#define RW_STEP(X, i) do { const f32x2 ka = {k_##X[0], k_##X[1]}, kb = {k_##X[2], k_##X[3]}, ra = {r_##X[0], r_##X[1]}, rb = {r_##X[2], r_##X[3]}; \
                const f32x2 ba = {b_##X[0], b_##X[1]}, bb = {b_##X[2], b_##X[3]}, da = {d_##X[0], d_##X[1]}, db = {d_##X[2], d_##X[3]}, wa = {w_##X[0], w_##X[1]}, wb = {w_##X[2], w_##X[3]}; \
                const f32x2 dt2 = Sa * ka + Sb * kb; const f32x2 qa = Sa * wa + da * v_##X, qb = Sb * wb + db * v_##X; const float sa = -allreduce16(dt2.x + dt2.y); \
                Sa = ba * sa + qa; Sb = bb * sa + qb; \
                const f32x2 y2 = Sa * ra + Sb * rb; \
                ypw[(i) * 64 + lane] = y2.x + y2.y; } while (0)
                f32x4 w_A, k_A, b_A, d_A, r_A, w_B, k_B, b_B, d_B, r_B, w_C, k_C, b_C, d_C, r_C, w_D, k_D, b_D, d_D, r_D; float v_A, v_B, v_C, v_D;
                RW_GET(A, 0); RW_GET(B, 1);
#pragma unroll 1
                for (int i = 0; i < TC; i += 4) {
                    RW_GET(C, i + 2);
                    RW_STEP(A, i);
                    RW_GET(D, i + 3);
                    RW_STEP(B, i + 1);
                    if (i + 4 < TC) RW_GET(A, i + 4);
                    RW_STEP(C, i + 2);
                    if (i + 4 < TC) RW_GET(B, i + 5);
                    RW_STEP(D, i + 3);
                }
                {
                    const int i = lane >> 1, rw = (lane & 1) * 2;
                    const f32x4* y4 = (const f32x4*)(ypw + i * 64 + rw * 16);
                    const f32x4 s4 = (y4[0] + y4[1]) + (y4[2] + y4[3]), t4 = (y4[4] + y4[5]) + (y4[6] + y4[7]);
                    *(unsigned*)(ydir + RW_ROW(ck, i) * 512 + h * 64 + qr * 16 + wid * 4 + rw) = pk2((s4[0] + s4[1]) + (s4[2] + s4[3]), (t4[0] + t4[1]) + (t4[2] + t4[3]));
                }
            }
            asm volatile("s_waitcnt lgkmcnt(0)\n\ts_barrier" ::: "memory");
        }
    }
    __syncthreads();
}
DI void ph_rwkv_post(const Prm& p, int l) { PH_IDS
    const int lane = TID & 63, wid = TID >> 6, ch0 = lane * 8;
    bf16_t* z = (bf16_t*)(p.ws + WS_Z); const bf16_t* ysum = (const bf16_t*)(p.ws + WS_YSUM); const bf16_t* rg = (const bf16_t*)(p.ws + WS_RG);
    for (int row = BID * 8 + wid; row < NTOK; row += NBLK * 8) {
        float y[8], y2[8], r[8], k[8], v[8], g[8], o[8];
        unpack8(*(const u32x4*)(ysum + (size_t)row * 512 + ch0), y); unpack8(*(const u32x4*)(ysum + (size_t)(NTOK + row) * 512 + ch0), y2);
#pragma unroll
        for (int e = 0; e < 8; ++e) y[e] += y2[e];
        bf16_t* zr = z + (size_t)row * ZW + ZC_RR + ch0;
        unpack8(*(const u32x4*)zr, r); unpack8(*(const u32x4*)(zr + 512), k); unpack8(*(const u32x4*)(zr + 1024), v); unpack8(*(const u32x4*)(rg + (size_t)row * 512 + ch0), g);
        float s = 0.f, bs = 0.f;
#pragma unroll
        for (int e = 0; e < 8; ++e) { s += y[e]; bs += r[e] * k[e] * p.r_rk[l * 512 + ch0 + e]; }
        s += __shfl_xor(s, 1); s += __shfl_xor(s, 2); s += __shfl_xor(s, 4); bs += __shfl_xor(bs, 1); bs += __shfl_xor(bs, 2); bs += __shfl_xor(bs, 4);
        const float mu = s * (1.f / 64.f); float vs = 0.f;
#pragma unroll
        for (int e = 0; e < 8; ++e) { const float dlt = y[e] - mu; vs += dlt * dlt; }
        vs += __shfl_xor(vs, 1); vs += __shfl_xor(vs, 2); vs += __shfl_xor(vs, 4);
        const float rstd = rsqrtf(vs * (1.f / 64.f) + 64e-5f);
#pragma unroll
        for (int e = 0; e < 8; ++e) o[e] = ((y[e] - mu) * rstd * p.r_lnw[l * 512 + ch0 + e] + p.r_lnb[l * 512 + ch0 + e] + bs * v[e]) * g[e];
        *(u32x4*)zr = pack8(o);
    }
}

#ifndef PROBE_A
#define PROBE_A 0
#endif
#ifndef PROBE_B
#define PROBE_B 0
#endif
#ifndef PROBE_BLK
#define PROBE_BLK 0
#endif
#ifndef PROBE_ADIV
#define PROBE_ADIV 1
#endif
#ifndef PROBE_BDIV
#define PROBE_BDIV 1
#endif
#if PROBE_A || PROBE_B
#define PT(id, ...) do { unsigned long long t0_ = wall_clock64(); __VA_ARGS__; unsigned long long dt_ = wall_clock64() - t0_; if ((id) == PROBE_A) pacc1 += dt_; if ((id) == PROBE_B) pacc2 += dt_; } while (0)
#else
#define PT(id, ...) do { __VA_ARGS__; } while (0)
#endif
DI void grid_bar(unsigned* ctr, unsigned& target, unsigned nblk) {
    __syncthreads();
    if (threadIdx.x == 0) {
        __builtin_amdgcn_fence(__ATOMIC_RELEASE, "agent");
        target += nblk;
        __hip_atomic_fetch_add(ctr, 1u, __ATOMIC_RELAXED, __HIP_MEMORY_SCOPE_AGENT);
        while (__hip_atomic_load(ctr, __ATOMIC_RELAXED, __HIP_MEMORY_SCOPE_AGENT) < target) __builtin_amdgcn_s_sleep(2);
        __builtin_amdgcn_fence(__ATOMIC_ACQUIRE, "agent");
    }
    __syncthreads();
}
__global__ void __launch_bounds__(512) mega(Prm p0) {
    Prm p = p0; p.wv = __builtin_amdgcn_readfirstlane((int)threadIdx.x >> 6);
    const int BIDK = (int)blockIdx.x;
    extern __shared__ __attribute__((aligned(16))) unsigned char smem[];
    cg::grid_group grid = cg::this_grid();
    unsigned bar_target = 0; unsigned* bar_ctr = (unsigned*)(p0.ws + WS_BAR);
#define GSYNC() grid_bar(bar_ctr, bar_target, gridDim.x)
    bf16_t* wt = (bf16_t*)(p.ws + WS_WT); bf16_t* zb = (bf16_t*)(p.ws + WS_Z); bf16_t* hb = (bf16_t*)(p.ws + WS_RWA); bf16_t* gtmp = hb + (size_t)NTOK * DM;
    bf16_t* zz = (bf16_t*)(p.ws + WS_MST); float* xc = (float*)(p.ws + WS_XC); const float* mods = (const float*)(p.ws + WS_MODS);
#if PROBE_A || PROBE_B
    unsigned long long pacc1 = 0, pacc2 = 0; const unsigned long long pstart = wall_clock64();
    if (PROBE_SCAN && blockIdx.x == 0 && threadIdx.x == 0) { g_pacc[0] = 0; g_pacc[1] = 0; }
#endif
    PT(15, ph_modpart(p, smem); ph_rope(p); conv_ffn(p, 0, 0, smem));
    PT(14, grid.sync());
    ph_modreduce(p);
    PT(14, GSYNC());
#define MERGE_B(l, b) do { \
                    { EpiGate E; E.G = gtmp; run_gemm(p.wv, smem, hb, DM, wt + WT_G + (size_t)(b) * DM * DM, (l) == 1 ? NLAT : NTOK, DM, DM, E); } \
                    { EpiBranch E; E.G = gtmp; E.ZZ = zz; E.first = ((b) == 0); const int yc = (b) == 0 ? ZC_MO : ((b) == 1 ? ZC_RR : ZC_AQ); \
                      run_gemm(p.wv, smem, zb + yc, ZW, wt + WT_P + (size_t)(b) * DM * 512, (l) == 1 ? NLAT : NTOK, DM, 512, E); } \
 } while (0)
#define MIXER_STAGE(l) do { const float* ml = mods + (size_t)(l) * 27648; \
                PT(13, ph_norm(p, l, 1, false, 11, ml + 2 * DM, 0.5f); conv_mixer(p, l, smem);); \
                PT(14, GSYNC()); \
                PT(8, { EpiWin E; E.Z = zb; run_gemm(p.wv, smem, hb, DM, wt + WT_IN, NTOK, ZWP, DM, E); }); \
                PT(14, GSYNC()); \
                PT(4, ph_rkv_conv(p, l); ph_attn_prep(p, l)); PT(5, ph_mlstm_a(p, l, smem)); \
                PT(14, GSYNC()); \
                PT(6, ph_rkv_copy(p)); PT(7, ph_mlstm_b(p)); \
                PT(14, GSYNC()); \
                PT(16, { EpiLora E; E.RWA = hb; E.RG = (bf16_t*)(p.ws + WS_RG); E.w0 = p.r_w0 + l * 1024; E.a0 = p.r_a0 + l * 1024; run_gemm(p.wv, smem, zb + ZC_RL, ZW, wt + WT_L, NTOK, 2560, 384, E); }); \
                PT(14, GSYNC()); \
                { int sc_u = BIDK, sc_s = NBLK, bh0 = 0, bh1 = 8, qf = BIDK, qs = NBLK, nq = (66 - BIDK + NBLK - 1) / NBLK, qx = -1, mc_u = BIDK, mc_s = NBLK, mc_c = 1 << 30; \
                  if (NBLK == 256) { const int xi = BIDK >> 3, bh = BIDK & 7; bh0 = bh; bh1 = bh + 1; sc_s = 128; \
                      if (xi < 16) { sc_u = bh * 16 + xi; nq = 0; mc_u = 256 + bh * 16 + xi; mc_s = 128; } \
                      else { const int a = xi - 16; sc_u = 128; qf = a; qs = 16; nq = 4; qx = a < 2 ? 64 + a : -1; mc_u = (bh * 16 + a) * 2; mc_s = 1; mc_c = 2; } } \
                  PT(1, ph_rwkv_scan(p, l, smem, sc_u, sc_s)); \
                  PT(2, for (int bh = bh0; bh < bh1; ++bh) ph_attn(p, l, smem, bh, qf, qs, nq, qx)); \
                  PT(3, ph_mlstm_c(p, l, smem, mc_u, mc_s, mc_c)); } \
                PT(14, GSYNC()); \
                PT(12, ph_rwkv_post(p, l); ph_norm(p, l, 1, false)); \
                PT(14, GSYNC()); \
                PT(9, MERGE_B(l, 0); MERGE_B(l, 1); MERGE_B(l, 2)); \
                PT(14, GSYNC()); \
                PT(17, { EpiResid E; E.xlat = p.out; E.xc = xc; E.gate = ml + 5 * DM; E.coef = 1.f; run_gemm(p.wv, smem, zz, DM, wt + WT_O, NLAT, DM, DM, E); \
              if ((l) == 0) { EpiPartial E2; E2.P = (float*)gtmp; E2.kslice_bytes = 512; run_gemm_ctx(p.wv, smem, zz, DM, wt + WT_O, DM, 4, 256, E2); } }); \
                PT(14, GSYNC()); \
 } while (0)
#define FFN_STAGE(l, f) do { const float* ml = mods + (size_t)(l) * 27648; \
            PT(18, ph_norm(p, l, f == 0 ? 0 : 2, l == 0 && f == 0, (f) == 1 ? ((l) == 0 ? 4 : 0) : ((l) == 1 ? 11 : 0), (f) == 1 ? ml + 5 * DM : mods + 8 * DM, (f) == 1 ? 1.f : 0.5f); \
            if (!(l == 0 && f == 0)) conv_ffn(p, l, f, smem)); \
            PT(14, GSYNC()); \
            PT(10, { EpiSwiglu E; E.H = zb; run_gemm(p.wv, smem, hb, DM, wt + WT_GU, ((l) == 1 && (f) == 1) ? NLAT : NTOK, 2 * DFF, DM, E); }); \
            PT(14, GSYNC()); \
            PT(11, { EpiResid E; E.xlat = p.out; E.xc = xc; E.gate = ml + (f == 0 ? 2 : 8) * DM; E.coef = 0.5f; run_gemm(p.wv, smem, zb, DFF, wt + WT_DN, NLAT, DM, DFF, E); \
              if (!((l) == 1 && (f) == 1)) { EpiPartial E2; E2.P = (float*)gtmp; E2.kslice_bytes = 512; run_gemm_ctx(p.wv, smem, zb, DFF, wt + WT_DN, DFF, 11, 256, E2); } }); \
            PT(14, GSYNC()); \
 } while (0)
    FFN_STAGE(0, 0); MIXER_STAGE(0); FFN_STAGE(0, 1); FFN_STAGE(1, 0); MIXER_STAGE(1); FFN_STAGE(1, 1);
#if PROBE_A || PROBE_B
    if (blockIdx.x == PROBE_BLK) {
        const unsigned long long pend = wall_clock64();
        if (PROBE_SCAN) { __syncthreads(); pacc1 = g_pacc[0]; pacc2 = g_pacc[1]; }
        if (PROBE_A == 99) pacc1 = pend - pstart;
        if (PROBE_B == 99) pacc2 = pend - pstart;
        unsigned long long q1 = pacc1 / (4000ull * PROBE_ADIV), q2 = pacc2 / (4000ull * PROBE_BDIV); if (q1 > 63) q1 = 63; if (q2 > 63) q2 = 63;
        const unsigned long long waitt = (q1 + 64 * q2) * 2000ull;
        while (wall_clock64() - pend < waitt) __builtin_amdgcn_s_sleep(32);
    }
#endif
}

extern "C" void kernel_launch(void* const* d_in, const int* in_sizes, int n_in, void* d_out, int out_size, void* d_ws, size_t ws_size, hipStream_t stream) {
    static int grid_blocks = 0;
    if (!grid_blocks) {
        int dev = 0, cus = 0, per_cu = 0;
        hipGetDevice(&dev);
        hipDeviceGetAttribute(&cus, hipDeviceAttributeMultiprocessorCount, dev);
        hipFuncSetAttribute((const void*)mega, hipFuncAttributeMaxDynamicSharedMemorySize, LDS_BYTES);
        hipOccupancyMaxActiveBlocksPerMultiprocessor(&per_cu, (const void*)mega, 512, LDS_BYTES);
        if (per_cu < 1) per_cu = 1;
        grid_blocks = cus * per_cu;
        if (ws_size < WS_END) fprintf(stderr, "kernel_launch: workspace too small: %zu < %zu\n", ws_size, (size_t)WS_END);
    }
    Prm p{};
    const float** pp = (const float**)&p;
    for (int i = 0; i < 31; ++i) pp[i] = (const float*)d_in[i];
    p.out = (float*)d_out; p.ws = (unsigned char*)d_ws;
    (void)hipMemsetAsync((unsigned char*)d_ws + WS_BAR, 0, 256, stream);
    void* args[] = {&p};
    hipError_t e = hipLaunchCooperativeKernel((const void*)mega, dim3(grid_blocks), dim3(512), args, LDS_BYTES, stream);
    if (e != hipSuccess) fprintf(stderr, "cooperative launch failed: %s (grid %d)\n", hipGetErrorString(e), grid_blocks);
}
```

```cpp
#include <hip/hip_runtime.h>
#include <hip/hip_cooperative_groups.h>
#include <cstdio>
#include <cstdint>
namespace cg = cooperative_groups;
#ifndef PROBE_SCAN
#define PROBE_SCAN 0
#endif

#define LAS __attribute__((address_space(3)))
#define DI __device__ __forceinline__
typedef unsigned short bf16_t;
typedef short bf16x8 __attribute__((ext_vector_type(8)));
typedef float f32x4 __attribute__((ext_vector_type(4)));
typedef float f32x16 __attribute__((ext_vector_type(16)));
typedef float f32x2 __attribute__((ext_vector_type(2)));
typedef unsigned u32x4 __attribute__((ext_vector_type(4)));
typedef unsigned u32x2 __attribute__((ext_vector_type(2)));
typedef __bf16 bf16x2_t __attribute__((ext_vector_type(2)));

constexpr int DM = 1024, NLAT = 16384, NTOK = 16896, SEQL = 8192, CTXL = 256, DFF = 2816, DIN = 8080, ZW = 5008, ZWP = 5120;
constexpr int ZC_MQ = 0, ZC_MK = 256, ZC_MV = 512, ZC_MO = 1024, ZC_MG = 1536, ZC_RR = 1552, ZC_RK = 2064, ZC_RV = 2576, ZC_RL = 3088, ZC_AQ = 3472, ZC_AK = 3984, ZC_AV = 4496;
constexpr int NCHK = 132;
constexpr size_t WS_MODP = 0;
constexpr size_t WS_MODS = WS_MODP + (size_t)2 * 16 * 3 * 9216 * 4;
constexpr size_t WS_ROPE = WS_MODS + (size_t)2 * 3 * 9216 * 4;
constexpr size_t WS_XC   = WS_ROPE + (size_t)8192 * 64 * 4;
constexpr size_t WS_INVN = WS_XC + (size_t)512 * 1024 * 4;
constexpr size_t WS_MSC  = WS_INVN + (size_t)NTOK * 8 * 4;
constexpr size_t WS_MN   = WS_MSC + (size_t)2112 * 4 * 4;
constexpr size_t WS_WT   = WS_MN + (size_t)2112 * 64 * 4;
constexpr size_t WS_Z    = WS_WT + (size_t)25165824;
constexpr size_t WS_RWA  = WS_Z + (size_t)NTOK * ZW * 2;
constexpr size_t WS_RG   = WS_RWA + (size_t)NTOK * 2048 * 2;
constexpr size_t WS_MST  = WS_RG + (size_t)NTOK * 512 * 2;
constexpr size_t WS_YSUM = WS_MST + (size_t)2112 * 8192 * 2;
constexpr size_t WS_BAR  = WS_YSUM + (size_t)NTOK * 512 * 4;
constexpr size_t WS_END  = WS_BAR + 256;
constexpr size_t WT_GU = 0, WT_DN = (size_t)5632 * 1024;
constexpr size_t WT_IN = 0, WT_G = (size_t)5120 * 1024, WT_P = WT_G + (size_t)3072 * 1024, WT_O = WT_P + (size_t)3 * 1024 * 512, WT_L = WT_O + (size_t)1024 * 1024;
constexpr int LDS_BYTES = 155648;

DI float bf2f(bf16_t b) { return __uint_as_float(((unsigned)b) << 16); }
DI unsigned pk2(float lo, float hi) { f32x2 v = {lo, hi}; bf16x2_t b = __builtin_convertvector(v, bf16x2_t); return __builtin_bit_cast(unsigned, b); }
DI bf16_t f2bf(float f) { return (bf16_t)(pk2(f, 0.f) & 0xffffu); }
DI float lo16(unsigned u) { return __uint_as_float(u << 16); }
DI float hi16(unsigned u) { return __uint_as_float(u & 0xffff0000u); }
DI float sigmoidf_(float x) { return __builtin_amdgcn_rcpf(1.f + __expf(-x)); }
DI float siluf_(float x) { return x * __builtin_amdgcn_rcpf(1.f + __expf(-x)); }
DI float logsigf_(float x) { return x < 0.f ? x - log1pf(expf(x)) : -log1pf(expf(-x)); }
DI float wave_sum(float v) {
#pragma unroll
    for (int o = 1; o < 64; o <<= 1) v += __shfl_xor(v, o);
    return v;
}
DI float wave_max(float v) {
#pragma unroll
    for (int o = 1; o < 64; o <<= 1) v = fmaxf(v, __shfl_xor(v, o));
    return v;
}
DI void unpack8(const u32x4 u, float* f) { f[0] = lo16(u.x); f[1] = hi16(u.x); f[2] = lo16(u.y); f[3] = hi16(u.y); f[4] = lo16(u.z); f[5] = hi16(u.z); f[6] = lo16(u.w); f[7] = hi16(u.w); }
DI u32x4 pack8(const float* f) { u32x4 u; u.x = pk2(f[0], f[1]); u.y = pk2(f[2], f[3]); u.z = pk2(f[4], f[5]); u.w = pk2(f[6], f[7]); return u; }
DI int launder_v(int v) { asm volatile("" : "+v"(v)); return v; }
DI int launder_s(int v) { asm volatile("" : "+s"(v)); return v; }
DI int lane_id_() { return (int)__builtin_amdgcn_mbcnt_hi(~0u, __builtin_amdgcn_mbcnt_lo(~0u, 0u)); }
namespace pg8 {
#define PG8_LAS __attribute__((address_space(3)))
typedef unsigned short bf16_t;
typedef short bf16x8 __attribute__((ext_vector_type(8)));
typedef float f32x4 __attribute__((ext_vector_type(4)));
typedef unsigned u32x4 __attribute__((ext_vector_type(4)));
constexpr int BM = 256, BK = 64, HALF = 128, HTB = HALF * BK * 2  , STAGE_BYTES = 8 * HTB, NXCD = 8, WGM = 8;

__host__ __device__ __forceinline__ int lds_byte(int r, int c) { const int st = (r >> 4) * 2 + (c >> 5), rr = r & 15, cc = c & 31, ob = rr * 64 + cc * 2; return st * 1024 + (ob ^ (((ob >> 9) & 1) << 5)); }
__host__ __device__ __forceinline__ void stage_rc(int b, int& R, int& C) { const int st = b / 1024, sb = b % 1024, swz = sb ^ (((sb >> 9) & 1) << 5); R = (st >> 1) * 16 + swz / 64; C = (st & 1) * 32 + (swz % 64) / 2; }
__host__ __device__ __forceinline__ int perm32(int rho) { const int n = rho >> 4, i = rho & 15; return 8 * (i >> 2) + 4 * n + (i & 3); }

struct Unit { int pm, pn; size_t koff; };
struct Gemm { const bf16_t* A; const bf16_t* Bt; int M, N, K, lda, ldb, tid0; };

struct StaticOrder {
    int nM, nN, nwg, G, c;
    __host__ __device__ void init(int M, int N, int G_, int c_) { nM = M / BM; nN = N / BM; nwg = nM * nN; G = G_; c = c_; }
    __host__ __device__ bool next(int i, Unit& u) const {
        const long L = (long)i * G + c; if (L >= nwg) return false;
        int wgid = (int)L; { const int q = nwg / NXCD, r = nwg % NXCD, xcd = wgid % NXCD, off = wgid / NXCD; wgid = (xcd < r ? xcd * (q + 1) : r * (q + 1) + (xcd - r) * q) + off; }
        const int nig = WGM * nN, gid = wgid / nig, fm = gid * WGM, gsz = (nM - fm) < WGM ? (nM - fm) : WGM;
        u.pm = fm + ((wgid % nig) % gsz); u.pn = (wgid % nig) / gsz; u.koff = 0; return true;
    }
    __device__ __forceinline__ void a_ready(const Unit&) const {}
    __device__ __forceinline__ void done(const Unit&) const {}
};


template <class Epi, class Sched, bool ALIGN_EPI = false, bool SP2 = false>
__device__ __forceinline__ void gemm_phase(PG8_LAS unsigned char* lds, const Gemm g, const Sched& S, const Epi& E) {
    int tid = g.tid0; asm volatile("" : "+v"(tid)); const int wid = __builtin_amdgcn_readfirstlane(tid >> 6), lane = tid & 63, wr = wid >> 2, wc = wid & 3, fr = lane & 15, fq = lane >> 4;
    const int K = g.K, nt = K / BK;
    unsigned voffA[2], voffB[2];
#pragma unroll
    for (int i = 0; i < 2; ++i) { int R, C; stage_rc(tid * 16 + i * 8192, R, C); const int Rb = Epi::PERM ? ((R & ~31) + perm32(R & 31)) : R;
        voffA[i] = (unsigned)(R * g.lda + C) * 2u; voffB[i] = (unsigned)(Rb * g.ldb + C) * 2u; }
    const size_t kstep = (size_t)(BK * 2);
    const size_t hstepB = (size_t)HALF * g.ldb * 2, hstepA = (size_t)HALF * g.lda * 2;
    const size_t tstepA = 2 * hstepA, tstepB = 2 * hstepB;
    const unsigned ldsw = (unsigned)wid * 1024u;
    const int aoff = lds_byte(wr * 64 + fr, fq * 8), boff = lds_byte(wc * 32 + fr, fq * 8);
#define PG8_SA(b, h) (((b) * 2 + (h)) * HTB)
#define PG8_SB(b, h) ((4 + (b) * 2 + (h)) * HTB)
#define PG8_STAGE(bufoff, gbase, voff) do { _Pragma("unroll") for (int _i = 0; _i < 2; ++_i) \
        __builtin_amdgcn_global_load_lds((const unsigned*)((const char*)(gbase) + (voff)[_i]), (PG8_LAS unsigned*)(lds + (bufoff) + ldsw + _i * 8192), 16, 0, 0); } while (0)
#define PG8_LDA(dst, b, h) do { _Pragma("unroll") for (int m = 0; m < 4; ++m) _Pragma("unroll") for (int k = 0; k < 2; ++k) dst[m][k] = *(const PG8_LAS bf16x8*)(lds + PG8_SA(b, h) + aoff + m * 2048 + k * 1024); } while (0)
#define PG8_LDB(dst, b, h) do { _Pragma("unroll") for (int n = 0; n < 2; ++n) _Pragma("unroll") for (int k = 0; k < 2; ++k) dst[n][k] = *(const PG8_LAS bf16x8*)(lds + PG8_SB(b, h) + boff + n * 2048 + k * 1024); } while (0)
#define PG8_MMA(ai, bj, At, Bt) do { __builtin_amdgcn_s_setprio(1); _Pragma("unroll") for (int m = 0; m < 4; ++m) _Pragma("unroll") for (int n = 0; n < 2; ++n) _Pragma("unroll") for (int k = 0; k < 2; ++k) \
        acc[ai][bj][m][n] = __builtin_amdgcn_mfma_f32_16x16x32_bf16(Bt[n][k], At[m][k], acc[ai][bj][m][n], 0, 0, 0); __builtin_amdgcn_s_setprio(0); } while (0)
#define PG8_WAIT_V(n) asm volatile("s_waitcnt vmcnt(" #n ")" ::: "memory")
#define PG8_WAIT_L(n) asm volatile("s_waitcnt lgkmcnt(" #n ")" ::: "memory")
#define PG8_BAR __builtin_amdgcn_s_barrier()
#define PG8_SCHED __builtin_amdgcn_sched_barrier(0)
    Unit cur, nxt; int ui = 0;
    if (!S.next(0, cur)) return;
    f32x4 acc[2][2][4][2];
#pragma unroll
    for (int a = 0; a < 2; ++a)
#pragma unroll
        for (int b = 0; b < 2; ++b)
#pragma unroll
            for (int m = 0; m < 4; ++m)
#pragma unroll
                for (int n = 0; n < 2; ++n) acc[a][b][m][n] = (f32x4){0.f, 0.f, 0.f, 0.f};
    bf16x8 At[4][2], B0[2][2], B1[2][2];
    const char* cA = (const char*)g.A + (size_t)cur.pm * tstepA + cur.koff; const char* cB = (const char*)g.Bt + (size_t)cur.pn * tstepB + cur.koff;
    S.a_ready(cur);
    if constexpr (SP2) {
        PG8_STAGE(PG8_SB(0, 0), cB, voffB); PG8_STAGE(PG8_SB(0, 1), cB + hstepB, voffB); PG8_STAGE(PG8_SA(0, 0), cA, voffA); PG8_STAGE(PG8_SA(0, 1), cA + hstepA, voffA);
        if (wr == 1) PG8_BAR;
        PG8_WAIT_V(2); PG8_BAR;
        PG8_STAGE(PG8_SB(1, 0), cB + kstep, voffB); PG8_STAGE(PG8_SA(1, 0), cA + kstep, voffA); PG8_STAGE(PG8_SB(1, 1), cB + hstepB + kstep, voffB);
        PG8_WAIT_V(6); PG8_BAR;
    } else {
        PG8_STAGE(PG8_SB(0, 0), cB, voffB); PG8_STAGE(PG8_SA(0, 0), cA, voffA); PG8_STAGE(PG8_SB(0, 1), cB + hstepB, voffB); PG8_STAGE(PG8_SA(0, 1), cA + hstepA, voffA);
        if (wr == 1) PG8_BAR;
        PG8_WAIT_V(4); PG8_BAR;
        PG8_STAGE(PG8_SB(1, 0), cB + kstep, voffB); PG8_STAGE(PG8_SA(1, 0), cA + kstep, voffA); PG8_STAGE(PG8_SB(1, 1), cB + hstepB + kstep, voffB);
        PG8_WAIT_V(6); PG8_BAR;
    }
    for (;;) {
        const bool has_next = S.next(ui + 1, nxt);
        const char* nA = has_next ? (const char*)g.A + (size_t)nxt.pm * tstepA + nxt.koff : cA; const char* nB = has_next ? (const char*)g.Bt + (size_t)nxt.pn * tstepB + nxt.koff : cB;
        for (int t = 0; t < nt; t += 2) {
            const bool last = (t == nt - 2);
            const char* a1 = cA + (size_t)(t + 1) * kstep;
            const char* a2 = last ? nA : cA + (size_t)(t + 2) * kstep; const char* b2 = last ? nB : cB + (size_t)(t + 2) * kstep;
            const char* a3 = a2 + kstep; const char* b3 = b2 + kstep;
            if (last && has_next) S.a_ready(nxt);
            if constexpr (SP2) {
            PG8_LDB(B0, 0, 0); PG8_LDB(B1, 0, 1); PG8_SCHED; PG8_LDA(At, 0, 0); PG8_STAGE(PG8_SA(1, 1), a1 + hstepA, voffA);
            PG8_WAIT_V(8); PG8_WAIT_L(0); PG8_BAR; PG8_MMA(0, 0, At, B0); PG8_MMA(0, 1, At, B1); PG8_BAR; PG8_SCHED;
            PG8_LDA(At, 0, 1); PG8_STAGE(PG8_SB(0, 0), b2, voffB); PG8_STAGE(PG8_SB(0, 1), b2 + hstepB, voffB); PG8_STAGE(PG8_SA(0, 0), a2, voffA);
            PG8_WAIT_V(8); PG8_WAIT_L(0); PG8_BAR; PG8_MMA(1, 0, At, B0); PG8_MMA(1, 1, At, B1); PG8_BAR; PG8_SCHED;
            PG8_LDB(B0, 1, 0); PG8_LDB(B1, 1, 1); PG8_SCHED; PG8_LDA(At, 1, 0); PG8_STAGE(PG8_SA(0, 1), a2 + hstepA, voffA);
            PG8_WAIT_V(8); PG8_WAIT_L(0); PG8_BAR; PG8_MMA(0, 0, At, B0); PG8_MMA(0, 1, At, B1); PG8_BAR; PG8_SCHED;
            PG8_LDA(At, 1, 1); PG8_STAGE(PG8_SB(1, 0), b3, voffB); PG8_STAGE(PG8_SB(1, 1), b3 + hstepB, voffB); PG8_STAGE(PG8_SA(1, 0), a3, voffA);
            PG8_WAIT_V(8); PG8_WAIT_L(0); PG8_BAR; PG8_MMA(1, 0, At, B0); PG8_MMA(1, 1, At, B1); PG8_BAR; PG8_SCHED;
            } else {
            PG8_LDB(B0, 0, 0); PG8_SCHED; PG8_LDA(At, 0, 0); PG8_STAGE(PG8_SA(1, 1), a1 + hstepA, voffA);
            PG8_WAIT_L(8); PG8_BAR; PG8_WAIT_L(0); PG8_MMA(0, 0, At, B0); PG8_BAR; PG8_SCHED;
            PG8_LDB(B1, 0, 1); PG8_STAGE(PG8_SB(0, 0), b2, voffB);
            PG8_BAR; PG8_WAIT_L(0); PG8_MMA(0, 1, At, B1); PG8_BAR;
            PG8_LDA(At, 0, 1); PG8_STAGE(PG8_SA(0, 0), a2, voffA);
            PG8_BAR; PG8_WAIT_L(0); PG8_MMA(1, 0, At, B0); PG8_BAR; PG8_SCHED;
            PG8_STAGE(PG8_SB(0, 1), b2 + hstepB, voffB);
            PG8_WAIT_V(6); PG8_BAR; PG8_MMA(1, 1, At, B1); PG8_BAR;
            PG8_LDB(B0, 1, 0); PG8_SCHED; PG8_LDA(At, 1, 0); PG8_STAGE(PG8_SA(0, 1), a2 + hstepA, voffA);
            PG8_WAIT_L(8); PG8_BAR; PG8_WAIT_L(0); PG8_MMA(0, 0, At, B0); PG8_BAR; PG8_SCHED;
            PG8_LDB(B1, 1, 1); PG8_STAGE(PG8_SB(1, 0), b3, voffB);
            PG8_BAR; PG8_WAIT_L(0); PG8_MMA(0, 1, At, B1); PG8_BAR;
            PG8_LDA(At, 1, 1); PG8_STAGE(PG8_SA(1, 0), a3, voffA);
            PG8_BAR; PG8_WAIT_L(0); PG8_MMA(1, 0, At, B0); PG8_BAR; PG8_SCHED;
            PG8_STAGE(PG8_SB(1, 1), b3 + hstepB, voffB);
            PG8_WAIT_V(6); PG8_BAR; PG8_MMA(1, 1, At, B1); PG8_BAR;
            }
        }
        if constexpr (ALIGN_EPI) { if (wr == 0) PG8_BAR; }
        if constexpr (!Epi::AFTER_DRAIN) { E(acc, cur, wr, wc, fr, fq); S.done(cur); }
        if (!has_next) break;
#pragma unroll
        for (int a = 0; a < 2; ++a)
#pragma unroll
            for (int b = 0; b < 2; ++b)
#pragma unroll
                for (int m = 0; m < 4; ++m)
#pragma unroll
                    for (int n = 0; n < 2; ++n) acc[a][b][m][n] = (f32x4){0.f, 0.f, 0.f, 0.f};
        cur = nxt; cA = nA; cB = nB; ++ui;
        if constexpr (ALIGN_EPI) { if (wr == 1) PG8_BAR; }
    }
    PG8_WAIT_V(0);
    if constexpr (!ALIGN_EPI) { if (wr == 0) PG8_BAR; }
    PG8_BAR;
    if constexpr (Epi::AFTER_DRAIN) { E.fused(acc, cur, wr, wc, fr, fq, lds, wid, lane); S.done(cur); }
#undef PG8_SA
#undef PG8_SB
#undef PG8_STAGE
#undef PG8_LDA
#undef PG8_LDB
#undef PG8_MMA
#undef PG8_WAIT_V
#undef PG8_WAIT_L
#undef PG8_BAR
#undef PG8_SCHED
}
}

typedef const pg8::f32x4 (&AccRef)[2][2][4][2];
struct EpiSwiglu {
    static constexpr bool PERM = true, AFTER_DRAIN = false;
    bf16_t* H;
    DI void operator()(AccRef acc, const pg8::Unit& u, int wr, int wc, int fr, int fq) const {
        const int row0 = u.pm * 256 + wr * 64 + fr, col = u.pn * 128 + wc * 32 + 8 * fq;
#pragma unroll
        for (int ai = 0; ai < 2; ++ai)
#pragma unroll
            for (int m = 0; m < 4; ++m) {
                const int row = row0 + ai * 128 + m * 16; float f[8];
#pragma unroll
                for (int n = 0; n < 2; ++n)
#pragma unroll
                    for (int e = 0; e < 4; ++e) f[n * 4 + e] = siluf_(acc[ai][0][m][n][e]) * acc[ai][1][m][n][e];
                *(u32x4*)(H + (size_t)row * DFF + col) = pack8(f);
            }
    }
};
struct EpiResid {
    static constexpr bool PERM = true, AFTER_DRAIN = false;
    float* xlat; float* xc; const float* gate; float coef;
    DI void operator()(AccRef acc, const pg8::Unit& u, int wr, int wc, int fr, int fq) const {
        const int r0 = u.pm * 256; const int vec = r0 < NLAT ? (r0 >> 13) : 2;
        const float* gp = gate + vec * 9216;
        float* base = r0 < NLAT ? xlat + (size_t)r0 * DM : xc + (size_t)(r0 - NLAT) * DM;
#pragma unroll
        for (int bj = 0; bj < 2; ++bj) {
            const int col = u.pn * 256 + bj * 128 + wc * 32 + 8 * fq;
            const f32x4 g0 = *(const f32x4*)(gp + col) * coef, g1 = *(const f32x4*)(gp + col + 4) * coef;
#pragma unroll
            for (int ai = 0; ai < 2; ++ai)
#pragma unroll
                for (int m = 0; m < 4; ++m) {
                    float* xp = base + (size_t)(wr * 64 + fr + ai * 128 + m * 16) * DM + col;
                    f32x4 x0 = *(f32x4*)xp, x1 = *(f32x4*)(xp + 4);
                    x0 += g0 * acc[ai][bj][m][0]; x1 += g1 * acc[ai][bj][m][1];
                    *(f32x4*)xp = x0; *(f32x4*)(xp + 4) = x1;
                }
        }
    }
};
struct EpiWin {
    static constexpr bool PERM = true, AFTER_DRAIN = false;
    bf16_t* Z;
    DI void operator()(AccRef acc, const pg8::Unit& u, int wr, int wc, int fr, int fq) const {
        const int row0 = u.pm * 256 + wr * 64 + fr;
#pragma unroll
        for (int bj = 0; bj < 2; ++bj) {
            const int col = u.pn * 256 + bj * 128 + wc * 32 + 8 * fq;
            if (col >= ZW) continue;
            const int mode = (col >= ZC_RL && col < ZC_RL + 128) ? 1 : ((col >= ZC_RL + 256 && col < ZC_AQ) ? 2 : 0);
#pragma unroll
            for (int ai = 0; ai < 2; ++ai)
#pragma unroll
                for (int m = 0; m < 4; ++m) {
                    const int row = row0 + ai * 128 + m * 16; float f[8];
#pragma unroll
                    for (int n = 0; n < 2; ++n)
#pragma unroll
                        for (int e = 0; e < 4; ++e) { float v = acc[ai][bj][m][n][e]; if (mode == 1) v = 1.f - 2.f * __builtin_amdgcn_rcpf(1.f + __expf(2.f * v)); else if (mode == 2) v = sigmoidf_(v); f[n * 4 + e] = v; }
                    *(u32x4*)(Z + (size_t)row * ZW + col) = pack8(f);
                }
        }
    }
};
struct EpiLora {
    static constexpr bool PERM = true, AFTER_DRAIN = false;
    bf16_t* RWA; bf16_t* RG; const float* w0; const float* a0;
    DI void operator()(AccRef acc, const pg8::Unit& u, int wr, int wc, int fr, int fq) const {
        const int row0 = u.pm * 256 + wr * 64 + fr;
#pragma unroll
        for (int bj = 0; bj < 2; ++bj) {
            const int col = u.pn * 256 + bj * 128 + wc * 32 + 8 * fq; const int seg = col >> 9, cc = col & 511;
            const float* bp = seg < 2 ? w0 + seg * 512 + cc : a0 + (seg & 1) * 512 + cc;
#pragma unroll
            for (int ai = 0; ai < 2; ++ai)
#pragma unroll
                for (int m = 0; m < 4; ++m) {
                    const int row = row0 + ai * 128 + m * 16; float f[8];
#pragma unroll
                    for (int n = 0; n < 2; ++n)
#pragma unroll
                        for (int e = 0; e < 4; ++e) {
                            float v = acc[ai][bj][m][n][e] + (seg < 4 ? bp[n * 4 + e] : 0.f);
                            if (seg < 2) { const float ee = 0.60653066f * sigmoidf_(v); v = 1.f - __expf(-ee); } else if (seg < 4) v = sigmoidf_(v);
                            f[n * 4 + e] = v;
                        }
                    if (seg < 4) *(u32x4*)(RWA + (size_t)row * 2048 + col) = pack8(f); else *(u32x4*)(RG + (size_t)row * 512 + cc) = pack8(f);
                    __builtin_amdgcn_sched_barrier(0);
                }
        }
    }
};
struct EpiGate {
    static constexpr bool PERM = true, AFTER_DRAIN = false;
    bf16_t* G;
    DI void operator()(AccRef acc, const pg8::Unit& u, int wr, int wc, int fr, int fq) const {
        const int row0 = u.pm * 256 + wr * 64 + fr;
#pragma unroll
        for (int bj = 0; bj < 2; ++bj) {
            const int col = u.pn * 256 + bj * 128 + wc * 32 + 8 * fq;
#pragma unroll
            for (int ai = 0; ai < 2; ++ai)
#pragma unroll
                for (int m = 0; m < 4; ++m) {
                    const int row = row0 + ai * 128 + m * 16; float f[8];
#pragma unroll
                    for (int n = 0; n < 2; ++n)
#pragma unroll
                        for (int e = 0; e < 4; ++e) f[n * 4 + e] = sigmoidf_(acc[ai][bj][m][n][e]);
                    *(u32x4*)(G + (size_t)row * DM + col) = pack8(f);
                }
        }
    }
};
struct EpiBranch {
    static constexpr bool PERM = true, AFTER_DRAIN = false;
    const bf16_t* G; bf16_t* ZZ; int first;
    DI void operator()(AccRef acc, const pg8::Unit& u, int wr, int wc, int fr, int fq) const {
        const int row0 = u.pm * 256 + wr * 64 + fr;
#pragma unroll
        for (int bj = 0; bj < 2; ++bj) {
            const int col = u.pn * 256 + bj * 128 + wc * 32 + 8 * fq;
#pragma unroll
            for (int ai = 0; ai < 2; ++ai)
#pragma unroll
                for (int m = 0; m < 4; ++m) {
                    const size_t off = (size_t)(row0 + ai * 128 + m * 16) * DM + col; float g[8], o[8], f[8];
                    unpack8(*(const u32x4*)(G + off), g);
                    if (first) {
#pragma unroll
                        for (int e = 0; e < 8; ++e) o[e] = 0.f;
                    } else unpack8(*(const u32x4*)(ZZ + off), o);
#pragma unroll
                    for (int n = 0; n < 2; ++n)
#pragma unroll
                        for (int e = 0; e < 4; ++e) f[n * 4 + e] = o[n * 4 + e] + g[n * 4 + e] * acc[ai][bj][m][n][e];
                    *(u32x4*)(ZZ + off) = pack8(f);
                }
        }
    }
};
struct CtxSplitOrder {
    int nun, G, c, kslice_bytes;
    DI void init(int nslices, int ksl_bytes, int G_, int c_) { nun = nslices * 8; G = G_; c = c_; kslice_bytes = ksl_bytes; }
    DI bool next(int i, pg8::Unit& u) const {
        const long L = (long)i * G + c; if (L >= nun) return false;
        const int ks = (int)L >> 3, t = (int)L & 7; u.pm = 64 + (t >> 2); u.pn = t & 3; u.koff = (size_t)ks * kslice_bytes; return true;
    }
    DI void a_ready(const pg8::Unit&) const {}
    DI void done(const pg8::Unit&) const {}
};
struct EpiPartial {
    static constexpr bool PERM = true, AFTER_DRAIN = false;
    float* P; int kslice_bytes;
    DI void operator()(AccRef acc, const pg8::Unit& u, int wr, int wc, int fr, int fq) const {
        const int ks = (int)(u.koff / (size_t)kslice_bytes);
        float* base = P + ((size_t)ks * 512 + (size_t)(u.pm - 64) * 256) * DM;
#pragma unroll
        for (int bj = 0; bj < 2; ++bj) {
            const int col = u.pn * 256 + bj * 128 + wc * 32 + 8 * fq;
#pragma unroll
            for (int ai = 0; ai < 2; ++ai)
#pragma unroll
                for (int m = 0; m < 4; ++m) {
                    float* xp = base + (size_t)(wr * 64 + fr + ai * 128 + m * 16) * DM + col;
                    *(f32x4*)xp = acc[ai][bj][m][0]; *(f32x4*)(xp + 4) = acc[ai][bj][m][1];
                }
        }
    }
};
template <class Epi> DI void run_gemm_ctx(const int wv, unsigned char* smem, const bf16_t* A, int lda, const bf16_t* Bt, int ldb, int nslices, int kslice, const Epi& E) {
    pg8::Gemm g; g.A = A; g.Bt = Bt; g.M = NTOK; g.N = DM; g.K = launder_s(kslice); g.lda = launder_s(lda); g.ldb = launder_s(ldb); g.tid0 = wv * 64 + lane_id_();
    CtxSplitOrder S; S.init(nslices, kslice * 2, (int)gridDim.x, ((int)gridDim.x - 1) - launder_s((int)blockIdx.x));
    pg8::gemm_phase<Epi, CtxSplitOrder, true, true>((PG8_LAS unsigned char*)smem, g, S, E);
    __syncthreads();
}
template <class Epi> DI void run_gemm(const int wv, unsigned char* smem, const bf16_t* A, int lda, const bf16_t* Bt, int M, int N, int K, const Epi& E) {
    pg8::Gemm g; g.A = A; g.Bt = Bt; g.M = M; g.N = N; g.K = launder_s(K); g.lda = launder_s(lda); g.ldb = g.K; g.tid0 = wv * 64 + lane_id_();
    pg8::StaticOrder S; S.init(M, N, (int)gridDim.x, launder_s((int)blockIdx.x));
    pg8::gemm_phase<Epi, pg8::StaticOrder, true, true>((PG8_LAS unsigned char*)smem, g, S, E);
    __syncthreads();
}

struct Prm {
    const float *x, *c, *ctx, *cctx, *w_ada, *b_ada, *norm_g, *f1gu, *f1dn, *f2gu, *f2dn, *w_in, *m_conv, *m_gb, *m_on, *r_conv, *r_w0, *r_w2, *r_a0, *r_a2, *r_g2,
        *r_kk, *r_ka, *r_rk, *r_lnw, *r_lnb, *a_qkn, *a_lam, *a_subln, *w_br, *w_o;
    float* out; unsigned char* ws; int wv, pad;
};
#define PH_IDS const int tid_l = launder_v(p.wv * 64 + lane_id_()); const int bid_l = launder_s((int)blockIdx.x); (void)tid_l; (void)bid_l;
#define TID tid_l
#define BID bid_l
#define NBLK ((int)gridDim.x)

DI void ph_modpart(const Prm& p, unsigned char* smem) { PH_IDS
    float* sc = (float*)smem; float* modp = (float*)(p.ws + WS_MODP);
    for (int it = BID; it < 576; it += NBLK) {
        const int l = it / 288, r = it % 288, ks = r / 18, cb = r % 18;
        __syncthreads();
        if (TID < 192) { const int v = TID >> 6, k = ks * 64 + (TID & 63); const float cv = v < 2 ? p.c[v * DM + k] : p.cctx[k]; sc[TID] = siluf_(cv); }
        __syncthreads();
        const int col = cb * 512 + TID; float a0 = 0.f, a1 = 0.f, a2 = 0.f;
        const float* w = p.w_ada + ((size_t)l * DM + ks * 64) * 9216 + col;
#pragma unroll 8
        for (int k = 0; k < 64; ++k) { const float wv = w[(size_t)k * 9216]; a0 += sc[k] * wv; a1 += sc[64 + k] * wv; a2 += sc[128 + k] * wv; }
        float* o = modp + ((size_t)(l * 16 + ks) * 3) * 9216 + col; o[0] = a0; o[9216] = a1; o[2 * 9216] = a2;
    }
    __syncthreads();
}
DI void ph_rope(const Prm& p) { PH_IDS
    float* rope = (float*)(p.ws + WS_ROPE);
    for (int i = BID * 512 + TID; i < SEQL * 32; i += NBLK * 512) {
        const int t = i >> 5, pp = i & 31, j = pp & 15;
        const float inv = powf(10000.f, -(float)j / 16.f); const float pos = (float)(pp < 16 ? (t >> 6) : (t & 63)); const float ang = pos * inv;
        rope[2 * i] = cosf(ang); rope[2 * i + 1] = sinf(ang);
    }
}
DI void ph_modreduce(const Prm& p) { PH_IDS
    const float* modp = (const float*)(p.ws + WS_MODP); float* mods = (float*)(p.ws + WS_MODS);
    for (int i = BID * 512 + TID; i < 2 * 3 * 9216; i += NBLK * 512) {
        const int l = i / 27648, rem = i % 27648, v = rem / 9216, col = rem % 9216;
        float s = p.b_ada[l * 9216 + col];
        for (int ks = 0; ks < 16; ++ks) s += modp[((size_t)(l * 16 + ks) * 3 + v) * 9216 + col];
        mods[i] = s;
    }
}
template <int MODE> DI void conv_weight(const Prm& p, const float* src, int ld, int c0, int K, int ncols, bf16_t* dst, unsigned char* smem) { PH_IDS
    float* t = (float*)smem; const int ntk = K / 64, ntn = (ncols + 63) / 64, tx = TID & 63, ty = TID >> 6;
    for (int it = BID; it < ntk * ntn; it += NBLK) {
        const int kt = it % ntk, nt = it / ntk;
        __syncthreads();
#pragma unroll
        for (int i = 0; i < 8; ++i) { const int k = ty * 8 + i, j = nt * 64 + tx; t[k * 65 + tx] = j < ncols ? src[(size_t)(kt * 64 + k) * ld + c0 + j] : 0.f; }
        __syncthreads();
#pragma unroll
        for (int i = 0; i < 8; ++i) {
            const int n = ty * 8 + i, j = nt * 64 + n;
            if (j < ncols) {
                int drow = j;
                if (MODE == 1) drow = j < DFF ? ((j >> 7) * 256 + (j & 127)) : (((j - DFF) >> 7) * 256 + 128 + ((j - DFF) & 127));
                dst[(size_t)drow * K + kt * 64 + tx] = f2bf(t[tx * 65 + n]);
            }
        }
    }
    __syncthreads();
}
DI void conv_ffn(const Prm& p, int l, int which, unsigned char* smem) {
    bf16_t* wt = (bf16_t*)(p.ws + WS_WT);
    conv_weight<1>(p, (which ? p.f2gu : p.f1gu) + (size_t)l * DM * 2 * DFF, 2 * DFF, 0, DM, 2 * DFF, wt + WT_GU, smem);
    conv_weight<0>(p, (which ? p.f2dn : p.f1dn) + (size_t)l * DFF * DM, DM, 0, DFF, DM, wt + WT_DN, smem);
}
DI void conv_mixer(const Prm& p, int l, unsigned char* smem) { PH_IDS
    bf16_t* wt = (bf16_t*)(p.ws + WS_WT);
    conv_weight<0>(p, p.w_in + (size_t)l * DM * DIN, DIN, 0, DM, ZW, wt + WT_IN, smem);
    conv_weight<0>(p, p.w_in + (size_t)l * DM * DIN, DIN, ZW, DM, 3 * DM, wt + WT_G, smem);
    for (int b = 0; b < 3; ++b) conv_weight<0>(p, p.w_br + (size_t)(l * 3 + b) * 512 * DM, DM, 0, 512, DM, wt + WT_P + (size_t)b * DM * 512, smem);
    conv_weight<0>(p, p.w_o + (size_t)l * DM * DM, DM, 0, DM, DM, wt + WT_O, smem);
    bf16_t* wl = wt + WT_L;
    for (int i = BID * 512 + TID; i < 2560 * 384; i += NBLK * 512) {
        const int n = i / 384, k = i % 384, seg = n >> 9, cc = n & 511; float v = 0.f;
        if (seg < 2) { if ((k >> 6) == seg) v = p.r_w2[((size_t)(l * 2 + seg) * 64 + (k & 63)) * 512 + cc]; }
        else if (seg < 4) { if ((k >> 6) == seg) v = p.r_a2[((size_t)(l * 2 + seg - 2) * 64 + (k & 63)) * 512 + cc]; }
        else { if (k >= 256) v = p.r_g2[((size_t)l * 128 + (k - 256)) * 512 + cc]; }
        wl[i] = f2bf(v);
    }
}
DI void ph_norm(const Prm& p, int l, int which, bool first, int nfix = 0, const float* fixgate = nullptr, float fixcoef = 0.f) { PH_IDS
    const int lane = TID & 63, wid = TID >> 6;
    const float* g = p.norm_g + (l * 3 + which) * DM; const float* mods = (const float*)(p.ws + WS_MODS) + (size_t)l * 27648;
    bf16_t* hb = (bf16_t*)(p.ws + WS_RWA); float* xc = (float*)(p.ws + WS_XC);
    for (int row = BID * 8 + wid; row < NTOK; row += NBLK * 8) {
        const int vec = row < NLAT ? (row >> 13) : 2;
        const float* sh = mods + vec * 9216 + (3 * which) * DM; const float* scl = sh + DM;
        float* xd = row < NLAT ? p.out + (size_t)row * DM : xc + (size_t)(row - NLAT) * DM;
        const float* xr = first ? (row < NLAT ? p.x + (size_t)row * DM : p.ctx + (size_t)(row - NLAT) * DM) : xd;
        f32x4 xv[4]; float ss = 0.f;
#pragma unroll
        for (int i = 0; i < 4; ++i) xv[i] = *(const f32x4*)(xr + i * 256 + lane * 4);
        if (nfix > 0 && row >= NLAT) {
            const float* P = (const float*)((const bf16_t*)(p.ws + WS_RWA) + (size_t)NTOK * DM) + (size_t)(row - NLAT) * DM;
#pragma unroll
            for (int i = 0; i < 4; ++i) {
                const int col = i * 256 + lane * 4; f32x4 sp = {0.f, 0.f, 0.f, 0.f};
                for (int ks = 0; ks < nfix; ++ks) sp += *(const f32x4*)(P + (size_t)ks * 512 * DM + col);
                xv[i] += *(const f32x4*)(fixgate + 2 * 9216 + col) * fixcoef * sp;
                *(f32x4*)(xd + col) = xv[i];
            }
        }
#pragma unroll
        for (int i = 0; i < 4; ++i) ss += xv[i][0] * xv[i][0] + xv[i][1] * xv[i][1] + xv[i][2] * xv[i][2] + xv[i][3] * xv[i][3];
        ss = wave_sum(ss); const float rinv = rsqrtf(ss * (1.f / DM) + 1e-6f);
#pragma unroll
        for (int i = 0; i < 4; ++i) {
            const int col = i * 256 + lane * 4;
            if (first) *(f32x4*)(xd + col) = xv[i];
            const f32x4 gv = *(const f32x4*)(g + col), sv = *(const f32x4*)(scl + col), hv = *(const f32x4*)(sh + col);
            float h[4];
#pragma unroll
            for (int e = 0; e < 4; ++e) h[e] = xv[i][e] * rinv * gv[e] * (1.f + sv[e]) + hv[e];
            u32x2 o; o.x = pk2(h[0], h[1]); o.y = pk2(h[2], h[3]);
            *(u32x2*)(hb + (size_t)row * DM + col) = o;
        }
    }
}
DI void ph_zero_ysum(const Prm& p) { PH_IDS
    f32x4* y = (f32x4*)(p.ws + WS_YSUM); const f32x4 zr = {0.f, 0.f, 0.f, 0.f};
    for (int i = BID * 512 + TID; i < NTOK * 128; i += NBLK * 512) y[i] = zr;
}
DI void ph_rkv_conv(const Prm& p, int l) { PH_IDS
    const int lane = TID & 63, wid = TID >> 6;
    const bf16_t* z = (const bf16_t*)(p.ws + WS_Z); bf16_t* tmp = (bf16_t*)(p.ws + WS_RWA); float* invn = (float*)(p.ws + WS_INVN);
    const float* cw = p.r_conv + (size_t)l * 3 * 1536;
    for (int row = BID * 8 + wid; row < NTOK; row += NBLK * 8) {
        const int t = row < NLAT ? (row & 8191) : ((row - NLAT) & 255), L = row < NLAT ? SEQL : CTXL;
        const bool hp = t > 0, hn = t < L - 1;
#pragma unroll
        for (int g = 0; g < 3; ++g) {
            const int ch = g * 512 + lane * 8; const bf16_t* zp = z + (size_t)row * ZW + ZC_RR + ch;
            const u32x4 zero = {0u, 0u, 0u, 0u};
            const u32x4 uc = *(const u32x4*)zp, up = hp ? *(const u32x4*)(zp - ZW) : zero, un = hn ? *(const u32x4*)(zp + ZW) : zero;
            float c[8], pv[8], nx[8], o[8]; unpack8(uc, c); unpack8(up, pv); unpack8(un, nx);
#pragma unroll
            for (int e = 0; e < 8; ++e) o[e] = cw[ch + e] * pv[e] + cw[1536 + ch + e] * c[e] + cw[3072 + ch + e] * nx[e];
            *(u32x4*)(tmp + (size_t)row * 1536 + ch) = pack8(o);
            if (g == 1) {
                float ss = 0.f;
#pragma unroll
                for (int e = 0; e < 8; ++e) { const float kk = o[e] * p.r_kk[l * 512 + lane * 8 + e]; ss += kk * kk; }
                ss += __shfl_xor(ss, 1); ss += __shfl_xor(ss, 2); ss += __shfl_xor(ss, 4);
                if ((lane & 7) == 0) invn[(size_t)row * 8 + (lane >> 3)] = 1.f / fmaxf(sqrtf(ss), 1e-12f);
            }
        }
    }
}
DI void ph_rkv_copy(const Prm& p) { PH_IDS
    const int lane = TID & 63, wid = TID >> 6;
    bf16_t* z = (bf16_t*)(p.ws + WS_Z); const bf16_t* tmp = (const bf16_t*)(p.ws + WS_RWA);
    for (int row = BID * 8 + wid; row < NTOK; row += NBLK * 8)
#pragma unroll
        for (int g = 0; g < 3; ++g) { const int ch = g * 512 + lane * 8; *(u32x4*)(z + (size_t)row * ZW + ZC_RR + ch) = *(const u32x4*)(tmp + (size_t)row * 1536 + ch); }
}
DI void ph_attn_prep(const Prm& p, int l) { PH_IDS
    const int lane = TID & 63, wid = TID >> 6, hw = lane >> 5, pp = lane & 31;
    bf16_t* z = (bf16_t*)(p.ws + WS_Z); const float* rope = (const float*)(p.ws + WS_ROPE); const float* qkn = p.a_qkn + l * 128;
    for (int row = BID * 8 + wid; row < NTOK; row += NBLK * 8) {
        const bool islat = row < NLAT; const int t = row & 8191;
        float cs = 1.f, sn = 0.f; if (islat) { cs = rope[((size_t)t * 32 + pp) * 2]; sn = rope[((size_t)t * 32 + pp) * 2 + 1]; }
#pragma unroll
        for (int it = 0; it < 8; ++it) {
            const int seg = it * 2 + hw, which = seg >> 3, col = (which ? ZC_AK : ZC_AQ) + (seg & 7) * 64 + 2 * pp;
            unsigned* zp = (unsigned*)(z + (size_t)row * ZW + col);
            const unsigned u = *zp; const float x1 = lo16(u), x2 = hi16(u);
            float ss = x1 * x1 + x2 * x2;
            ss += __shfl_xor(ss, 1); ss += __shfl_xor(ss, 2); ss += __shfl_xor(ss, 4); ss += __shfl_xor(ss, 8); ss += __shfl_xor(ss, 16);
            const float rinv = rsqrtf(ss * (1.f / 64.f) + 1e-6f) * (which ? 1.f : 0.125f * 1.4426950408889634f);
            const float y1 = x1 * rinv * qkn[which * 64 + 2 * pp], y2 = x2 * rinv * qkn[which * 64 + 2 * pp + 1];
            *zp = pk2(y1 * cs - y2 * sn, y1 * sn + y2 * cs);
        }
    }
}

#define MFMA16(a, b, c) __builtin_amdgcn_mfma_f32_16x16x32_bf16((a), (b), (c), 0, 0, 0)
#define MFMA32(a, b, c) __builtin_amdgcn_mfma_f32_32x32x16_bf16((a), (b), (c), 0, 0, 0)
DI float wave_incl_scan_add(float v, int lane) {
#pragma unroll
    for (int o = 1; o < 64; o <<= 1) { const float t = __shfl_up(v, o); if (lane >= o) v += t; }
    return v;
}
DI float wave_incl_scan_max(float v, int lane) {
#pragma unroll
    for (int o = 1; o < 64; o <<= 1) { const float t = __shfl_up(v, o); if (lane >= o) v = fmaxf(v, t); }
    return v;
}
DI float mconv(const bf16_t* z, const float* cw, size_t row, int t, int L, int ch) {
    const bf16_t* zp = z + row * ZW + ch;
    float a = cw[512 + ch] * bf2f(zp[0]);
    if (t > 0) a += cw[ch] * bf2f(zp[-ZW]);
    if (t < L - 1) a += cw[1024 + ch] * bf2f(zp[ZW]);
    return siluf_(a);
}
DI void mconv8(const bf16_t* z, const float* cw, size_t row, int t, int L, int ch, float* out) {
    const bf16_t* zp = z + row * ZW + ch; const u32x4 zero = {0u, 0u, 0u, 0u};
    const u32x4 uc = *(const u32x4*)zp, up = t > 0 ? *(const u32x4*)(zp - ZW) : zero, un = t < L - 1 ? *(const u32x4*)(zp + ZW) : zero;
    float c[8], pv[8], nx[8]; unpack8(uc, c); unpack8(up, pv); unpack8(un, nx);
#pragma unroll
    for (int e = 0; e < 8; ++e) out[e] = siluf_(cw[ch + e] * pv[e] + cw[512 + ch + e] * c[e] + cw[1024 + ch + e] * nx[e]);
}
DI void ph_mlstm_a(const Prm& p, int l, unsigned char* smem) { PH_IDS
    const int lane = TID & 63, wid = TID >> 6;
    const bf16_t* z = (const bf16_t*)(p.ws + WS_Z); bf16_t* mst = (bf16_t*)(p.ws + WS_MST); float* msc = (float*)(p.ws + WS_MSC); float* mn = (float*)(p.ws + WS_MN);
    const float* cw = p.m_conv + (size_t)l * 3 * 512; const float* gb = p.m_gb + l * 16;
    bf16_t* kT = (bf16_t*)smem; bf16_t* vT = (bf16_t*)(smem + 9216); float* wsl = (float*)(smem + 9216 + 18432);
    for (int u = BID; u < 2112; u += NBLK) {
        const int d = u / 1056, r = u % 1056, b = r / 528, h = (r % 528) / NCHK, c = r % NCHK;
        const int slot = ((d * 2 + b) * 4 + h) * NCHK + c;
        const bool isctx = c < 4; const int cs = isctx ? c : c - 4, nch = isctx ? 4 : 128, oc = d ? nch - 1 - cs : cs, L = isctx ? CTXL : SEQL;
        const size_t base = isctx ? (size_t)NLAT + b * CTXL + oc * 64 : (size_t)b * SEQL + oc * 64;
        __syncthreads();
        if (wid == 0) {
            const int o = d ? 63 - lane : lane; const bf16_t* zr = z + (base + o) * ZW + ZC_MG + 8 * d + h;
            const float ig = bf2f(zr[0]) + gb[(2 * d) * 4 + h], lf = logsigf_(bf2f(zr[4]) + gb[(2 * d + 1) * 4 + h]);
            const float bc = wave_incl_scan_add(lf, lane), bt = __shfl(bc, 63), wl = bt - bc + ig, ml = wave_max(wl);
            wsl[lane] = __expf(wl - ml);
            if (lane == 0) { msc[slot * 4] = bt; msc[slot * 4 + 1] = ml; }
        }
        __syncthreads();
        {
            const int pp = TID >> 3, g = TID & 7, o = d ? 63 - pp : pp; float kv[8];
            mconv8(z, cw, base + o, oc * 64 + o, L, 256 + h * 64 + g * 8, kv);
#pragma unroll
            for (int e = 0; e < 8; ++e) kT[(g * 8 + e) * 72 + pp] = f2bf(kv[e] * 0.125f);
        }
#pragma unroll
        for (int i = 0; i < 2; ++i) {
            const int idx = TID + 512 * i, pp = idx >> 4, g = idx & 15, o = d ? 63 - pp : pp; float vv8[8];
            unpack8(*(const u32x4*)(z + (base + o) * ZW + ZC_MV + h * 128 + g * 8), vv8); const float wv = wsl[pp];
#pragma unroll
            for (int e = 0; e < 8; ++e) vT[(g * 8 + e) * 72 + pp] = f2bf(vv8[e] * wv);
        }
        __syncthreads();
        f32x4 acc[4];
#pragma unroll
        for (int nt = 0; nt < 4; ++nt) acc[nt] = (f32x4){0.f, 0.f, 0.f, 0.f};
#pragma unroll
        for (int ks = 0; ks < 2; ++ks) {
            const bf16x8 a = *(const bf16x8*)(vT + (16 * wid + (lane & 15)) * 72 + ks * 32 + (lane >> 4) * 8);
#pragma unroll
            for (int nt = 0; nt < 4; ++nt) { const bf16x8 bb = *(const bf16x8*)(kT + (16 * nt + (lane & 15)) * 72 + ks * 32 + (lane >> 4) * 8); acc[nt] = MFMA16(a, bb, acc[nt]); }
        }
#pragma unroll
        for (int nt = 0; nt < 4; ++nt)
#pragma unroll
            for (int j = 0; j < 4; ++j) mst[(size_t)slot * 8192 + (16 * wid + (lane >> 4) * 4 + j) * 64 + 16 * nt + (lane & 15)] = f2bf(acc[nt][j]);
        if (TID < 64) { float s = 0.f; for (int pp = 0; pp < 64; ++pp) s += wsl[pp] * bf2f(kT[TID * 72 + pp]); mn[slot * 64 + TID] = s; }
    }
    __syncthreads();
}
DI void ph_mlstm_b(const Prm& p) { PH_IDS
    bf16_t* mst = (bf16_t*)(p.ws + WS_MST); float* msc = (float*)(p.ws + WS_MSC); float* mn = (float*)(p.ws + WS_MN);
    for (int e = BID * 512 + TID; e < 16 * 8256; e += NBLK * 512) {
        const int chain = e / 8256, idx = e % 8256; float m = 0.f, C = 0.f;
        for (int c0 = 0; c0 < NCHK; c0 += 22) {
            float uu[22], bt[22], ml[22];
#pragma unroll
            for (int j = 0; j < 22; ++j) {
                const int slot = chain * NCHK + c0 + j; bt[j] = msc[slot * 4]; ml[j] = msc[slot * 4 + 1];
                uu[j] = idx < 8192 ? bf2f(mst[(size_t)slot * 8192 + idx]) : mn[slot * 64 + idx - 8192];
            }
#pragma unroll
            for (int j = 0; j < 22; ++j) {
                const int slot = chain * NCHK + c0 + j;
                if (idx < 8192) mst[(size_t)slot * 8192 + idx] = f2bf(C); else mn[slot * 64 + idx - 8192] = C;
                if (idx == 0) msc[slot * 4 + 2] = m;
                const float mnew = fmaxf(bt[j] + m, ml[j]);
                C = __expf(bt[j] + m - mnew) * C + __expf(ml[j] - mnew) * uu[j]; m = mnew;
            }
        }
    }
}
DI void ph_mlstm_c(const Prm& p, int l, unsigned char* smem, int ubeg, int ustride, int ucount = 1 << 30) { PH_IDS
    const int lane = TID & 63, wid = TID >> 6;
    bf16_t* z = (bf16_t*)(p.ws + WS_Z); const bf16_t* mst = (const bf16_t*)(p.ws + WS_MST); const float* msc = (const float*)(p.ws + WS_MSC); const float* mn = (const float*)(p.ws + WS_MN);
    const float* cw = p.m_conv + (size_t)l * 3 * 512; const float* gb = p.m_gb + l * 16;
    bf16_t* qs = (bf16_t*)smem; bf16_t* ks_ = (bf16_t*)(smem + 9216); bf16_t* vT = (bf16_t*)(smem + 18432); bf16_t* Sp = (bf16_t*)(smem + 36864);
    float* hsum = (float*)(smem + 46080); float* fa = (float*)(smem + 46080 + 33792);
    float *bcum = fa, *gg = fa + 64, *Mrow = fa + 128, *iw = fa + 192, *den = fa + 256, *nq = fa + 320;
    for (int u = ubeg, un = 0; u < 1056 && un < ucount; u += ustride, ++un) {
        const int b = u / 528, h = (u % 528) / NCHK, cc = u % NCHK;
        const bool isctx = cc < 4; const int oc = isctx ? cc : cc - 4, nch = isctx ? 4 : 128, L = isctx ? CTXL : SEQL;
        const size_t base = isctx ? (size_t)NLAT + b * CTXL + oc * 64 : (size_t)b * SEQL + oc * 64;
        for (int d = 0; d < 2; ++d) {
            const int cs = d ? nch - 1 - oc : oc, c = isctx ? cs : cs + 4, slot = ((d * 2 + b) * 4 + h) * NCHK + c;
            const float mst_m = msc[slot * 4 + 2];
            __syncthreads();
            if (wid == 0) {
                const int o = d ? 63 - lane : lane; const bf16_t* zr = z + (base + o) * ZW + ZC_MG + 8 * d + h;
                const float ig = bf2f(zr[0]) + gb[(2 * d) * 4 + h], lf = logsigf_(bf2f(zr[4]) + gb[(2 * d + 1) * 4 + h]);
                const float bc = wave_incl_scan_add(lf, lane), g = ig - bc, pm = wave_incl_scan_max(g, lane), M = fmaxf(mst_m, pm);
                bcum[lane] = bc; gg[lane] = g; Mrow[lane] = M; iw[lane] = __expf(mst_m - M);
            }
#pragma unroll
            for (int i = 0; i < 2; ++i) {
                const int idx = TID + 512 * i, pp = idx >> 4, g = idx & 15, isk = g >> 3, dq0 = (g & 7) * 8, o = d ? 63 - pp : pp; float qv[8];
                mconv8(z, cw, base + o, oc * 64 + o, L, isk * 256 + h * 64 + dq0, qv);
                if (isk) {
#pragma unroll
                    for (int e = 0; e < 8; ++e) qv[e] *= 0.125f;
                }
                *(u32x4*)((isk ? ks_ : qs) + pp * 72 + dq0) = pack8(qv);
            }
#pragma unroll
            for (int i = 0; i < 2; ++i) {
                const int idx = TID + 512 * i, pp = idx >> 4, g = idx & 15, o = d ? 63 - pp : pp;
                const u32x4 uv = *(const u32x4*)(z + (base + o) * ZW + ZC_MV + h * 128 + g * 8);
                vT[(g * 8 + 0) * 72 + pp] = (bf16_t)(uv.x & 0xffffu); vT[(g * 8 + 1) * 72 + pp] = (bf16_t)(uv.x >> 16);
                vT[(g * 8 + 2) * 72 + pp] = (bf16_t)(uv.y & 0xffffu); vT[(g * 8 + 3) * 72 + pp] = (bf16_t)(uv.y >> 16);
                vT[(g * 8 + 4) * 72 + pp] = (bf16_t)(uv.z & 0xffffu); vT[(g * 8 + 5) * 72 + pp] = (bf16_t)(uv.z >> 16);
                vT[(g * 8 + 6) * 72 + pp] = (bf16_t)(uv.w & 0xffffu); vT[(g * 8 + 7) * 72 + pp] = (bf16_t)(uv.w >> 16);
            }
            __syncthreads();
            {
                const int mt = wid >> 1;
#pragma unroll
                for (int nn = 0; nn < 2; ++nn) {
                    const int nt = 2 * (wid & 1) + nn; f32x4 acc = {0.f, 0.f, 0.f, 0.f};
#pragma unroll
                    for (int ks = 0; ks < 2; ++ks) {
                        const bf16x8 a = *(const bf16x8*)(qs + (16 * mt + (lane & 15)) * 72 + ks * 32 + (lane >> 4) * 8);
                        const bf16x8 bb = *(const bf16x8*)(ks_ + (16 * nt + (lane & 15)) * 72 + ks * 32 + (lane >> 4) * 8);
                        acc = MFMA16(a, bb, acc);
                    }
                    const int s = 16 * nt + (lane & 15);
#pragma unroll
                    for (int j = 0; j < 4; ++j) { const int pp = 16 * mt + (lane >> 4) * 4 + j; const float v = s <= pp ? acc[j] * __expf(gg[s] - Mrow[pp]) : 0.f; Sp[pp * 72 + s] = f2bf(v); }
                }
                if (TID < 64) { float s = 0.f; for (int dq = 0; dq < 64; ++dq) s += mn[slot * 64 + dq] * bf2f(qs[TID * 72 + dq]); nq[TID] = s; }
            }
            __syncthreads();
            if (TID < 64) { float s = 0.f; for (int k = 0; k < 64; ++k) s += bf2f(Sp[TID * 72 + k]); den[TID] = s + iw[TID] * nq[TID]; }
            f32x4 a1[4], a2[4];
#pragma unroll
            for (int mt = 0; mt < 4; ++mt) { a1[mt] = (f32x4){0.f, 0.f, 0.f, 0.f}; a2[mt] = (f32x4){0.f, 0.f, 0.f, 0.f}; }
#pragma unroll
            for (int ks = 0; ks < 2; ++ks) {
                const bf16x8 bv = *(const bf16x8*)(vT + (16 * wid + (lane & 15)) * 72 + ks * 32 + (lane >> 4) * 8);
                const bf16x8 bc = *(const bf16x8*)(mst + (size_t)slot * 8192 + (16 * wid + (lane & 15)) * 64 + ks * 32 + (lane >> 4) * 8);
#pragma unroll
                for (int mt = 0; mt < 4; ++mt) {
                    const bf16x8 as = *(const bf16x8*)(Sp + (16 * mt + (lane & 15)) * 72 + ks * 32 + (lane >> 4) * 8);
                    const bf16x8 aq = *(const bf16x8*)(qs + (16 * mt + (lane & 15)) * 72 + ks * 32 + (lane >> 4) * 8);
                    a1[mt] = MFMA16(as, bv, a1[mt]); a2[mt] = MFMA16(aq, bc, a2[mt]);
                }
            }
            __syncthreads();
            {
                const int vv = 16 * wid + (lane & 15);
#pragma unroll
                for (int mt = 0; mt < 4; ++mt)
#pragma unroll
                    for (int j = 0; j < 4; ++j) {
                        const int pp = 16 * mt + (lane >> 4) * 4 + j, o = d ? 63 - pp : pp;
                        const float val = (a1[mt][j] + iw[pp] * a2[mt][j]) / fmaxf(fabsf(den[pp]), __expf(-(bcum[pp] + Mrow[pp])));
                        if (d == 0) hsum[o * 132 + vv] = val; else hsum[o * 132 + vv] += val;
                    }
            }
        }
        __syncthreads();
#pragma unroll
        for (int i = 0; i < 8; ++i) {
            const int o = wid * 8 + i; const float x0 = hsum[o * 132 + lane], x1 = hsum[o * 132 + lane + 64];
            const float ss = wave_sum(x0 * x0 + x1 * x1), rinv = rsqrtf(ss * (1.f / 128.f) + 1e-6f);
            bf16_t* zo = z + (base + o) * ZW + ZC_MO + h * 128; const float* on = p.m_on + l * 512 + h * 128;
            zo[lane] = f2bf(x0 * rinv * on[lane] * sigmoidf_(bf2f(zo[lane])));
            zo[lane + 64] = f2bf(x1 * rinv * on[lane + 64] * sigmoidf_(bf2f(zo[lane + 64])));
        }
    }
    __syncthreads();
}
DI int swap23(int s) { return (s & ~12) | ((s & 4) << 1) | ((s & 8) >> 1); }
DI void ph_attn(const Prm& p, int l, unsigned char* smem, int bh, int qfirst, int qstep, int nq, int qextra) { PH_IDS
    const int lane = TID & 63, wid = TID >> 6, q = lane & 31, hh = lane >> 5, qg = wid >> 1, mp = wid & 1, grp = wid >> 2;
    bf16_t* z = (bf16_t*)(p.ws + WS_Z);
    float lam; const float lam_init = 0.8f - 0.6f * expf(-0.3f * (float)l);
    { const float* lp = p.a_lam + l * 256; float s1 = 0.f, s2 = 0.f; for (int i = 0; i < 64; ++i) { s1 += lp[i] * lp[64 + i]; s2 += lp[128 + i] * lp[192 + i]; } lam = expf(s1) - expf(s2) + lam_init; }
    bf16_t* Qs = (bf16_t*)smem; float* ex = (float*)smem;
    constexpr int KB_OFF = 34816, VT_OFF = 69632;
    float kmax = 0.f; { const float* gk = p.a_qkn + l * 128 + 64; for (int i = 0; i < 64; ++i) kmax = fmaxf(kmax, fabsf(gk[i])); kmax *= 8.f; }
#define ATT_BAR asm volatile("s_waitcnt lgkmcnt(0)\n\ts_barrier" ::: "memory")
    for (int ui = 0; ui < nq + (qextra >= 0 ? 1 : 0); ++ui) {
        const int qi = ui < nq ? qfirst + ui * qstep : qextra;
        const int b = bh >> 2, head = bh & 3; int nt; size_t qrow0;
        const bool lat = qi < 64;
        if (lat) { qrow0 = (size_t)b * SEQL + qi * 128; nt = 132; } else { qrow0 = (size_t)NLAT + b * CTXL + (qi - 64) * 128; nt = 4; }
        __syncthreads();
#pragma unroll
        for (int i = 0; i < 4; ++i) { const int idx = TID + 512 * i, r = idx >> 4, cp = idx & 15; *(u32x4*)(Qs + r * 136 + cp * 8) = *(const u32x4*)(z + (qrow0 + r) * ZW + ZC_AQ + head * 128 + cp * 8); }
        u32x4 kreg[2], vreg[2];
        const int kp = TID & 31, vg = TID >> 5;
#define ATT_KROW0(j) ((lat && (j) >= 4) ? (size_t)b * SEQL + 64 * ((j) - 4) : (size_t)NLAT + b * CTXL + 64 * (j))
#define ATT_LOADK(j) do { const size_t kr0 = ATT_KROW0(j); \
            _Pragma("unroll") for (int i = 0; i < 2; ++i) { const int idx = TID + 512 * i, r = idx >> 4, cp = idx & 15; kreg[i] = *(const u32x4*)(z + (kr0 + r) * ZW + ZC_AK + head * 128 + cp * 8); } } while (0)
#define ATT_LOADV(j) do { const size_t kr0 = ATT_KROW0(j); \
            _Pragma("unroll") for (int i = 0; i < 2; ++i) vreg[i] = *(const u32x4*)(z + (kr0 + 2 * kp + i) * ZW + ZC_AV + head * 128 + 8 * vg); } while (0)
#define ATT_WRITEK(buf) do { bf16_t* Kw = (bf16_t*)(smem + KB_OFF + (buf) * 17408); \
            _Pragma("unroll") for (int i = 0; i < 2; ++i) { const int idx = TID + 512 * i, r = idx >> 4, cp = idx & 15; *(u32x4*)(Kw + r * 136 + cp * 8) = kreg[i]; } } while (0)
#define ATT_WRITEV(buf) do { bf16_t* Vw = (bf16_t*)(smem + VT_OFF + (buf) * 18432); \
            _Pragma("unroll") for (int w = 0; w < 4; ++w) { \
                *(unsigned*)(Vw + (8 * vg + 2 * w) * 72 + 2 * kp) = (vreg[0][w] & 0xffffu) | (vreg[1][w] << 16); \
                *(unsigned*)(Vw + (8 * vg + 2 * w + 1) * 72 + 2 * kp) = (vreg[0][w] >> 16) | (vreg[1][w] & 0xffff0000u); } } while (0)
        f32x16 o[4]; float lrun = 0.f; bf16x8 pf[4];
        float mfix;
        { __syncthreads(); float qq = 0.f;
#pragma unroll
          for (int c8 = 0; c8 < 8; ++c8) { float f8[8]; unpack8(*(const u32x4*)(Qs + (32 * qg + q) * 136 + mp * 64 + c8 * 8), f8);
#pragma unroll
              for (int e = 0; e < 8; ++e) qq += f8[e] * f8[e]; }
          mfix = sqrtf(qq) * kmax * 1.01f + 0.01f; }
        const float nmfix = -mfix;
#pragma unroll
        for (int dvb = 0; dvb < 4; ++dvb)
#pragma unroll
            for (int i = 0; i < 16; ++i) o[dvb][i] = 0.f;
#define ATT_QK(j) do { const bf16_t* Kb = (const bf16_t*)(smem + KB_OFF + ((j) & 1) * 17408); \
            f32x16 s0, s1; \
            _Pragma("unroll") for (int i = 0; i < 16; ++i) { s0[i] = nmfix; s1[i] = nmfix; } \
            _Pragma("unroll") for (int kk = 0; kk < 4; ++kk) { \
                const bf16x8 qf = *(const bf16x8*)(Qs + (32 * qg + q) * 136 + mp * 64 + kk * 16 + hh * 8); \
                const bf16x8 k0 = *(const bf16x8*)(Kb + swap23(q) * 136 + mp * 64 + kk * 16 + hh * 8); \
                const bf16x8 k1 = *(const bf16x8*)(Kb + (32 + swap23(q)) * 136 + mp * 64 + kk * 16 + hh * 8); \
                s0 = MFMA32(k0, qf, s0); s1 = MFMA32(k1, qf, s1); } \
            f32x2 ps = {0.f, 0.f}; \
            _Pragma("unroll") for (int i = 0; i < 16; i += 2) { s0[i] = __builtin_amdgcn_exp2f(s0[i]); s0[i + 1] = __builtin_amdgcn_exp2f(s0[i + 1]); s1[i] = __builtin_amdgcn_exp2f(s1[i]); s1[i + 1] = __builtin_amdgcn_exp2f(s1[i + 1]); \
                const f32x2 a2 = {s0[i], s0[i + 1]}, b2 = {s1[i], s1[i + 1]}; ps += a2 + b2; } \
            lrun += ps.x + ps.y; \
            _Pragma("unroll") for (int cc = 0; cc < 2; ++cc) { u32x4 a, c2; \
                a.x = pk2(s0[8 * cc], s0[8 * cc + 1]); a.y = pk2(s0[8 * cc + 2], s0[8 * cc + 3]); a.z = pk2(s0[8 * cc + 4], s0[8 * cc + 5]); a.w = pk2(s0[8 * cc + 6], s0[8 * cc + 7]); \
                c2.x = pk2(s1[8 * cc], s1[8 * cc + 1]); c2.y = pk2(s1[8 * cc + 2], s1[8 * cc + 3]); c2.z = pk2(s1[8 * cc + 4], s1[8 * cc + 5]); c2.w = pk2(s1[8 * cc + 6], s1[8 * cc + 7]); \
                pf[cc] = __builtin_bit_cast(bf16x8, a); pf[2 + cc] = __builtin_bit_cast(bf16x8, c2); } } while (0)
#define ATT_PV(j) do { const bf16_t* Vt = (const bf16_t*)(smem + VT_OFF + ((j) & 1) * 18432); \
            _Pragma("unroll") for (int dvb = 0; dvb < 4; ++dvb) _Pragma("unroll") for (int c = 0; c < 4; ++c) { \
                const bf16x8 vf = *(const bf16x8*)(Vt + (dvb * 32 + q) * 72 + 16 * c + 8 * hh); o[dvb] = MFMA32(vf, pf[c], o[dvb]); } } while (0)
        ATT_LOADK(0); ATT_LOADV(0); ATT_WRITEK(0); ATT_WRITEV(0);
        __syncthreads();
        for (int j = 0; j < nt; ++j) {
            if (j + 1 < nt) { ATT_LOADK(j + 1); ATT_LOADV(j + 1); }
            ATT_QK(j); ATT_PV(j);
            if (j + 1 < nt) { ATT_WRITEK((j + 1) & 1); ATT_WRITEV((j + 1) & 1); }
            __syncthreads();
        }
        const float lsum = lrun + __shfl_xor(lrun, 32);
        const float inv = (mp ? lam : 1.f) / lsum;
        if (mp) {
#pragma unroll
            for (int dvb = 0; dvb < 4; ++dvb)
#pragma unroll
                for (int i = 0; i < 16; ++i) ex[(qg * 64 + dvb * 16 + i) * 64 + lane] = o[dvb][i] * inv;
        }
        __syncthreads();
        if (!mp) {
            float ss = 0.f;
#pragma unroll
            for (int dvb = 0; dvb < 4; ++dvb)
#pragma unroll
                for (int i = 0; i < 16; ++i) { const float v = o[dvb][i] * inv - ex[(qg * 64 + dvb * 16 + i) * 64 + lane]; o[dvb][i] = v; ss += v * v; }
            ss += __shfl_xor(ss, 32);
            const float rinv = rsqrtf(ss * (1.f / 128.f) + 1e-6f) * (1.f - lam_init);
            bf16_t* orow = z + (qrow0 + 32 * qg + q) * ZW + ZC_AQ + head * 128; const float* sub = p.a_subln + l * 128;
#pragma unroll
            for (int dvb = 0; dvb < 4; ++dvb)
#pragma unroll
                for (int ig = 0; ig < 4; ++ig) {
                    const int dv0 = dvb * 32 + 8 * ig + 4 * hh; u32x2 w;
                    w.x = pk2(o[dvb][4 * ig] * rinv * sub[dv0], o[dvb][4 * ig + 1] * rinv * sub[dv0 + 1]);
                    w.y = pk2(o[dvb][4 * ig + 2] * rinv * sub[dv0 + 2], o[dvb][4 * ig + 3] * rinv * sub[dv0 + 3]);
                    *(u32x2*)(orow + dv0) = w;
                }
        }
    }
    __syncthreads();
}

__device__ unsigned long long g_pacc[4];
template <int CTRL> DI float dppf(float v) { return __int_as_float(__builtin_amdgcn_update_dpp(0, __float_as_int(v), CTRL, 0xf, 0xf, false)); }
DI float allreduce16(float x) { x += dppf<0x128>(x); x += dppf<0x124>(x); x += dppf<0x122>(x); x += dppf<0x121>(x); return x; }
DI void ph_rwkv_scan(const Prm& p, int l, unsigned char* smem, int ubeg, int ustride) { PH_IDS
    const int lane = TID & 63, wid = TID >> 6;
    const bf16_t* z = (const bf16_t*)(p.ws + WS_Z); const bf16_t* rwa = (const bf16_t*)(p.ws + WS_RWA); const float* invn = (const float*)(p.ws + WS_INVN);
    constexpr int TC = 32, OPW = 336, NC = 264, OPS_B = TC * OPW * 4, YP_OFF = 2 * OPS_B;
    for (int u = ubeg; u < 128; u += ustride) {
        const int chain = u >> 2, qr = u & 3, d = chain >> 4, b = (chain >> 3) & 1, h = chain & 7;
        const float ckk = p.r_kk[l * 512 + h * 64 + lane], cka = p.r_ka[l * 512 + h * 64 + lane];
        bf16_t* ydir = (bf16_t*)(p.ws + WS_YSUM) + (size_t)d * NTOK * 512;
#define RW_ROW(ck, i) ((ck) < 8 ? (size_t)NLAT + b * CTXL + (d ? CTXL - 1 - ((ck) * TC + (i)) : ((ck) * TC + (i))) : (size_t)b * SEQL + (d ? SEQL - 1 - (((ck) - 8) * TC + (i)) : (((ck) - 8) * TC + (i))))
        bf16_t g_r[8], g_k[8], g_u[8], g_a[8]; float g_i[8]; unsigned g_v;
        const int sw = wid - 4, st = TID - 256;
#define RW_LOAD(ck) do { _Pragma("unroll") for (int jj = 0; jj < 8; ++jj) { const size_t row = RW_ROW(ck, sw + 4 * jj); \
            g_r[jj] = z[row * ZW + ZC_RR + h * 64 + lane]; g_k[jj] = z[row * ZW + ZC_RK + h * 64 + lane]; \
            g_u[jj] = rwa[row * 2048 + d * 512 + h * 64 + lane]; g_a[jj] = rwa[row * 2048 + 1024 + d * 512 + h * 64 + lane]; g_i[jj] = invn[row * 8 + h]; } \
            g_v = *(const unsigned*)(z + RW_ROW(ck, st >> 3) * ZW + ZC_RV + h * 64 + qr * 16 + (st & 7) * 2); } while (0)
#define RW_WRITE(buf) do { float* ops = (float*)(smem + (buf) * OPS_B); _Pragma("unroll") for (int jj = 0; jj < 8; ++jj) { \
            const float k = bf2f(g_k[jj]), a = bf2f(g_a[jj]), kk = k * ckk * g_i[jj]; float* o = ops + (sw + 4 * jj) * OPW; \
            o[lane] = 1.f - bf2f(g_u[jj]); o[64 + lane] = kk; o[128 + lane] = kk * a; o[192 + lane] = k * (1.f + (a - 1.f) * cka); o[256 + lane] = bf2f(g_r[jj]); } \
            { float* o = ops + (st >> 3) * OPW + 320 + (st & 7) * 2; o[0] = lo16(g_v); o[1] = hi16(g_v); } } while (0)
        __syncthreads();
        if (wid >= 4) { RW_LOAD(0); RW_WRITE(0); RW_LOAD(1); }
        __syncthreads();
        f32x2 Sa = {0.f, 0.f}, Sb = {0.f, 0.f};
        const int rl = (wid & 3) * 4 + (lane >> 4), ksub = lane & 15;
        float* ypw = (float*)(smem + YP_OFF) + (wid & 3) * (TC * 64);
        for (int ck = 0; ck < NC; ++ck) {
            if (wid >= 4) {
                if (ck + 1 < NC) RW_WRITE((ck + 1) & 1);
                if (ck + 2 < NC) RW_LOAD(ck + 2);
            } else {
                const float* ops = (const float*)(smem + (ck & 1) * OPS_B);
#define RW_GET(X, i) do { const float* o_ = ops + (i) * OPW; w_##X = *(const f32x4*)(o_ + 4 * ksub); k_##X = *(const f32x4*)(o_ + 64 + 4 * ksub); b_##X = *(const f32x4*)(o_ + 128 + 4 * ksub); \
                d_##X = *(const f32x4*)(o_ + 192 + 4 * ksub); r_##X = *(const f32x4*)(o_ + 256 + 4 * ksub); v_##X = o_[320 + rl]; } while (0)
#define RW_STEP(X, i) do { const f32x2 ka = {k_##X[0], k_##X[1]}, kb = {k_##X[2], k_##X[3]}, ra = {r_##X[0], r_##X[1]}, rb = {r_##X[2], r_##X[3]}; \
                const f32x2 ba = {b_##X[0], b_##X[1]}, bb = {b_##X[2], b_##X[3]}, da = {d_##X[0], d_##X[1]}, db = {d_##X[2], d_##X[3]}, wa = {w_##X[0], w_##X[1]}, wb = {w_##X[2], w_##X[3]}; \
                const f32x2 dt2 = Sa * ka + Sb * kb; const f32x2 qa = Sa * wa + da * v_##X, qb = Sb * wb + db * v_##X; const float sa = -allreduce16(dt2.x + dt2.y); \
                Sa = ba * sa + qa; Sb = bb * sa + qb; \
                const f32x2 y2 = Sa * ra + Sb * rb; \
                ypw[(i) * 64 + lane] = y2.x + y2.y; } while (0)
                f32x4 w_A, k_A, b_A, d_A, r_A, w_B, k_B, b_B, d_B, r_B, w_C, k_C, b_C, d_C, r_C, w_D, k_D, b_D, d_D, r_D; float v_A, v_B, v_C, v_D;
                RW_GET(A, 0); RW_GET(B, 1);
#pragma unroll 1
                for (int i = 0; i < TC; i += 4) {
                    RW_GET(C, i + 2);
                    RW_STEP(A, i);
                    RW_GET(D, i + 3);
                    RW_STEP(B, i + 1);
                    if (i + 4 < TC) RW_GET(A, i + 4);
                    RW_STEP(C, i + 2);
                    if (i + 4 < TC) RW_GET(B, i + 5);
                    RW_STEP(D, i + 3);
                }
                {
                    const int i = lane >> 1, rw = (lane & 1) * 2;
                    const f32x4* y4 = (const f32x4*)(ypw + i * 64 + rw * 16);
                    const f32x4 s4 = (y4[0] + y4[1]) + (y4[2] + y4[3]), t4 = (y4[4] + y4[5]) + (y4[6] + y4[7]);
                    *(unsigned*)(ydir + RW_ROW(ck, i) * 512 + h * 64 + qr * 16 + wid * 4 + rw) = pk2((s4[0] + s4[1]) + (s4[2] + s4[3]), (t4[0] + t4[1]) + (t4[2] + t4[3]));
                }
            }
            asm volatile("s_waitcnt lgkmcnt(0)\n\ts_barrier" ::: "memory");
        }
    }
    __syncthreads();
}
DI void ph_rwkv_post(const Prm& p, int l) { PH_IDS
    const int lane = TID & 63, wid = TID >> 6, ch0 = lane * 8;
    bf16_t* z = (bf16_t*)(p.ws + WS_Z); const bf16_t* ysum = (const bf16_t*)(p.ws + WS_YSUM); const bf16_t* rg = (const bf16_t*)(p.ws + WS_RG);
    for (int row = BID * 8 + wid; row < NTOK; row += NBLK * 8) {
        float y[8], y2[8], r[8], k[8], v[8], g[8], o[8];
        unpack8(*(const u32x4*)(ysum + (size_t)row * 512 + ch0), y); unpack8(*(const u32x4*)(ysum + (size_t)(NTOK + row) * 512 + ch0), y2);
#pragma unroll
        for (int e = 0; e < 8; ++e) y[e] += y2[e];
        bf16_t* zr = z + (size_t)row * ZW + ZC_RR + ch0;
        unpack8(*(const u32x4*)zr, r); unpack8(*(const u32x4*)(zr + 512), k); unpack8(*(const u32x4*)(zr + 1024), v); unpack8(*(const u32x4*)(rg + (size_t)row * 512 + ch0), g);
        float s = 0.f, bs = 0.f;
#pragma unroll
        for (int e = 0; e < 8; ++e) { s += y[e]; bs += r[e] * k[e] * p.r_rk[l * 512 + ch0 + e]; }
        s += __shfl_xor(s, 1); s += __shfl_xor(s, 2); s += __shfl_xor(s, 4); bs += __shfl_xor(bs, 1); bs += __shfl_xor(bs, 2); bs += __shfl_xor(bs, 4);
        const float mu = s * (1.f / 64.f); float vs = 0.f;
#pragma unroll
        for (int e = 0; e < 8; ++e) { const float dlt = y[e] - mu; vs += dlt * dlt; }
        vs += __shfl_xor(vs, 1); vs += __shfl_xor(vs, 2); vs += __shfl_xor(vs, 4);
        const float rstd = rsqrtf(vs * (1.f / 64.f) + 64e-5f);
#pragma unroll
        for (int e = 0; e < 8; ++e) o[e] = ((y[e] - mu) * rstd * p.r_lnw[l * 512 + ch0 + e] + p.r_lnb[l * 512 + ch0 + e] + bs * v[e]) * g[e];
        *(u32x4*)zr = pack8(o);
    }
}

#ifndef PROBE_A
#define PROBE_A 0
#endif
#ifndef PROBE_B
#define PROBE_B 0
#endif
#ifndef PROBE_BLK
#define PROBE_BLK 0
#endif
#ifndef PROBE_ADIV
#define PROBE_ADIV 1
#endif
#ifndef PROBE_BDIV
#define PROBE_BDIV 1
#endif
#if PROBE_A || PROBE_B
#define PT(id, ...) do { unsigned long long t0_ = wall_clock64(); __VA_ARGS__; unsigned long long dt_ = wall_clock64() - t0_; if ((id) == PROBE_A) pacc1 += dt_; if ((id) == PROBE_B) pacc2 += dt_; } while (0)
#else
#define PT(id, ...) do { __VA_ARGS__; } while (0)
#endif
DI void grid_bar(unsigned* ctr, unsigned& target, unsigned nblk) {
    __syncthreads();
    if (threadIdx.x == 0) {
        __builtin_amdgcn_fence(__ATOMIC_RELEASE, "agent");
        target += nblk;
        __hip_atomic_fetch_add(ctr, 1u, __ATOMIC_RELAXED, __HIP_MEMORY_SCOPE_AGENT);
        while (__hip_atomic_load(ctr, __ATOMIC_RELAXED, __HIP_MEMORY_SCOPE_AGENT) < target) __builtin_amdgcn_s_sleep(2);
        __builtin_amdgcn_fence(__ATOMIC_ACQUIRE, "agent");
    }
    __syncthreads();
}
__global__ void __launch_bounds__(512) mega(Prm p0) {
    Prm p = p0; p.wv = __builtin_amdgcn_readfirstlane((int)threadIdx.x >> 6);
    const int BIDK = (int)blockIdx.x;
    extern __shared__ __attribute__((aligned(16))) unsigned char smem[];
    cg::grid_group grid = cg::this_grid();
    unsigned bar_target = 0; unsigned* bar_ctr = (unsigned*)(p0.ws + WS_BAR);
#define GSYNC() grid_bar(bar_ctr, bar_target, gridDim.x)
    bf16_t* wt = (bf16_t*)(p.ws + WS_WT); bf16_t* zb = (bf16_t*)(p.ws + WS_Z); bf16_t* hb = (bf16_t*)(p.ws + WS_RWA); bf16_t* gtmp = hb + (size_t)NTOK * DM;
    bf16_t* zz = (bf16_t*)(p.ws + WS_MST); float* xc = (float*)(p.ws + WS_XC); const float* mods = (const float*)(p.ws + WS_MODS);
#if PROBE_A || PROBE_B
    unsigned long long pacc1 = 0, pacc2 = 0; const unsigned long long pstart = wall_clock64();
    if (PROBE_SCAN && blockIdx.x == 0 && threadIdx.x == 0) { g_pacc[0] = 0; g_pacc[1] = 0; }
#endif
    PT(15, ph_modpart(p, smem); ph_rope(p); conv_ffn(p, 0, 0, smem));
    PT(14, grid.sync());
    ph_modreduce(p);
    PT(14, GSYNC());
#define MERGE_B(l, b) do { \
                    { EpiGate E; E.G = gtmp; run_gemm(p.wv, smem, hb, DM, wt + WT_G + (size_t)(b) * DM * DM, (l) == 1 ? NLAT : NTOK, DM, DM, E); } \
                    { EpiBranch E; E.G = gtmp; E.ZZ = zz; E.first = ((b) == 0); const int yc = (b) == 0 ? ZC_MO : ((b) == 1 ? ZC_RR : ZC_AQ); \
                      run_gemm(p.wv, smem, zb + yc, ZW, wt + WT_P + (size_t)(b) * DM * 512, (l) == 1 ? NLAT : NTOK, DM, 512, E); } \
 } while (0)
#define MIXER_STAGE(l) do { const float* ml = mods + (size_t)(l) * 27648; \
                PT(13, ph_norm(p, l, 1, false, 11, ml + 2 * DM, 0.5f); conv_mixer(p, l, smem);); \
                PT(14, GSYNC()); \
                PT(8, { EpiWin E; E.Z = zb; run_gemm(p.wv, smem, hb, DM, wt + WT_IN, NTOK, ZWP, DM, E); }); \
                PT(14, GSYNC()); \
                PT(4, ph_rkv_conv(p, l); ph_attn_prep(p, l)); PT(5, ph_mlstm_a(p, l, smem)); \
                PT(14, GSYNC()); \
                PT(6, ph_rkv_copy(p)); PT(7, ph_mlstm_b(p)); \
                PT(14, GSYNC()); \
                PT(16, { EpiLora E; E.RWA = hb; E.RG = (bf16_t*)(p.ws + WS_RG); E.w0 = p.r_w0 + l * 1024; E.a0 = p.r_a0 + l * 1024; run_gemm(p.wv, smem, zb + ZC_RL, ZW, wt + WT_L, NTOK, 2560, 384, E); }); \
                PT(14, GSYNC()); \
                { int sc_u = BIDK, sc_s = NBLK, bh0 = 0, bh1 = 8, qf = BIDK, qs = NBLK, nq = (66 - BIDK + NBLK - 1) / NBLK, qx = -1, mc_u = BIDK, mc_s = NBLK, mc_c = 1 << 30; \
                  if (NBLK == 256) { const int xi = BIDK >> 3, bh = BIDK & 7; bh0 = bh; bh1 = bh + 1; sc_s = 128; \
                      if (xi < 16) { sc_u = bh * 16 + xi; nq = 0; mc_u = 256 + bh * 16 + xi; mc_s = 128; } \
                      else { const int a = xi - 16; sc_u = 128; qf = a; qs = 16; nq = 4; qx = a < 2 ? 64 + a : -1; mc_u = (bh * 16 + a) * 2; mc_s = 1; mc_c = 2; } } \
                  PT(1, ph_rwkv_scan(p, l, smem, sc_u, sc_s)); \
                  PT(2, for (int bh = bh0; bh < bh1; ++bh) ph_attn(p, l, smem, bh, qf, qs, nq, qx)); \
                  PT(3, ph_mlstm_c(p, l, smem, mc_u, mc_s, mc_c)); } \
                PT(14, GSYNC()); \
                PT(12, ph_rwkv_post(p, l); ph_norm(p, l, 1, false)); \
                PT(14, GSYNC()); \
                PT(9, MERGE_B(l, 0); MERGE_B(l, 1); MERGE_B(l, 2)); \
                PT(14, GSYNC()); \
                PT(17, { EpiResid E; E.xlat = p.out; E.xc = xc; E.gate = ml + 5 * DM; E.coef = 1.f; run_gemm(p.wv, smem, zz, DM, wt + WT_O, NLAT, DM, DM, E); \
              if ((l) == 0) { EpiPartial E2; E2.P = (float*)gtmp; E2.kslice_bytes = 512; run_gemm_ctx(p.wv, smem, zz, DM, wt + WT_O, DM, 4, 256, E2); } }); \
                PT(14, GSYNC()); \
 } while (0)
#define FFN_STAGE(l, f) do { const float* ml = mods + (size_t)(l) * 27648; \
            PT(18, ph_norm(p, l, f == 0 ? 0 : 2, l == 0 && f == 0, (f) == 1 ? ((l) == 0 ? 4 : 0) : ((l) == 1 ? 11 : 0), (f) == 1 ? ml + 5 * DM : mods + 8 * DM, (f) == 1 ? 1.f : 0.5f); \
            if (!(l == 0 && f == 0)) conv_ffn(p, l, f, smem)); \
            PT(14, GSYNC()); \
            PT(10, { EpiSwiglu E; E.H = zb; run_gemm(p.wv, smem, hb, DM, wt + WT_GU, ((l) == 1 && (f) == 1) ? NLAT : NTOK, 2 * DFF, DM, E); }); \
            PT(14, GSYNC()); \
            PT(11, { EpiResid E; E.xlat = p.out; E.xc = xc; E.gate = ml + (f == 0 ? 2 : 8) * DM; E.coef = 0.5f; run_gemm(p.wv, smem, zb, DFF, wt + WT_DN, NLAT, DM, DFF, E); \
              if (!((l) == 1 && (f) == 1)) { EpiPartial E2; E2.P = (float*)gtmp; E2.kslice_bytes = 512; run_gemm_ctx(p.wv, smem, zb, DFF, wt + WT_DN, DFF, 11, 256, E2); } }); \
            PT(14, GSYNC()); \
 } while (0)
    FFN_STAGE(0, 0); MIXER_STAGE(0); FFN_STAGE(0, 1); FFN_STAGE(1, 0); MIXER_STAGE(1); FFN_STAGE(1, 1);
#if PROBE_A || PROBE_B
    if (blockIdx.x == PROBE_BLK) {
        const unsigned long long pend = wall_clock64();
        if (PROBE_SCAN) { __syncthreads(); pacc1 = g_pacc[0]; pacc2 = g_pacc[1]; }
        if (PROBE_A == 99) pacc1 = pend - pstart;
        if (PROBE_B == 99) pacc2 = pend - pstart;
        unsigned long long q1 = pacc1 / (4000ull * PROBE_ADIV), q2 = pacc2 / (4000ull * PROBE_BDIV); if (q1 > 63) q1 = 63; if (q2 > 63) q2 = 63;
        const unsigned long long waitt = (q1 + 64 * q2) * 2000ull;
        while (wall_clock64() - pend < waitt) __builtin_amdgcn_s_sleep(32);
    }
#endif
}

extern "C" void kernel_launch(void* const* d_in, const int* in_sizes, int n_in, void* d_out, int out_size, void* d_ws, size_t ws_size, hipStream_t stream) {
    static int grid_blocks = 0;
    if (!grid_blocks) {
        int dev = 0, cus = 0, per_cu = 0;
        hipGetDevice(&dev);
        hipDeviceGetAttribute(&cus, hipDeviceAttributeMultiprocessorCount, dev);
        hipFuncSetAttribute((const void*)mega, hipFuncAttributeMaxDynamicSharedMemorySize, LDS_BYTES);
        hipOccupancyMaxActiveBlocksPerMultiprocessor(&per_cu, (const void*)mega, 512, LDS_BYTES);
        if (per_cu < 1) per_cu = 1;
        grid_blocks = cus * per_cu;
        if (ws_size < WS_END) fprintf(stderr, "kernel_launch: workspace too small: %zu < %zu\n", ws_size, (size_t)WS_END);
    }
    Prm p{};
    const float** pp = (const float**)&p;
    for (int i = 0; i < 31; ++i) pp[i] = (const float*)d_in[i];
    p.out = (float*)d_out; p.ws = (unsigned char*)d_ws;
    (void)hipMemsetAsync((unsigned char*)d_ws + WS_BAR, 0, 256, stream);
    void* args[] = {&p};
    hipError_t e = hipLaunchCooperativeKernel((const void*)mega, dim3(grid_blocks), dim3(512), args, LDS_BYTES, stream);
    if (e != hipSuccess) fprintf(stderr, "cooperative launch failed: %s (grid %d)\n", hipGetErrorString(e), grid_blocks);
}
```

```cpp
#include <hip/hip_runtime.h>
#include <hip/hip_cooperative_groups.h>
#include <cstdio>
#include <cstdint>
namespace cg = cooperative_groups;
#ifndef PROBE_SCAN
#define PROBE_SCAN 0
#endif

#define LAS __attribute__((address_space(3)))
#define DI __device__ __forceinline__
typedef unsigned short bf16_t;
typedef short bf16x8 __attribute__((ext_vector_type(8)));
typedef float f32x4 __attribute__((ext_vector_type(4)));
typedef float f32x16 __attribute__((ext_vector_type(16)));
typedef float f32x2 __attribute__((ext_vector_type(2)));
typedef unsigned u32x4 __attribute__((ext_vector_type(4)));
typedef unsigned u32x2 __attribute__((ext_vector_type(2)));
typedef __bf16 bf16x2_t __attribute__((ext_vector_type(2)));

constexpr int DM = 1024, NLAT = 16384, NTOK = 16896, SEQL = 8192, CTXL = 256, DFF = 2816, DIN = 8080, ZW = 5008, ZWP = 5120;
constexpr int ZC_MQ = 0, ZC_MK = 256, ZC_MV = 512, ZC_MO = 1024, ZC_MG = 1536, ZC_RR = 1552, ZC_RK = 2064, ZC_RV = 2576, ZC_RL = 3088, ZC_AQ = 3472, ZC_AK = 3984, ZC_AV = 4496;
constexpr int NCHK = 132;
constexpr size_t WS_MODP = 0;
constexpr size_t WS_MODS = WS_MODP + (size_t)2 * 16 * 3 * 9216 * 4;
constexpr size_t WS_ROPE = WS_MODS + (size_t)2 * 3 * 9216 * 4;
constexpr size_t WS_XC   = WS_ROPE + (size_t)8192 * 64 * 4;
constexpr size_t WS_INVN = WS_XC + (size_t)512 * 1024 * 4;
constexpr size_t WS_MSC  = WS_INVN + (size_t)NTOK * 8 * 4;
constexpr size_t WS_MN   = WS_MSC + (size_t)2112 * 4 * 4;
constexpr size_t WS_WT   = WS_MN + (size_t)2112 * 64 * 4;
constexpr size_t WS_Z    = WS_WT + (size_t)25165824;
constexpr size_t WS_RWA  = WS_Z + (size_t)NTOK * ZW * 2;
constexpr size_t WS_RG   = WS_RWA + (size_t)NTOK * 2048 * 2;
constexpr size_t WS_MST  = WS_RG + (size_t)NTOK * 512 * 2;
constexpr size_t WS_YSUM = WS_MST + (size_t)2112 * 8192 * 2;
constexpr size_t WS_BAR  = WS_YSUM + (size_t)NTOK * 512 * 4;
constexpr size_t WS_END  = WS_BAR + 256;
constexpr size_t WT_GU = 0, WT_DN = (size_t)5632 * 1024;
constexpr size_t WT_IN = 0, WT_G = (size_t)5120 * 1024, WT_P = WT_G + (size_t)3072 * 1024, WT_O = WT_P + (size_t)3 * 1024 * 512, WT_L = WT_O + (size_t)1024 * 1024;
constexpr int LDS_BYTES = 155648;

DI float bf2f(bf16_t b) { return __uint_as_float(((unsigned)b) << 16); }
DI unsigned pk2(float lo, float hi) { f32x2 v = {lo, hi}; bf16x2_t b = __builtin_convertvector(v, bf16x2_t); return __builtin_bit_cast(unsigned, b); }
DI bf16_t f2bf(float f) { return (bf16_t)(pk2(f, 0.f) & 0xffffu); }
DI float lo16(unsigned u) { return __uint_as_float(u << 16); }
DI float hi16(unsigned u) { return __uint_as_float(u & 0xffff0000u); }
DI float sigmoidf_(float x) { return __builtin_amdgcn_rcpf(1.f + __expf(-x)); }
DI float siluf_(float x) { return x * __builtin_amdgcn_rcpf(1.f + __expf(-x)); }
DI float logsigf_(float x) { return x < 0.f ? x - log1pf(expf(x)) : -log1pf(expf(-x)); }
DI float wave_sum(float v) {
#pragma unroll
    for (int o = 1; o < 64; o <<= 1) v += __shfl_xor(v, o);
    return v;
}
DI float wave_max(float v) {
#pragma unroll
    for (int o = 1; o < 64; o <<= 1) v = fmaxf(v, __shfl_xor(v, o));
    return v;
}
DI void unpack8(const u32x4 u, float* f) { f[0] = lo16(u.x); f[1] = hi16(u.x); f[2] = lo16(u.y); f[3] = hi16(u.y); f[4] = lo16(u.z); f[5] = hi16(u.z); f[6] = lo16(u.w); f[7] = hi16(u.w); }
DI u32x4 pack8(const float* f) { u32x4 u; u.x = pk2(f[0], f[1]); u.y = pk2(f[2], f[3]); u.z = pk2(f[4], f[5]); u.w = pk2(f[6], f[7]); return u; }
DI int launder_v(int v) { asm volatile("" : "+v"(v)); return v; }
DI int launder_s(int v) { asm volatile("" : "+s"(v)); return v; }
DI int lane_id_() { return (int)__builtin_amdgcn_mbcnt_hi(~0u, __builtin_amdgcn_mbcnt_lo(~0u, 0u)); }
namespace pg8 {
#define PG8_LAS __attribute__((address_space(3)))
typedef unsigned short bf16_t;
typedef short bf16x8 __attribute__((ext_vector_type(8)));
typedef float f32x4 __attribute__((ext_vector_type(4)));
typedef unsigned u32x4 __attribute__((ext_vector_type(4)));
constexpr int BM = 256, BK = 64, HALF = 128, HTB = HALF * BK * 2  , STAGE_BYTES = 8 * HTB, NXCD = 8, WGM = 8;

__host__ __device__ __forceinline__ int lds_byte(int r, int c) { const int st = (r >> 4) * 2 + (c >> 5), rr = r & 15, cc = c & 31, ob = rr * 64 + cc * 2; return st * 1024 + (ob ^ (((ob >> 9) & 1) << 5)); }
__host__ __device__ __forceinline__ void stage_rc(int b, int& R, int& C) { const int st = b / 1024, sb = b % 1024, swz = sb ^ (((sb >> 9) & 1) << 5); R = (st >> 1) * 16 + swz / 64; C = (st & 1) * 32 + (swz % 64) / 2; }
__host__ __device__ __forceinline__ int perm32(int rho) { const int n = rho >> 4, i = rho & 15; return 8 * (i >> 2) + 4 * n + (i & 3); }

struct Unit { int pm, pn; size_t koff; };
struct Gemm { const bf16_t* A; const bf16_t* Bt; int M, N, K, lda, ldb, tid0; };

struct StaticOrder {
    int nM, nN, nwg, G, c;
    __host__ __device__ void init(int M, int N, int G_, int c_) { nM = M / BM; nN = N / BM; nwg = nM * nN; G = G_; c = c_; }
    __host__ __device__ bool next(int i, Unit& u) const {
        const long L = (long)i * G + c; if (L >= nwg) return false;
        int wgid = (int)L; { const int q = nwg / NXCD, r = nwg % NXCD, xcd = wgid % NXCD, off = wgid / NXCD; wgid = (xcd < r ? xcd * (q + 1) : r * (q + 1) + (xcd - r) * q) + off; }
        const int nig = WGM * nN, gid = wgid / nig, fm = gid * WGM, gsz = (nM - fm) < WGM ? (nM - fm) : WGM;
        u.pm = fm + ((wgid % nig) % gsz); u.pn = (wgid % nig) / gsz; u.koff = 0; return true;
    }
    __device__ __forceinline__ void a_ready(const Unit&) const {}
    __device__ __forceinline__ void done(const Unit&) const {}
};


template <class Epi, class Sched, bool ALIGN_EPI = false, bool SP2 = false>
__device__ __forceinline__ void gemm_phase(PG8_LAS unsigned char* lds, const Gemm g, const Sched& S, const Epi& E) {
    int tid = g.tid0; asm volatile("" : "+v"(tid)); const int wid = __builtin_amdgcn_readfirstlane(tid >> 6), lane = tid & 63, wr = wid >> 2, wc = wid & 3, fr = lane & 15, fq = lane >> 4;
    const int K = g.K, nt = K / BK;
    unsigned voffA[2], voffB[2];
#pragma unroll
    for (int i = 0; i < 2; ++i) { int R, C; stage_rc(tid * 16 + i * 8192, R, C); const int Rb = Epi::PERM ? ((R & ~31) + perm32(R & 31)) : R;
        voffA[i] = (unsigned)(R * g.lda + C) * 2u; voffB[i] = (unsigned)(Rb * g.ldb + C) * 2u; }
    const size_t kstep = (size_t)(BK * 2);
    const size_t hstepB = (size_t)HALF * g.ldb * 2, hstepA = (size_t)HALF * g.lda * 2;
    const size_t tstepA = 2 * hstepA, tstepB = 2 * hstepB;
    const unsigned ldsw = (unsigned)wid * 1024u;
    const int aoff = lds_byte(wr * 64 + fr, fq * 8), boff = lds_byte(wc * 32 + fr, fq * 8);
#define PG8_SA(b, h) (((b) * 2 + (h)) * HTB)
#define PG8_SB(b, h) ((4 + (b) * 2 + (h)) * HTB)
#define PG8_STAGE(bufoff, gbase, voff) do { _Pragma("unroll") for (int _i = 0; _i < 2; ++_i) \
        __builtin_amdgcn_global_load_lds((const unsigned*)((const char*)(gbase) + (voff)[_i]), (PG8_LAS unsigned*)(lds + (bufoff) + ldsw + _i * 8192), 16, 0, 0); } while (0)
#define PG8_LDA(dst, b, h) do { _Pragma("unroll") for (int m = 0; m < 4; ++m) _Pragma("unroll") for (int k = 0; k < 2; ++k) dst[m][k] = *(const PG8_LAS bf16x8*)(lds + PG8_SA(b, h) + aoff + m * 2048 + k * 1024); } while (0)
#define PG8_LDB(dst, b, h) do { _Pragma("unroll") for (int n = 0; n < 2; ++n) _Pragma("unroll") for (int k = 0; k < 2; ++k) dst[n][k] = *(const PG8_LAS bf16x8*)(lds + PG8_SB(b, h) + boff + n * 2048 + k * 1024); } while (0)
#define PG8_MMA(ai, bj, At, Bt) do { __builtin_amdgcn_s_setprio(1); _Pragma("unroll") for (int m = 0; m < 4; ++m) _Pragma("unroll") for (int n = 0; n < 2; ++n) _Pragma("unroll") for (int k = 0; k < 2; ++k) \
        acc[ai][bj][m][n] = __builtin_amdgcn_mfma_f32_16x16x32_bf16(Bt[n][k], At[m][k], acc[ai][bj][m][n], 0, 0, 0); __builtin_amdgcn_s_setprio(0); } while (0)
#define PG8_WAIT_V(n) asm volatile("s_waitcnt vmcnt(" #n ")" ::: "memory")
#define PG8_WAIT_L(n) asm volatile("s_waitcnt lgkmcnt(" #n ")" ::: "memory")
#define PG8_BAR __builtin_amdgcn_s_barrier()
#define PG8_SCHED __builtin_amdgcn_sched_barrier(0)
    Unit cur, nxt; int ui = 0;
    if (!S.next(0, cur)) return;
    f32x4 acc[2][2][4][2];
#pragma unroll
    for (int a = 0; a < 2; ++a)
#pragma unroll
        for (int b = 0; b < 2; ++b)
#pragma unroll
            for (int m = 0; m < 4; ++m)
#pragma unroll
                for (int n = 0; n < 2; ++n) acc[a][b][m][n] = (f32x4){0.f, 0.f, 0.f, 0.f};
    bf16x8 At[4][2], B0[2][2], B1[2][2];
    const char* cA = (const char*)g.A + (size_t)cur.pm * tstepA + cur.koff; const char* cB = (const char*)g.Bt + (size_t)cur.pn * tstepB + cur.koff;
    S.a_ready(cur);
    if constexpr (SP2) {
        PG8_STAGE(PG8_SB(0, 0), cB, voffB); PG8_STAGE(PG8_SB(0, 1), cB + hstepB, voffB); PG8_STAGE(PG8_SA(0, 0), cA, voffA); PG8_STAGE(PG8_SA(0, 1), cA + hstepA, voffA);
        if (wr == 1) PG8_BAR;
        PG8_WAIT_V(2); PG8_BAR;
        PG8_STAGE(PG8_SB(1, 0), cB + kstep, voffB); PG8_STAGE(PG8_SA(1, 0), cA + kstep, voffA); PG8_STAGE(PG8_SB(1, 1), cB + hstepB + kstep, voffB);
        PG8_WAIT_V(6); PG8_BAR;
    } else {
        PG8_STAGE(PG8_SB(0, 0), cB, voffB); PG8_STAGE(PG8_SA(0, 0), cA, voffA); PG8_STAGE(PG8_SB(0, 1), cB + hstepB, voffB); PG8_STAGE(PG8_SA(0, 1), cA + hstepA, voffA);
        if (wr == 1) PG8_BAR;
        PG8_WAIT_V(4); PG8_BAR;
        PG8_STAGE(PG8_SB(1, 0), cB + kstep, voffB); PG8_STAGE(PG8_SA(1, 0), cA + kstep, voffA); PG8_STAGE(PG8_SB(1, 1), cB + hstepB + kstep, voffB);
        PG8_WAIT_V(6); PG8_BAR;
    }
    for (;;) {
        const bool has_next = S.next(ui + 1, nxt);
        const char* nA = has_next ? (const char*)g.A + (size_t)nxt.pm * tstepA + nxt.koff : cA; const char* nB = has_next ? (const char*)g.Bt + (size_t)nxt.pn * tstepB + nxt.koff : cB;
        for (int t = 0; t < nt; t += 2) {
            const bool last = (t == nt - 2);
            const char* a1 = cA + (size_t)(t + 1) * kstep;
            const char* a2 = last ? nA : cA + (size_t)(t + 2) * kstep; const char* b2 = last ? nB : cB + (size_t)(t + 2) * kstep;
            const char* a3 = a2 + kstep; const char* b3 = b2 + kstep;
            if (last && has_next) S.a_ready(nxt);
            if constexpr (SP2) {
            PG8_LDB(B0, 0, 0); PG8_LDB(B1, 0, 1); PG8_SCHED; PG8_LDA(At, 0, 0); PG8_STAGE(PG8_SA(1, 1), a1 + hstepA, voffA);
            PG8_WAIT_V(8); PG8_WAIT_L(0); PG8_BAR; PG8_MMA(0, 0, At, B0); PG8_MMA(0, 1, At, B1); PG8_BAR; PG8_SCHED;
            PG8_LDA(At, 0, 1); PG8_STAGE(PG8_SB(0, 0), b2, voffB); PG8_STAGE(PG8_SB(0, 1), b2 + hstepB, voffB); PG8_STAGE(PG8_SA(0, 0), a2, voffA);
            PG8_WAIT_V(8); PG8_WAIT_L(0); PG8_BAR; PG8_MMA(1, 0, At, B0); PG8_MMA(1, 1, At, B1); PG8_BAR; PG8_SCHED;
            PG8_LDB(B0, 1, 0); PG8_LDB(B1, 1, 1); PG8_SCHED; PG8_LDA(At, 1, 0); PG8_STAGE(PG8_SA(0, 1), a2 + hstepA, voffA);
            PG8_WAIT_V(8); PG8_WAIT_L(0); PG8_BAR; PG8_MMA(0, 0, At, B0); PG8_MMA(0, 1, At, B1); PG8_BAR; PG8_SCHED;
            PG8_LDA(At, 1, 1); PG8_STAGE(PG8_SB(1, 0), b3, voffB); PG8_STAGE(PG8_SB(1, 1), b3 + hstepB, voffB); PG8_STAGE(PG8_SA(1, 0), a3, voffA);
            PG8_WAIT_V(8); PG8_WAIT_L(0); PG8_BAR; PG8_MMA(1, 0, At, B0); PG8_MMA(1, 1, At, B1); PG8_BAR; PG8_SCHED;
            } else {
            PG8_LDB(B0, 0, 0); PG8_SCHED; PG8_LDA(At, 0, 0); PG8_STAGE(PG8_SA(1, 1), a1 + hstepA, voffA);
            PG8_WAIT_L(8); PG8_BAR; PG8_WAIT_L(0); PG8_MMA(0, 0, At, B0); PG8_BAR; PG8_SCHED;
            PG8_LDB(B1, 0, 1); PG8_STAGE(PG8_SB(0, 0), b2, voffB);
            PG8_BAR; PG8_WAIT_L(0); PG8_MMA(0, 1, At, B1); PG8_BAR;
            PG8_LDA(At, 0, 1); PG8_STAGE(PG8_SA(0, 0), a2, voffA);
            PG8_BAR; PG8_WAIT_L(0); PG8_MMA(1, 0, At, B0); PG8_BAR; PG8_SCHED;
            PG8_STAGE(PG8_SB(0, 1), b2 + hstepB, voffB);
            PG8_WAIT_V(6); PG8_BAR; PG8_MMA(1, 1, At, B1); PG8_BAR;
            PG8_LDB(B0, 1, 0); PG8_SCHED; PG8_LDA(At, 1, 0); PG8_STAGE(PG8_SA(0, 1), a2 + hstepA, voffA);
            PG8_WAIT_L(8); PG8_BAR; PG8_WAIT_L(0); PG8_MMA(0, 0, At, B0); PG8_BAR; PG8_SCHED;
            PG8_LDB(B1, 1, 1); PG8_STAGE(PG8_SB(1, 0), b3, voffB);
            PG8_BAR; PG8_WAIT_L(0); PG8_MMA(0, 1, At, B1); PG8_BAR;
            PG8_LDA(At, 1, 1); PG8_STAGE(PG8_SA(1, 0), a3, voffA);
            PG8_BAR; PG8_WAIT_L(0); PG8_MMA(1, 0, At, B0); PG8_BAR; PG8_SCHED;
            PG8_STAGE(PG8_SB(1, 1), b3 + hstepB, voffB);
            PG8_WAIT_V(6); PG8_BAR; PG8_MMA(1, 1, At, B1); PG8_BAR;
            }
        }
        if constexpr (ALIGN_EPI) { if (wr == 0) PG8_BAR; }
        if constexpr (!Epi::AFTER_DRAIN) { E(acc, cur, wr, wc, fr, fq); S.done(cur); }
        if (!has_next) break;
#pragma unroll
        for (int a = 0; a < 2; ++a)
#pragma unroll
            for (int b = 0; b < 2; ++b)
#pragma unroll
                for (int m = 0; m < 4; ++m)
#pragma unroll
                    for (int n = 0; n < 2; ++n) acc[a][b][m][n] = (f32x4){0.f, 0.f, 0.f, 0.f};
        cur = nxt; cA = nA; cB = nB; ++ui;
        if constexpr (ALIGN_EPI) { if (wr == 1) PG8_BAR; }
    }
    PG8_WAIT_V(0);
    if constexpr (!ALIGN_EPI) { if (wr == 0) PG8_BAR; }
    PG8_BAR;
    if constexpr (Epi::AFTER_DRAIN) { E.fused(acc, cur, wr, wc, fr, fq, lds, wid, lane); S.done(cur); }
#undef PG8_SA
#undef PG8_SB
#undef PG8_STAGE
#undef PG8_LDA
#undef PG8_LDB
#undef PG8_MMA
#undef PG8_WAIT_V
#undef PG8_WAIT_L
#undef PG8_BAR
#undef PG8_SCHED
}
}

typedef const pg8::f32x4 (&AccRef)[2][2][4][2];
struct EpiSwiglu {
    static constexpr bool PERM = true, AFTER_DRAIN = false;
    bf16_t* H;
    DI void operator()(AccRef acc, const pg8::Unit& u, int wr, int wc, int fr, int fq) const {
        const int row0 = u.pm * 256 + wr * 64 + fr, col = u.pn * 128 + wc * 32 + 8 * fq;
#pragma unroll
        for (int ai = 0; ai < 2; ++ai)
#pragma unroll
            for (int m = 0; m < 4; ++m) {
                const int row = row0 + ai * 128 + m * 16; float f[8];
#pragma unroll
                for (int n = 0; n < 2; ++n)
#pragma unroll
                    for (int e = 0; e < 4; ++e) f[n * 4 + e] = siluf_(acc[ai][0][m][n][e]) * acc[ai][1][m][n][e];
                *(u32x4*)(H + (size_t)row * DFF + col) = pack8(f);
            }
    }
};
struct EpiResid {
    static constexpr bool PERM = true, AFTER_DRAIN = false;
    float* xlat; float* xc; const float* gate; float coef;
    DI void operator()(AccRef acc, const pg8::Unit& u, int wr, int wc, int fr, int fq) const {
        const int r0 = u.pm * 256; const int vec = r0 < NLAT ? (r0 >> 13) : 2;
        const float* gp = gate + vec * 9216;
        float* base = r0 < NLAT ? xlat + (size_t)r0 * DM : xc + (size_t)(r0 - NLAT) * DM;
#pragma unroll
        for (int bj = 0; bj < 2; ++bj) {
            const int col = u.pn * 256 + bj * 128 + wc * 32 + 8 * fq;
            const f32x4 g0 = *(const f32x4*)(gp + col) * coef, g1 = *(const f32x4*)(gp + col + 4) * coef;
#pragma unroll
            for (int ai = 0; ai < 2; ++ai)
#pragma unroll
                for (int m = 0; m < 4; ++m) {
                    float* xp = base + (size_t)(wr * 64 + fr + ai * 128 + m * 16) * DM + col;
                    f32x4 x0 = *(f32x4*)xp, x1 = *(f32x4*)(xp + 4);
                    x0 += g0 * acc[ai][bj][m][0]; x1 += g1 * acc[ai][bj][m][1];
                    *(f32x4*)xp = x0; *(f32x4*)(xp + 4) = x1;
                }
        }
    }
};
struct EpiWin {
    static constexpr bool PERM = true, AFTER_DRAIN = false;
    bf16_t* Z;
    DI void operator()(AccRef acc, const pg8::Unit& u, int wr, int wc, int fr, int fq) const {
        const int row0 = u.pm * 256 + wr * 64 + fr;
#pragma unroll
        for (int bj = 0; bj < 2; ++bj) {
            const int col = u.pn * 256 + bj * 128 + wc * 32 + 8 * fq;
            if (col >= ZW) continue;
            const int mode = (col >= ZC_RL && col < ZC_RL + 128) ? 1 : ((col >= ZC_RL + 256 && col < ZC_AQ) ? 2 : 0);
#pragma unroll
            for (int ai = 0; ai < 2; ++ai)
#pragma unroll
                for (int m = 0; m < 4; ++m) {
                    const int row = row0 + ai * 128 + m * 16; float f[8];
#pragma unroll
                    for (int n = 0; n < 2; ++n)
#pragma unroll
                        for (int e = 0; e < 4; ++e) { float v = acc[ai][bj][m][n][e]; if (mode == 1) v = 1.f - 2.f * __builtin_amdgcn_rcpf(1.f + __expf(2.f * v)); else if (mode == 2) v = sigmoidf_(v); f[n * 4 + e] = v; }
                    *(u32x4*)(Z + (size_t)row * ZW + col) = pack8(f);
                }
        }
    }
};
struct EpiLora {
    static constexpr bool PERM = true, AFTER_DRAIN = false;
    bf16_t* RWA; bf16_t* RG; const float* w0; const float* a0;
    DI void operator()(AccRef acc, const pg8::Unit& u, int wr, int wc, int fr, int fq) const {
        const int row0 = u.pm * 256 + wr * 64 + fr;
#pragma unroll
        for (int bj = 0; bj < 2; ++bj) {
            const int col = u.pn * 256 + bj * 128 + wc * 32 + 8 * fq; const int seg = col >> 9, cc = col & 511;
            const float* bp = seg < 2 ? w0 + seg * 512 + cc : a0 + (seg & 1) * 512 + cc;
#pragma unroll
            for (int ai = 0; ai < 2; ++ai)
#pragma unroll
                for (int m = 0; m < 4; ++m) {
                    const int row = row0 + ai * 128 + m * 16; float f[8];
#pragma unroll
                    for (int n = 0; n < 2; ++n)
#pragma unroll
                        for (int e = 0; e < 4; ++e) {
                            float v = acc[ai][bj][m][n][e] + (seg < 4 ? bp[n * 4 + e] : 0.f);
                            if (seg < 2) { const float ee = 0.60653066f * sigmoidf_(v); v = 1.f - __expf(-ee); } else if (seg < 4) v = sigmoidf_(v);
                            f[n * 4 + e] = v;
                        }
                    if (seg < 4) *(u32x4*)(RWA + (size_t)row * 2048 + col) = pack8(f); else *(u32x4*)(RG + (size_t)row * 512 + cc) = pack8(f);
                    __builtin_amdgcn_sched_barrier(0);
                }
        }
    }
};
struct EpiGate {
    static constexpr bool PERM = true, AFTER_DRAIN = false;
    bf16_t* G;
    DI void operator()(AccRef acc, const pg8::Unit& u, int wr, int wc, int fr, int fq) const {
        const int row0 = u.pm * 256 + wr * 64 + fr;
#pragma unroll
        for (int bj = 0; bj < 2; ++bj) {
            const int col = u.pn * 256 + bj * 128 + wc * 32 + 8 * fq;
#pragma unroll
            for (int ai = 0; ai < 2; ++ai)
#pragma unroll
                for (int m = 0; m < 4; ++m) {
                    const int row = row0 + ai * 128 + m * 16; float f[8];
#pragma unroll
                    for (int n = 0; n < 2; ++n)
#pragma unroll
                        for (int e = 0; e < 4; ++e) f[n * 4 + e] = sigmoidf_(acc[ai][bj][m][n][e]);
                    *(u32x4*)(G + (size_t)row * DM + col) = pack8(f);
                }
        }
    }
};
struct EpiBranch {
    static constexpr bool PERM = true, AFTER_DRAIN = false;
    const bf16_t* G; bf16_t* ZZ; int first;
    DI void operator()(AccRef acc, const pg8::Unit& u, int wr, int wc, int fr, int fq) const {
        const int row0 = u.pm * 256 + wr * 64 + fr;
#pragma unroll
        for (int bj = 0; bj < 2; ++bj) {
            const int col = u.pn * 256 + bj * 128 + wc * 32 + 8 * fq;
#pragma unroll
            for (int ai = 0; ai < 2; ++ai)
#pragma unroll
                for (int m = 0; m < 4; ++m) {
                    const size_t off = (size_t)(row0 + ai * 128 + m * 16) * DM + col; float g[8], o[8], f[8];
                    unpack8(*(const u32x4*)(G + off), g);
                    if (first) {
#pragma unroll
                        for (int e = 0; e < 8; ++e) o[e] = 0.f;
                    } else unpack8(*(const u32x4*)(ZZ + off), o);
#pragma unroll
                    for (int n = 0; n < 2; ++n)
#pragma unroll
                        for (int e = 0; e < 4; ++e) f[n * 4 + e] = o[n * 4 + e] + g[n * 4 + e] * acc[ai][bj][m][n][e];
                    *(u32x4*)(ZZ + off) = pack8(f);
                }
        }
    }
};
struct CtxSplitOrder {
    int nun, G, c, kslice_bytes;
    DI void init(int nslices, int ksl_bytes, int G_, int c_) { nun = nslices * 8; G = G_; c = c_; kslice_bytes = ksl_bytes; }
    DI bool next(int i, pg8::Unit& u) const {
        const long L = (long)i * G + c; if (L >= nun) return false;
        const int ks = (int)L >> 3, t = (int)L & 7; u.pm = 64 + (t >> 2); u.pn = t & 3; u.koff = (size_t)ks * kslice_bytes; return true;
    }
    DI void a_ready(const pg8::Unit&) const {}
    DI void done(const pg8::Unit&) const {}
};
struct EpiPartial {
    static constexpr bool PERM = true, AFTER_DRAIN = false;
    float* P; int kslice_bytes;
    DI void operator()(AccRef acc, const pg8::Unit& u, int wr, int wc, int fr, int fq) const {
        const int ks = (int)(u.koff / (size_t)kslice_bytes);
        float* base = P + ((size_t)ks * 512 + (size_t)(u.pm - 64) * 256) * DM;
#pragma unroll
        for (int bj = 0; bj < 2; ++bj) {
            const int col = u.pn * 256 + bj * 128 + wc * 32 + 8 * fq;
#pragma unroll
            for (int ai = 0; ai < 2; ++ai)
#pragma unroll
                for (int m = 0; m < 4; ++m) {
                    float* xp = base + (size_t)(wr * 64 + fr + ai * 128 + m * 16) * DM + col;
                    *(f32x4*)xp = acc[ai][bj][m][0]; *(f32x4*)(xp + 4) = acc[ai][bj][m][1];
                }
        }
    }
};
template <class Epi> DI void run_gemm_ctx(const int wv, unsigned char* smem, const bf16_t* A, int lda, const bf16_t* Bt, int ldb, int nslices, int kslice, const Epi& E) {
    pg8::Gemm g; g.A = A; g.Bt = Bt; g.M = NTOK; g.N = DM; g.K = launder_s(kslice); g.lda = launder_s(lda); g.ldb = launder_s(ldb); g.tid0 = wv * 64 + lane_id_();
    CtxSplitOrder S; S.init(nslices, kslice * 2, (int)gridDim.x, ((int)gridDim.x - 1) - launder_s((int)blockIdx.x));
    pg8::gemm_phase<Epi, CtxSplitOrder, true, true>((PG8_LAS unsigned char*)smem, g, S, E);
    __syncthreads();
}
template <class Epi> DI void run_gemm(const int wv, unsigned char* smem, const bf16_t* A, int lda, const bf16_t* Bt, int M, int N, int K, const Epi& E) {
    pg8::Gemm g; g.A = A; g.Bt = Bt; g.M = M; g.N = N; g.K = launder_s(K); g.lda = launder_s(lda); g.ldb = g.K; g.tid0 = wv * 64 + lane_id_();
    pg8::StaticOrder S; S.init(M, N, (int)gridDim.x, launder_s((int)blockIdx.x));
    pg8::gemm_phase<Epi, pg8::StaticOrder, true, true>((PG8_LAS unsigned char*)smem, g, S, E);
    __syncthreads();
}

struct Prm {
    const float *x, *c, *ctx, *cctx, *w_ada, *b_ada, *norm_g, *f1gu, *f1dn, *f2gu, *f2dn, *w_in, *m_conv, *m_gb, *m_on, *r_conv, *r_w0, *r_w2, *r_a0, *r_a2, *r_g2,
        *r_kk, *r_ka, *r_rk, *r_lnw, *r_lnb, *a_qkn, *a_lam, *a_subln, *w_br, *w_o;
    float* out; unsigned char* ws; int wv, pad;
};
#define PH_IDS const int tid_l = launder_v(p.wv * 64 + lane_id_()); const int bid_l = launder_s((int)blockIdx.x); (void)tid_l; (void)bid_l;
#define TID tid_l
#define BID bid_l
#define NBLK ((int)gridDim.x)

DI void ph_modpart(const Prm& p, unsigned char* smem) { PH_IDS
    float* sc = (float*)smem; float* modp = (float*)(p.ws + WS_MODP);
    for (int it = BID; it < 576; it += NBLK) {
        const int l = it / 288, r = it % 288, ks = r / 18, cb = r % 18;
        __syncthreads();
        if (TID < 192) { const int v = TID >> 6, k = ks * 64 + (TID & 63); const float cv = v < 2 ? p.c[v * DM + k] : p.cctx[k]; sc[TID] = siluf_(cv); }
        __syncthreads();
        const int col = cb * 512 + TID; float a0 = 0.f, a1 = 0.f, a2 = 0.f;
        const float* w = p.w_ada + ((size_t)l * DM + ks * 64) * 9216 + col;
#pragma unroll 8
        for (int k = 0; k < 64; ++k) { const float wv = w[(size_t)k * 9216]; a0 += sc[k] * wv; a1 += sc[64 + k] * wv; a2 += sc[128 + k] * wv; }
        float* o = modp + ((size_t)(l * 16 + ks) * 3) * 9216 + col; o[0] = a0; o[9216] = a1; o[2 * 9216] = a2;
    }
    __syncthreads();
}
DI void ph_rope(const Prm& p) { PH_IDS
    float* rope = (float*)(p.ws + WS_ROPE);
    for (int i = BID * 512 + TID; i < SEQL * 32; i += NBLK * 512) {
        const int t = i >> 5, pp = i & 31, j = pp & 15;
        const float inv = powf(10000.f, -(float)j / 16.f); const float pos = (float)(pp < 16 ? (t >> 6) : (t & 63)); const float ang = pos * inv;
        rope[2 * i] = cosf(ang); rope[2 * i + 1] = sinf(ang);
    }
}
DI void ph_modreduce(const Prm& p) { PH_IDS
    const float* modp = (const float*)(p.ws + WS_MODP); float* mods = (float*)(p.ws + WS_MODS);
    for (int i = BID * 512 + TID; i < 2 * 3 * 9216; i += NBLK * 512) {
        const int l = i / 27648, rem = i % 27648, v = rem / 9216, col = rem % 9216;
        float s = p.b_ada[l * 9216 + col];
        for (int ks = 0; ks < 16; ++ks) s += modp[((size_t)(l * 16 + ks) * 3 + v) * 9216 + col];
        mods[i] = s;
    }
}
template <int MODE> DI void conv_weight(const Prm& p, const float* src, int ld, int c0, int K, int ncols, bf16_t* dst, unsigned char* smem) { PH_IDS
    float* t = (float*)smem; const int ntk = K / 64, ntn = (ncols + 127) / 128, tx = TID & 63, ty = TID >> 6;
    for (int it = BID; it < ntk * ntn; it += NBLK) {
        const int kt = it % ntk, nt = it / ntk;
        float v[16];
#pragma unroll
        for (int i = 0; i < 16; ++i) { const int k = ty * 8 + (i & 7), j = nt * 128 + (i >> 3) * 64 + tx; v[i] = j < ncols ? src[(size_t)(kt * 64 + k) * ld + c0 + j] : 0.f; }
        __syncthreads();
#pragma unroll
        for (int i = 0; i < 16; ++i) t[(i >> 3) * 4160 + (ty * 8 + (i & 7)) * 65 + tx] = v[i];
        __syncthreads();
#pragma unroll
        for (int i = 0; i < 16; ++i) {
            const int n = ty * 8 + (i & 7), j = nt * 128 + (i >> 3) * 64 + n;
            if (j < ncols) {
                int drow = j;
                if (MODE == 1) drow = j < DFF ? ((j >> 7) * 256 + (j & 127)) : (((j - DFF) >> 7) * 256 + 128 + ((j - DFF) & 127));
                dst[(size_t)drow * K + kt * 64 + tx] = f2bf(t[(i >> 3) * 4160 + tx * 65 + n]);
            }
        }
    }
    __syncthreads();
}
DI void conv_ffn(const Prm& p, int l, int which, unsigned char* smem) {
    bf16_t* wt = (bf16_t*)(p.ws + WS_WT);
    conv_weight<1>(p, (which ? p.f2gu : p.f1gu) + (size_t)l * DM * 2 * DFF, 2 * DFF, 0, DM, 2 * DFF, wt + WT_GU, smem);
    conv_weight<0>(p, (which ? p.f2dn : p.f1dn) + (size_t)l * DFF * DM, DM, 0, DFF, DM, wt + WT_DN, smem);
}
DI void conv_mixer(const Prm& p, int l, unsigned char* smem) { PH_IDS
    bf16_t* wt = (bf16_t*)(p.ws + WS_WT);
    conv_weight<0>(p, p.w_in + (size_t)l * DM * DIN, DIN, 0, DM, ZW, wt + WT_IN, smem);
    conv_weight<0>(p, p.w_in + (size_t)l * DM * DIN, DIN, ZW, DM, 3 * DM, wt + WT_G, smem);
    for (int b = 0; b < 3; ++b) conv_weight<0>(p, p.w_br + (size_t)(l * 3 + b) * 512 * DM, DM, 0, 512, DM, wt + WT_P + (size_t)b * DM * 512, smem);
    conv_weight<0>(p, p.w_o + (size_t)l * DM * DM, DM, 0, DM, DM, wt + WT_O, smem);
    bf16_t* wl = wt + WT_L;
    for (int i = BID * 512 + TID; i < 2560 * 384; i += NBLK * 512) {
        const int n = i / 384, k = i % 384, seg = n >> 9, cc = n & 511; float v = 0.f;
        if (seg < 2) { if ((k >> 6) == seg) v = p.r_w2[((size_t)(l * 2 + seg) * 64 + (k & 63)) * 512 + cc]; }
        else if (seg < 4) { if ((k >> 6) == seg) v = p.r_a2[((size_t)(l * 2 + seg - 2) * 64 + (k & 63)) * 512 + cc]; }
        else { if (k >= 256) v = p.r_g2[((size_t)l * 128 + (k - 256)) * 512 + cc]; }
        wl[i] = f2bf(v);
    }
}
DI void ph_norm(const Prm& p, int l, int which, bool first, int nfix = 0, const float* fixgate = nullptr, float fixcoef = 0.f) { PH_IDS
    const int lane = TID & 63, wid = TID >> 6;
    const float* g = p.norm_g + (l * 3 + which) * DM; const float* mods = (const float*)(p.ws + WS_MODS) + (size_t)l * 27648;
    bf16_t* hb = (bf16_t*)(p.ws + WS_RWA); float* xc = (float*)(p.ws + WS_XC);
    for (int row = BID * 8 + wid; row < NTOK; row += NBLK * 8) {
        const int vec = row < NLAT ? (row >> 13) : 2;
        const float* sh = mods + vec * 9216 + (3 * which) * DM; const float* scl = sh + DM;
        float* xd = row < NLAT ? p.out + (size_t)row * DM : xc + (size_t)(row - NLAT) * DM;
        const float* xr = first ? (row < NLAT ? p.x + (size_t)row * DM : p.ctx + (size_t)(row - NLAT) * DM) : xd;
        f32x4 xv[4]; float ss = 0.f;
#pragma unroll
        for (int i = 0; i < 4; ++i) xv[i] = *(const f32x4*)(xr + i * 256 + lane * 4);
        if (nfix > 0 && row >= NLAT) {
            const float* P = (const float*)((const bf16_t*)(p.ws + WS_RWA) + (size_t)NTOK * DM) + (size_t)(row - NLAT) * DM;
#pragma unroll
            for (int i = 0; i < 4; ++i) {
                const int col = i * 256 + lane * 4; f32x4 sp = {0.f, 0.f, 0.f, 0.f};
                for (int ks = 0; ks < nfix; ++ks) sp += *(const f32x4*)(P + (size_t)ks * 512 * DM + col);
                xv[i] += *(const f32x4*)(fixgate + 2 * 9216 + col) * fixcoef * sp;
                *(f32x4*)(xd + col) = xv[i];
            }
        }
#pragma unroll
        for (int i = 0; i < 4; ++i) ss += xv[i][0] * xv[i][0] + xv[i][1] * xv[i][1] + xv[i][2] * xv[i][2] + xv[i][3] * xv[i][3];
        ss = wave_sum(ss); const float rinv = rsqrtf(ss * (1.f / DM) + 1e-6f);
#pragma unroll
        for (int i = 0; i < 4; ++i) {
            const int col = i * 256 + lane * 4;
            if (first) *(f32x4*)(xd + col) = xv[i];
            const f32x4 gv = *(const f32x4*)(g + col), sv = *(const f32x4*)(scl + col), hv = *(const f32x4*)(sh + col);
            float h[4];
#pragma unroll
            for (int e = 0; e < 4; ++e) h[e] = xv[i][e] * rinv * gv[e] * (1.f + sv[e]) + hv[e];
            u32x2 o; o.x = pk2(h[0], h[1]); o.y = pk2(h[2], h[3]);
            *(u32x2*)(hb + (size_t)row * DM + col) = o;
        }
    }
}
DI void ph_zero_ysum(const Prm& p) { PH_IDS
    f32x4* y = (f32x4*)(p.ws + WS_YSUM); const f32x4 zr = {0.f, 0.f, 0.f, 0.f};
    for (int i = BID * 512 + TID; i < NTOK * 128; i += NBLK * 512) y[i] = zr;
}
DI void ph_rkv_conv(const Prm& p, int l) { PH_IDS
    const int lane = TID & 63, wid = TID >> 6;
    const bf16_t* z = (const bf16_t*)(p.ws + WS_Z); bf16_t* tmp = (bf16_t*)(p.ws + WS_RWA); float* invn = (float*)(p.ws + WS_INVN);
    const float* cw = p.r_conv + (size_t)l * 3 * 1536;
    for (int row = BID * 8 + wid; row < NTOK; row += NBLK * 8) {
        const int t = row < NLAT ? (row & 8191) : ((row - NLAT) & 255), L = row < NLAT ? SEQL : CTXL;
        const bool hp = t > 0, hn = t < L - 1;
#pragma unroll
        for (int g = 0; g < 3; ++g) {
            const int ch = g * 512 + lane * 8; const bf16_t* zp = z + (size_t)row * ZW + ZC_RR + ch;
            const u32x4 zero = {0u, 0u, 0u, 0u};
            const u32x4 uc = *(const u32x4*)zp, up = hp ? *(const u32x4*)(zp - ZW) : zero, un = hn ? *(const u32x4*)(zp + ZW) : zero;
            float c[8], pv[8], nx[8], o[8]; unpack8(uc, c); unpack8(up, pv); unpack8(un, nx);
#pragma unroll
            for (int e = 0; e < 8; ++e) o[e] = cw[ch + e] * pv[e] + cw[1536 + ch + e] * c[e] + cw[3072 + ch + e] * nx[e];
            *(u32x4*)(tmp + (size_t)row * 1536 + ch) = pack8(o);
            if (g == 1) {
                float ss = 0.f;
#pragma unroll
                for (int e = 0; e < 8; ++e) { const float kk = o[e] * p.r_kk[l * 512 + lane * 8 + e]; ss += kk * kk; }
                ss += __shfl_xor(ss, 1); ss += __shfl_xor(ss, 2); ss += __shfl_xor(ss, 4);
                if ((lane & 7) == 0) invn[(size_t)row * 8 + (lane >> 3)] = 1.f / fmaxf(sqrtf(ss), 1e-12f);
            }
        }
    }
}
DI void ph_rkv_copy(const Prm& p) { PH_IDS
    const int lane = TID & 63, wid = TID >> 6;
    bf16_t* z = (bf16_t*)(p.ws + WS_Z); const bf16_t* tmp = (const bf16_t*)(p.ws + WS_RWA);
    for (int row = BID * 8 + wid; row < NTOK; row += NBLK * 8)
#pragma unroll
        for (int g = 0; g < 3; ++g) { const int ch = g * 512 + lane * 8; *(u32x4*)(z + (size_t)row * ZW + ZC_RR + ch) = *(const u32x4*)(tmp + (size_t)row * 1536 + ch); }
}
DI void ph_attn_prep(const Prm& p, int l) { PH_IDS
    const int lane = TID & 63, wid = TID >> 6, hw = lane >> 5, pp = lane & 31;
    bf16_t* z = (bf16_t*)(p.ws + WS_Z); const float* rope = (const float*)(p.ws + WS_ROPE); const float* qkn = p.a_qkn + l * 128;
    for (int row = BID * 8 + wid; row < NTOK; row += NBLK * 8) {
        const bool islat = row < NLAT; const int t = row & 8191;
        float cs = 1.f, sn = 0.f; if (islat) { cs = rope[((size_t)t * 32 + pp) * 2]; sn = rope[((size_t)t * 32 + pp) * 2 + 1]; }
#pragma unroll
        for (int it = 0; it < 8; ++it) {
            const int seg = it * 2 + hw, which = seg >> 3, col = (which ? ZC_AK : ZC_AQ) + (seg & 7) * 64 + 2 * pp;
            unsigned* zp = (unsigned*)(z + (size_t)row * ZW + col);
            const unsigned u = *zp; const float x1 = lo16(u), x2 = hi16(u);
            float ss = x1 * x1 + x2 * x2;
            ss += __shfl_xor(ss, 1); ss += __shfl_xor(ss, 2); ss += __shfl_xor(ss, 4); ss += __shfl_xor(ss, 8); ss += __shfl_xor(ss, 16);
            const float rinv = rsqrtf(ss * (1.f / 64.f) + 1e-6f) * (which ? 1.f : 0.125f * 1.4426950408889634f);
            const float y1 = x1 * rinv * qkn[which * 64 + 2 * pp], y2 = x2 * rinv * qkn[which * 64 + 2 * pp + 1];
            *zp = pk2(y1 * cs - y2 * sn, y1 * sn + y2 * cs);
        }
    }
}

#define MFMA16(a, b, c) __builtin_amdgcn_mfma_f32_16x16x32_bf16((a), (b), (c), 0, 0, 0)
#define MFMA32(a, b, c) __builtin_amdgcn_mfma_f32_32x32x16_bf16((a), (b), (c), 0, 0, 0)
DI float wave_incl_scan_add(float v, int lane) {
#pragma unroll
    for (int o = 1; o < 64; o <<= 1) { const float t = __shfl_up(v, o); if (lane >= o) v += t; }
    return v;
}
DI float wave_incl_scan_max(float v, int lane) {
#pragma unroll
    for (int o = 1; o < 64; o <<= 1) { const float t = __shfl_up(v, o); if (lane >= o) v = fmaxf(v, t); }
    return v;
}
DI float mconv(const bf16_t* z, const float* cw, size_t row, int t, int L, int ch) {
    const bf16_t* zp = z + row * ZW + ch;
    float a = cw[512 + ch] * bf2f(zp[0]);
    if (t > 0) a += cw[ch] * bf2f(zp[-ZW]);
    if (t < L - 1) a += cw[1024 + ch] * bf2f(zp[ZW]);
    return siluf_(a);
}
DI void mconv8(const bf16_t* z, const float* cw, size_t row, int t, int L, int ch, float* out) {
    const bf16_t* zp = z + row * ZW + ch; const u32x4 zero = {0u, 0u, 0u, 0u};
    const u32x4 uc = *(const u32x4*)zp, up = t > 0 ? *(const u32x4*)(zp - ZW) : zero, un = t < L - 1 ? *(const u32x4*)(zp + ZW) : zero;
    float c[8], pv[8], nx[8]; unpack8(uc, c); unpack8(up, pv); unpack8(un, nx);
#pragma unroll
    for (int e = 0; e < 8; ++e) out[e] = siluf_(cw[ch + e] * pv[e] + cw[512 + ch + e] * c[e] + cw[1024 + ch + e] * nx[e]);
}
DI void ph_mlstm_a(const Prm& p, int l, unsigned char* smem) { PH_IDS
    const int lane = TID & 63, wid = TID >> 6;
    const bf16_t* z = (const bf16_t*)(p.ws + WS_Z); bf16_t* mst = (bf16_t*)(p.ws + WS_MST); float* msc = (float*)(p.ws + WS_MSC); float* mn = (float*)(p.ws + WS_MN);
    const float* cw = p.m_conv + (size_t)l * 3 * 512; const float* gb = p.m_gb + l * 16;
    bf16_t* kT = (bf16_t*)smem; bf16_t* vT = (bf16_t*)(smem + 9216); float* wsl = (float*)(smem + 9216 + 18432);
    for (int u = BID; u < 2112; u += NBLK) {
        const int d = u / 1056, r = u % 1056, b = r / 528, h = (r % 528) / NCHK, c = r % NCHK;
        const int slot = ((d * 2 + b) * 4 + h) * NCHK + c;
        const bool isctx = c < 4; const int cs = isctx ? c : c - 4, nch = isctx ? 4 : 128, oc = d ? nch - 1 - cs : cs, L = isctx ? CTXL : SEQL;
        const size_t base = isctx ? (size_t)NLAT + b * CTXL + oc * 64 : (size_t)b * SEQL + oc * 64;
        __syncthreads();
        if (wid == 0) {
            const int o = d ? 63 - lane : lane; const bf16_t* zr = z + (base + o) * ZW + ZC_MG + 8 * d + h;
            const float ig = bf2f(zr[0]) + gb[(2 * d) * 4 + h], lf = logsigf_(bf2f(zr[4]) + gb[(2 * d + 1) * 4 + h]);
            const float bc = wave_incl_scan_add(lf, lane), bt = __shfl(bc, 63), wl = bt - bc + ig, ml = wave_max(wl);
            wsl[lane] = __expf(wl - ml);
            if (lane == 0) { msc[slot * 4] = bt; msc[slot * 4 + 1] = ml; }
        }
        __syncthreads();
        {
            const int pp = TID >> 3, g = TID & 7, o = d ? 63 - pp : pp; float kv[8];
            mconv8(z, cw, base + o, oc * 64 + o, L, 256 + h * 64 + g * 8, kv);
#pragma unroll
            for (int e = 0; e < 8; ++e) kT[(g * 8 + e) * 72 + pp] = f2bf(kv[e] * 0.125f);
        }
#pragma unroll
        for (int i = 0; i < 2; ++i) {
            const int idx = TID + 512 * i, pp = idx >> 4, g = idx & 15, o = d ? 63 - pp : pp; float vv8[8];
            unpack8(*(const u32x4*)(z + (base + o) * ZW + ZC_MV + h * 128 + g * 8), vv8); const float wv = wsl[pp];
#pragma unroll
            for (int e = 0; e < 8; ++e) vT[(g * 8 + e) * 72 + pp] = f2bf(vv8[e] * wv);
        }
        __syncthreads();
        f32x4 acc[4];
#pragma unroll
        for (int nt = 0; nt < 4; ++nt) acc[nt] = (f32x4){0.f, 0.f, 0.f, 0.f};
#pragma unroll
        for (int ks = 0; ks < 2; ++ks) {
            const bf16x8 a = *(const bf16x8*)(vT + (16 * wid + (lane & 15)) * 72 + ks * 32 + (lane >> 4) * 8);
#pragma unroll
            for (int nt = 0; nt < 4; ++nt) { const bf16x8 bb = *(const bf16x8*)(kT + (16 * nt + (lane & 15)) * 72 + ks * 32 + (lane >> 4) * 8); acc[nt] = MFMA16(a, bb, acc[nt]); }
        }
#pragma unroll
        for (int nt = 0; nt < 4; ++nt)
#pragma unroll
            for (int j = 0; j < 4; ++j) mst[(size_t)slot * 8192 + (16 * wid + (lane >> 4) * 4 + j) * 64 + 16 * nt + (lane & 15)] = f2bf(acc[nt][j]);
        if (TID < 64) { float s = 0.f; for (int pp = 0; pp < 64; ++pp) s += wsl[pp] * bf2f(kT[TID * 72 + pp]); mn[slot * 64 + TID] = s; }
    }
    __syncthreads();
}
DI void ph_mlstm_b(const Prm& p) { PH_IDS
    bf16_t* mst = (bf16_t*)(p.ws + WS_MST); float* msc = (float*)(p.ws + WS_MSC); float* mn = (float*)(p.ws + WS_MN);
    for (int e = BID * 512 + TID; e < 16 * 4096 + 16 * 64; e += NBLK * 512) {
        const bool isn = e >= 16 * 4096; const int chain = isn ? (e - 16 * 4096) >> 6 : e >> 12, idx = isn ? (e & 63) : (e & 4095);
        float m = 0.f, C0 = 0.f, C1 = 0.f;
        for (int c0 = 0; c0 < NCHK; c0 += 22) {
            float u0[22], u1[22], bt[22], ml[22];
#pragma unroll
            for (int j = 0; j < 22; ++j) {
                const int slot = chain * NCHK + c0 + j; bt[j] = msc[slot * 4]; ml[j] = msc[slot * 4 + 1];
                if (isn) { u0[j] = mn[slot * 64 + idx]; u1[j] = 0.f; }
                else { const unsigned uu = *(const unsigned*)(mst + (size_t)slot * 8192 + 2 * idx); u0[j] = lo16(uu); u1[j] = hi16(uu); }
            }
#pragma unroll
            for (int j = 0; j < 22; ++j) {
                const int slot = chain * NCHK + c0 + j;
                if (isn) mn[slot * 64 + idx] = C0; else *(unsigned*)(mst + (size_t)slot * 8192 + 2 * idx) = pk2(C0, C1);
                if (!isn && idx == 0) msc[slot * 4 + 2] = m;
                const float mnew = fmaxf(bt[j] + m, ml[j]), dA = __expf(bt[j] + m - mnew), dB = __expf(ml[j] - mnew);
                C0 = dA * C0 + dB * u0[j]; C1 = dA * C1 + dB * u1[j]; m = mnew;
            }
        }
    }
}
DI void ph_mlstm_c(const Prm& p, int l, unsigned char* smem, int ubeg, int ustride, int ucount = 1 << 30) { PH_IDS
    const int lane = TID & 63, wid = TID >> 6;
    bf16_t* z = (bf16_t*)(p.ws + WS_Z); const bf16_t* mst = (const bf16_t*)(p.ws + WS_MST); const float* msc = (const float*)(p.ws + WS_MSC); const float* mn = (const float*)(p.ws + WS_MN);
    const float* cw = p.m_conv + (size_t)l * 3 * 512; const float* gb = p.m_gb + l * 16;
    bf16_t* qs = (bf16_t*)smem; bf16_t* ks_ = (bf16_t*)(smem + 9216); bf16_t* vT = (bf16_t*)(smem + 18432); bf16_t* Sp = (bf16_t*)(smem + 36864);
    float* hsum = (float*)(smem + 46080); float* fa = (float*)(smem + 46080 + 33792);
    float *bcum = fa, *gg = fa + 64, *Mrow = fa + 128, *iw = fa + 192, *den = fa + 256, *nq = fa + 320;
    for (int u = ubeg, un = 0; u < 1056 && un < ucount; u += ustride, ++un) {
        const int b = u / 528, h = (u % 528) / NCHK, cc = u % NCHK;
        const bool isctx = cc < 4; const int oc = isctx ? cc : cc - 4, nch = isctx ? 4 : 128, L = isctx ? CTXL : SEQL;
        const size_t base = isctx ? (size_t)NLAT + b * CTXL + oc * 64 : (size_t)b * SEQL + oc * 64;
        for (int d = 0; d < 2; ++d) {
            const int cs = d ? nch - 1 - oc : oc, c = isctx ? cs : cs + 4, slot = ((d * 2 + b) * 4 + h) * NCHK + c;
            const float mst_m = msc[slot * 4 + 2];
            __syncthreads();
            if (wid == 0) {
                const int o = d ? 63 - lane : lane; const bf16_t* zr = z + (base + o) * ZW + ZC_MG + 8 * d + h;
                const float ig = bf2f(zr[0]) + gb[(2 * d) * 4 + h], lf = logsigf_(bf2f(zr[4]) + gb[(2 * d + 1) * 4 + h]);
                const float bc = wave_incl_scan_add(lf, lane), g = ig - bc, pm = wave_incl_scan_max(g, lane), M = fmaxf(mst_m, pm);
                bcum[lane] = bc; gg[lane] = g; Mrow[lane] = M; iw[lane] = __expf(mst_m - M);
            }
#pragma unroll
            for (int i = 0; i < 2; ++i) {
                const int idx = TID + 512 * i, pp = idx >> 4, g = idx & 15, isk = g >> 3, dq0 = (g & 7) * 8, o = d ? 63 - pp : pp; float qv[8];
                mconv8(z, cw, base + o, oc * 64 + o, L, isk * 256 + h * 64 + dq0, qv);
                if (isk) {
#pragma unroll
                    for (int e = 0; e < 8; ++e) qv[e] *= 0.125f;
                }
                *(u32x4*)((isk ? ks_ : qs) + pp * 72 + dq0) = pack8(qv);
            }
#pragma unroll
            for (int i = 0; i < 2; ++i) {
                const int idx = TID + 512 * i, pp = idx >> 4, g = idx & 15, o = d ? 63 - pp : pp;
                const u32x4 uv = *(const u32x4*)(z + (base + o) * ZW + ZC_MV + h * 128 + g * 8);
                vT[(g * 8 + 0) * 72 + pp] = (bf16_t)(uv.x & 0xffffu); vT[(g * 8 + 1) * 72 + pp] = (bf16_t)(uv.x >> 16);
                vT[(g * 8 + 2) * 72 + pp] = (bf16_t)(uv.y & 0xffffu); vT[(g * 8 + 3) * 72 + pp] = (bf16_t)(uv.y >> 16);
                vT[(g * 8 + 4) * 72 + pp] = (bf16_t)(uv.z & 0xffffu); vT[(g * 8 + 5) * 72 + pp] = (bf16_t)(uv.z >> 16);
                vT[(g * 8 + 6) * 72 + pp] = (bf16_t)(uv.w & 0xffffu); vT[(g * 8 + 7) * 72 + pp] = (bf16_t)(uv.w >> 16);
            }
            __syncthreads();
            {
                const int mt = wid >> 1;
#pragma unroll
                for (int nn = 0; nn < 2; ++nn) {
                    const int nt = 2 * (wid & 1) + nn; f32x4 acc = {0.f, 0.f, 0.f, 0.f};
#pragma unroll
                    for (int ks = 0; ks < 2; ++ks) {
                        const bf16x8 a = *(const bf16x8*)(qs + (16 * mt + (lane & 15)) * 72 + ks * 32 + (lane >> 4) * 8);
                        const bf16x8 bb = *(const bf16x8*)(ks_ + (16 * nt + (lane & 15)) * 72 + ks * 32 + (lane >> 4) * 8);
                        acc = MFMA16(a, bb, acc);
                    }
                    const int s = 16 * nt + (lane & 15);
#pragma unroll
                    for (int j = 0; j < 4; ++j) { const int pp = 16 * mt + (lane >> 4) * 4 + j; const float v = s <= pp ? acc[j] * __expf(gg[s] - Mrow[pp]) : 0.f; Sp[pp * 72 + s] = f2bf(v); }
                }
                if (TID < 64) { float s = 0.f; for (int dq = 0; dq < 64; ++dq) s += mn[slot * 64 + dq] * bf2f(qs[TID * 72 + dq]); nq[TID] = s; }
            }
            __syncthreads();
            if (TID < 64) { float s = 0.f; for (int k = 0; k < 64; ++k) s += bf2f(Sp[TID * 72 + k]); den[TID] = s + iw[TID] * nq[TID]; }
            f32x4 a1[4], a2[4];
#pragma unroll
            for (int mt = 0; mt < 4; ++mt) { a1[mt] = (f32x4){0.f, 0.f, 0.f, 0.f}; a2[mt] = (f32x4){0.f, 0.f, 0.f, 0.f}; }
#pragma unroll
            for (int ks = 0; ks < 2; ++ks) {
                const bf16x8 bv = *(const bf16x8*)(vT + (16 * wid + (lane & 15)) * 72 + ks * 32 + (lane >> 4) * 8);
                const bf16x8 bc = *(const bf16x8*)(mst + (size_t)slot * 8192 + (16 * wid + (lane & 15)) * 64 + ks * 32 + (lane >> 4) * 8);
#pragma unroll
                for (int mt = 0; mt < 4; ++mt) {
                    const bf16x8 as = *(const bf16x8*)(Sp + (16 * mt + (lane & 15)) * 72 + ks * 32 + (lane >> 4) * 8);
                    const bf16x8 aq = *(const bf16x8*)(qs + (16 * mt + (lane & 15)) * 72 + ks * 32 + (lane >> 4) * 8);
                    a1[mt] = MFMA16(as, bv, a1[mt]); a2[mt] = MFMA16(aq, bc, a2[mt]);
                }
            }
            __syncthreads();
            {
                const int vv = 16 * wid + (lane & 15);
#pragma unroll
                for (int mt = 0; mt < 4; ++mt)
#pragma unroll
                    for (int j = 0; j < 4; ++j) {
                        const int pp = 16 * mt + (lane >> 4) * 4 + j, o = d ? 63 - pp : pp;
                        const float val = (a1[mt][j] + iw[pp] * a2[mt][j]) / fmaxf(fabsf(den[pp]), __expf(-(bcum[pp] + Mrow[pp])));
                        if (d == 0) hsum[o * 132 + vv] = val; else hsum[o * 132 + vv] += val;
                    }
            }
        }
        __syncthreads();
#pragma unroll
        for (int i = 0; i < 8; ++i) {
            const int o = wid * 8 + i; const float x0 = hsum[o * 132 + lane], x1 = hsum[o * 132 + lane + 64];
            const float ss = wave_sum(x0 * x0 + x1 * x1), rinv = rsqrtf(ss * (1.f / 128.f) + 1e-6f);
            bf16_t* zo = z + (base + o) * ZW + ZC_MO + h * 128; const float* on = p.m_on + l * 512 + h * 128;
            zo[lane] = f2bf(x0 * rinv * on[lane] * sigmoidf_(bf2f(zo[lane])));
            zo[lane + 64] = f2bf(x1 * rinv * on[lane + 64] * sigmoidf_(bf2f(zo[lane + 64])));
        }
    }
    __syncthreads();
}
DI int swap23(int s) { return (s & ~12) | ((s & 4) << 1) | ((s & 8) >> 1); }
DI void ph_attn(const Prm& p, int l, unsigned char* smem, int bh, int qfirst, int qstep, int nq, int qextra) { PH_IDS
    const int lane = TID & 63, wid = TID >> 6, q = lane & 31, hh = lane >> 5, qg = wid >> 1, mp = wid & 1, grp = wid >> 2;
    bf16_t* z = (bf16_t*)(p.ws + WS_Z);
    float lam; const float lam_init = 0.8f - 0.6f * expf(-0.3f * (float)l);
    { const float* lp = p.a_lam + l * 256; float s1 = 0.f, s2 = 0.f; for (int i = 0; i < 64; ++i) { s1 += lp[i] * lp[64 + i]; s2 += lp[128 + i] * lp[192 + i]; } lam = expf(s1) - expf(s2) + lam_init; }
    bf16_t* Qs = (bf16_t*)smem; float* ex = (float*)smem;
    constexpr int KB_OFF = 34816, VT_OFF = 69632;
    float kmax = 0.f; { const float* gk = p.a_qkn + l * 128 + 64; for (int i = 0; i < 64; ++i) kmax = fmaxf(kmax, fabsf(gk[i])); kmax *= 8.f; }
#define ATT_BAR asm volatile("s_waitcnt lgkmcnt(0)\n\ts_barrier" ::: "memory")
    for (int ui = 0; ui < nq + (qextra >= 0 ? 1 : 0); ++ui) {
        const int qi = ui < nq ? qfirst + ui * qstep : qextra;
        const int b = bh >> 2, head = bh & 3; int nt; size_t qrow0;
        const bool lat = qi < 64;
        if (lat) { qrow0 = (size_t)b * SEQL + qi * 128; nt = 132; } else { qrow0 = (size_t)NLAT + b * CTXL + (qi - 64) * 128; nt = 4; }
        __syncthreads();
#pragma unroll
        for (int i = 0; i < 4; ++i) { const int idx = TID + 512 * i, r = idx >> 4, cp = idx & 15; *(u32x4*)(Qs + r * 136 + cp * 8) = *(const u32x4*)(z + (qrow0 + r) * ZW + ZC_AQ + head * 128 + cp * 8); }
        u32x4 kreg[2], vreg[2];
        const int kp = TID & 31, vg = TID >> 5;
#define ATT_KROW0(j) ((lat && (j) >= 4) ? (size_t)b * SEQL + 64 * ((j) - 4) : (size_t)NLAT + b * CTXL + 64 * (j))
#define ATT_LOADK(j) do { const size_t kr0 = ATT_KROW0(j); \
            _Pragma("unroll") for (int i = 0; i < 2; ++i) { const int idx = TID + 512 * i, r = idx >> 4, cp = idx & 15; kreg[i] = *(const u32x4*)(z + (kr0 + r) * ZW + ZC_AK + head * 128 + cp * 8); } } while (0)
#define ATT_LOADV(j) do { const size_t kr0 = ATT_KROW0(j); \
            _Pragma("unroll") for (int i = 0; i < 2; ++i) vreg[i] = *(const u32x4*)(z + (kr0 + 2 * kp + i) * ZW + ZC_AV + head * 128 + 8 * vg); } while (0)
#define ATT_WRITEK(buf) do { bf16_t* Kw = (bf16_t*)(smem + KB_OFF + (buf) * 17408); \
            _Pragma("unroll") for (int i = 0; i < 2; ++i) { const int idx = TID + 512 * i, r = idx >> 4, cp = idx & 15; *(u32x4*)(Kw + r * 136 + cp * 8) = kreg[i]; } } while (0)
#define ATT_WRITEV(buf) do { bf16_t* Vw = (bf16_t*)(smem + VT_OFF + (buf) * 18432); \
            _Pragma("unroll") for (int w = 0; w < 4; ++w) { \
                *(unsigned*)(Vw + (8 * vg + 2 * w) * 72 + 2 * kp) = (vreg[0][w] & 0xffffu) | (vreg[1][w] << 16); \
                *(unsigned*)(Vw + (8 * vg + 2 * w + 1) * 72 + 2 * kp) = (vreg[0][w] >> 16) | (vreg[1][w] & 0xffff0000u); } } while (0)
        f32x16 o[4]; float lrun = 0.f; bf16x8 pf[4];
        float mfix;
        { __syncthreads(); float qq = 0.f;
#pragma unroll
          for (int c8 = 0; c8 < 8; ++c8) { float f8[8]; unpack8(*(const u32x4*)(Qs + (32 * qg + q) * 136 + mp * 64 + c8 * 8), f8);
#pragma unroll
              for (int e = 0; e < 8; ++e) qq += f8[e] * f8[e]; }
          mfix = sqrtf(qq) * kmax * 1.01f + 0.01f; }
        const float nmfix = -mfix;
#pragma unroll
        for (int dvb = 0; dvb < 4; ++dvb)
#pragma unroll
            for (int i = 0; i < 16; ++i) o[dvb][i] = 0.f;
#define ATT_QK(j) do { const bf16_t* Kb = (const bf16_t*)(smem + KB_OFF + ((j) & 1) * 17408); \
            f32x16 s0, s1; \
            _Pragma("unroll") for (int i = 0; i < 16; ++i) { s0[i] = nmfix; s1[i] = nmfix; } \
            _Pragma("unroll") for (int kk = 0; kk < 4; ++kk) { \
                const bf16x8 qf = *(const bf16x8*)(Qs + (32 * qg + q) * 136 + mp * 64 + kk * 16 + hh * 8); \
                const bf16x8 k0 = *(const bf16x8*)(Kb + swap23(q) * 136 + mp * 64 + kk * 16 + hh * 8); \
                const bf16x8 k1 = *(const bf16x8*)(Kb + (32 + swap23(q)) * 136 + mp * 64 + kk * 16 + hh * 8); \
                s0 = MFMA32(k0, qf, s0); s1 = MFMA32(k1, qf, s1); } \
            f32x2 ps = {0.f, 0.f}; \
            _Pragma("unroll") for (int i = 0; i < 16; i += 2) { s0[i] = __builtin_amdgcn_exp2f(s0[i]); s0[i + 1] = __builtin_amdgcn_exp2f(s0[i + 1]); s1[i] = __builtin_amdgcn_exp2f(s1[i]); s1[i + 1] = __builtin_amdgcn_exp2f(s1[i + 1]); \
                const f32x2 a2 = {s0[i], s0[i + 1]}, b2 = {s1[i], s1[i + 1]}; ps += a2 + b2; } \
            lrun += ps.x + ps.y; \
            _Pragma("unroll") for (int cc = 0; cc < 2; ++cc) { u32x4 a, c2; \
                a.x = pk2(s0[8 * cc], s0[8 * cc + 1]); a.y = pk2(s0[8 * cc + 2], s0[8 * cc + 3]); a.z = pk2(s0[8 * cc + 4], s0[8 * cc + 5]); a.w = pk2(s0[8 * cc + 6], s0[8 * cc + 7]); \
                c2.x = pk2(s1[8 * cc], s1[8 * cc + 1]); c2.y = pk2(s1[8 * cc + 2], s1[8 * cc + 3]); c2.z = pk2(s1[8 * cc + 4], s1[8 * cc + 5]); c2.w = pk2(s1[8 * cc + 6], s1[8 * cc + 7]); \
                pf[cc] = __builtin_bit_cast(bf16x8, a); pf[2 + cc] = __builtin_bit_cast(bf16x8, c2); } } while (0)
#define ATT_PV(j) do { const bf16_t* Vt = (const bf16_t*)(smem + VT_OFF + ((j) & 1) * 18432); \
            _Pragma("unroll") for (int dvb = 0; dvb < 4; ++dvb) _Pragma("unroll") for (int c = 0; c < 4; ++c) { \
                const bf16x8 vf = *(const bf16x8*)(Vt + (dvb * 32 + q) * 72 + 16 * c + 8 * hh); o[dvb] = MFMA32(vf, pf[c], o[dvb]); } } while (0)
        ATT_LOADK(0); ATT_LOADV(0); ATT_WRITEK(0); ATT_WRITEV(0);
        __syncthreads();
        for (int j = 0; j < nt; ++j) {
            if (j + 1 < nt) { ATT_LOADK(j + 1); ATT_LOADV(j + 1); }
            ATT_QK(j); ATT_PV(j);
            if (j + 1 < nt) { ATT_WRITEK((j + 1) & 1); ATT_WRITEV((j + 1) & 1); }
            __syncthreads();
        }
        const float lsum = lrun + __shfl_xor(lrun, 32);
        const float inv = (mp ? lam : 1.f) / lsum;
        if (mp) {
#pragma unroll
            for (int dvb = 0; dvb < 4; ++dvb)
#pragma unroll
                for (int i = 0; i < 16; ++i) ex[(qg * 64 + dvb * 16 + i) * 64 + lane] = o[dvb][i] * inv;
        }
        __syncthreads();
        if (!mp) {
            float ss = 0.f;
#pragma unroll
            for (int dvb = 0; dvb < 4; ++dvb)
#pragma unroll
                for (int i = 0; i < 16; ++i) { const float v = o[dvb][i] * inv - ex[(qg * 64 + dvb * 16 + i) * 64 + lane]; o[dvb][i] = v; ss += v * v; }
            ss += __shfl_xor(ss, 32);
            const float rinv = rsqrtf(ss * (1.f / 128.f) + 1e-6f) * (1.f - lam_init);
            bf16_t* orow = z + (qrow0 + 32 * qg + q) * ZW + ZC_AQ + head * 128; const float* sub = p.a_subln + l * 128;
#pragma unroll
            for (int dvb = 0; dvb < 4; ++dvb)
#pragma unroll
                for (int ig = 0; ig < 4; ++ig) {
                    const int dv0 = dvb * 32 + 8 * ig + 4 * hh; u32x2 w;
                    w.x = pk2(o[dvb][4 * ig] * rinv * sub[dv0], o[dvb][4 * ig + 1] * rinv * sub[dv0 + 1]);
                    w.y = pk2(o[dvb][4 * ig + 2] * rinv * sub[dv0 + 2], o[dvb][4 * ig + 3] * rinv * sub[dv0 + 3]);
                    *(u32x2*)(orow + dv0) = w;
                }
        }
    }
    __syncthreads();
}

__device__ unsigned long long g_pacc[4];
template <int CTRL> DI float dppf(float v) { return __int_as_float(__builtin_amdgcn_update_dpp(0, __float_as_int(v), CTRL, 0xf, 0xf, false)); }
DI float allreduce16(float x) { x += dppf<0x128>(x); x += dppf<0x124>(x); x += dppf<0x122>(x); x += dppf<0x121>(x); return x; }
DI void ph_rwkv_scan(const Prm& p, int l, unsigned char* smem, int ubeg, int ustride) { PH_IDS
    const int lane = TID & 63, wid = TID >> 6;
    const bf16_t* z = (const bf16_t*)(p.ws + WS_Z); const bf16_t* rwa = (const bf16_t*)(p.ws + WS_RWA); const float* invn = (const float*)(p.ws + WS_INVN);
    constexpr int TC = 32, OPW = 336, NC = 264, OPS_B = TC * OPW * 4, YP_OFF = 2 * OPS_B;
    for (int u = ubeg; u < 128; u += ustride) {
        const int chain = u >> 2, qr = u & 3, d = chain >> 4, b = (chain >> 3) & 1, h = chain & 7;
        const float ckk = p.r_kk[l * 512 + h * 64 + lane], cka = p.r_ka[l * 512 + h * 64 + lane];
        bf16_t* ydir = (bf16_t*)(p.ws + WS_YSUM) + (size_t)d * NTOK * 512;
#define RW_ROW(ck, i) ((ck) < 8 ? (size_t)NLAT + b * CTXL + (d ? CTXL - 1 - ((ck) * TC + (i)) : ((ck) * TC + (i))) : (size_t)b * SEQL + (d ? SEQL - 1 - (((ck) - 8) * TC + (i)) : (((ck) - 8) * TC + (i))))
        bf16_t g_r[8], g_k[8], g_u[8], g_a[8]; float g_i[8]; unsigned g_v;
        const int sw = wid - 4, st = TID - 256;
#define RW_LOAD(ck) do { const long row0 = (long)RW_ROW(ck, 0), sgn = d ? -1 : 1;         \
            const bf16_t* zq = z + (row0 + sgn * sw) * ZW + ZC_RR + h * 64 + lane; const bf16_t* rq = rwa + (row0 + sgn * sw) * 2048 + d * 512 + h * 64 + lane; const float* iq = invn + (row0 + sgn * sw) * 8 + h; \
            const long zs = sgn * 4 * ZW, rs = sgn * 4 * 2048, is = sgn * 4 * 8; \
            _Pragma("unroll") for (int jj = 0; jj < 8; ++jj) { \
            g_r[jj] = zq[jj * zs]; g_k[jj] = zq[jj * zs + 512]; g_u[jj] = rq[jj * rs]; g_a[jj] = rq[jj * rs + 1024]; g_i[jj] = iq[jj * is]; } \
            g_v = *(const unsigned*)(z + (row0 + sgn * (st >> 3)) * ZW + ZC_RV + h * 64 + qr * 16 + (st & 7) * 2); } while (0)
#define RW_WRITE(buf) do { float* ops = (float*)(smem + (buf) * OPS_B); _Pragma("unroll") for (int jj = 0; jj < 8; ++jj) { \
            const float k = bf2f(g_k[jj]), a = bf2f(g_a[jj]), kk = k * ckk * g_i[jj]; float* o = ops + (sw + 4 * jj) * OPW; \
            o[lane] = 1.f - bf2f(g_u[jj]); o[64 + lane] = kk; o[128 + lane] = kk * a; o[192 + lane] = k * (1.f + (a - 1.f) * cka); o[256 + lane] = bf2f(g_r[jj]); } \
            { float* o = ops + (st >> 3) * OPW + 320 + (st & 7) * 2; o[0] = lo16(g_v); o[1] = hi16(g_v); } } while (0)
        __syncthreads();
        if (wid >= 4) { RW_LOAD(0); RW_WRITE(0); RW_LOAD(1); }
        __syncthreads();
        f32x2 Sa = {0.f, 0.f}, Sb = {0.f, 0.f};
        const int rl = (wid & 3) * 4 + (lane >> 4), ksub = lane & 15;
        float* ypw = (float*)(smem + YP_OFF) + (wid & 3) * (TC * 64);
        for (int ck = 0; ck < NC; ++ck) {
            if (wid >= 4) {
                if (ck + 1 < NC) RW_WRITE((ck + 1) & 1);
                if (ck + 2 < NC) RW_LOAD(ck + 2);
            } else {
                const float* ops = (const float*)(smem + (ck & 1) * OPS_B);
#define RW_GET(X, i) do { const float* o_ = ops + (i) * OPW; w_##X = *(const f32x4*)(o_ + 4 * ksub); k_##X = *(const f32x4*)(o_ + 64 + 4 * ksub); b_##X = *(const f32x4*)(o_ + 128 + 4 * ksub); \
                d_##X = *(const f32x4*)(o_ + 192 + 4 * ksub); r_##X = *(const f32x4*)(o_ + 256 + 4 * ksub); v_##X = o_[320 + rl]; } while (0)
#define RW_STEP(X, i) do { const f32x2 ka = {k_##X[0], k_##X[1]}, kb = {k_##X[2], k_##X[3]}, ra = {r_##X[0], r_##X[1]}, rb = {r_##X[2], r_##X[3]}; \
                const f32x2 ba = {b_##X[0], b_##X[1]}, bb = {b_##X[2], b_##X[3]}, da = {d_##X[0], d_##X[1]}, db = {d_##X[2], d_##X[3]}, wa = {w_##X[0], w_##X[1]}, wb = {w_##X[2], w_##X[3]}; \
                const f32x2 dt2 = Sa * ka + Sb * kb; const f32x2 qa = Sa * wa + da * v_##X, qb = Sb * wb + db * v_##X; const float sa = -allreduce16(dt2.x + dt2.y); \
                Sa = ba * sa + qa; Sb = bb * sa + qb; \
                const f32x2 y2 = Sa * ra + Sb * rb; \
                ypw[(i) * 64 + lane] = y2.x + y2.y; } while (0)
                f32x4 w_A, k_A, b_A, d_A, r_A, w_B, k_B, b_B, d_B, r_B, w_C, k_C, b_C, d_C, r_C, w_D, k_D, b_D, d_D, r_D; float v_A, v_B, v_C, v_D;
                RW_GET(A, 0); RW_GET(B, 1);
#pragma unroll 1
                for (int i = 0; i < TC; i += 4) {
                    RW_GET(C, i + 2);
                    RW_STEP(A, i);
                    RW_GET(D, i + 3);
                    RW_STEP(B, i + 1);
                    if (i + 4 < TC) RW_GET(A, i + 4);
                    RW_STEP(C, i + 2);
                    if (i + 4 < TC) RW_GET(B, i + 5);
                    RW_STEP(D, i + 3);
                }
                {
                    const int i = lane >> 1, rw = (lane & 1) * 2;
                    const f32x4* y4 = (const f32x4*)(ypw + i * 64 + rw * 16);
                    const f32x4 s4 = (y4[0] + y4[1]) + (y4[2] + y4[3]), t4 = (y4[4] + y4[5]) + (y4[6] + y4[7]);
                    *(unsigned*)(ydir + RW_ROW(ck, i) * 512 + h * 64 + qr * 16 + wid * 4 + rw) = pk2((s4[0] + s4[1]) + (s4[2] + s4[3]), (t4[0] + t4[1]) + (t4[2] + t4[3]));
                }
            }
            asm volatile("s_waitcnt lgkmcnt(0)\n\ts_barrier" ::: "memory");
        }
    }
    __syncthreads();
}
DI void ph_rwkv_post(const Prm& p, int l) { PH_IDS
    const int lane = TID & 63, wid = TID >> 6, ch0 = lane * 8;
    bf16_t* z = (bf16_t*)(p.ws + WS_Z); const bf16_t* ysum = (const bf16_t*)(p.ws + WS_YSUM); const bf16_t* rg = (const bf16_t*)(p.ws + WS_RG);
    for (int row = BID * 8 + wid; row < NTOK; row += NBLK * 8) {
        float y[8], y2[8], r[8], k[8], v[8], g[8], o[8];
        unpack8(*(const u32x4*)(ysum + (size_t)row * 512 + ch0), y); unpack8(*(const u32x4*)(ysum + (size_t)(NTOK + row) * 512 + ch0), y2);
#pragma unroll
        for (int e = 0; e < 8; ++e) y[e] += y2[e];
        bf16_t* zr = z + (size_t)row * ZW + ZC_RR + ch0;
        unpack8(*(const u32x4*)zr, r); unpack8(*(const u32x4*)(zr + 512), k); unpack8(*(const u32x4*)(zr + 1024), v); unpack8(*(const u32x4*)(rg + (size_t)row * 512 + ch0), g);
        float s = 0.f, bs = 0.f;
#pragma unroll
        for (int e = 0; e < 8; ++e) { s += y[e]; bs += r[e] * k[e] * p.r_rk[l * 512 + ch0 + e]; }
        s += __shfl_xor(s, 1); s += __shfl_xor(s, 2); s += __shfl_xor(s, 4); bs += __shfl_xor(bs, 1); bs += __shfl_xor(bs, 2); bs += __shfl_xor(bs, 4);
        const float mu = s * (1.f / 64.f); float vs = 0.f;
#pragma unroll
        for (int e = 0; e < 8; ++e) { const float dlt = y[e] - mu; vs += dlt * dlt; }
        vs += __shfl_xor(vs, 1); vs += __shfl_xor(vs, 2); vs += __shfl_xor(vs, 4);
        const float rstd = rsqrtf(vs * (1.f / 64.f) + 64e-5f);
#pragma unroll
        for (int e = 0; e < 8; ++e) o[e] = ((y[e] - mu) * rstd * p.r_lnw[l * 512 + ch0 + e] + p.r_lnb[l * 512 + ch0 + e] + bs * v[e]) * g[e];
        *(u32x4*)zr = pack8(o);
    }
}

#ifndef PROBE_A
#define PROBE_A 0
#endif
#ifndef PROBE_B
#define PROBE_B 0
#endif
#ifndef PROBE_BLK
#define PROBE_BLK 0
#endif
#ifndef PROBE_ADIV
#define PROBE_ADIV 1
#endif
#ifndef PROBE_BDIV
#define PROBE_BDIV 1
#endif
#if PROBE_A || PROBE_B
#define PT(id, ...) do { unsigned long long t0_ = wall_clock64(); __VA_ARGS__; unsigned long long dt_ = wall_clock64() - t0_; if ((id) == PROBE_A) pacc1 += dt_; if ((id) == PROBE_B) pacc2 += dt_; } while (0)
#else
#define PT(id, ...) do { __VA_ARGS__; } while (0)
#endif
DI void grid_bar(unsigned* ctr, unsigned& target, unsigned nblk) {
    __syncthreads();
    if (threadIdx.x == 0) {
        __builtin_amdgcn_fence(__ATOMIC_RELEASE, "agent");
        target += nblk;
        __hip_atomic_fetch_add(ctr, 1u, __ATOMIC_RELAXED, __HIP_MEMORY_SCOPE_AGENT);
        while (__hip_atomic_load(ctr, __ATOMIC_RELAXED, __HIP_MEMORY_SCOPE_AGENT) < target) __builtin_amdgcn_s_sleep(2);
        __builtin_amdgcn_fence(__ATOMIC_ACQUIRE, "agent");
    }
    __syncthreads();
}
__global__ void __launch_bounds__(512) mega(Prm p0) {
    Prm p = p0; p.wv = __builtin_amdgcn_readfirstlane((int)threadIdx.x >> 6);
    const int BIDK = (int)blockIdx.x;
    extern __shared__ __attribute__((aligned(16))) unsigned char smem[];
    cg::grid_group grid = cg::this_grid();
    unsigned bar_target = 0; unsigned* bar_ctr = (unsigned*)(p0.ws + WS_BAR);
#define GSYNC() grid_bar(bar_ctr, bar_target, gridDim.x)
    bf16_t* wt = (bf16_t*)(p.ws + WS_WT); bf16_t* zb = (bf16_t*)(p.ws + WS_Z); bf16_t* hb = (bf16_t*)(p.ws + WS_RWA); bf16_t* gtmp = hb + (size_t)NTOK * DM;
    bf16_t* zz = (bf16_t*)(p.ws + WS_MST); float* xc = (float*)(p.ws + WS_XC); const float* mods = (const float*)(p.ws + WS_MODS);
#if PROBE_A || PROBE_B
    unsigned long long pacc1 = 0, pacc2 = 0; const unsigned long long pstart = wall_clock64();
    if (PROBE_SCAN && blockIdx.x == 0 && threadIdx.x == 0) { g_pacc[0] = 0; g_pacc[1] = 0; }
#endif
    PT(15, ph_modpart(p, smem); ph_rope(p); conv_ffn(p, 0, 0, smem));
    PT(14, grid.sync());
    ph_modreduce(p);
    PT(14, GSYNC());
#define MERGE_B(l, b) do { \
                    { EpiGate E; E.G = gtmp; run_gemm(p.wv, smem, hb, DM, wt + WT_G + (size_t)(b) * DM * DM, (l) == 1 ? NLAT : NTOK, DM, DM, E); } \
                    { EpiBranch E; E.G = gtmp; E.ZZ = zz; E.first = ((b) == 0); const int yc = (b) == 0 ? ZC_MO : ((b) == 1 ? ZC_RR : ZC_AQ); \
                      run_gemm(p.wv, smem, zb + yc, ZW, wt + WT_P + (size_t)(b) * DM * 512, (l) == 1 ? NLAT : NTOK, DM, 512, E); } \
 } while (0)
#define MIXER_STAGE(l) do { const float* ml = mods + (size_t)(l) * 27648; \
                PT(13, ph_norm(p, l, 1, false, 11, ml + 2 * DM, 0.5f); conv_mixer(p, l, smem);); \
                PT(14, GSYNC()); \
                PT(8, { EpiWin E; E.Z = zb; run_gemm(p.wv, smem, hb, DM, wt + WT_IN, NTOK, ZWP, DM, E); }); \
                PT(14, GSYNC()); \
                PT(4, ph_rkv_conv(p, l); ph_attn_prep(p, l)); PT(5, ph_mlstm_a(p, l, smem)); \
                PT(14, GSYNC()); \
                PT(6, ph_rkv_copy(p)); PT(7, ph_mlstm_b(p)); \
                PT(14, GSYNC()); \
                PT(16, { EpiLora E; E.RWA = hb; E.RG = (bf16_t*)(p.ws + WS_RG); E.w0 = p.r_w0 + l * 1024; E.a0 = p.r_a0 + l * 1024; run_gemm(p.wv, smem, zb + ZC_RL, ZW, wt + WT_L, NTOK, 2560, 384, E); }); \
                PT(14, GSYNC()); \
                { int sc_u = BIDK, sc_s = NBLK, bh0 = 0, bh1 = 8, qf = BIDK, qs = NBLK, nq = (66 - BIDK + NBLK - 1) / NBLK, qx = -1, mc_u = BIDK, mc_s = NBLK, mc_c = 1 << 30; \
                  if (NBLK == 256) { const int xi = BIDK >> 3, bh = BIDK & 7; bh0 = bh; bh1 = bh + 1; sc_s = 128; \
                      if (xi < 16) { sc_u = bh * 16 + xi; nq = 0; mc_u = 256 + bh * 16 + xi; mc_s = 128; } \
                      else { const int a = xi - 16; sc_u = 128; qf = a; qs = 16; nq = 4; qx = a < 2 ? 64 + a : -1; mc_u = (bh * 16 + a) * 2; mc_s = 1; mc_c = 2; } } \
                  PT(1, ph_rwkv_scan(p, l, smem, sc_u, sc_s)); \
                  PT(2, for (int bh = bh0; bh < bh1; ++bh) ph_attn(p, l, smem, bh, qf, qs, nq, qx)); \
                  PT(3, ph_mlstm_c(p, l, smem, mc_u, mc_s, mc_c)); } \
                PT(14, GSYNC()); \
                PT(12, ph_rwkv_post(p, l); ph_norm(p, l, 1, false)); \
                PT(14, GSYNC()); \
                PT(9, MERGE_B(l, 0); MERGE_B(l, 1); MERGE_B(l, 2)); \
                PT(14, GSYNC()); \
                PT(17, { EpiResid E; E.xlat = p.out; E.xc = xc; E.gate = ml + 5 * DM; E.coef = 1.f; run_gemm(p.wv, smem, zz, DM, wt + WT_O, NLAT, DM, DM, E); \
              if ((l) == 0) { EpiPartial E2; E2.P = (float*)gtmp; E2.kslice_bytes = 512; run_gemm_ctx(p.wv, smem, zz, DM, wt + WT_O, DM, 4, 256, E2); } }); \
                PT(14, GSYNC()); \
 } while (0)
#define FFN_STAGE(l, f) do { const float* ml = mods + (size_t)(l) * 27648; \
            PT(18, ph_norm(p, l, f == 0 ? 0 : 2, l == 0 && f == 0, (f) == 1 ? ((l) == 0 ? 4 : 0) : ((l) == 1 ? 11 : 0), (f) == 1 ? ml + 5 * DM : mods + 8 * DM, (f) == 1 ? 1.f : 0.5f); \
            if (!(l == 0 && f == 0)) conv_ffn(p, l, f, smem)); \
            PT(14, GSYNC()); \
            PT(10, { EpiSwiglu E; E.H = zb; run_gemm(p.wv, smem, hb, DM, wt + WT_GU, ((l) == 1 && (f) == 1) ? NLAT : NTOK, 2 * DFF, DM, E); }); \
            PT(14, GSYNC()); \
            PT(11, { EpiResid E; E.xlat = p.out; E.xc = xc; E.gate = ml + (f == 0 ? 2 : 8) * DM; E.coef = 0.5f; run_gemm(p.wv, smem, zb, DFF, wt + WT_DN, NLAT, DM, DFF, E); \
              if (!((l) == 1 && (f) == 1)) { EpiPartial E2; E2.P = (float*)gtmp; E2.kslice_bytes = 512; run_gemm_ctx(p.wv, smem, zb, DFF, wt + WT_DN, DFF, 11, 256, E2); } }); \
            PT(14, GSYNC()); \
 } while (0)
    FFN_STAGE(0, 0); MIXER_STAGE(0); FFN_STAGE(0, 1); FFN_STAGE(1, 0); MIXER_STAGE(1); FFN_STAGE(1, 1);
#if PROBE_A || PROBE_B
    if (blockIdx.x == PROBE_BLK) {
        const unsigned long long pend = wall_clock64();
        if (PROBE_SCAN) { __syncthreads(); pacc1 = g_pacc[0]; pacc2 = g_pacc[1]; }
        if (PROBE_A == 99) pacc1 = pend - pstart;
        if (PROBE_B == 99) pacc2 = pend - pstart;
        unsigned long long q1 = pacc1 / (4000ull * PROBE_ADIV), q2 = pacc2 / (4000ull * PROBE_BDIV); if (q1 > 63) q1 = 63; if (q2 > 63) q2 = 63;
        const unsigned long long waitt = (q1 + 64 * q2) * 2000ull;
        while (wall_clock64() - pend < waitt) __builtin_amdgcn_s_sleep(32);
    }
#endif
}

extern "C" void kernel_launch(void* const* d_in, const int* in_sizes, int n_in, void* d_out, int out_size, void* d_ws, size_t ws_size, hipStream_t stream) {
    static int grid_blocks = 0;
    if (!grid_blocks) {
        int dev = 0, cus = 0, per_cu = 0;
        hipGetDevice(&dev);
        hipDeviceGetAttribute(&cus, hipDeviceAttributeMultiprocessorCount, dev);
        hipFuncSetAttribute((const void*)mega, hipFuncAttributeMaxDynamicSharedMemorySize, LDS_BYTES);
        hipOccupancyMaxActiveBlocksPerMultiprocessor(&per_cu, (const void*)mega, 512, LDS_BYTES);
        if (per_cu < 1) per_cu = 1;
        grid_blocks = cus * per_cu;
        if (ws_size < WS_END) fprintf(stderr, "kernel_launch: workspace too small: %zu < %zu\n", ws_size, (size_t)WS_END);
    }
    Prm p{};
    const float** pp = (const float**)&p;
    for (int i = 0; i < 31; ++i) pp[i] = (const float*)d_in[i];
    p.out = (float*)d_out; p.ws = (unsigned char*)d_ws;
    (void)hipMemsetAsync((unsigned char*)d_ws + WS_BAR, 0, 256, stream);
    void* args[] = {&p};
    hipError_t e = hipLaunchCooperativeKernel((const void*)mega, dim3(grid_blocks), dim3(512), args, LDS_BYTES, stream);
    if (e != hipSuccess) fprintf(stderr, "cooperative launch failed: %s (grid %d)\n", hipGetErrorString(e), grid_blocks);
}
```

```cpp
#include <hip/hip_runtime.h>
#include <hip/hip_cooperative_groups.h>
#include <cstdio>
#include <cstdint>
namespace cg = cooperative_groups;
#ifndef PROBE_SCAN
#define PROBE_SCAN 0
#endif

#define LAS __attribute__((address_space(3)))
#define DI __device__ __forceinline__
typedef unsigned short bf16_t;
typedef short bf16x8 __attribute__((ext_vector_type(8)));
typedef float f32x4 __attribute__((ext_vector_type(4)));
typedef float f32x16 __attribute__((ext_vector_type(16)));
typedef float f32x2 __attribute__((ext_vector_type(2)));
typedef unsigned u32x4 __attribute__((ext_vector_type(4)));
typedef unsigned u32x2 __attribute__((ext_vector_type(2)));
typedef __bf16 bf16x2_t __attribute__((ext_vector_type(2)));

constexpr int DM = 1024, NLAT = 16384, NTOK = 16896, SEQL = 8192, CTXL = 256, DFF = 2816, DIN = 8080, ZW = 5008, ZWP = 5120;
constexpr int ZC_MQ = 0, ZC_MK = 256, ZC_MV = 512, ZC_MO = 1024, ZC_MG = 1536, ZC_RR = 1552, ZC_RK = 2064, ZC_RV = 2576, ZC_RL = 3088, ZC_AQ = 3472, ZC_AK = 3984, ZC_AV = 4496;
constexpr int NCHK = 132;
constexpr size_t WS_MODP = 0;
constexpr size_t WS_MODS = WS_MODP + (size_t)2 * 16 * 3 * 9216 * 4;
constexpr size_t WS_ROPE = WS_MODS + (size_t)2 * 3 * 9216 * 4;
constexpr size_t WS_XC   = WS_ROPE + (size_t)8192 * 64 * 4;
constexpr size_t WS_INVN = WS_XC + (size_t)512 * 1024 * 4;
constexpr size_t WS_MSC  = WS_INVN + (size_t)NTOK * 8 * 4;
constexpr size_t WS_MN   = WS_MSC + (size_t)2112 * 4 * 4;
constexpr size_t WS_WT   = WS_MN + (size_t)2112 * 64 * 4;
constexpr size_t WS_Z    = WS_WT + (size_t)25165824;
constexpr size_t WS_RWA  = WS_Z + (size_t)NTOK * ZW * 2;
constexpr size_t WS_RG   = WS_RWA + (size_t)NTOK * 2048 * 2;
constexpr size_t WS_MST  = WS_RG + (size_t)NTOK * 512 * 2;
constexpr size_t WS_YSUM = WS_MST + (size_t)2112 * 8192 * 2;
constexpr size_t WS_BAR  = WS_YSUM + (size_t)NTOK * 512 * 4;
constexpr size_t WS_END  = WS_BAR + 256;
constexpr size_t WT_GU = 0, WT_DN = (size_t)5632 * 1024;
constexpr size_t WT_IN = 0, WT_G = (size_t)5120 * 1024, WT_P = WT_G + (size_t)3072 * 1024, WT_O = WT_P + (size_t)3 * 1024 * 512, WT_L = WT_O + (size_t)1024 * 1024;
constexpr int LDS_BYTES = 155648;

DI float bf2f(bf16_t b) { return __uint_as_float(((unsigned)b) << 16); }
DI unsigned pk2(float lo, float hi) { f32x2 v = {lo, hi}; bf16x2_t b = __builtin_convertvector(v, bf16x2_t); return __builtin_bit_cast(unsigned, b); }
DI bf16_t f2bf(float f) { return (bf16_t)(pk2(f, 0.f) & 0xffffu); }
DI float lo16(unsigned u) { return __uint_as_float(u << 16); }
DI float hi16(unsigned u) { return __uint_as_float(u & 0xffff0000u); }
DI float sigmoidf_(float x) { return __builtin_amdgcn_rcpf(1.f + __expf(-x)); }
DI float siluf_(float x) { return x * __builtin_amdgcn_rcpf(1.f + __expf(-x)); }
DI float logsigf_(float x) { return x < 0.f ? x - log1pf(expf(x)) : -log1pf(expf(-x)); }
DI float wave_sum(float v) {
#pragma unroll
    for (int o = 1; o < 64; o <<= 1) v += __shfl_xor(v, o);
    return v;
}
DI float wave_max(float v) {
#pragma unroll
    for (int o = 1; o < 64; o <<= 1) v = fmaxf(v, __shfl_xor(v, o));
    return v;
}
DI void unpack8(const u32x4 u, float* f) { f[0] = lo16(u.x); f[1] = hi16(u.x); f[2] = lo16(u.y); f[3] = hi16(u.y); f[4] = lo16(u.z); f[5] = hi16(u.z); f[6] = lo16(u.w); f[7] = hi16(u.w); }
DI u32x4 pack8(const float* f) { u32x4 u; u.x = pk2(f[0], f[1]); u.y = pk2(f[2], f[3]); u.z = pk2(f[4], f[5]); u.w = pk2(f[6], f[7]); return u; }
DI int launder_v(int v) { asm volatile("" : "+v"(v)); return v; }
DI int launder_s(int v) { asm volatile("" : "+s"(v)); return v; }
DI int lane_id_() { return (int)__builtin_amdgcn_mbcnt_hi(~0u, __builtin_amdgcn_mbcnt_lo(~0u, 0u)); }
namespace pg8 {
#define PG8_LAS __attribute__((address_space(3)))
typedef unsigned short bf16_t;
typedef short bf16x8 __attribute__((ext_vector_type(8)));
typedef float f32x4 __attribute__((ext_vector_type(4)));
typedef unsigned u32x4 __attribute__((ext_vector_type(4)));
constexpr int BM = 256, BK = 64, HALF = 128, HTB = HALF * BK * 2  , STAGE_BYTES = 8 * HTB, NXCD = 8, WGM = 8;

__host__ __device__ __forceinline__ int lds_byte(int r, int c) { const int st = (r >> 4) * 2 + (c >> 5), rr = r & 15, cc = c & 31, ob = rr * 64 + cc * 2; return st * 1024 + (ob ^ (((ob >> 9) & 1) << 5)); }
__host__ __device__ __forceinline__ void stage_rc(int b, int& R, int& C) { const int st = b / 1024, sb = b % 1024, swz = sb ^ (((sb >> 9) & 1) << 5); R = (st >> 1) * 16 + swz / 64; C = (st & 1) * 32 + (swz % 64) / 2; }
__host__ __device__ __forceinline__ int perm32(int rho) { const int n = rho >> 4, i = rho & 15; return 8 * (i >> 2) + 4 * n + (i & 3); }

struct Unit { int pm, pn; size_t koff; };
struct Gemm { const bf16_t* A; const bf16_t* Bt; int M, N, K, lda, ldb, tid0; };

struct StaticOrder {
    int nM, nN, nwg, G, c;
    __host__ __device__ void init(int M, int N, int G_, int c_) { nM = M / BM; nN = N / BM; nwg = nM * nN; G = G_; c = c_; }
    __host__ __device__ bool next(int i, Unit& u) const {
        const long L = (long)i * G + c; if (L >= nwg) return false;
        int wgid = (int)L; { const int q = nwg / NXCD, r = nwg % NXCD, xcd = wgid % NXCD, off = wgid / NXCD; wgid = (xcd < r ? xcd * (q + 1) : r * (q + 1) + (xcd - r) * q) + off; }
        const int nig = WGM * nN, gid = wgid / nig, fm = gid * WGM, gsz = (nM - fm) < WGM ? (nM - fm) : WGM;
        u.pm = fm + ((wgid % nig) % gsz); u.pn = (wgid % nig) / gsz; u.koff = 0; return true;
    }
    __device__ __forceinline__ void a_ready(const Unit&) const {}
    __device__ __forceinline__ void done(const Unit&) const {}
};


template <class Epi, class Sched, bool ALIGN_EPI = false, bool SP2 = false>
__device__ __forceinline__ void gemm_phase(PG8_LAS unsigned char* lds, const Gemm g, const Sched& S, const Epi& E) {
    int tid = g.tid0; asm volatile("" : "+v"(tid)); const int wid = __builtin_amdgcn_readfirstlane(tid >> 6), lane = tid & 63, wr = wid >> 2, wc = wid & 3, fr = lane & 15, fq = lane >> 4;
    const int K = g.K, nt = K / BK;
    unsigned voffA[2], voffB[2];
#pragma unroll
    for (int i = 0; i < 2; ++i) { int R, C; stage_rc(tid * 16 + i * 8192, R, C); const int Rb = Epi::PERM ? ((R & ~31) + perm32(R & 31)) : R;
        voffA[i] = (unsigned)(R * g.lda + C) * 2u; voffB[i] = (unsigned)(Rb * g.ldb + C) * 2u; }
    const size_t kstep = (size_t)(BK * 2);
    const size_t hstepB = (size_t)HALF * g.ldb * 2, hstepA = (size_t)HALF * g.lda * 2;
    const size_t tstepA = 2 * hstepA, tstepB = 2 * hstepB;
    const unsigned ldsw = (unsigned)wid * 1024u;
    const int aoff = lds_byte(wr * 64 + fr, fq * 8), boff = lds_byte(wc * 32 + fr, fq * 8);
#define PG8_SA(b, h) (((b) * 2 + (h)) * HTB)
#define PG8_SB(b, h) ((4 + (b) * 2 + (h)) * HTB)
#define PG8_STAGE(bufoff, gbase, voff) do { _Pragma("unroll") for (int _i = 0; _i < 2; ++_i) \
        __builtin_amdgcn_global_load_lds((const unsigned*)((const char*)(gbase) + (voff)[_i]), (PG8_LAS unsigned*)(lds + (bufoff) + ldsw + _i * 8192), 16, 0, 0); } while (0)
#define PG8_LDA(dst, b, h) do { _Pragma("unroll") for (int m = 0; m < 4; ++m) _Pragma("unroll") for (int k = 0; k < 2; ++k) dst[m][k] = *(const PG8_LAS bf16x8*)(lds + PG8_SA(b, h) + aoff + m * 2048 + k * 1024); } while (0)
#define PG8_LDB(dst, b, h) do { _Pragma("unroll") for (int n = 0; n < 2; ++n) _Pragma("unroll") for (int k = 0; k < 2; ++k) dst[n][k] = *(const PG8_LAS bf16x8*)(lds + PG8_SB(b, h) + boff + n * 2048 + k * 1024); } while (0)
#define PG8_MMA(ai, bj, At, Bt) do { __builtin_amdgcn_s_setprio(1); _Pragma("unroll") for (int m = 0; m < 4; ++m) _Pragma("unroll") for (int n = 0; n < 2; ++n) _Pragma("unroll") for (int k = 0; k < 2; ++k) \
        acc[ai][bj][m][n] = __builtin_amdgcn_mfma_f32_16x16x32_bf16(Bt[n][k], At[m][k], acc[ai][bj][m][n], 0, 0, 0); __builtin_amdgcn_s_setprio(0); } while (0)
#define PG8_WAIT_V(n) asm volatile("s_waitcnt vmcnt(" #n ")" ::: "memory")
#define PG8_WAIT_L(n) asm volatile("s_waitcnt lgkmcnt(" #n ")" ::: "memory")
#define PG8_BAR __builtin_amdgcn_s_barrier()
#define PG8_SCHED __builtin_amdgcn_sched_barrier(0)
    Unit cur, nxt; int ui = 0;
    if (!S.next(0, cur)) return;
    f32x4 acc[2][2][4][2];
#pragma unroll
    for (int a = 0; a < 2; ++a)
#pragma unroll
        for (int b = 0; b < 2; ++b)
#pragma unroll
            for (int m = 0; m < 4; ++m)
#pragma unroll
                for (int n = 0; n < 2; ++n) acc[a][b][m][n] = (f32x4){0.f, 0.f, 0.f, 0.f};
    bf16x8 At[4][2], B0[2][2], B1[2][2];
    const char* cA = (const char*)g.A + (size_t)cur.pm * tstepA + cur.koff; const char* cB = (const char*)g.Bt + (size_t)cur.pn * tstepB + cur.koff;
    S.a_ready(cur);
    if constexpr (SP2) {
        PG8_STAGE(PG8_SB(0, 0), cB, voffB); PG8_STAGE(PG8_SB(0, 1), cB + hstepB, voffB); PG8_STAGE(PG8_SA(0, 0), cA, voffA); PG8_STAGE(PG8_SA(0, 1), cA + hstepA, voffA);
        if (wr == 1) PG8_BAR;
        PG8_WAIT_V(2); PG8_BAR;
        PG8_STAGE(PG8_SB(1, 0), cB + kstep, voffB); PG8_STAGE(PG8_SA(1, 0), cA + kstep, voffA); PG8_STAGE(PG8_SB(1, 1), cB + hstepB + kstep, voffB);
        PG8_WAIT_V(6); PG8_BAR;
    } else {
        PG8_STAGE(PG8_SB(0, 0), cB, voffB); PG8_STAGE(PG8_SA(0, 0), cA, voffA); PG8_STAGE(PG8_SB(0, 1), cB + hstepB, voffB); PG8_STAGE(PG8_SA(0, 1), cA + hstepA, voffA);
        if (wr == 1) PG8_BAR;
        PG8_WAIT_V(4); PG8_BAR;
        PG8_STAGE(PG8_SB(1, 0), cB + kstep, voffB); PG8_STAGE(PG8_SA(1, 0), cA + kstep, voffA); PG8_STAGE(PG8_SB(1, 1), cB + hstepB + kstep, voffB);
        PG8_WAIT_V(6); PG8_BAR;
    }
    for (;;) {
        const bool has_next = S.next(ui + 1, nxt);
        const char* nA = has_next ? (const char*)g.A + (size_t)nxt.pm * tstepA + nxt.koff : cA; const char* nB = has_next ? (const char*)g.Bt + (size_t)nxt.pn * tstepB + nxt.koff : cB;
        for (int t = 0; t < nt; t += 2) {
            const bool last = (t == nt - 2);
            const char* a1 = cA + (size_t)(t + 1) * kstep;
            const char* a2 = last ? nA : cA + (size_t)(t + 2) * kstep; const char* b2 = last ? nB : cB + (size_t)(t + 2) * kstep;
            const char* a3 = a2 + kstep; const char* b3 = b2 + kstep;
            if (last && has_next) S.a_ready(nxt);
            if constexpr (SP2) {
            PG8_LDB(B0, 0, 0); PG8_LDB(B1, 0, 1); PG8_SCHED; PG8_LDA(At, 0, 0); PG8_STAGE(PG8_SA(1, 1), a1 + hstepA, voffA);
            PG8_WAIT_V(8); PG8_WAIT_L(0); PG8_BAR; PG8_MMA(0, 0, At, B0); PG8_MMA(0, 1, At, B1); PG8_BAR; PG8_SCHED;
            PG8_LDA(At, 0, 1); PG8_STAGE(PG8_SB(0, 0), b2, voffB); PG8_STAGE(PG8_SB(0, 1), b2 + hstepB, voffB); PG8_STAGE(PG8_SA(0, 0), a2, voffA);
            PG8_WAIT_V(8); PG8_WAIT_L(0); PG8_BAR; PG8_MMA(1, 0, At, B0); PG8_MMA(1, 1, At, B1); PG8_BAR; PG8_SCHED;
            PG8_LDB(B0, 1, 0); PG8_LDB(B1, 1, 1); PG8_SCHED; PG8_LDA(At, 1, 0); PG8_STAGE(PG8_SA(0, 1), a2 + hstepA, voffA);
            PG8_WAIT_V(8); PG8_WAIT_L(0); PG8_BAR; PG8_MMA(0, 0, At, B0); PG8_MMA(0, 1, At, B1); PG8_BAR; PG8_SCHED;
            PG8_LDA(At, 1, 1); PG8_STAGE(PG8_SB(1, 0), b3, voffB); PG8_STAGE(PG8_SB(1, 1), b3 + hstepB, voffB); PG8_STAGE(PG8_SA(1, 0), a3, voffA);
            PG8_WAIT_V(8); PG8_WAIT_L(0); PG8_BAR; PG8_MMA(1, 0, At, B0); PG8_MMA(1, 1, At, B1); PG8_BAR; PG8_SCHED;
            } else {
            PG8_LDB(B0, 0, 0); PG8_SCHED; PG8_LDA(At, 0, 0); PG8_STAGE(PG8_SA(1, 1), a1 + hstepA, voffA);
            PG8_WAIT_L(8); PG8_BAR; PG8_WAIT_L(0); PG8_MMA(0, 0, At, B0); PG8_BAR; PG8_SCHED;
            PG8_LDB(B1, 0, 1); PG8_STAGE(PG8_SB(0, 0), b2, voffB);
            PG8_BAR; PG8_WAIT_L(0); PG8_MMA(0, 1, At, B1); PG8_BAR;
            PG8_LDA(At, 0, 1); PG8_STAGE(PG8_SA(0, 0), a2, voffA);
            PG8_BAR; PG8_WAIT_L(0); PG8_MMA(1, 0, At, B0); PG8_BAR; PG8_SCHED;
            PG8_STAGE(PG8_SB(0, 1), b2 + hstepB, voffB);
            PG8_WAIT_V(6); PG8_BAR; PG8_MMA(1, 1, At, B1); PG8_BAR;
            PG8_LDB(B0, 1, 0); PG8_SCHED; PG8_LDA(At, 1, 0); PG8_STAGE(PG8_SA(0, 1), a2 + hstepA, voffA);
            PG8_WAIT_L(8); PG8_BAR; PG8_WAIT_L(0); PG8_MMA(0, 0, At, B0); PG8_BAR; PG8_SCHED;
            PG8_LDB(B1, 1, 1); PG8_STAGE(PG8_SB(1, 0), b3, voffB);
            PG8_BAR; PG8_WAIT_L(0); PG8_MMA(0, 1, At, B1); PG8_BAR;
            PG8_LDA(At, 1, 1); PG8_STAGE(PG8_SA(1, 0), a3, voffA);
            PG8_BAR; PG8_WAIT_L(0); PG8_MMA(1, 0, At, B0); PG8_BAR; PG8_SCHED;
            PG8_STAGE(PG8_SB(1, 1), b3 + hstepB, voffB);
            PG8_WAIT_V(6); PG8_BAR; PG8_MMA(1, 1, At, B1); PG8_BAR;
            }
        }
        if constexpr (ALIGN_EPI) { if (wr == 0) PG8_BAR; }
        if constexpr (!Epi::AFTER_DRAIN) { E(acc, cur, wr, wc, fr, fq); S.done(cur); }
        if (!has_next) break;
#pragma unroll
        for (int a = 0; a < 2; ++a)
#pragma unroll
            for (int b = 0; b < 2; ++b)
#pragma unroll
                for (int m = 0; m < 4; ++m)
#pragma unroll
                    for (int n = 0; n < 2; ++n) acc[a][b][m][n] = (f32x4){0.f, 0.f, 0.f, 0.f};
        cur = nxt; cA = nA; cB = nB; ++ui;
        if constexpr (ALIGN_EPI) { if (wr == 1) PG8_BAR; }
    }
    PG8_WAIT_V(0);
    if constexpr (!ALIGN_EPI) { if (wr == 0) PG8_BAR; }
    PG8_BAR;
    if constexpr (Epi::AFTER_DRAIN) { E.fused(acc, cur, wr, wc, fr, fq, lds, wid, lane); S.done(cur); }
#undef PG8_SA
#undef PG8_SB
#undef PG8_STAGE
#undef PG8_LDA
#undef PG8_LDB
#undef PG8_MMA
#undef PG8_WAIT_V
#undef PG8_WAIT_L
#undef PG8_BAR
#undef PG8_SCHED
}
}

typedef const pg8::f32x4 (&AccRef)[2][2][4][2];
struct EpiSwiglu {
    static constexpr bool PERM = true, AFTER_DRAIN = false;
    bf16_t* H;
    DI void operator()(AccRef acc, const pg8::Unit& u, int wr, int wc, int fr, int fq) const {
        const int row0 = u.pm * 256 + wr * 64 + fr, col = u.pn * 128 + wc * 32 + 8 * fq;
#pragma unroll
        for (int ai = 0; ai < 2; ++ai)
#pragma unroll
            for (int m = 0; m < 4; ++m) {
                const int row = row0 + ai * 128 + m * 16; float f[8];
#pragma unroll
                for (int n = 0; n < 2; ++n)
#pragma unroll
                    for (int e = 0; e < 4; ++e) f[n * 4 + e] = siluf_(acc[ai][0][m][n][e]) * acc[ai][1][m][n][e];
                *(u32x4*)(H + (size_t)row * DFF + col) = pack8(f);
            }
    }
};
struct EpiResid {
    static constexpr bool PERM = true, AFTER_DRAIN = false;
    float* xlat; float* xc; const float* gate; float coef;
    DI void operator()(AccRef acc, const pg8::Unit& u, int wr, int wc, int fr, int fq) const {
        const int r0 = u.pm * 256; const int vec = r0 < NLAT ? (r0 >> 13) : 2;
        const float* gp = gate + vec * 9216;
        float* base = r0 < NLAT ? xlat + (size_t)r0 * DM : xc + (size_t)(r0 - NLAT) * DM;
#pragma unroll
        for (int bj = 0; bj < 2; ++bj) {
            const int col = u.pn * 256 + bj * 128 + wc * 32 + 8 * fq;
            const f32x4 g0 = *(const f32x4*)(gp + col) * coef, g1 = *(const f32x4*)(gp + col + 4) * coef;
#pragma unroll
            for (int ai = 0; ai < 2; ++ai)
#pragma unroll
                for (int m = 0; m < 4; ++m) {
                    float* xp = base + (size_t)(wr * 64 + fr + ai * 128 + m * 16) * DM + col;
                    f32x4 x0 = *(f32x4*)xp, x1 = *(f32x4*)(xp + 4);
                    x0 += g0 * acc[ai][bj][m][0]; x1 += g1 * acc[ai][bj][m][1];
                    *(f32x4*)xp = x0; *(f32x4*)(xp + 4) = x1;
                }
        }
    }
};
struct EpiWin {
    static constexpr bool PERM = true, AFTER_DRAIN = false;
    bf16_t* Z;
    DI void operator()(AccRef acc, const pg8::Unit& u, int wr, int wc, int fr, int fq) const {
        const int row0 = u.pm * 256 + wr * 64 + fr;
#pragma unroll
        for (int bj = 0; bj < 2; ++bj) {
            const int col = u.pn * 256 + bj * 128 + wc * 32 + 8 * fq;
            if (col >= ZW) continue;
            const int mode = (col >= ZC_RL && col < ZC_RL + 128) ? 1 : ((col >= ZC_RL + 256 && col < ZC_AQ) ? 2 : 0);
#pragma unroll
            for (int ai = 0; ai < 2; ++ai)
#pragma unroll
                for (int m = 0; m < 4; ++m) {
                    const int row = row0 + ai * 128 + m * 16; float f[8];
#pragma unroll
                    for (int n = 0; n < 2; ++n)
#pragma unroll
                        for (int e = 0; e < 4; ++e) { float v = acc[ai][bj][m][n][e]; if (mode == 1) v = 1.f - 2.f * __builtin_amdgcn_rcpf(1.f + __expf(2.f * v)); else if (mode == 2) v = sigmoidf_(v); f[n * 4 + e] = v; }
                    *(u32x4*)(Z + (size_t)row * ZW + col) = pack8(f);
                }
        }
    }
};
struct EpiLora {
    static constexpr bool PERM = true, AFTER_DRAIN = false;
    bf16_t* RWA; bf16_t* RG; const float* w0; const float* a0;
    DI void operator()(AccRef acc, const pg8::Unit& u, int wr, int wc, int fr, int fq) const {
        const int row0 = u.pm * 256 + wr * 64 + fr;
#pragma unroll
        for (int bj = 0; bj < 2; ++bj) {
            const int col = u.pn * 256 + bj * 128 + wc * 32 + 8 * fq; const int seg = col >> 9, cc = col & 511;
            const float* bp = seg < 2 ? w0 + seg * 512 + cc : a0 + (seg & 1) * 512 + cc;
#pragma unroll
            for (int ai = 0; ai < 2; ++ai)
#pragma unroll
                for (int m = 0; m < 4; ++m) {
                    const int row = row0 + ai * 128 + m * 16; float f[8];
#pragma unroll
                    for (int n = 0; n < 2; ++n)
#pragma unroll
                        for (int e = 0; e < 4; ++e) {
                            float v = acc[ai][bj][m][n][e] + (seg < 4 ? bp[n * 4 + e] : 0.f);
                            if (seg < 2) { const float ee = 0.60653066f * sigmoidf_(v); v = 1.f - __expf(-ee); } else if (seg < 4) v = sigmoidf_(v);
                            f[n * 4 + e] = v;
                        }
                    if (seg < 4) *(u32x4*)(RWA + (size_t)row * 2048 + col) = pack8(f); else *(u32x4*)(RG + (size_t)row * 512 + cc) = pack8(f);
                    __builtin_amdgcn_sched_barrier(0);
                }
        }
    }
};
struct EpiGate {
    static constexpr bool PERM = true, AFTER_DRAIN = false;
    bf16_t* G;
    DI void operator()(AccRef acc, const pg8::Unit& u, int wr, int wc, int fr, int fq) const {
        const int row0 = u.pm * 256 + wr * 64 + fr;
#pragma unroll
        for (int bj = 0; bj < 2; ++bj) {
            const int col = u.pn * 256 + bj * 128 + wc * 32 + 8 * fq;
#pragma unroll
            for (int ai = 0; ai < 2; ++ai)
#pragma unroll
                for (int m = 0; m < 4; ++m) {
                    const int row = row0 + ai * 128 + m * 16; float f[8];
#pragma unroll
                    for (int n = 0; n < 2; ++n)
#pragma unroll
                        for (int e = 0; e < 4; ++e) f[n * 4 + e] = sigmoidf_(acc[ai][bj][m][n][e]);
                    *(u32x4*)(G + (size_t)row * DM + col) = pack8(f);
                }
        }
    }
};
struct EpiBranch {
    static constexpr bool PERM = true, AFTER_DRAIN = false;
    const bf16_t* G; bf16_t* ZZ; int first;
    DI void operator()(AccRef acc, const pg8::Unit& u, int wr, int wc, int fr, int fq) const {
        const int row0 = u.pm * 256 + wr * 64 + fr;
#pragma unroll
        for (int bj = 0; bj < 2; ++bj) {
            const int col = u.pn * 256 + bj * 128 + wc * 32 + 8 * fq;
#pragma unroll
            for (int ai = 0; ai < 2; ++ai)
#pragma unroll
                for (int m = 0; m < 4; ++m) {
                    const size_t off = (size_t)(row0 + ai * 128 + m * 16) * DM + col; float g[8], o[8], f[8];
                    unpack8(*(const u32x4*)(G + off), g);
                    if (first) {
#pragma unroll
                        for (int e = 0; e < 8; ++e) o[e] = 0.f;
                    } else unpack8(*(const u32x4*)(ZZ + off), o);
#pragma unroll
                    for (int n = 0; n < 2; ++n)
#pragma unroll
                        for (int e = 0; e < 4; ++e) f[n * 4 + e] = o[n * 4 + e] + g[n * 4 + e] * acc[ai][bj][m][n][e];
                    *(u32x4*)(ZZ + off) = pack8(f);
                }
        }
    }
};
struct CtxSplitOrder {
    int nun, G, c, kslice_bytes;
    DI void init(int nslices, int ksl_bytes, int G_, int c_) { nun = nslices * 8; G = G_; c = c_; kslice_bytes = ksl_bytes; }
    DI bool next(int i, pg8::Unit& u) const {
        const long L = (long)i * G + c; if (L >= nun) return false;
        const int ks = (int)L >> 3, t = (int)L & 7; u.pm = 64 + (t >> 2); u.pn = t & 3; u.koff = (size_t)ks * kslice_bytes; return true;
    }
    DI void a_ready(const pg8::Unit&) const {}
    DI void done(const pg8::Unit&) const {}
};
struct EpiPartial {
    static constexpr bool PERM = true, AFTER_DRAIN = false;
    float* P; int kslice_bytes;
    DI void operator()(AccRef acc, const pg8::Unit& u, int wr, int wc, int fr, int fq) const {
        const int ks = (int)(u.koff / (size_t)kslice_bytes);
        float* base = P + ((size_t)ks * 512 + (size_t)(u.pm - 64) * 256) * DM;
#pragma unroll
        for (int bj = 0; bj < 2; ++bj) {
            const int col = u.pn * 256 + bj * 128 + wc * 32 + 8 * fq;
#pragma unroll
            for (int ai = 0; ai < 2; ++ai)
#pragma unroll
                for (int m = 0; m < 4; ++m) {
                    float* xp = base + (size_t)(wr * 64 + fr + ai * 128 + m * 16) * DM + col;
                    *(f32x4*)xp = acc[ai][bj][m][0]; *(f32x4*)(xp + 4) = acc[ai][bj][m][1];
                }
        }
    }
};
template <class Epi> DI void run_gemm_ctx(const int wv, unsigned char* smem, const bf16_t* A, int lda, const bf16_t* Bt, int ldb, int nslices, int kslice, const Epi& E) {
    pg8::Gemm g; g.A = A; g.Bt = Bt; g.M = NTOK; g.N = DM; g.K = launder_s(kslice); g.lda = launder_s(lda); g.ldb = launder_s(ldb); g.tid0 = wv * 64 + lane_id_();
    CtxSplitOrder S; S.init(nslices, kslice * 2, (int)gridDim.x, ((int)gridDim.x - 1) - launder_s((int)blockIdx.x));
    pg8::gemm_phase<Epi, CtxSplitOrder, true, true>((PG8_LAS unsigned char*)smem, g, S, E);
    __syncthreads();
}
template <class Epi> DI void run_gemm(const int wv, unsigned char* smem, const bf16_t* A, int lda, const bf16_t* Bt, int M, int N, int K, const Epi& E) {
    pg8::Gemm g; g.A = A; g.Bt = Bt; g.M = M; g.N = N; g.K = launder_s(K); g.lda = launder_s(lda); g.ldb = g.K; g.tid0 = wv * 64 + lane_id_();
    pg8::StaticOrder S; S.init(M, N, (int)gridDim.x, launder_s((int)blockIdx.x));
    pg8::gemm_phase<Epi, pg8::StaticOrder, true, true>((PG8_LAS unsigned char*)smem, g, S, E);
    __syncthreads();
}

struct Prm {
    const float *x, *c, *ctx, *cctx, *w_ada, *b_ada, *norm_g, *f1gu, *f1dn, *f2gu, *f2dn, *w_in, *m_conv, *m_gb, *m_on, *r_conv, *r_w0, *r_w2, *r_a0, *r_a2, *r_g2,
        *r_kk, *r_ka, *r_rk, *r_lnw, *r_lnb, *a_qkn, *a_lam, *a_subln, *w_br, *w_o;
    float* out; unsigned char* ws; int wv, pad;
};
#define PH_IDS const int tid_l = launder_v(p.wv * 64 + lane_id_()); const int bid_l = launder_s((int)blockIdx.x); (void)tid_l; (void)bid_l;
#define TID tid_l
#define BID bid_l
#define NBLK ((int)gridDim.x)

DI void ph_modpart(const Prm& p, unsigned char* smem) { PH_IDS
    float* sc = (float*)smem; float* modp = (float*)(p.ws + WS_MODP);
    for (int it = BID; it < 576; it += NBLK) {
        const int l = it / 288, r = it % 288, ks = r / 18, cb = r % 18;
        __syncthreads();
        if (TID < 192) { const int v = TID >> 6, k = ks * 64 + (TID & 63); const float cv = v < 2 ? p.c[v * DM + k] : p.cctx[k]; sc[TID] = siluf_(cv); }
        __syncthreads();
        const int col = cb * 512 + TID; float a0 = 0.f, a1 = 0.f, a2 = 0.f;
        const float* w = p.w_ada + ((size_t)l * DM + ks * 64) * 9216 + col;
#pragma unroll 8
        for (int k = 0; k < 64; ++k) { const float wv = w[(size_t)k * 9216]; a0 += sc[k] * wv; a1 += sc[64 + k] * wv; a2 += sc[128 + k] * wv; }
        float* o = modp + ((size_t)(l * 16 + ks) * 3) * 9216 + col; o[0] = a0; o[9216] = a1; o[2 * 9216] = a2;
    }
    __syncthreads();
}
DI void ph_rope(const Prm& p) { PH_IDS
    float* rope = (float*)(p.ws + WS_ROPE);
    for (int i = BID * 512 + TID; i < SEQL * 32; i += NBLK * 512) {
        const int t = i >> 5, pp = i & 31, j = pp & 15;
        const float inv = powf(10000.f, -(float)j / 16.f); const float pos = (float)(pp < 16 ? (t >> 6) : (t & 63)); const float ang = pos * inv;
        rope[2 * i] = cosf(ang); rope[2 * i + 1] = sinf(ang);
    }
}
DI void ph_modreduce(const Prm& p) { PH_IDS
    const float* modp = (const float*)(p.ws + WS_MODP); float* mods = (float*)(p.ws + WS_MODS);
    for (int i = BID * 512 + TID; i < 2 * 3 * 9216; i += NBLK * 512) {
        const int l = i / 27648, rem = i % 27648, v = rem / 9216, col = rem % 9216;
        float s = p.b_ada[l * 9216 + col];
        for (int ks = 0; ks < 16; ++ks) s += modp[((size_t)(l * 16 + ks) * 3 + v) * 9216 + col];
        mods[i] = s;
    }
}
template <int MODE> DI void conv_weight(const Prm& p, const float* src, int ld, int c0, int K, int ncols, bf16_t* dst, unsigned char* smem) { PH_IDS
    float* t = (float*)smem; const int ntk = K / 64, ntn = (ncols + 127) / 128, tx = TID & 63, ty = TID >> 6;
    for (int it = BID; it < ntk * ntn; it += NBLK) {
        const int kt = it % ntk, nt = it / ntk;
        float v[16];
#pragma unroll
        for (int i = 0; i < 16; ++i) { const int k = ty * 8 + (i & 7), j = nt * 128 + (i >> 3) * 64 + tx; v[i] = j < ncols ? src[(size_t)(kt * 64 + k) * ld + c0 + j] : 0.f; }
        __syncthreads();
#pragma unroll
        for (int i = 0; i < 16; ++i) t[(i >> 3) * 4160 + (ty * 8 + (i & 7)) * 65 + tx] = v[i];
        __syncthreads();
#pragma unroll
        for (int i = 0; i < 16; ++i) {
            const int n = ty * 8 + (i & 7), j = nt * 128 + (i >> 3) * 64 + n;
            if (j < ncols) {
                int drow = j;
                if (MODE == 1) drow = j < DFF ? ((j >> 7) * 256 + (j & 127)) : (((j - DFF) >> 7) * 256 + 128 + ((j - DFF) & 127));
                dst[(size_t)drow * K + kt * 64 + tx] = f2bf(t[(i >> 3) * 4160 + tx * 65 + n]);
            }
        }
    }
    __syncthreads();
}
DI void conv_ffn(const Prm& p, int l, int which, unsigned char* smem) {
    bf16_t* wt = (bf16_t*)(p.ws + WS_WT);
    conv_weight<1>(p, (which ? p.f2gu : p.f1gu) + (size_t)l * DM * 2 * DFF, 2 * DFF, 0, DM, 2 * DFF, wt + WT_GU, smem);
    conv_weight<0>(p, (which ? p.f2dn : p.f1dn) + (size_t)l * DFF * DM, DM, 0, DFF, DM, wt + WT_DN, smem);
}
DI void conv_mixer(const Prm& p, int l, unsigned char* smem) { PH_IDS
    bf16_t* wt = (bf16_t*)(p.ws + WS_WT);
    conv_weight<0>(p, p.w_in + (size_t)l * DM * DIN, DIN, 0, DM, ZW, wt + WT_IN, smem);
    conv_weight<0>(p, p.w_in + (size_t)l * DM * DIN, DIN, ZW, DM, 3 * DM, wt + WT_G, smem);
    for (int b = 0; b < 3; ++b) conv_weight<0>(p, p.w_br + (size_t)(l * 3 + b) * 512 * DM, DM, 0, 512, DM, wt + WT_P + (size_t)b * DM * 512, smem);
    conv_weight<0>(p, p.w_o + (size_t)l * DM * DM, DM, 0, DM, DM, wt + WT_O, smem);
    bf16_t* wl = wt + WT_L;
    for (int i = BID * 512 + TID; i < 2560 * 384; i += NBLK * 512) {
        const int n = i / 384, k = i % 384, seg = n >> 9, cc = n & 511; float v = 0.f;
        if (seg < 2) { if ((k >> 6) == seg) v = p.r_w2[((size_t)(l * 2 + seg) * 64 + (k & 63)) * 512 + cc]; }
        else if (seg < 4) { if ((k >> 6) == seg) v = p.r_a2[((size_t)(l * 2 + seg - 2) * 64 + (k & 63)) * 512 + cc]; }
        else { if (k >= 256) v = p.r_g2[((size_t)l * 128 + (k - 256)) * 512 + cc]; }
        wl[i] = f2bf(v);
    }
}
DI void ph_norm(const Prm& p, int l, int which, bool first, int nfix = 0, const float* fixgate = nullptr, float fixcoef = 0.f) { PH_IDS
    const int lane = TID & 63, wid = TID >> 6;
    const float* g = p.norm_g + (l * 3 + which) * DM; const float* mods = (const float*)(p.ws + WS_MODS) + (size_t)l * 27648;
    bf16_t* hb = (bf16_t*)(p.ws + WS_RWA); float* xc = (float*)(p.ws + WS_XC);
    for (int row = BID * 8 + wid; row < NTOK; row += NBLK * 8) {
        const int vec = row < NLAT ? (row >> 13) : 2;
        const float* sh = mods + vec * 9216 + (3 * which) * DM; const float* scl = sh + DM;
        float* xd = row < NLAT ? p.out + (size_t)row * DM : xc + (size_t)(row - NLAT) * DM;
        const float* xr = first ? (row < NLAT ? p.x + (size_t)row * DM : p.ctx + (size_t)(row - NLAT) * DM) : xd;
        f32x4 xv[4]; float ss = 0.f;
#pragma unroll
        for (int i = 0; i < 4; ++i) xv[i] = *(const f32x4*)(xr + i * 256 + lane * 4);
        if (nfix > 0 && row >= NLAT) {
            const float* P = (const float*)((const bf16_t*)(p.ws + WS_RWA) + (size_t)NTOK * DM) + (size_t)(row - NLAT) * DM;
#pragma unroll
            for (int i = 0; i < 4; ++i) {
                const int col = i * 256 + lane * 4; f32x4 sp = {0.f, 0.f, 0.f, 0.f};
                for (int ks = 0; ks < nfix; ++ks) sp += *(const f32x4*)(P + (size_t)ks * 512 * DM + col);
                xv[i] += *(const f32x4*)(fixgate + 2 * 9216 + col) * fixcoef * sp;
                *(f32x4*)(xd + col) = xv[i];
            }
        }
#pragma unroll
        for (int i = 0; i < 4; ++i) ss += xv[i][0] * xv[i][0] + xv[i][1] * xv[i][1] + xv[i][2] * xv[i][2] + xv[i][3] * xv[i][3];
        ss = wave_sum(ss); const float rinv = rsqrtf(ss * (1.f / DM) + 1e-6f);
#pragma unroll
        for (int i = 0; i < 4; ++i) {
            const int col = i * 256 + lane * 4;
            if (first) *(f32x4*)(xd + col) = xv[i];
            const f32x4 gv = *(const f32x4*)(g + col), sv = *(const f32x4*)(scl + col), hv = *(const f32x4*)(sh + col);
            float h[4];
#pragma unroll
            for (int e = 0; e < 4; ++e) h[e] = xv[i][e] * rinv * gv[e] * (1.f + sv[e]) + hv[e];
            u32x2 o; o.x = pk2(h[0], h[1]); o.y = pk2(h[2], h[3]);
            *(u32x2*)(hb + (size_t)row * DM + col) = o;
        }
    }
}
DI void ph_zero_ysum(const Prm& p) { PH_IDS
    f32x4* y = (f32x4*)(p.ws + WS_YSUM); const f32x4 zr = {0.f, 0.f, 0.f, 0.f};
    for (int i = BID * 512 + TID; i < NTOK * 128; i += NBLK * 512) y[i] = zr;
}
DI void ph_rkv_conv(const Prm& p, int l) { PH_IDS
    const int lane = TID & 63, wid = TID >> 6;
    const bf16_t* z = (const bf16_t*)(p.ws + WS_Z); bf16_t* tmp = (bf16_t*)(p.ws + WS_RWA); float* invn = (float*)(p.ws + WS_INVN);
    const float* cw = p.r_conv + (size_t)l * 3 * 1536;
    for (int row = BID * 8 + wid; row < NTOK; row += NBLK * 8) {
        const int t = row < NLAT ? (row & 8191) : ((row - NLAT) & 255), L = row < NLAT ? SEQL : CTXL;
        const bool hp = t > 0, hn = t < L - 1;
#pragma unroll
        for (int g = 0; g < 3; ++g) {
            const int ch = g * 512 + lane * 8; const bf16_t* zp = z + (size_t)row * ZW + ZC_RR + ch;
            const u32x4 zero = {0u, 0u, 0u, 0u};
            const u32x4 uc = *(const u32x4*)zp, up = hp ? *(const u32x4*)(zp - ZW) : zero, un = hn ? *(const u32x4*)(zp + ZW) : zero;
            float c[8], pv[8], nx[8], o[8]; unpack8(uc, c); unpack8(up, pv); unpack8(un, nx);
#pragma unroll
            for (int e = 0; e < 8; ++e) o[e] = cw[ch + e] * pv[e] + cw[1536 + ch + e] * c[e] + cw[3072 + ch + e] * nx[e];
            *(u32x4*)(tmp + (size_t)row * 1536 + ch) = pack8(o);
            if (g == 1) {
                float ss = 0.f;
#pragma unroll
                for (int e = 0; e < 8; ++e) { const float kk = o[e] * p.r_kk[l * 512 + lane * 8 + e]; ss += kk * kk; }
                ss += __shfl_xor(ss, 1); ss += __shfl_xor(ss, 2); ss += __shfl_xor(ss, 4);
                if ((lane & 7) == 0) invn[(size_t)row * 8 + (lane >> 3)] = 1.f / fmaxf(sqrtf(ss), 1e-12f);
            }
        }
    }
}
DI void ph_rkv_copy(const Prm& p) { PH_IDS
    const int lane = TID & 63, wid = TID >> 6;
    bf16_t* z = (bf16_t*)(p.ws + WS_Z); const bf16_t* tmp = (const bf16_t*)(p.ws + WS_RWA);
    for (int row = BID * 8 + wid; row < NTOK; row += NBLK * 8)
#pragma unroll
        for (int g = 0; g < 3; ++g) { const int ch = g * 512 + lane * 8; *(u32x4*)(z + (size_t)row * ZW + ZC_RR + ch) = *(const u32x4*)(tmp + (size_t)row * 1536 + ch); }
}
DI void ph_attn_prep(const Prm& p, int l) { PH_IDS
    const int lane = TID & 63, wid = TID >> 6, hw = lane >> 5, pp = lane & 31;
    bf16_t* z = (bf16_t*)(p.ws + WS_Z); const float* rope = (const float*)(p.ws + WS_ROPE); const float* qkn = p.a_qkn + l * 128;
    for (int row = BID * 8 + wid; row < NTOK; row += NBLK * 8) {
        const bool islat = row < NLAT; const int t = row & 8191;
        float cs = 1.f, sn = 0.f; if (islat) { cs = rope[((size_t)t * 32 + pp) * 2]; sn = rope[((size_t)t * 32 + pp) * 2 + 1]; }
#pragma unroll
        for (int it = 0; it < 8; ++it) {
            const int seg = it * 2 + hw, which = seg >> 3, col = (which ? ZC_AK : ZC_AQ) + (seg & 7) * 64 + 2 * pp;
            unsigned* zp = (unsigned*)(z + (size_t)row * ZW + col);
            const unsigned u = *zp; const float x1 = lo16(u), x2 = hi16(u);
            float ss = x1 * x1 + x2 * x2;
            ss += __shfl_xor(ss, 1); ss += __shfl_xor(ss, 2); ss += __shfl_xor(ss, 4); ss += __shfl_xor(ss, 8); ss += __shfl_xor(ss, 16);
            const float rinv = rsqrtf(ss * (1.f / 64.f) + 1e-6f) * (which ? 1.f : 0.125f * 1.4426950408889634f);
            const float y1 = x1 * rinv * qkn[which * 64 + 2 * pp], y2 = x2 * rinv * qkn[which * 64 + 2 * pp + 1];
            *zp = pk2(y1 * cs - y2 * sn, y1 * sn + y2 * cs);
        }
    }
}

#define MFMA16(a, b, c) __builtin_amdgcn_mfma_f32_16x16x32_bf16((a), (b), (c), 0, 0, 0)
#define MFMA32(a, b, c) __builtin_amdgcn_mfma_f32_32x32x16_bf16((a), (b), (c), 0, 0, 0)
DI float wave_incl_scan_add(float v, int lane) {
#pragma unroll
    for (int o = 1; o < 64; o <<= 1) { const float t = __shfl_up(v, o); if (lane >= o) v += t; }
    return v;
}
DI float wave_incl_scan_max(float v, int lane) {
#pragma unroll
    for (int o = 1; o < 64; o <<= 1) { const float t = __shfl_up(v, o); if (lane >= o) v = fmaxf(v, t); }
    return v;
}
DI float mconv(const bf16_t* z, const float* cw, size_t row, int t, int L, int ch) {
    const bf16_t* zp = z + row * ZW + ch;
    float a = cw[512 + ch] * bf2f(zp[0]);
    if (t > 0) a += cw[ch] * bf2f(zp[-ZW]);
    if (t < L - 1) a += cw[1024 + ch] * bf2f(zp[ZW]);
    return siluf_(a);
}
DI void mconv8(const bf16_t* z, const float* cw, size_t row, int t, int L, int ch, float* out) {
    const bf16_t* zp = z + row * ZW + ch; const u32x4 zero = {0u, 0u, 0u, 0u};
    const u32x4 uc = *(const u32x4*)zp, up = t > 0 ? *(const u32x4*)(zp - ZW) : zero, un = t < L - 1 ? *(const u32x4*)(zp + ZW) : zero;
    float c[8], pv[8], nx[8]; unpack8(uc, c); unpack8(up, pv); unpack8(un, nx);
#pragma unroll
    for (int e = 0; e < 8; ++e) out[e] = siluf_(cw[ch + e] * pv[e] + cw[512 + ch + e] * c[e] + cw[1024 + ch + e] * nx[e]);
}
DI void ph_mlstm_a(const Prm& p, int l, unsigned char* smem) { PH_IDS
    const int lane = TID & 63, wid = TID >> 6;
    const bf16_t* z = (const bf16_t*)(p.ws + WS_Z); bf16_t* mst = (bf16_t*)(p.ws + WS_MST); float* msc = (float*)(p.ws + WS_MSC); float* mn = (float*)(p.ws + WS_MN);
    const float* cw = p.m_conv + (size_t)l * 3 * 512; const float* gb = p.m_gb + l * 16;
    bf16_t* kT = (bf16_t*)smem; bf16_t* vT = (bf16_t*)(smem + 9216); float* wsl = (float*)(smem + 9216 + 18432);
    for (int u = BID; u < 2112; u += NBLK) {
        const int d = u / 1056, r = u % 1056, b = r / 528, h = (r % 528) / NCHK, c = r % NCHK;
        const int slot = ((d * 2 + b) * 4 + h) * NCHK + c;
        const bool isctx = c < 4; const int cs = isctx ? c : c - 4, nch = isctx ? 4 : 128, oc = d ? nch - 1 - cs : cs, L = isctx ? CTXL : SEQL;
        const size_t base = isctx ? (size_t)NLAT + b * CTXL + oc * 64 : (size_t)b * SEQL + oc * 64;
        __syncthreads();
        if (wid == 0) {
            const int o = d ? 63 - lane : lane; const bf16_t* zr = z + (base + o) * ZW + ZC_MG + 8 * d + h;
            const float ig = bf2f(zr[0]) + gb[(2 * d) * 4 + h], lf = logsigf_(bf2f(zr[4]) + gb[(2 * d + 1) * 4 + h]);
            const float bc = wave_incl_scan_add(lf, lane), bt = __shfl(bc, 63), wl = bt - bc + ig, ml = wave_max(wl);
            wsl[lane] = __expf(wl - ml);
            if (lane == 0) { msc[slot * 4] = bt; msc[slot * 4 + 1] = ml; }
        }
        __syncthreads();
        {
            const int pp = TID >> 3, g = TID & 7, o = d ? 63 - pp : pp; float kv[8];
            mconv8(z, cw, base + o, oc * 64 + o, L, 256 + h * 64 + g * 8, kv);
#pragma unroll
            for (int e = 0; e < 8; ++e) kT[(g * 8 + e) * 72 + pp] = f2bf(kv[e] * 0.125f);
        }
#pragma unroll
        for (int i = 0; i < 2; ++i) {
            const int idx = TID + 512 * i, pp = idx >> 4, g = idx & 15, o = d ? 63 - pp : pp; float vv8[8];
            unpack8(*(const u32x4*)(z + (base + o) * ZW + ZC_MV + h * 128 + g * 8), vv8); const float wv = wsl[pp];
#pragma unroll
            for (int e = 0; e < 8; ++e) vT[(g * 8 + e) * 72 + pp] = f2bf(vv8[e] * wv);
        }
        __syncthreads();
        f32x4 acc[4];
#pragma unroll
        for (int nt = 0; nt < 4; ++nt) acc[nt] = (f32x4){0.f, 0.f, 0.f, 0.f};
#pragma unroll
        for (int ks = 0; ks < 2; ++ks) {
            const bf16x8 a = *(const bf16x8*)(vT + (16 * wid + (lane & 15)) * 72 + ks * 32 + (lane >> 4) * 8);
#pragma unroll
            for (int nt = 0; nt < 4; ++nt) { const bf16x8 bb = *(const bf16x8*)(kT + (16 * nt + (lane & 15)) * 72 + ks * 32 + (lane >> 4) * 8); acc[nt] = MFMA16(a, bb, acc[nt]); }
        }
#pragma unroll
        for (int nt = 0; nt < 4; ++nt)
#pragma unroll
            for (int j = 0; j < 4; ++j) mst[(size_t)slot * 8192 + (16 * wid + (lane >> 4) * 4 + j) * 64 + 16 * nt + (lane & 15)] = f2bf(acc[nt][j]);
        if (TID < 64) { float s = 0.f; for (int pp = 0; pp < 64; ++pp) s += wsl[pp] * bf2f(kT[TID * 72 + pp]); mn[slot * 64 + TID] = s; }
    }
    __syncthreads();
}
DI void ph_mlstm_b(const Prm& p) { PH_IDS
    bf16_t* mst = (bf16_t*)(p.ws + WS_MST); float* msc = (float*)(p.ws + WS_MSC); float* mn = (float*)(p.ws + WS_MN);
    for (int e = BID * 512 + TID; e < 16 * 4096 + 16 * 64; e += NBLK * 512) {
        const bool isn = e >= 16 * 4096; const int chain = isn ? (e - 16 * 4096) >> 6 : e >> 12, idx = isn ? (e & 63) : (e & 4095);
        float m = 0.f, C0 = 0.f, C1 = 0.f;
        for (int c0 = 0; c0 < NCHK; c0 += 22) {
            float u0[22], u1[22], bt[22], ml[22];
#pragma unroll
            for (int j = 0; j < 22; ++j) {
                const int slot = chain * NCHK + c0 + j; bt[j] = msc[slot * 4]; ml[j] = msc[slot * 4 + 1];
                if (isn) { u0[j] = mn[slot * 64 + idx]; u1[j] = 0.f; }
                else { const unsigned uu = *(const unsigned*)(mst + (size_t)slot * 8192 + 2 * idx); u0[j] = lo16(uu); u1[j] = hi16(uu); }
            }
#pragma unroll
            for (int j = 0; j < 22; ++j) {
                const int slot = chain * NCHK + c0 + j;
                if (isn) mn[slot * 64 + idx] = C0; else *(unsigned*)(mst + (size_t)slot * 8192 + 2 * idx) = pk2(C0, C1);
                if (!isn && idx == 0) msc[slot * 4 + 2] = m;
                const float mnew = fmaxf(bt[j] + m, ml[j]), dA = __expf(bt[j] + m - mnew), dB = __expf(ml[j] - mnew);
                C0 = dA * C0 + dB * u0[j]; C1 = dA * C1 + dB * u1[j]; m = mnew;
            }
        }
    }
}
DI void ph_mlstm_c(const Prm& p, int l, unsigned char* smem, int ubeg, int ustride, int ucount = 1 << 30) { PH_IDS
    const int lane = TID & 63, wid = TID >> 6;
    bf16_t* z = (bf16_t*)(p.ws + WS_Z); const bf16_t* mst = (const bf16_t*)(p.ws + WS_MST); const float* msc = (const float*)(p.ws + WS_MSC); const float* mn = (const float*)(p.ws + WS_MN);
    const float* cw = p.m_conv + (size_t)l * 3 * 512; const float* gb = p.m_gb + l * 16;
    bf16_t* qs = (bf16_t*)smem; bf16_t* ks_ = (bf16_t*)(smem + 9216); bf16_t* vT = (bf16_t*)(smem + 18432); bf16_t* Sp = (bf16_t*)(smem + 36864);
    float* hsum = (float*)(smem + 46080); float* fa = (float*)(smem + 46080 + 33792);
    float *bcum = fa, *gg = fa + 64, *Mrow = fa + 128, *iw = fa + 192, *den = fa + 256, *nq = fa + 320;
    for (int u = ubeg, un = 0; u < 1056 && un < ucount; u += ustride, ++un) {
        const int b = u / 528, h = (u % 528) / NCHK, cc = u % NCHK;
        const bool isctx = cc < 4; const int oc = isctx ? cc : cc - 4, nch = isctx ? 4 : 128, L = isctx ? CTXL : SEQL;
        const size_t base = isctx ? (size_t)NLAT + b * CTXL + oc * 64 : (size_t)b * SEQL + oc * 64;
        for (int d = 0; d < 2; ++d) {
            const int cs = d ? nch - 1 - oc : oc, c = isctx ? cs : cs + 4, slot = ((d * 2 + b) * 4 + h) * NCHK + c;
            const float mst_m = msc[slot * 4 + 2];
            __syncthreads();
            if (wid == 0) {
                const int o = d ? 63 - lane : lane; const bf16_t* zr = z + (base + o) * ZW + ZC_MG + 8 * d + h;
                const float ig = bf2f(zr[0]) + gb[(2 * d) * 4 + h], lf = logsigf_(bf2f(zr[4]) + gb[(2 * d + 1) * 4 + h]);
                const float bc = wave_incl_scan_add(lf, lane), g = ig - bc, pm = wave_incl_scan_max(g, lane), M = fmaxf(mst_m, pm);
                bcum[lane] = bc; gg[lane] = g; Mrow[lane] = M; iw[lane] = __expf(mst_m - M);
            }
#pragma unroll
            for (int i = 0; i < 2; ++i) {
                const int idx = TID + 512 * i, pp = idx >> 4, g = idx & 15, isk = g >> 3, dq0 = (g & 7) * 8, o = d ? 63 - pp : pp; float qv[8];
                mconv8(z, cw, base + o, oc * 64 + o, L, isk * 256 + h * 64 + dq0, qv);
                if (isk) {
#pragma unroll
                    for (int e = 0; e < 8; ++e) qv[e] *= 0.125f;
                }
                *(u32x4*)((isk ? ks_ : qs) + pp * 72 + dq0) = pack8(qv);
            }
#pragma unroll
            for (int i = 0; i < 2; ++i) {
                const int idx = TID + 512 * i, pp = idx >> 4, g = idx & 15, o = d ? 63 - pp : pp;
                const u32x4 uv = *(const u32x4*)(z + (base + o) * ZW + ZC_MV + h * 128 + g * 8);
                vT[(g * 8 + 0) * 72 + pp] = (bf16_t)(uv.x & 0xffffu); vT[(g * 8 + 1) * 72 + pp] = (bf16_t)(uv.x >> 16);
                vT[(g * 8 + 2) * 72 + pp] = (bf16_t)(uv.y & 0xffffu); vT[(g * 8 + 3) * 72 + pp] = (bf16_t)(uv.y >> 16);
                vT[(g * 8 + 4) * 72 + pp] = (bf16_t)(uv.z & 0xffffu); vT[(g * 8 + 5) * 72 + pp] = (bf16_t)(uv.z >> 16);
                vT[(g * 8 + 6) * 72 + pp] = (bf16_t)(uv.w & 0xffffu); vT[(g * 8 + 7) * 72 + pp] = (bf16_t)(uv.w >> 16);
            }
            __syncthreads();
            {
                const int mt = wid >> 1;
#pragma unroll
                for (int nn = 0; nn < 2; ++nn) {
                    const int nt = 2 * (wid & 1) + nn; f32x4 acc = {0.f, 0.f, 0.f, 0.f};
#pragma unroll
                    for (int ks = 0; ks < 2; ++ks) {
                        const bf16x8 a = *(const bf16x8*)(qs + (16 * mt + (lane & 15)) * 72 + ks * 32 + (lane >> 4) * 8);
                        const bf16x8 bb = *(const bf16x8*)(ks_ + (16 * nt + (lane & 15)) * 72 + ks * 32 + (lane >> 4) * 8);
                        acc = MFMA16(a, bb, acc);
                    }
                    const int s = 16 * nt + (lane & 15);
#pragma unroll
                    for (int j = 0; j < 4; ++j) { const int pp = 16 * mt + (lane >> 4) * 4 + j; const float v = s <= pp ? acc[j] * __expf(gg[s] - Mrow[pp]) : 0.f; Sp[pp * 72 + s] = f2bf(v); }
                }
                if (TID < 64) { float s = 0.f; for (int dq = 0; dq < 64; ++dq) s += mn[slot * 64 + dq] * bf2f(qs[TID * 72 + dq]); nq[TID] = s; }
            }
            __syncthreads();
            if (TID < 64) { float s = 0.f; for (int k = 0; k < 64; ++k) s += bf2f(Sp[TID * 72 + k]); den[TID] = s + iw[TID] * nq[TID]; }
            f32x4 a1[4], a2[4];
#pragma unroll
            for (int mt = 0; mt < 4; ++mt) { a1[mt] = (f32x4){0.f, 0.f, 0.f, 0.f}; a2[mt] = (f32x4){0.f, 0.f, 0.f, 0.f}; }
#pragma unroll
            for (int ks = 0; ks < 2; ++ks) {
                const bf16x8 bv = *(const bf16x8*)(vT + (16 * wid + (lane & 15)) * 72 + ks * 32 + (lane >> 4) * 8);
                const bf16x8 bc = *(const bf16x8*)(mst + (size_t)slot * 8192 + (16 * wid + (lane & 15)) * 64 + ks * 32 + (lane >> 4) * 8);
#pragma unroll
                for (int mt = 0; mt < 4; ++mt) {
                    const bf16x8 as = *(const bf16x8*)(Sp + (16 * mt + (lane & 15)) * 72 + ks * 32 + (lane >> 4) * 8);
                    const bf16x8 aq = *(const bf16x8*)(qs + (16 * mt + (lane & 15)) * 72 + ks * 32 + (lane >> 4) * 8);
                    a1[mt] = MFMA16(as, bv, a1[mt]); a2[mt] = MFMA16(aq, bc, a2[mt]);
                }
            }
            __syncthreads();
            {
                const int vv = 16 * wid + (lane & 15);
#pragma unroll
                for (int mt = 0; mt < 4; ++mt)
#pragma unroll
                    for (int j = 0; j < 4; ++j) {
                        const int pp = 16 * mt + (lane >> 4) * 4 + j, o = d ? 63 - pp : pp;
                        const float val = (a1[mt][j] + iw[pp] * a2[mt][j]) / fmaxf(fabsf(den[pp]), __expf(-(bcum[pp] + Mrow[pp])));
                        if (d == 0) hsum[o * 132 + vv] = val; else hsum[o * 132 + vv] += val;
                    }
            }
        }
        __syncthreads();
#pragma unroll
        for (int i = 0; i < 8; ++i) {
            const int o = wid * 8 + i; const float x0 = hsum[o * 132 + lane], x1 = hsum[o * 132 + lane + 64];
            const float ss = wave_sum(x0 * x0 + x1 * x1), rinv = rsqrtf(ss * (1.f / 128.f) + 1e-6f);
            bf16_t* zo = z + (base + o) * ZW + ZC_MO + h * 128; const float* on = p.m_on + l * 512 + h * 128;
            zo[lane] = f2bf(x0 * rinv * on[lane] * sigmoidf_(bf2f(zo[lane])));
            zo[lane + 64] = f2bf(x1 * rinv * on[lane + 64] * sigmoidf_(bf2f(zo[lane + 64])));
        }
    }
    __syncthreads();
}
DI int swap23(int s) { return (s & ~12) | ((s & 4) << 1) | ((s & 8) >> 1); }
DI void ph_attn(const Prm& p, int l, unsigned char* smem, int bh, int qfirst, int qstep, int nq, int qextra) { PH_IDS
    const int lane = TID & 63, wid = TID >> 6, q = lane & 31, hh = lane >> 5, qg = wid >> 1, mp = wid & 1, grp = wid >> 2;
    bf16_t* z = (bf16_t*)(p.ws + WS_Z);
    float lam; const float lam_init = 0.8f - 0.6f * expf(-0.3f * (float)l);
    { const float* lp = p.a_lam + l * 256; float s1 = 0.f, s2 = 0.f; for (int i = 0; i < 64; ++i) { s1 += lp[i] * lp[64 + i]; s2 += lp[128 + i] * lp[192 + i]; } lam = expf(s1) - expf(s2) + lam_init; }
    bf16_t* Qs = (bf16_t*)smem; float* ex = (float*)smem;
    constexpr int KB_OFF = 34816, VT_OFF = 69632;
    float kmax = 0.f; { const float* gk = p.a_qkn + l * 128 + 64; for (int i = 0; i < 64; ++i) kmax = fmaxf(kmax, fabsf(gk[i])); kmax *= 8.f; }
#define ATT_BAR asm volatile("s_waitcnt lgkmcnt(0)\n\ts_barrier" ::: "memory")
    for (int ui = 0; ui < nq + (qextra >= 0 ? 1 : 0); ++ui) {
        const int qi = ui < nq ? qfirst + ui * qstep : qextra;
        const int b = bh >> 2, head = bh & 3; int nt; size_t qrow0;
        const bool lat = qi < 64;
        if (lat) { qrow0 = (size_t)b * SEQL + qi * 128; nt = 132; } else { qrow0 = (size_t)NLAT + b * CTXL + (qi - 64) * 128; nt = 4; }
        __syncthreads();
#pragma unroll
        for (int i = 0; i < 4; ++i) { const int idx = TID + 512 * i, r = idx >> 4, cp = idx & 15; *(u32x4*)(Qs + r * 136 + cp * 8) = *(const u32x4*)(z + (qrow0 + r) * ZW + ZC_AQ + head * 128 + cp * 8); }
        u32x4 kreg[2], vreg[2];
        const int kp = TID & 31, vg = TID >> 5;
#define ATT_KROW0(j) ((lat && (j) >= 4) ? (size_t)b * SEQL + 64 * ((j) - 4) : (size_t)NLAT + b * CTXL + 64 * (j))
#define ATT_LOADK(j) do { const size_t kr0 = ATT_KROW0(j); \
            _Pragma("unroll") for (int i = 0; i < 2; ++i) { const int idx = TID + 512 * i, r = idx >> 4, cp = idx & 15; kreg[i] = *(const u32x4*)(z + (kr0 + r) * ZW + ZC_AK + head * 128 + cp * 8); } } while (0)
#define ATT_LOADV(j) do { const size_t kr0 = ATT_KROW0(j); \
            _Pragma("unroll") for (int i = 0; i < 2; ++i) vreg[i] = *(const u32x4*)(z + (kr0 + 2 * kp + i) * ZW + ZC_AV + head * 128 + 8 * vg); } while (0)
#define ATT_WRITEK(buf) do { bf16_t* Kw = (bf16_t*)(smem + KB_OFF + (buf) * 17408); \
            _Pragma("unroll") for (int i = 0; i < 2; ++i) { const int idx = TID + 512 * i, r = idx >> 4, cp = idx & 15; *(u32x4*)(Kw + r * 136 + cp * 8) = kreg[i]; } } while (0)
#define ATT_WRITEV(buf) do { bf16_t* Vw = (bf16_t*)(smem + VT_OFF + (buf) * 18432); \
            _Pragma("unroll") for (int w = 0; w < 4; ++w) { \
                *(unsigned*)(Vw + (8 * vg + 2 * w) * 72 + 2 * kp) = (vreg[0][w] & 0xffffu) | (vreg[1][w] << 16); \
                *(unsigned*)(Vw + (8 * vg + 2 * w + 1) * 72 + 2 * kp) = (vreg[0][w] >> 16) | (vreg[1][w] & 0xffff0000u); } } while (0)
        f32x16 o[4]; float lrun = 0.f; bf16x8 pf[4];
        float mfix;
        { __syncthreads(); float qq = 0.f;
#pragma unroll
          for (int c8 = 0; c8 < 8; ++c8) { float f8[8]; unpack8(*(const u32x4*)(Qs + (32 * qg + q) * 136 + mp * 64 + c8 * 8), f8);
#pragma unroll
              for (int e = 0; e < 8; ++e) qq += f8[e] * f8[e]; }
          mfix = sqrtf(qq) * kmax * 1.01f + 0.01f; }
        const float nmfix = -mfix;
#pragma unroll
        for (int dvb = 0; dvb < 4; ++dvb)
#pragma unroll
            for (int i = 0; i < 16; ++i) o[dvb][i] = 0.f;
#define ATT_QK(j) do { const bf16_t* Kb = (const bf16_t*)(smem + KB_OFF + ((j) & 1) * 17408); \
            f32x16 s0, s1; \
            _Pragma("unroll") for (int i = 0; i < 16; ++i) { s0[i] = nmfix; s1[i] = nmfix; } \
            _Pragma("unroll") for (int kk = 0; kk < 4; ++kk) { \
                const bf16x8 qf = *(const bf16x8*)(Qs + (32 * qg + q) * 136 + mp * 64 + kk * 16 + hh * 8); \
                const bf16x8 k0 = *(const bf16x8*)(Kb + swap23(q) * 136 + mp * 64 + kk * 16 + hh * 8); \
                const bf16x8 k1 = *(const bf16x8*)(Kb + (32 + swap23(q)) * 136 + mp * 64 + kk * 16 + hh * 8); \
                s0 = MFMA32(k0, qf, s0); s1 = MFMA32(k1, qf, s1); } \
            f32x2 ps = {0.f, 0.f}; \
            _Pragma("unroll") for (int i = 0; i < 16; i += 2) { s0[i] = __builtin_amdgcn_exp2f(s0[i]); s0[i + 1] = __builtin_amdgcn_exp2f(s0[i + 1]); s1[i] = __builtin_amdgcn_exp2f(s1[i]); s1[i + 1] = __builtin_amdgcn_exp2f(s1[i + 1]); \
                const f32x2 a2 = {s0[i], s0[i + 1]}, b2 = {s1[i], s1[i + 1]}; ps += a2 + b2; } \
            lrun += ps.x + ps.y; \
            _Pragma("unroll") for (int cc = 0; cc < 2; ++cc) { u32x4 a, c2; \
                a.x = pk2(s0[8 * cc], s0[8 * cc + 1]); a.y = pk2(s0[8 * cc + 2], s0[8 * cc + 3]); a.z = pk2(s0[8 * cc + 4], s0[8 * cc + 5]); a.w = pk2(s0[8 * cc + 6], s0[8 * cc + 7]); \
                c2.x = pk2(s1[8 * cc], s1[8 * cc + 1]); c2.y = pk2(s1[8 * cc + 2], s1[8 * cc + 3]); c2.z = pk2(s1[8 * cc + 4], s1[8 * cc + 5]); c2.w = pk2(s1[8 * cc + 6], s1[8 * cc + 7]); \
                pf[cc] = __builtin_bit_cast(bf16x8, a); pf[2 + cc] = __builtin_bit_cast(bf16x8, c2); } } while (0)
#define ATT_PV(j) do { const bf16_t* Vt = (const bf16_t*)(smem + VT_OFF + ((j) & 1) * 18432); \
            _Pragma("unroll") for (int dvb = 0; dvb < 4; ++dvb) _Pragma("unroll") for (int c = 0; c < 4; ++c) { \
                const bf16x8 vf = *(const bf16x8*)(Vt + (dvb * 32 + q) * 72 + 16 * c + 8 * hh); o[dvb] = MFMA32(vf, pf[c], o[dvb]); } } while (0)
        ATT_LOADK(0); ATT_LOADV(0); ATT_WRITEK(0); ATT_WRITEV(0);
        __syncthreads();
        for (int j = 0; j < nt; ++j) {
            if (j + 1 < nt) { ATT_LOADK(j + 1); ATT_LOADV(j + 1); }
            ATT_QK(j); ATT_PV(j);
            if (j + 1 < nt) { ATT_WRITEK((j + 1) & 1); ATT_WRITEV((j + 1) & 1); }
            __syncthreads();
        }
        const float lsum = lrun + __shfl_xor(lrun, 32);
        const float inv = (mp ? lam : 1.f) / lsum;
        if (mp) {
#pragma unroll
            for (int dvb = 0; dvb < 4; ++dvb)
#pragma unroll
                for (int i = 0; i < 16; ++i) ex[(qg * 64 + dvb * 16 + i) * 64 + lane] = o[dvb][i] * inv;
        }
        __syncthreads();
        if (!mp) {
            float ss = 0.f;
#pragma unroll
            for (int dvb = 0; dvb < 4; ++dvb)
#pragma unroll
                for (int i = 0; i < 16; ++i) { const float v = o[dvb][i] * inv - ex[(qg * 64 + dvb * 16 + i) * 64 + lane]; o[dvb][i] = v; ss += v * v; }
            ss += __shfl_xor(ss, 32);
            const float rinv = rsqrtf(ss * (1.f / 128.f) + 1e-6f) * (1.f - lam_init);
            bf16_t* orow = z + (qrow0 + 32 * qg + q) * ZW + ZC_AQ + head * 128; const float* sub = p.a_subln + l * 128;
#pragma unroll
            for (int dvb = 0; dvb < 4; ++dvb)
#pragma unroll
                for (int ig = 0; ig < 4; ++ig) {
                    const int dv0 = dvb * 32 + 8 * ig + 4 * hh; u32x2 w;
                    w.x = pk2(o[dvb][4 * ig] * rinv * sub[dv0], o[dvb][4 * ig + 1] * rinv * sub[dv0 + 1]);
                    w.y = pk2(o[dvb][4 * ig + 2] * rinv * sub[dv0 + 2], o[dvb][4 * ig + 3] * rinv * sub[dv0 + 3]);
                    *(u32x2*)(orow + dv0) = w;
                }
        }
    }
    __syncthreads();
}

__device__ unsigned long long g_pacc[4];
template <int CTRL> DI float dppf(float v) { return __int_as_float(__builtin_amdgcn_update_dpp(0, __float_as_int(v), CTRL, 0xf, 0xf, false)); }
DI float allreduce16(float x) { x += dppf<0x128>(x); x += dppf<0x124>(x); x += dppf<0x122>(x); x += dppf<0x121>(x); return x; }
DI void ph_rwkv_scan(const Prm& p, int l, unsigned char* smem, int ubeg, int ustride) { PH_IDS
    const int lane = TID & 63, wid = TID >> 6;
    const bf16_t* z = (const bf16_t*)(p.ws + WS_Z); const bf16_t* rwa = (const bf16_t*)(p.ws + WS_RWA); const float* invn = (const float*)(p.ws + WS_INVN);
    constexpr int TC = 32, OPW = 336, NC = 264, OPS_B = TC * OPW * 4, YP_OFF = 2 * OPS_B;
    for (int u = ubeg; u < 128; u += ustride) {
        const int chain = u >> 2, qr = u & 3, d = chain >> 4, b = (chain >> 3) & 1, h = chain & 7;
        const float ckk = p.r_kk[l * 512 + h * 64 + lane], cka = p.r_ka[l * 512 + h * 64 + lane];
        bf16_t* ydir = (bf16_t*)(p.ws + WS_YSUM) + (size_t)d * NTOK * 512;
#define RW_ROW(ck, i) ((ck) < 8 ? (size_t)NLAT + b * CTXL + (d ? CTXL - 1 - ((ck) * TC + (i)) : ((ck) * TC + (i))) : (size_t)b * SEQL + (d ? SEQL - 1 - (((ck) - 8) * TC + (i)) : (((ck) - 8) * TC + (i))))
        bf16_t g_r[8], g_k[8], g_u[8], g_a[8]; float g_i[8]; unsigned g_v;
        const int sw = wid - 4, st = TID - 256;
#define RW_LOAD(ck) do { const long row0 = (long)RW_ROW(ck, 0), sgn = d ? -1 : 1;         \
            const bf16_t* zq = z + (row0 + sgn * sw) * ZW + ZC_RR + h * 64 + lane; const bf16_t* rq = rwa + (row0 + sgn * sw) * 2048 + d * 512 + h * 64 + lane; const float* iq = invn + (row0 + sgn * sw) * 8 + h; \
            const long zs = sgn * 4 * ZW, rs = sgn * 4 * 2048, is = sgn * 4 * 8; \
            _Pragma("unroll") for (int jj = 0; jj < 8; ++jj) { \
            g_r[jj] = zq[jj * zs]; g_k[jj] = zq[jj * zs + 512]; g_u[jj] = rq[jj * rs]; g_a[jj] = rq[jj * rs + 1024]; g_i[jj] = iq[jj * is]; } \
            g_v = *(const unsigned*)(z + (row0 + sgn * (st >> 3)) * ZW + ZC_RV + h * 64 + qr * 16 + (st & 7) * 2); } while (0)
#define RW_WRITE(buf) do { float* ops = (float*)(smem + (buf) * OPS_B); _Pragma("unroll") for (int jj = 0; jj < 8; ++jj) { \
            const float k = bf2f(g_k[jj]), a = bf2f(g_a[jj]), kk = k * ckk * g_i[jj]; float* o = ops + (sw + 4 * jj) * OPW; \
            o[lane] = 1.f - bf2f(g_u[jj]); o[64 + lane] = kk; o[128 + lane] = kk * a; o[192 + lane] = k * (1.f + (a - 1.f) * cka); o[256 + lane] = bf2f(g_r[jj]); } \
            { float* o = ops + (st >> 3) * OPW + 320 + (st & 7) * 2; o[0] = lo16(g_v); o[1] = hi16(g_v); } } while (0)
        __syncthreads();
        if (wid >= 4) { RW_LOAD(0); RW_WRITE(0); RW_LOAD(1); }
        __syncthreads();
        f32x2 Sa = {0.f, 0.f}, Sb = {0.f, 0.f};
        const int rl = (wid & 3) * 4 + (lane >> 4), ksub = lane & 15;
        float* ypw = (float*)(smem + YP_OFF) + (wid & 3) * (TC * 64);
        for (int ck = 0; ck < NC; ++ck) {
            if (wid >= 4) {
                if (ck + 1 < NC) RW_WRITE((ck + 1) & 1);
                if (ck + 2 < NC) RW_LOAD(ck + 2);
            } else {
                const float* ops = (const float*)(smem + (ck & 1) * OPS_B);
#define RW_GET(X, i) do { const float* o_ = ops + (i) * OPW; w_##X = *(const f32x4*)(o_ + 4 * ksub); k_##X = *(const f32x4*)(o_ + 64 + 4 * ksub); b_##X = *(const f32x4*)(o_ + 128 + 4 * ksub); \
                d_##X = *(const f32x4*)(o_ + 192 + 4 * ksub); r_##X = *(const f32x4*)(o_ + 256 + 4 * ksub); v_##X = o_[320 + rl]; } while (0)
#define RW_STEP(X, i) do { const f32x2 ka = {k_##X[0], k_##X[1]}, kb = {k_##X[2], k_##X[3]}, ra = {r_##X[0], r_##X[1]}, rb = {r_##X[2], r_##X[3]}; \
                const f32x2 ba = {b_##X[0], b_##X[1]}, bb = {b_##X[2], b_##X[3]}, da = {d_##X[0], d_##X[1]}, db = {d_##X[2], d_##X[3]}, wa = {w_##X[0], w_##X[1]}, wb = {w_##X[2], w_##X[3]}; \
                const f32x2 dt2 = Sa * ka + Sb * kb; const f32x2 qa = Sa * wa + da * v_##X, qb = Sb * wb + db * v_##X; const float sa = -allreduce16(dt2.x + dt2.y); \
                Sa = ba * sa + qa; Sb = bb * sa + qb; \
                const f32x2 y2 = Sa * ra + Sb * rb; \
                ypw[(i) * 64 + lane] = y2.x + y2.y; } while (0)
                f32x4 w_A, k_A, b_A, d_A, r_A, w_B, k_B, b_B, d_B, r_B, w_C, k_C, b_C, d_C, r_C, w_D, k_D, b_D, d_D, r_D; float v_A, v_B, v_C, v_D;
                RW_GET(A, 0); RW_GET(B, 1);
#pragma unroll 1
                for (int i = 0; i < TC; i += 4) {
                    RW_GET(C, i + 2);
                    RW_STEP(A, i);
                    RW_GET(D, i + 3);
                    RW_STEP(B, i + 1);
                    if (i + 4 < TC) RW_GET(A, i + 4);
                    RW_STEP(C, i + 2);
                    if (i + 4 < TC) RW_GET(B, i + 5);
                    RW_STEP(D, i + 3);
                }
                {
                    const int i = lane >> 1, rw = (lane & 1) * 2;
                    const f32x4* y4 = (const f32x4*)(ypw + i * 64 + rw * 16);
                    const f32x4 s4 = (y4[0] + y4[1]) + (y4[2] + y4[3]), t4 = (y4[4] + y4[5]) + (y4[6] + y4[7]);
                    *(unsigned*)(ydir + RW_ROW(ck, i) * 512 + h * 64 + qr * 16 + wid * 4 + rw) = pk2((s4[0] + s4[1]) + (s4[2] + s4[3]), (t4[0] + t4[1]) + (t4[2] + t4[3]));
                }
            }
            asm volatile("s_waitcnt lgkmcnt(0)\n\ts_barrier" ::: "memory");
        }
    }
    __syncthreads();
}
DI void ph_rwkv_post(const Prm& p, int l) { PH_IDS
    const int lane = TID & 63, wid = TID >> 6, ch0 = lane * 8;
    bf16_t* z = (bf16_t*)(p.ws + WS_Z); const bf16_t* ysum = (const bf16_t*)(p.ws + WS_YSUM); const bf16_t* rg = (const bf16_t*)(p.ws + WS_RG);
    for (int row = BID * 8 + wid; row < NTOK; row += NBLK * 8) {
        float y[8], y2[8], r[8], k[8], v[8], g[8], o[8];
        unpack8(*(const u32x4*)(ysum + (size_t)row * 512 + ch0), y); unpack8(*(const u32x4*)(ysum + (size_t)(NTOK + row) * 512 + ch0), y2);
#pragma unroll
        for (int e = 0; e < 8; ++e) y[e] += y2[e];
        bf16_t* zr = z + (size_t)row * ZW + ZC_RR + ch0;
        unpack8(*(const u32x4*)zr, r); unpack8(*(const u32x4*)(zr + 512), k); unpack8(*(const u32x4*)(zr + 1024), v); unpack8(*(const u32x4*)(rg + (size_t)row * 512 + ch0), g);
        float s = 0.f, bs = 0.f;
#pragma unroll
        for (int e = 0; e < 8; ++e) { s += y[e]; bs += r[e] * k[e] * p.r_rk[l * 512 + ch0 + e]; }
        s += __shfl_xor(s, 1); s += __shfl_xor(s, 2); s += __shfl_xor(s, 4); bs += __shfl_xor(bs, 1); bs += __shfl_xor(bs, 2); bs += __shfl_xor(bs, 4);
        const float mu = s * (1.f / 64.f); float vs = 0.f;
#pragma unroll
        for (int e = 0; e < 8; ++e) { const float dlt = y[e] - mu; vs += dlt * dlt; }
        vs += __shfl_xor(vs, 1); vs += __shfl_xor(vs, 2); vs += __shfl_xor(vs, 4);
        const float rstd = rsqrtf(vs * (1.f / 64.f) + 64e-5f);
#pragma unroll
        for (int e = 0; e < 8; ++e) o[e] = ((y[e] - mu) * rstd * p.r_lnw[l * 512 + ch0 + e] + p.r_lnb[l * 512 + ch0 + e] + bs * v[e]) * g[e];
        *(u32x4*)zr = pack8(o);
    }
}

#ifndef PROBE_A
#define PROBE_A 0
#endif
#ifndef PROBE_B
#define PROBE_B 0
#endif
#ifndef PROBE_BLK
#define PROBE_BLK 0
#endif
#ifndef PROBE_ADIV
#define PROBE_ADIV 1
#endif
#ifndef PROBE_BDIV
#define PROBE_BDIV 1
#endif
#if PROBE_A || PROBE_B
#define PT(id, ...) do { unsigned long long t0_ = wall_clock64(); __VA_ARGS__; unsigned long long dt_ = wall_clock64() - t0_; if ((id) == PROBE_A) pacc1 += dt_; if ((id) == PROBE_B) pacc2 += dt_; } while (0)
#else
#define PT(id, ...) do { __VA_ARGS__; } while (0)
#endif
DI void grid_bar(unsigned* ctr, unsigned& target, unsigned nblk) {
    __syncthreads();
    if (threadIdx.x == 0) {
        __builtin_amdgcn_fence(__ATOMIC_RELEASE, "agent");
        target += nblk;
        __hip_atomic_fetch_add(ctr, 1u, __ATOMIC_RELAXED, __HIP_MEMORY_SCOPE_AGENT);
        while (__hip_atomic_load(ctr, __ATOMIC_RELAXED, __HIP_MEMORY_SCOPE_AGENT) < target) __builtin_amdgcn_s_sleep(2);
        __builtin_amdgcn_fence(__ATOMIC_ACQUIRE, "agent");
    }
    __syncthreads();
}
__global__ void __launch_bounds__(512) mega(Prm p0) {
    Prm p = p0; p.wv = __builtin_amdgcn_readfirstlane((int)threadIdx.x >> 6);
    const int BIDK = (int)blockIdx.x;
    extern __shared__ __attribute__((aligned(16))) unsigned char smem[];
    cg::grid_group grid = cg::this_grid();
    unsigned bar_target = 0; unsigned* bar_ctr = (unsigned*)(p0.ws + WS_BAR);
#define GSYNC() grid_bar(bar_ctr, bar_target, gridDim.x)
    bf16_t* wt = (bf16_t*)(p.ws + WS_WT); bf16_t* zb = (bf16_t*)(p.ws + WS_Z); bf16_t* hb = (bf16_t*)(p.ws + WS_RWA); bf16_t* gtmp = hb + (size_t)NTOK * DM;
    bf16_t* zz = (bf16_t*)(p.ws + WS_MST); float* xc = (float*)(p.ws + WS_XC); const float* mods = (const float*)(p.ws + WS_MODS);
#if PROBE_A || PROBE_B
    unsigned long long pacc1 = 0, pacc2 = 0; const unsigned long long pstart = wall_clock64();
    if (PROBE_SCAN && blockIdx.x == 0 && threadIdx.x == 0) { g_pacc[0] = 0; g_pacc[1] = 0; }
#endif
    PT(15, ph_modpart(p, smem); ph_rope(p); conv_ffn(p, 0, 0, smem));
    PT(14, grid.sync());
    ph_modreduce(p);
    PT(14, GSYNC());
#define MERGE_B(l, b) do { \
                    { EpiGate E; E.G = gtmp; run_gemm(p.wv, smem, hb, DM, wt + WT_G + (size_t)(b) * DM * DM, (l) == 1 ? NLAT : NTOK, DM, DM, E); } \
                    { EpiBranch E; E.G = gtmp; E.ZZ = zz; E.first = ((b) == 0); const int yc = (b) == 0 ? ZC_MO : ((b) == 1 ? ZC_RR : ZC_AQ); \
                      run_gemm(p.wv, smem, zb + yc, ZW, wt + WT_P + (size_t)(b) * DM * 512, (l) == 1 ? NLAT : NTOK, DM, 512, E); } \
 } while (0)
#define MIXER_STAGE(l) do { const float* ml = mods + (size_t)(l) * 27648; \
                PT(13, ph_norm(p, l, 1, false, 11, ml + 2 * DM, 0.5f); conv_mixer(p, l, smem);); \
                PT(14, GSYNC()); \
                PT(8, { EpiWin E; E.Z = zb; run_gemm(p.wv, smem, hb, DM, wt + WT_IN, NTOK, ZWP, DM, E); }); \
                PT(14, GSYNC()); \
                PT(4, ph_rkv_conv(p, l); ph_attn_prep(p, l)); PT(5, ph_mlstm_a(p, l, smem)); \
                PT(14, GSYNC()); \
                PT(6, ph_rkv_copy(p)); PT(7, ph_mlstm_b(p)); \
                PT(14, GSYNC()); \
                PT(16, { EpiLora E; E.RWA = hb; E.RG = (bf16_t*)(p.ws + WS_RG); E.w0 = p.r_w0 + l * 1024; E.a0 = p.r_a0 + l * 1024; run_gemm(p.wv, smem, zb + ZC_RL, ZW, wt + WT_L, NTOK, 2560, 384, E); }); \
                PT(14, GSYNC()); \
                { int sc_u = BIDK, sc_s = NBLK, bh0 = 0, bh1 = 8, qf = BIDK, qs = NBLK, nq = (66 - BIDK + NBLK - 1) / NBLK, qx = -1, mc_u = BIDK, mc_s = NBLK, mc_c = 1 << 30; \
                  if (NBLK == 256) { const int xi = BIDK >> 3, bh = BIDK & 7; bh0 = bh; bh1 = bh + 1; sc_s = 128; \
                      if (xi < 16) { sc_u = bh * 16 + xi; nq = 0; mc_u = 768 + bh * 16 + xi; mc_s = 128; } \
                      else { const int a = xi - 16; sc_u = 128; qf = a; qs = 16; nq = 4; qx = a < 2 ? 64 + a : -1; mc_u = (bh * 16 + a) * 6; mc_s = 1; mc_c = 6; } } \
                  PT(1, ph_rwkv_scan(p, l, smem, sc_u, sc_s)); \
                  PT(2, for (int bh = bh0; bh < bh1; ++bh) ph_attn(p, l, smem, bh, qf, qs, nq, qx)); \
                  PT(3, ph_mlstm_c(p, l, smem, mc_u, mc_s, mc_c)); } \
                PT(14, GSYNC()); \
                PT(12, ph_rwkv_post(p, l); ph_norm(p, l, 1, false)); \
                PT(14, GSYNC()); \
                PT(9, MERGE_B(l, 0); MERGE_B(l, 1); MERGE_B(l, 2)); \
                PT(14, GSYNC()); \
                PT(17, { EpiResid E; E.xlat = p.out; E.xc = xc; E.gate = ml + 5 * DM; E.coef = 1.f; run_gemm(p.wv, smem, zz, DM, wt + WT_O, NLAT, DM, DM, E); \
              if ((l) == 0) { EpiPartial E2; E2.P = (float*)gtmp; E2.kslice_bytes = 512; run_gemm_ctx(p.wv, smem, zz, DM, wt + WT_O, DM, 4, 256, E2); } }); \
                PT(14, GSYNC()); \
 } while (0)
#define FFN_STAGE(l, f) do { const float* ml = mods + (size_t)(l) * 27648; \
            PT(18, ph_norm(p, l, f == 0 ? 0 : 2, l == 0 && f == 0, (f) == 1 ? ((l) == 0 ? 4 : 0) : ((l) == 1 ? 11 : 0), (f) == 1 ? ml + 5 * DM : mods + 8 * DM, (f) == 1 ? 1.f : 0.5f); \
            if (!(l == 0 && f == 0)) conv_ffn(p, l, f, smem)); \
            PT(14, GSYNC()); \
            PT(10, { EpiSwiglu E; E.H = zb; run_gemm(p.wv, smem, hb, DM, wt + WT_GU, ((l) == 1 && (f) == 1) ? NLAT : NTOK, 2 * DFF, DM, E); }); \
            PT(14, GSYNC()); \
            PT(11, { EpiResid E; E.xlat = p.out; E.xc = xc; E.gate = ml + (f == 0 ? 2 : 8) * DM; E.coef = 0.5f; run_gemm(p.wv, smem, zb, DFF, wt + WT_DN, NLAT, DM, DFF, E); \
              if (!((l) == 1 && (f) == 1)) { EpiPartial E2; E2.P = (float*)gtmp; E2.kslice_bytes = 512; run_gemm_ctx(p.wv, smem, zb, DFF, wt + WT_DN, DFF, 11, 256, E2); } }); \
            PT(14, GSYNC()); \
 } while (0)
    FFN_STAGE(0, 0); MIXER_STAGE(0); FFN_STAGE(0, 1); FFN_STAGE(1, 0); MIXER_STAGE(1); FFN_STAGE(1, 1);
#if PROBE_A || PROBE_B
    if (blockIdx.x == PROBE_BLK) {
        const unsigned long long pend = wall_clock64();
        if (PROBE_SCAN) { __syncthreads(); pacc1 = g_pacc[0]; pacc2 = g_pacc[1]; }
        if (PROBE_A == 99) pacc1 = pend - pstart;
        if (PROBE_B == 99) pacc2 = pend - pstart;
        unsigned long long q1 = pacc1 / (4000ull * PROBE_ADIV), q2 = pacc2 / (4000ull * PROBE_BDIV); if (q1 > 63) q1 = 63; if (q2 > 63) q2 = 63;
        const unsigned long long waitt = (q1 + 64 * q2) * 2000ull;
        while (wall_clock64() - pend < waitt) __builtin_amdgcn_s_sleep(32);
    }
#endif
}

extern "C" void kernel_launch(void* const* d_in, const int* in_sizes, int n_in, void* d_out, int out_size, void* d_ws, size_t ws_size, hipStream_t stream) {
    static int grid_blocks = 0;
    if (!grid_blocks) {
        int dev = 0, cus = 0, per_cu = 0;
        hipGetDevice(&dev);
        hipDeviceGetAttribute(&cus, hipDeviceAttributeMultiprocessorCount, dev);
        hipFuncSetAttribute((const void*)mega, hipFuncAttributeMaxDynamicSharedMemorySize, LDS_BYTES);
        hipOccupancyMaxActiveBlocksPerMultiprocessor(&per_cu, (const void*)mega, 512, LDS_BYTES);
        if (per_cu < 1) per_cu = 1;
        grid_blocks = cus * per_cu;
        if (ws_size < WS_END) fprintf(stderr, "kernel_launch: workspace too small: %zu < %zu\n", ws_size, (size_t)WS_END);
    }
    Prm p{};
    const float** pp = (const float**)&p;
    for (int i = 0; i < 31; ++i) pp[i] = (const float*)d_in[i];
    p.out = (float*)d_out; p.ws = (unsigned char*)d_ws;
    (void)hipMemsetAsync((unsigned char*)d_ws + WS_BAR, 0, 256, stream);
    void* args[] = {&p};
    hipError_t e = hipLaunchCooperativeKernel((const void*)mega, dim3(grid_blocks), dim3(512), args, LDS_BYTES, stream);
    if (e != hipSuccess) fprintf(stderr, "cooperative launch failed: %s (grid %d)\n", hipGetErrorString(e), grid_blocks);
}
```
